# Optimizing an MI355X kernel written in HIP

```python
import jax
import jax.numpy as jnp
from jax import lax
import numpy as np

D_MODEL = 2048
BATCH = 8
SEQ = 2048
DEPTH = 4

GRID_W = 64
CTX_LEN = 256
F32 = jnp.float32
EPS = 1e-6
ROPE_BASE = 10000.0
N_MOD = 6
N_EVEN = (DEPTH + 1) // 2
N_ODD = DEPTH // 2

FOURIER_GROUPS = 4
FOURIER_GROUP_DIM = D_MODEL // 16
FOURIER_DIM = FOURIER_GROUPS * FOURIER_GROUP_DIM
ATTN_HEAD_DIM = 128
ATTN_HEADS = (D_MODEL - FOURIER_DIM) // ATTN_HEAD_DIM
ATTN_KV_HEADS = 4
ATTN_GROUP = ATTN_HEADS // ATTN_KV_HEADS
ATTN_Q_BLOCK = 128
EVEN_IN_DIM = FOURIER_DIM + (ATTN_HEADS + 2 * ATTN_KV_HEADS) * ATTN_HEAD_DIM
EVEN_MIX_DIM = FOURIER_DIM + ATTN_HEADS * ATTN_HEAD_DIM

RET_HEADS = 8
RET_QK_DIM = D_MODEL // RET_HEADS
RET_V_DIM = 2 * RET_QK_DIM
RET_CHUNK = 128
ODD_IN_DIM = 2 * RET_HEADS * RET_QK_DIM + 2 * RET_HEADS * RET_V_DIM
ODD_MIX_DIM = RET_HEADS * RET_V_DIM

FFN_DIM = -(-8 * D_MODEL // 768) * 256

kernel_name = 'hybrid_fourier_gqa_retention_dit'


def rms_norm(x, eps=EPS):
    xf = x.astype(F32)
    return (xf * lax.rsqrt(jnp.mean(xf * xf, axis=-1, keepdims=True) + eps)).astype(x.dtype)


def modulate(x, shift, scale):
    return rms_norm(x) * (1.0 + scale) + shift


def grid_positions(n_tokens):
    rows = n_tokens // GRID_W
    row = jnp.repeat(jnp.arange(rows, dtype=jnp.int32), GRID_W)
    col = jnp.tile(jnp.arange(GRID_W, dtype=jnp.int32), rows)
    return row, col


def rope_1d(x, pos):
    dp = x.shape[-1]
    inv = ROPE_BASE ** (-jnp.arange(0, dp, 2, dtype=F32) / dp)
    ang = pos.astype(F32)[:, None] * inv[None, :]
    cos = jnp.cos(ang)[None, :, None, :]
    sin = jnp.sin(ang)[None, :, None, :]
    x1, x2 = jnp.split(x.astype(F32), 2, axis=-1)
    return jnp.concatenate([x1 * cos - x2 * sin, x2 * cos + x1 * sin], axis=-1).astype(x.dtype)


def axial_rope(x, row, col):
    half = x.shape[-1] // 2
    return jnp.concatenate([rope_1d(x[..., :half], row), rope_1d(x[..., half:], col)], axis=-1)


def head_rms_norm(x, gain):
    return rms_norm(x) * gain


def fourier_mix(u):
    b, t, _ = u.shape
    uf = u.astype(F32).reshape(b, t, FOURIER_GROUPS, FOURIER_GROUP_DIM)
    y = jnp.fft.fftn(uf, axes=(1, 3), norm='ortho').real
    return y.reshape(b, t, FOURIER_DIM).astype(u.dtype)


def softmax_attend(q, k, v):
    s = jnp.einsum('bqkgd,bskd->bkgqs', q.astype(F32), k.astype(F32)) * (ATTN_HEAD_DIM ** -0.5)
    p = jax.nn.softmax(s, axis=-1)
    return jnp.einsum('bkgqs,bskd->bqkgd', p, v.astype(F32)).astype(q.dtype)


def blocked_attend(q, k, v):
    b, t = q.shape[:2]
    nb = t // ATTN_Q_BLOCK
    qb = jnp.moveaxis(q.reshape(b, nb, ATTN_Q_BLOCK, *q.shape[2:]), 1, 0)
    ob = lax.map(lambda blk: softmax_attend(blk, k, v), qb)
    return jnp.moveaxis(ob, 0, 1).reshape(q.shape)


def split_even(p):
    b, t, _ = p.shape
    hq = ATTN_HEADS * ATTN_HEAD_DIM
    hkv = ATTN_KV_HEADS * ATTN_HEAD_DIM
    f, q, k, v = jnp.split(p, [FOURIER_DIM, FOURIER_DIM + hq, FOURIER_DIM + hq + hkv], axis=-1)
    return (f, q.reshape(b, t, ATTN_HEADS, ATTN_HEAD_DIM),
            k.reshape(b, t, ATTN_KV_HEADS, ATTN_HEAD_DIM),
            v.reshape(b, t, ATTN_KV_HEADS, ATTN_HEAD_DIM))


def group_heads(q):
    b, t = q.shape[:2]
    return q.reshape(b, t, ATTN_KV_HEADS, ATTN_GROUP, ATTN_HEAD_DIM)


def fourier_gqa_mixer(u_ctx, u_lat, w_in, w_out, q_gain, k_gain, need_ctx):
    b, n_lat, _ = u_lat.shape
    row, col = grid_positions(n_lat)
    f_c, q_c, k_c, v_c = split_even(u_ctx @ w_in)
    f_l, q_l, k_l, v_l = split_even(u_lat @ w_in)
    k_c = head_rms_norm(k_c, k_gain)
    k_l = axial_rope(head_rms_norm(k_l, k_gain), row, col)
    q_l = axial_rope(head_rms_norm(q_l, q_gain), row, col)
    k_all = jnp.concatenate([k_l, k_c], axis=1)
    v_all = jnp.concatenate([v_l, v_c], axis=1)
    a_l = blocked_attend(group_heads(q_l), k_all, v_all).reshape(b, n_lat, -1)
    o_l = jnp.concatenate([fourier_mix(f_l), a_l], axis=-1) @ w_out
    o_c = None
    if need_ctx:
        q_c = head_rms_norm(q_c, q_gain)
        a_c = softmax_attend(group_heads(q_c), k_c, v_c).reshape(b, u_ctx.shape[1], -1)
        o_c = jnp.concatenate([fourier_mix(f_c), a_c], axis=-1) @ w_out
    return o_c, o_l


def retention_scan(q, k, v, log_gamma, init_state, strict):
    b, h, t, _ = q.shape
    dv = v.shape[-1]
    n = t // RET_CHUNK
    idx = jnp.arange(RET_CHUNK, dtype=F32)
    diff = idx[:, None] - idx[None, :]
    lg = log_gamma.astype(F32)[:, None, None]
    mask = diff > 0 if strict else diff >= 0
    inner_decay = jnp.where(mask, jnp.exp(jnp.maximum(diff, 0.0) * lg), 0.0)
    q_decay = jnp.exp((idx + 1.0) * lg[:, :, 0])[..., None]
    k_decay = jnp.exp((RET_CHUNK - 1.0 - idx) * lg[:, :, 0])[..., None]
    chunk_decay = jnp.exp(RET_CHUNK * lg)

    def to_chunks(a):
        return jnp.moveaxis(a.reshape(b, h, n, RET_CHUNK, a.shape[-1]), 2, 0)

    def step(state, inp):
        qc, kc, vc = inp
        scores = jnp.einsum('bhid,bhjd->bhij', qc, kc) * inner_decay
        out = (jnp.einsum('bhij,bhje->bhie', scores, vc)
               + jnp.einsum('bhid,bhde->bhie', qc * q_decay, state))
        state = state * chunk_decay + jnp.einsum('bhjd,bhje->bhde', kc * k_decay, vc)
        return state, out

    final, out = lax.scan(step, init_state, (to_chunks(q), to_chunks(k), to_chunks(v)))
    return jnp.moveaxis(out, 0, 2).reshape(b, h, t, dv), final


def bidir_retention(q, k, v, lg_fwd, lg_bwd, init_fwd, init_bwd):
    o_f, s_f = retention_scan(q, k, v, lg_fwd, init_fwd, False)
    flip = lambda a: jnp.flip(a, axis=2)
    o_b, s_b = retention_scan(flip(q), flip(k), flip(v), lg_bwd, init_bwd, True)
    return o_f + flip(o_b), s_f, s_b


def split_odd(p):
    b, t, _ = p.shape
    dqk = RET_HEADS * RET_QK_DIM
    dvv = RET_HEADS * RET_V_DIM
    q, k, v, g = jnp.split(p, [dqk, 2 * dqk, 2 * dqk + dvv], axis=-1)
    return (q.reshape(b, t, RET_HEADS, RET_QK_DIM), k.reshape(b, t, RET_HEADS, RET_QK_DIM),
            v.reshape(b, t, RET_HEADS, RET_V_DIM), g)


def retention_mixer(u_ctx, u_lat, w_in, w_out, lg_fwd, lg_bwd, need_ctx):
    b, n_lat, _ = u_lat.shape
    row, col = grid_positions(n_lat)
    q_c, k_c, v_c, g_c = split_odd(u_ctx @ w_in)
    q_l, k_l, v_l, g_l = split_odd(u_lat @ w_in)
    q_l = axial_rope(q_l, row, col)
    k_l = axial_rope(k_l, row, col)
    bhtd = lambda a: jnp.swapaxes(a, 1, 2).astype(F32)
    k_scale = RET_QK_DIM ** -0.5
    zero = jnp.zeros((b, RET_HEADS, RET_QK_DIM, RET_V_DIM), F32)
    o_c, s_f, s_b = bidir_retention(bhtd(q_c), bhtd(k_c) * k_scale, bhtd(v_c), lg_fwd, lg_bwd, zero, zero)
    o_l, _, _ = bidir_retention(bhtd(q_l), bhtd(k_l) * k_scale, bhtd(v_l), lg_fwd, lg_bwd, s_f, s_b)

    def finish(o, g):
        t = o.shape[2]
        o = rms_norm(jnp.swapaxes(o, 1, 2)).reshape(b, t, ODD_MIX_DIM).astype(g.dtype)
        return (jax.nn.silu(g) * o) @ w_out

    out_l = finish(o_l, g_l)
    out_c = finish(o_c, g_c) if need_ctx else None
    return out_c, out_l


def swiglu(u, w_in, w_out):
    gate, up = jnp.split(u @ w_in, 2, axis=-1)
    return (jax.nn.silu(gate) * up) @ w_out


def setup_inputs(seed: int = 0) -> dict:
    key = jax.random.key(seed)
    ks = jax.random.split(key, 17)

    def dense(k, shape, fan_in):
        return jax.random.normal(k, shape, F32) * (fan_in ** -0.5)

    ret_base = jnp.log1p(-jnp.exp2(-5.0 - jnp.arange(RET_HEADS, dtype=F32)))
    return {
        'x': jax.random.normal(ks[0], (BATCH, SEQ, D_MODEL), F32),
        'c': jax.random.normal(ks[1], (BATCH, D_MODEL), F32),
        'ctx': jax.random.normal(ks[2], (BATCH, CTX_LEN, D_MODEL), F32),
        'c_ctx': jax.random.normal(ks[3], (D_MODEL,), F32),
        'w_mod': dense(ks[4], (DEPTH, D_MODEL, N_MOD * D_MODEL), D_MODEL),
        'b_mod': 0.01 * jax.random.normal(ks[5], (DEPTH, N_MOD * D_MODEL), F32),
        'w_in_even': dense(ks[6], (N_EVEN, D_MODEL, EVEN_IN_DIM), D_MODEL),
        'w_out_even': dense(ks[7], (N_EVEN, EVEN_MIX_DIM, D_MODEL), EVEN_MIX_DIM),
        'q_gain_even': 1.0 + 0.02 * jax.random.normal(ks[8], (N_EVEN, ATTN_HEAD_DIM), F32),
        'k_gain_even': 1.0 + 0.02 * jax.random.normal(ks[9], (N_EVEN, ATTN_HEAD_DIM), F32),
        'w_in_odd': dense(ks[10], (N_ODD, D_MODEL, ODD_IN_DIM), D_MODEL),
        'w_out_odd': dense(ks[11], (N_ODD, ODD_MIX_DIM, D_MODEL), ODD_MIX_DIM),
        'log_decay_fwd': ret_base[None] * (1.0 + 0.05 * jax.random.normal(ks[12], (N_ODD, RET_HEADS), F32)),
        'log_decay_bwd': ret_base[None] * (1.0 + 0.05 * jax.random.normal(ks[13], (N_ODD, RET_HEADS), F32)),
        'w_ffn_in': dense(ks[14], (DEPTH, D_MODEL, 2 * FFN_DIM), D_MODEL),
        'w_ffn_out': dense(ks[15], (DEPTH, FFN_DIM, D_MODEL), FFN_DIM),
    }


def reference(x, c, ctx, c_ctx, w_mod, b_mod, w_in_even, w_out_even, q_gain_even, k_gain_even,
              w_in_odd, w_out_odd, log_decay_fwd, log_decay_bwd, w_ffn_in, w_ffn_out):
    h_lat, h_ctx = x, ctx
    cond_lat = jax.nn.silu(c)
    cond_ctx = jax.nn.silu(c_ctx)[None]
    for i in range(DEPTH):
        need_ctx = i < DEPTH - 1
        mod_l = (cond_lat @ w_mod[i] + b_mod[i])[:, None, :]
        mod_c = (cond_ctx @ w_mod[i] + b_mod[i])[:, None, :]
        sh1, sc1, g1, sh2, sc2, g2 = jnp.split(mod_l, N_MOD, axis=-1)
        csh1, csc1, cg1, csh2, csc2, cg2 = jnp.split(mod_c, N_MOD, axis=-1)
        u_l = modulate(h_lat, sh1, sc1)
        u_c = modulate(h_ctx, csh1, csc1)
        j = i // 2
        if i % 2 == 0:
            o_c, o_l = fourier_gqa_mixer(u_c, u_l, w_in_even[j], w_out_even[j],
                                         q_gain_even[j], k_gain_even[j], need_ctx)
        else:
            o_c, o_l = retention_mixer(u_c, u_l, w_in_odd[j], w_out_odd[j],
                                       log_decay_fwd[j], log_decay_bwd[j], need_ctx)
        h_lat = h_lat + g1 * o_l
        h_lat = h_lat + g2 * swiglu(modulate(h_lat, sh2, sc2), w_ffn_in[i], w_ffn_out[i])
        if need_ctx:
            h_ctx = h_ctx + cg1 * o_c
            h_ctx = h_ctx + cg2 * swiglu(modulate(h_ctx, csh2, csc2), w_ffn_in[i], w_ffn_out[i])
    return h_lat
```

```cpp
#include <hip/hip_runtime.h>
#include <cstdio>
#include <cstdint>
#include <cmath>
#ifndef WGM_SET
#define WGM_SET 8
#endif
namespace pg8 {
#define PG8_LAS __attribute__((address_space(3)))
typedef unsigned short bf16_t;
typedef short bf16x8 __attribute__((ext_vector_type(8)));
typedef float f32x4 __attribute__((ext_vector_type(4)));
typedef unsigned u32x4 __attribute__((ext_vector_type(4)));
constexpr int BM = 256, BK = 64, HALF = 128, HTB = HALF * BK * 2  , STAGE_BYTES = 8 * HTB, NXCD = 8, WGM = WGM_SET;

__host__ __device__ __forceinline__ int lds_byte(int r, int c) { const int st = (r >> 4) * 2 + (c >> 5), rr = r & 15, cc = c & 31, ob = rr * 64 + cc * 2; return st * 1024 + (ob ^ (((ob >> 9) & 1) << 5)); }
__host__ __device__ __forceinline__ void stage_rc(int b, int& R, int& C) { const int st = b / 1024, sb = b % 1024, swz = sb ^ (((sb >> 9) & 1) << 5); R = (st >> 1) * 16 + swz / 64; C = (st & 1) * 32 + (swz % 64) / 2; }
__host__ __device__ __forceinline__ int perm32(int rho) { const int n = rho >> 4, i = rho & 15; return 8 * (i >> 2) + 4 * n + (i & 3); }

struct Unit { int pm, pn, kt0, nkt, split; };
struct Gemm { const bf16_t* A; const bf16_t* Bt; int M, N, K; };

#ifndef WGM_WIDE
#define WGM_WIDE WGM
#endif
#ifndef WGM_NARROW
#define WGM_NARROW 2
#endif
struct StaticOrder {
    int nM, nN, nwg, G, c;
    __host__ __device__ void init(int M, int N, int G_, int c_) { nM = M / BM; nN = N / BM; nwg = nM * nN; G = G_; c = c_; }
    __host__ __device__ void map(int wgid, Unit& u) const {
        { const int q = nwg / NXCD, r = nwg % NXCD, xcd = wgid % NXCD, off = wgid / NXCD; wgid = (xcd < r ? xcd * (q + 1) : r * (q + 1) + (xcd - r) * q) + off; }
        const int wgm = nN >= 12 ? WGM_WIDE : WGM_NARROW;
        const int nig = wgm * nN, gid = wgid / nig, fm = gid * wgm, gsz = (nM - fm) < wgm ? (nM - fm) : wgm;
        u.pm = fm + ((wgid % nig) % gsz); u.pn = (wgid % nig) / gsz;
    }
    __device__ __forceinline__ void a_ready(const Unit&) const {}
    __device__ __forceinline__ void done(const Unit&) const {}
};

typedef __bf16 bf16x2_cv __attribute__((ext_vector_type(2)));
typedef float f32x2_cv __attribute__((ext_vector_type(2)));
__device__ __forceinline__ unsigned cvt_pk_bf16(float lo, float hi) { const f32x2_cv v = {lo, hi}; const bf16x2_cv b = __builtin_convertvector(v, bf16x2_cv); return __builtin_bit_cast(unsigned, b); }
typedef float f32x2 __attribute__((ext_vector_type(2)));
#ifndef WT_STORES
#define WT_STORES 0
#endif
__device__ __forceinline__ void st16_wt(void* p, u32x4 v) {
#if WT_STORES
    asm volatile("global_store_dwordx4 %0, %1, off sc1" :: "v"(p), "v"(v) : "memory");
#else
    *(u32x4*)p = v;
#endif
}
__device__ __forceinline__ void st16_wt(void* p, f32x4 v) { st16_wt(p, __builtin_bit_cast(u32x4, v)); }
#ifndef WT_HID
#define WT_HID 0
#endif
__device__ __forceinline__ void st16_hid(void* p, u32x4 v) {
#if WT_HID
    asm volatile("global_store_dwordx4 %0, %1, off sc1" :: "v"(p), "v"(v) : "memory");
#else
    *(u32x4*)p = v;
#endif
}
#ifndef GEMM_G_LIMIT
#define GEMM_G_LIMIT 0
#endif
struct TokOrder : StaticOrder {
    int skip, nktfull, nfull, rem, S, nextra;
    __device__ __forceinline__ void init2(int M, int N, int K, int G_, int c_, int skip_, int allow_split, int ctxkv = 0, int glimit = 0) {
        init(M, N, G_, c_); if (glimit > 0 && glimit < G_) G = glimit;     if (GEMM_G_LIMIT > 0 && GEMM_G_LIMIT < G_) { G = GEMM_G_LIMIT; }     skip = skip_; nktfull = K / BK; nfull = (nwg / G) * G; rem = nwg - nfull; S = 1; nextra = ctxkv ? 8 * 24 : 0;
        if (allow_split && rem > 0) { const int s = G / rem; S = s >= 4 ? 4 : 1;     if ((nktfull % (2 * S)) != 0 || nktfull / S < 4) S = 1; }
    }
    __device__ __forceinline__ bool next(int i, Unit& u) const {
        if (c >= G) return false;
        const long L = (long)i * G + c; int idx;
        if (L < nfull || S == 1) {
            if (L >= nwg) { const int r = (int)(L - nwg); if (r >= nextra) return false; u.kt0 = 0; u.nkt = nktfull; u.split = 0; u.pm = 9 * (r / 24) + 8; u.pn = 8 + r % 24; return true; }
            idx = (int)L; u.kt0 = 0; u.nkt = nktfull; u.split = 0; }
        else { const int sub = (int)(L - nfull); if (sub >= rem * S) return false; idx = nfull + sub / S; u.nkt = nktfull / S; u.kt0 = (sub % S) * u.nkt; u.split = 1 + (sub / S) * 4 + (sub % S); }
        map(idx, u); if (skip) u.pm += (u.pm >> 3); return true;
    }
};
struct EpiStore {
    static constexpr bool PERM = true, AFTER_DRAIN = false;
    bf16_t* O; int ldc; int mode; const float* rope;
    __device__ __forceinline__ void operator()(const f32x4 (&acc)[2][2][4][2], const Unit& u, int wr, int wc, int fr, int fq) const {
        size_t base;
        if (mode == 0 || mode == 3) base = (size_t)u.pm * BM * (size_t)ldc + (size_t)u.pn * BM;
        else if (mode == 1) { const int part = u.pm >> 3, t0 = (u.pm & 7) * 256, b = u.pn >> 1, c0 = (u.pn & 1) * 256; base = ((size_t)(b * 2304 + t0)) * 1024 + part * 512 + c0; }
        else { const int part = u.pm, b = u.pn >> 1, c0 = (u.pn & 1) * 256; base = ((size_t)(b * 2304 + 2048)) * 1024 + part * 512 + c0; }
        const int tt = u.pm % 9;
        if (mode == 3 && u.pn < 16 && tt != 8) {
            const int half = wc >> 1, f0 = 32 * (wc & 1) + 8 * fq;
            bf16_t* p0 = O + base + (size_t)(wr * 64 + fr) * ldc + half * 128 + f0;
#pragma unroll
            for (int ai = 0; ai < 2; ++ai)
#pragma unroll
                for (int m = 0; m < 4; ++m) { const int t = tt * 256 + ai * HALF + wr * 64 + m * 16 + fr, pos = half ? (t & 63) : (t >> 6);
                    const f32x4* tb = (const f32x4*)(rope + (size_t)(pos * 64 + f0) * 2);
                    const f32x4 t0 = tb[0], t1 = tb[1], t2 = tb[2], t3 = tb[3];
                    const f32x4 a0 = acc[ai][0][m][0], a1 = acc[ai][0][m][1], b0 = acc[ai][1][m][0], b1 = acc[ai][1][m][1];
                    const f32x4 cs0 = {t0[0], t0[2], t1[0], t1[2]}, sn0 = {t0[1], t0[3], t1[1], t1[3]}, cs1 = {t2[0], t2[2], t3[0], t3[2]}, sn1 = {t2[1], t2[3], t3[1], t3[3]};
                    const f32x4 x0 = a0 * cs0 - b0 * sn0, x1 = a1 * cs1 - b1 * sn1, y0 = b0 * cs0 + a0 * sn0, y1 = b1 * cs1 + a1 * sn1;
                    bf16_t* rowp = p0 + (size_t)(ai * HALF + m * 16) * ldc;
                    u32x4 w; w.x = cvt_pk_bf16(x0[0], x0[1]); w.y = cvt_pk_bf16(x0[2], x0[3]); w.z = cvt_pk_bf16(x1[0], x1[1]); w.w = cvt_pk_bf16(x1[2], x1[3]);
                    st16_wt(rowp, w);
                    w.x = cvt_pk_bf16(y0[0], y0[1]); w.y = cvt_pk_bf16(y0[2], y0[3]); w.z = cvt_pk_bf16(y1[0], y1[1]); w.w = cvt_pk_bf16(y1[2], y1[3]);
                    st16_wt(rowp + 64, w); }
            return;
        }
        if (mode == 3 && u.pn < 16) {
            const int half = wc >> 1, f0 = 32 * (wc & 1) + 8 * fq;
            bf16_t* p0 = O + base + (size_t)(wr * 64 + fr) * ldc + half * 128 + f0;
#pragma unroll
            for (int ai = 0; ai < 2; ++ai)
#pragma unroll
                for (int m = 0; m < 4; ++m) { bf16_t* rowp = p0 + (size_t)(ai * HALF + m * 16) * ldc;
#pragma unroll
                    for (int bj = 0; bj < 2; ++bj) { const f32x4 v0 = acc[ai][bj][m][0], v1 = acc[ai][bj][m][1];
                        u32x4 w; w.x = cvt_pk_bf16(v0[0], v0[1]); w.y = cvt_pk_bf16(v0[2], v0[3]); w.z = cvt_pk_bf16(v1[0], v1[1]); w.w = cvt_pk_bf16(v1[2], v1[3]);
                        st16_wt(rowp + bj * 64, w); } }
            return;
        }
        bf16_t* p0 = O + base + (size_t)(wr * 64 + fr) * ldc + wc * 32 + 8 * fq;
#pragma unroll
        for (int ai = 0; ai < 2; ++ai)
#pragma unroll
            for (int m = 0; m < 4; ++m) { bf16_t* rowp = p0 + (size_t)(ai * HALF + m * 16) * ldc;
#pragma unroll
                for (int bj = 0; bj < 2; ++bj) { const f32x4 v0 = acc[ai][bj][m][0], v1 = acc[ai][bj][m][1];
                    u32x4 w; w.x = cvt_pk_bf16(v0[0], v0[1]); w.y = cvt_pk_bf16(v0[2], v0[3]); w.z = cvt_pk_bf16(v1[0], v1[1]); w.w = cvt_pk_bf16(v1[2], v1[3]);
                    st16_wt(rowp + bj * HALF, w); } }
    }
};
__device__ __forceinline__ float silu_f(float g) { return g * __builtin_amdgcn_rcpf(1.0f + __builtin_amdgcn_exp2f(-1.4426950408889634f * g)); }
struct EpiSwiglu {
    static constexpr bool PERM = true, AFTER_DRAIN = false;
    bf16_t* H; int ldh;
    __device__ __forceinline__ void operator()(const f32x4 (&acc)[2][2][4][2], const Unit& u, int wr, int wc, int fr, int fq) const {
        bf16_t* p0 = H + (size_t)(u.pm * BM + wr * 64 + fr) * ldh + u.pn * HALF + wc * 32 + 8 * fq;
#pragma unroll
        for (int ai = 0; ai < 2; ++ai)
#pragma unroll
            for (int m = 0; m < 4; ++m) { bf16_t* rowp = p0 + (size_t)(ai * HALF + m * 16) * ldh;
                const f32x4 g0 = acc[ai][0][m][0], g1 = acc[ai][0][m][1], u0 = acc[ai][1][m][0], u1 = acc[ai][1][m][1];
                u32x4 w; w.x = cvt_pk_bf16(silu_f(g0[0]) * u0[0], silu_f(g0[1]) * u0[1]); w.y = cvt_pk_bf16(silu_f(g0[2]) * u0[2], silu_f(g0[3]) * u0[3]);
                w.z = cvt_pk_bf16(silu_f(g1[0]) * u1[0], silu_f(g1[1]) * u1[1]); w.w = cvt_pk_bf16(silu_f(g1[2]) * u1[2], silu_f(g1[3]) * u1[3]);
                st16_hid(rowp, w); }
    }
};
#ifndef EPI_RB
#define EPI_RB 2
#endif
struct EpiResid {
    static constexpr bool PERM = true, AFTER_DRAIN = false;
    float* h; const float* gates; int goff; float* out; float* delta; int dry; const float* x0; const float* c0;
    __device__ __forceinline__ void operator()(const f32x4 (&acc)[2][2][4][2], const Unit& u, int wr, int wc, int fr, int fq) const {
        const int b = u.pm / 9, tt = u.pm - 9 * b, set = (tt == 8) ? 8 : b;
        const int col0 = u.pn * BM + wc * 32 + 8 * fq;
        const float* gp = gates + (size_t)set * 12288 + goff + col0;
        f32x4 gv[2][2];
#pragma unroll
        for (int bj = 0; bj < 2; ++bj)
#pragma unroll
            for (int n = 0; n < 2; ++n) { gv[bj][n] = *(const f32x4*)(gp + bj * HALF + n * 4); if (dry) gv[bj][n] = gv[bj][n] * 0.0f; }
        const int rl = wr * 64 + fr;
        const float* hp = (x0 && !dry) ? (tt == 8 ? c0 + (size_t)(b * 256 + rl) * 2048 + col0 : x0 + (size_t)(b * 2048 + tt * 256 + rl) * 2048 + col0) : h + (size_t)(u.pm * BM + rl) * 2048 + col0;
        float* op = (out && !dry) ? out + (size_t)(b * 2048 + tt * 256 + rl) * 2048 + col0 : h + (size_t)(u.pm * BM + rl) * 2048 + col0;
        if (u.split && dry) return;
        if (u.split) {
            float* sp = delta + (size_t)(u.split - 1) * 65536 + (size_t)rl * 256 + wc * 32 + 8 * fq;
#pragma unroll
            for (int ai = 0; ai < 2; ++ai)
#pragma unroll
                for (int m = 0; m < 4; ++m)
#pragma unroll
                    for (int bj = 0; bj < 2; ++bj)
#pragma unroll
                        for (int n = 0; n < 2; ++n) *(f32x4*)(sp + (ai * HALF + m * 16) * 256 + bj * HALF + n * 4) = gv[bj][n] * acc[ai][bj][m][n];
            return;
        }
#pragma unroll
        for (int ai = 0; ai < 2; ++ai)
#pragma unroll
            for (int mp = 0; mp < 4; mp += EPI_RB) {
                f32x4 hv[EPI_RB][2][2];
#pragma unroll
                for (int mm = 0; mm < EPI_RB; ++mm)
#pragma unroll
                    for (int bj = 0; bj < 2; ++bj)
#pragma unroll
                        for (int n = 0; n < 2; ++n) hv[mm][bj][n] = *(const f32x4*)(hp + (size_t)(ai * HALF + (mp + mm) * 16) * 2048 + bj * HALF + n * 4);
                asm volatile("" ::: "memory");
#pragma unroll
                for (int mm = 0; mm < EPI_RB; ++mm) { const int m = mp + mm; const size_t ro = (size_t)(ai * HALF + m * 16) * 2048;
#pragma unroll
                    for (int bj = 0; bj < 2; ++bj)
#pragma unroll
                        for (int n = 0; n < 2; ++n) st16_wt(op + ro + bj * HALF + n * 4, hv[mm][bj][n] + gv[bj][n] * acc[ai][bj][m][n]); }
                asm volatile("" ::: "memory"); }
    }
};

template <class Epi, class Sched, bool ALIGN_EPI = false, bool SP2 = false>
__device__ __forceinline__ void gemm_phase(PG8_LAS unsigned char* lds, const Gemm g, const Sched& S, const Epi& E) {
    int tid = threadIdx.x; asm volatile("" : "+v"(tid));
    const int wid = __builtin_amdgcn_readfirstlane(tid >> 6), lane = tid & 63, wr = wid >> 2, wc = wid & 3, fr = lane & 15, fq = lane >> 4;
    const int K = g.K;
    unsigned voffA[2], voffB[2];
#pragma unroll
    for (int i = 0; i < 2; ++i) { int R, C; stage_rc(tid * 16 + i * 8192, R, C); const int Rb = Epi::PERM ? ((R & ~31) + perm32(R & 31)) : R;
        voffA[i] = (unsigned)(R * K + C) * 2u; voffB[i] = (unsigned)(Rb * K + C) * 2u; }
    const size_t kstep = (size_t)(BK * 2);
    const size_t hstep = (size_t)HALF * K * 2;
    const size_t tstep = 2 * hstep;
    const unsigned ldsw = (unsigned)wid * 1024u;
    const int aoff = lds_byte(wr * 64 + fr, fq * 8), boff = lds_byte(wc * 32 + fr, fq * 8);
#define PG8_SA(b, h) (((b) * 2 + (h)) * HTB)
#define PG8_SB(b, h) ((4 + (b) * 2 + (h)) * HTB)
#define PG8_STAGE(bufoff, gbase, voff) do { _Pragma("unroll") for (int _i = 0; _i < 2; ++_i) \
        __builtin_amdgcn_global_load_lds((const unsigned*)((const char*)(gbase) + (voff)[_i]), (PG8_LAS unsigned*)(lds + (bufoff) + ldsw + _i * 8192), 16, 0, 0); } while (0)
#define PG8_LDA(dst, b, h) do { _Pragma("unroll") for (int m = 0; m < 4; ++m) _Pragma("unroll") for (int k = 0; k < 2; ++k) dst[m][k] = *(const PG8_LAS bf16x8*)(lds + PG8_SA(b, h) + aoff + m * 2048 + k * 1024); } while (0)
#define PG8_LDB(dst, b, h) do { _Pragma("unroll") for (int n = 0; n < 2; ++n) _Pragma("unroll") for (int k = 0; k < 2; ++k) dst[n][k] = *(const PG8_LAS bf16x8*)(lds + PG8_SB(b, h) + boff + n * 2048 + k * 1024); } while (0)
#define PG8_MMA(ai, bj, At, Bt) do { __builtin_amdgcn_s_setprio(1); _Pragma("unroll") for (int m = 0; m < 4; ++m) _Pragma("unroll") for (int n = 0; n < 2; ++n) _Pragma("unroll") for (int k = 0; k < 2; ++k) \
        acc[ai][bj][m][n] = __builtin_amdgcn_mfma_f32_16x16x32_bf16(Bt[n][k], At[m][k], acc[ai][bj][m][n], 0, 0, 0); __builtin_amdgcn_s_setprio(0); } while (0)
#define PG8_WAIT_V(n) asm volatile("s_waitcnt vmcnt(" #n ")" ::: "memory")
#define PG8_WAIT_L(n) asm volatile("s_waitcnt lgkmcnt(" #n ")" ::: "memory")
#define PG8_BAR __builtin_amdgcn_s_barrier()
#define PG8_SCHED __builtin_amdgcn_sched_barrier(0)
    Unit cur, nxt; int ui = 0;
    if (!S.next(0, cur)) return;
    f32x4 acc[2][2][4][2];
#pragma unroll
    for (int a = 0; a < 2; ++a)
#pragma unroll
        for (int b = 0; b < 2; ++b)
#pragma unroll
            for (int m = 0; m < 4; ++m)
#pragma unroll
                for (int n = 0; n < 2; ++n) acc[a][b][m][n] = (f32x4){0.f, 0.f, 0.f, 0.f};
    bf16x8 At[4][2], B0[2][2], B1[2][2];
    const char* cA = (const char*)g.A + (size_t)cur.pm * tstep + (size_t)cur.kt0 * kstep; const char* cB = (const char*)g.Bt + (size_t)cur.pn * tstep + (size_t)cur.kt0 * kstep;
    S.a_ready(cur);
    if constexpr (SP2) {
        PG8_STAGE(PG8_SB(0, 0), cB, voffB); PG8_STAGE(PG8_SB(0, 1), cB + hstep, voffB); PG8_STAGE(PG8_SA(0, 0), cA, voffA); PG8_STAGE(PG8_SA(0, 1), cA + hstep, voffA);
        if (wr == 1) PG8_BAR;
        PG8_WAIT_V(2); PG8_BAR;
        PG8_STAGE(PG8_SB(1, 0), cB + kstep, voffB); PG8_STAGE(PG8_SA(1, 0), cA + kstep, voffA); PG8_STAGE(PG8_SB(1, 1), cB + hstep + kstep, voffB);
        PG8_WAIT_V(6); PG8_BAR;
    } else {
        PG8_STAGE(PG8_SB(0, 0), cB, voffB); PG8_STAGE(PG8_SA(0, 0), cA, voffA); PG8_STAGE(PG8_SB(0, 1), cB + hstep, voffB); PG8_STAGE(PG8_SA(0, 1), cA + hstep, voffA);
        if (wr == 1) PG8_BAR;
        PG8_WAIT_V(4); PG8_BAR;
        PG8_STAGE(PG8_SB(1, 0), cB + kstep, voffB); PG8_STAGE(PG8_SA(1, 0), cA + kstep, voffA); PG8_STAGE(PG8_SB(1, 1), cB + hstep + kstep, voffB);
        PG8_WAIT_V(6); PG8_BAR;
    }
    for (;;) {
        const bool has_next = S.next(ui + 1, nxt);
        const char* nA = has_next ? (const char*)g.A + (size_t)nxt.pm * tstep + (size_t)nxt.kt0 * kstep : cA; const char* nB = has_next ? (const char*)g.Bt + (size_t)nxt.pn * tstep + (size_t)nxt.kt0 * kstep : cB;
        const int nt = cur.nkt;
        for (int t = 0; t < nt; t += 2) {
            const bool last = (t == nt - 2);
            const char* a1 = cA + (size_t)(t + 1) * kstep;
            const char* a2 = last ? nA : cA + (size_t)(t + 2) * kstep; const char* b2 = last ? nB : cB + (size_t)(t + 2) * kstep;
            const char* a3 = a2 + kstep; const char* b3 = b2 + kstep;
            if (last && has_next) S.a_ready(nxt);
            if constexpr (SP2) {
            PG8_LDB(B0, 0, 0); PG8_LDB(B1, 0, 1); PG8_SCHED; PG8_LDA(At, 0, 0); PG8_STAGE(PG8_SA(1, 1), a1 + hstep, voffA);
            PG8_WAIT_V(8); PG8_WAIT_L(0); PG8_BAR; PG8_MMA(0, 0, At, B0); PG8_MMA(0, 1, At, B1); PG8_BAR; PG8_SCHED;
            PG8_LDA(At, 0, 1); PG8_STAGE(PG8_SB(0, 0), b2, voffB); PG8_STAGE(PG8_SB(0, 1), b2 + hstep, voffB); PG8_STAGE(PG8_SA(0, 0), a2, voffA);
            PG8_WAIT_V(8); PG8_WAIT_L(0); PG8_BAR; PG8_MMA(1, 0, At, B0); PG8_MMA(1, 1, At, B1); PG8_BAR; PG8_SCHED;
            PG8_LDB(B0, 1, 0); PG8_LDB(B1, 1, 1); PG8_SCHED; PG8_LDA(At, 1, 0); PG8_STAGE(PG8_SA(0, 1), a2 + hstep, voffA);
            PG8_WAIT_V(8); PG8_WAIT_L(0); PG8_BAR; PG8_MMA(0, 0, At, B0); PG8_MMA(0, 1, At, B1); PG8_BAR; PG8_SCHED;
            PG8_LDA(At, 1, 1); PG8_STAGE(PG8_SB(1, 0), b3, voffB); PG8_STAGE(PG8_SB(1, 1), b3 + hstep, voffB); PG8_STAGE(PG8_SA(1, 0), a3, voffA);
            PG8_WAIT_V(8); PG8_WAIT_L(0); PG8_BAR; PG8_MMA(1, 0, At, B0); PG8_MMA(1, 1, At, B1); PG8_BAR; PG8_SCHED;
            } else {
            PG8_LDB(B0, 0, 0); PG8_SCHED; PG8_LDA(At, 0, 0); PG8_STAGE(PG8_SA(1, 1), a1 + hstep, voffA);
            PG8_WAIT_L(8); PG8_BAR; PG8_WAIT_L(0); PG8_MMA(0, 0, At, B0); PG8_BAR; PG8_SCHED;
            PG8_LDB(B1, 0, 1); PG8_STAGE(PG8_SB(0, 0), b2, voffB);
            PG8_BAR; PG8_WAIT_L(0); PG8_MMA(0, 1, At, B1); PG8_BAR;
            PG8_LDA(At, 0, 1); PG8_STAGE(PG8_SA(0, 0), a2, voffA);
            PG8_BAR; PG8_WAIT_L(0); PG8_MMA(1, 0, At, B0); PG8_BAR; PG8_SCHED;
            PG8_STAGE(PG8_SB(0, 1), b2 + hstep, voffB);
            PG8_WAIT_V(6); PG8_BAR; PG8_MMA(1, 1, At, B1); PG8_BAR;
            PG8_LDB(B0, 1, 0); PG8_SCHED; PG8_LDA(At, 1, 0); PG8_STAGE(PG8_SA(0, 1), a2 + hstep, voffA);
            PG8_WAIT_L(8); PG8_BAR; PG8_WAIT_L(0); PG8_MMA(0, 0, At, B0); PG8_BAR; PG8_SCHED;
            PG8_LDB(B1, 1, 1); PG8_STAGE(PG8_SB(1, 0), b3, voffB);
            PG8_BAR; PG8_WAIT_L(0); PG8_MMA(0, 1, At, B1); PG8_BAR;
            PG8_LDA(At, 1, 1); PG8_STAGE(PG8_SA(1, 0), a3, voffA);
            PG8_BAR; PG8_WAIT_L(0); PG8_MMA(1, 0, At, B0); PG8_BAR; PG8_SCHED;
            PG8_STAGE(PG8_SB(1, 1), b3 + hstep, voffB);
            PG8_WAIT_V(6); PG8_BAR; PG8_MMA(1, 1, At, B1); PG8_BAR;
            }
        }
        if constexpr (ALIGN_EPI) { if (wr == 0) PG8_BAR; }
        if constexpr (!Epi::AFTER_DRAIN) { E(acc, cur, wr, wc, fr, fq); S.done(cur); }
        if (!has_next) break;
#pragma unroll
        for (int a = 0; a < 2; ++a)
#pragma unroll
            for (int b = 0; b < 2; ++b)
#pragma unroll
                for (int m = 0; m < 4; ++m)
#pragma unroll
                    for (int n = 0; n < 2; ++n) acc[a][b][m][n] = (f32x4){0.f, 0.f, 0.f, 0.f};
        cur = nxt; cA = nA; cB = nB; ++ui;
        if constexpr (ALIGN_EPI) { if (wr == 1) PG8_BAR; }
    }
    PG8_WAIT_V(0);
    if constexpr (!ALIGN_EPI) { if (wr == 0) PG8_BAR; }
    PG8_BAR;
    if constexpr (Epi::AFTER_DRAIN) { E.fused(acc, cur, wr, wc, fr, fq, lds, wid, lane); S.done(cur); }
#undef PG8_SA
#undef PG8_SB
#undef PG8_STAGE
#undef PG8_LDA
#undef PG8_LDB
#undef PG8_MMA
#undef PG8_WAIT_V
#undef PG8_WAIT_L
#undef PG8_BAR
#undef PG8_SCHED
}
}
namespace att {
typedef unsigned short bf16;
constexpr int   D = 128, NW = 8, QBLK = 32, KVBLK = 64;
constexpr float SCALE = 0.088388347648318440f;
constexpr float THR = 8.f;
constexpr int LDQ = 3072, LDK = 3072, LDO = 2048;
constexpr size_t SHM_V = KVBLK * D * 2, SHM_K = KVBLK * D * 2, SHM_ATTN = 2 * SHM_V + 2 * SHM_K + NW * 64 * 4;
using bf16x8 = __attribute__((ext_vector_type(8))) short;
using s16x4  = __attribute__((ext_vector_type(4))) short;
using f32x16 = __attribute__((ext_vector_type(16))) float;
using u32x4  = __attribute__((ext_vector_type(4))) unsigned;
#define KSWZ(row, colB) ((row) * 256 + ((colB) ^ (((row) & 7) << 4)))
#define SBAR() __builtin_amdgcn_sched_barrier(0)
__device__ __forceinline__ int crow(int r, int hi) { return (r & 3) + 8 * (r >> 2) + 4 * hi; }
__device__ __forceinline__ unsigned cvtpk(float lo, float hi) {
  typedef __bf16 b2 __attribute__((ext_vector_type(2))); typedef float f2 __attribute__((ext_vector_type(2)));
  const f2 v = {lo, hi}; const b2 b = __builtin_convertvector(v, b2); return __builtin_bit_cast(unsigned, b);
}
__device__ __forceinline__ bf16x8 ld8(const bf16* p) { return *reinterpret_cast<const bf16x8*>(p); }
__device__ __forceinline__ void partialSM(f32x16& p0, f32x16& p1, float& m_reg, float& mn, float& alpha) {
  constexpr float C = SCALE * 1.4426950408889634f;
  float pmax = p0[0]; for (int r = 1; r < 16; ++r) pmax = fmaxf(pmax, p0[r]); for (int r = 0; r < 16; ++r) pmax = fmaxf(pmax, p1[r]);
  { auto rr = __builtin_amdgcn_permlane32_swap(__float_as_uint(pmax), __float_as_uint(pmax), false, false);
    pmax = fmaxf(__uint_as_float(rr[0]), __uint_as_float(rr[1])); }
  if (__builtin_expect(__all(pmax - m_reg <= THR / SCALE), 1)) { mn = m_reg; alpha = 1.f; }
  else { mn = fmaxf(m_reg, pmax); alpha = __builtin_amdgcn_exp2f((m_reg - mn) * C); m_reg = mn; }
  float mnC = -mn * C;
  for (int r = 0; r < 16; ++r) p0[r] = fmaf(p0[r], C, mnC); for (int r = 0; r < 16; ++r) p1[r] = fmaf(p1[r], C, mnC);
  for (int r = 0; r < 16; ++r) p0[r] = __builtin_amdgcn_exp2f(p0[r]);
}
__device__ __forceinline__ void finishSM(f32x16& p0, f32x16& p1, float alpha, float& l_reg, bf16x8& pa0, bf16x8& pa1, bf16x8& pa2, bf16x8& pa3) {
  for (int r = 0; r < 16; ++r) p1[r] = __builtin_amdgcn_exp2f(p1[r]);
  float ps = 0; for (int r = 0; r < 16; ++r) ps += p0[r]; for (int r = 0; r < 16; ++r) ps += p1[r];
  { auto rr = __builtin_amdgcn_permlane32_swap(__float_as_uint(ps), __float_as_uint(ps), false, false);
    ps = __uint_as_float(rr[0]) + __uint_as_float(rr[1]); }
  l_reg = l_reg * alpha + ps;
#define PK4(P, BASE, OUT) do { unsigned a0 = cvtpk(P[BASE + 0], P[BASE + 1]), a1 = cvtpk(P[BASE + 2], P[BASE + 3]);   \
    unsigned b0 = cvtpk(P[BASE + 4], P[BASE + 5]), b1 = cvtpk(P[BASE + 6], P[BASE + 7]);                              \
    auto r0 = __builtin_amdgcn_permlane32_swap(a0, b0, false, false); auto r1 = __builtin_amdgcn_permlane32_swap(a1, b1, false, false); \
    u32x4 w = {r0[0], r1[0], r0[1], r1[1]}; OUT = *reinterpret_cast<bf16x8*>(&w); } while (0)
  PK4(p0, 0, pa0); PK4(p0, 8, pa1); PK4(p1, 0, pa2); PK4(p1, 8, pa3);
#undef PK4
}
__device__ __forceinline__ void qkt(f32x16& p0, f32x16& p1, const bf16* Ks, const bf16x8* qr, int r32, int hi) {
  p0 = f32x16{}; p1 = f32x16{};
  for (int d0 = 0; d0 < 8; ++d0) { int cb = (d0 * 16 + hi * 8) * 2;
    bf16x8 b0 = *reinterpret_cast<const bf16x8*>((const char*)Ks + KSWZ(r32, cb));
    bf16x8 b1 = *reinterpret_cast<const bf16x8*>((const char*)Ks + KSWZ(32 + r32, cb));
    p0 = __builtin_amdgcn_mfma_f32_32x32x16_bf16(b0, qr[d0], p0, 0, 0, 0);
    p1 = __builtin_amdgcn_mfma_f32_32x32x16_bf16(b1, qr[d0], p1, 0, 0, 0); }
}
__device__ __forceinline__ int v_st(int k, int c) { const int kk = (k & ~0xC) | ((k & 4) << 1) | ((k & 8) >> 1); return ((kk >> 3) * 4 + (c >> 5)) * 512 + ((kk & 7) * 32 + (c & 31)) * 2; }
__device__ __forceinline__ int v_rd_base(int lane) { return ((lane & 3) << 3) | (((lane >> 2) & 3) << 6) | (((lane >> 4) & 1) << 5) | (((lane >> 5) & 1) << 8); }
constexpr int v_rd_off(int d0, int ks, int half) { return d0 * 512 + ks * 4096 + half * 2048; }
template <int OFF> __device__ __forceinline__ s16x4 tr_read(int vb) {
  s16x4 r; asm volatile("ds_read_b64_tr_b16 %0, %1 offset:%2" : "=&v"(r) : "v"(vb), "i"(OFF) : "memory"); return r;
}
template <int D0> __device__ __forceinline__ void pv_one(f32x16& od, int vb, bf16x8 pa0, bf16x8 pa1, bf16x8 pa2, bf16x8 pa3) {
  const s16x4 l0 = tr_read<v_rd_off(D0, 0, 0)>(vb), h0 = tr_read<v_rd_off(D0, 0, 1)>(vb), l1 = tr_read<v_rd_off(D0, 1, 0)>(vb), h1 = tr_read<v_rd_off(D0, 1, 1)>(vb);
  const s16x4 l2 = tr_read<v_rd_off(D0, 2, 0)>(vb), h2 = tr_read<v_rd_off(D0, 2, 1)>(vb), l3 = tr_read<v_rd_off(D0, 3, 0)>(vb), h3 = tr_read<v_rd_off(D0, 3, 1)>(vb);
  asm volatile("s_waitcnt lgkmcnt(0)" ::: "memory"); SBAR();
#define PK(L, H) (bf16x8){L[0], L[1], L[2], L[3], H[0], H[1], H[2], H[3]}
  od = __builtin_amdgcn_mfma_f32_32x32x16_bf16(pa0, PK(l0, h0), od, 0, 0, 0);
  od = __builtin_amdgcn_mfma_f32_32x32x16_bf16(pa1, PK(l1, h1), od, 0, 0, 0);
  od = __builtin_amdgcn_mfma_f32_32x32x16_bf16(pa2, PK(l2, h2), od, 0, 0, 0);
  od = __builtin_amdgcn_mfma_f32_32x32x16_bf16(pa3, PK(l3, h3), od, 0, 0, 0);
#undef PK
}
__device__ __forceinline__ void pv_d0(f32x16* o, int vb, bf16x8 pa0, bf16x8 pa1, bf16x8 pa2, bf16x8 pa3) {
  pv_one<0>(o[0], vb, pa0, pa1, pa2, pa3); pv_one<1>(o[1], vb, pa0, pa1, pa2, pa3); pv_one<2>(o[2], vb, pa0, pa1, pa2, pa3); pv_one<3>(o[3], vb, pa0, pa1, pa2, pa3);
}
__device__ __forceinline__ void attn_dense_body(const bf16* __restrict__ Qb, const bf16* __restrict__ Kh, const bf16* __restrict__ Vh,
                                                bf16* __restrict__ Ob, int seq, char* lds, const float* __restrict__ qgain = nullptr, const float* __restrict__ rope = nullptr, int t0 = 0) {
  int tid = threadIdx.x; asm volatile("" : "+v"(tid));
  const int wid = tid >> 6, lane = tid & 63, r32 = lane & 31, hi = lane >> 5;
  bf16* V_lds = (bf16*)lds; bf16* K_lds = (bf16*)(lds + 2 * SHM_V);
  float* ws = (float*)(lds + 2 * SHM_V + 2 * SHM_K) + wid * 64; float* li_l = ws; float* al_l = ws + 32;
  float m_reg = -1e30f, l_reg = 0; f32x16 o[4] = {}; bf16x8 qr[8];
  const bf16* Qw = Qb + (long)(wid * QBLK + r32) * LDQ + hi * 8;
#pragma unroll
  for (int d0 = 0; d0 < 8; ++d0) qr[d0] = ld8(Qw + d0 * 16);
  if (qgain) {
    float ssq = 0.f;
#pragma unroll
    for (int d0 = 0; d0 < 8; ++d0)
#pragma unroll
      for (int x = 0; x < 8; ++x) { const float v = __uint_as_float((unsigned)(unsigned short)qr[d0][x] << 16); ssq += v * v; }
    { auto rr = __builtin_amdgcn_permlane32_swap(__float_as_uint(ssq), __float_as_uint(ssq), false, false); ssq = __uint_as_float(rr[0]) + __uint_as_float(rr[1]); }
    const float rstd = 1.0f / sqrtf(ssq * (1.0f / 128.0f) + 1e-6f);
    const int t = t0 + wid * QBLK + r32;
#pragma unroll
    for (int hp = 0; hp < 2; ++hp) {
      const int pos = hp ? (t & 63) : (t >> 6);
#pragma unroll
      for (int dd = 0; dd < 2; ++dd) { const int d0 = 4 * hp + dd;
        const float* g1 = qgain + 16 * d0 + 8 * hi; const float* g2 = g1 + 32;
        const float* tb = rope ? rope + (size_t)(pos * 32 + 16 * dd + 8 * hi) * 2 : nullptr;
        float y1[8], y2[8];
#pragma unroll
        for (int x = 0; x < 8; ++x) { const float a1 = __uint_as_float((unsigned)(unsigned short)qr[d0][x] << 16) * rstd * g1[x], a2 = __uint_as_float((unsigned)(unsigned short)qr[d0 + 2][x] << 16) * rstd * g2[x];
          if (rope) { const float cs = tb[2 * x], sn = tb[2 * x + 1]; y1[x] = a1 * cs - a2 * sn; y2[x] = a2 * cs + a1 * sn; } else { y1[x] = a1; y2[x] = a2; } }
        { u32x4 w = {cvtpk(y1[0], y1[1]), cvtpk(y1[2], y1[3]), cvtpk(y1[4], y1[5]), cvtpk(y1[6], y1[7])}; qr[d0] = *reinterpret_cast<bf16x8*>(&w); }
        { u32x4 w = {cvtpk(y2[0], y2[1]), cvtpk(y2[2], y2[3]), cvtpk(y2[4], y2[5]), cvtpk(y2[6], y2[7])}; qr[d0 + 2] = *reinterpret_cast<bf16x8*>(&w); } }
    }
  }
  const int sr = tid >> 4, sc = (tid & 15) * 8, vst0 = v_st(sr, sc), vst1 = v_st(32 + sr, sc);
  const int vb0 = (int)(uintptr_t)V_lds + v_rd_base(lane);
  struct { bf16x8 vs0, vs1, ks0, ks1; } sr_[2];
#define SLOAD(i, k0) do { sr_[i].vs0 = ld8(&Vh[(long)((k0) + sr) * LDK + sc]); sr_[i].vs1 = ld8(&Vh[(long)((k0) + 32 + sr) * LDK + sc]); \
    sr_[i].ks0 = ld8(&Kh[(long)((k0) + sr) * LDK + sc]); sr_[i].ks1 = ld8(&Kh[(long)((k0) + 32 + sr) * LDK + sc]); } while (0)
#define SWRITE(b, i) do { *(bf16x8*)((char*)V_lds + (b) * SHM_V + vst0) = sr_[i].vs0;          \
    *(bf16x8*)((char*)V_lds + (b) * SHM_V + vst1) = sr_[i].vs1; int kc = sc * 2;               \
    *(bf16x8*)((char*)K_lds + (b) * SHM_K + KSWZ(sr, kc)) = sr_[i].ks0;                       \
    *(bf16x8*)((char*)K_lds + (b) * SHM_K + KSWZ(32 + sr, kc)) = sr_[i].ks1; } while (0)
#define SWAIT() asm volatile("s_waitcnt vmcnt(4)" ::: "memory")
#define RESC(a) do { if (__any((a) < 1.f)) { if (hi == 0) al_l[r32] = (a); asm volatile("s_waitcnt lgkmcnt(0)" ::: "memory"); \
    for (int d = 0; d < 4; ++d) for (int r = 0; r < 16; ++r) o[d][r] *= al_l[crow(r, hi)]; } } while (0)
  f32x16 pA0, pA1, pB0, pB1; float mnA, mnB, alA, alB; bf16x8 pa0, pa1, pa2, pa3; const int NT = seq / KVBLK;
  constexpr int SE = 0, SO = 1;
  SLOAD(SE, 0); asm volatile("s_waitcnt vmcnt(0)" ::: "memory"); SWRITE(0, SE); __syncthreads();
  qkt(pA0, pA1, K_lds, qr, r32, hi); partialSM(pA0, pA1, m_reg, mnA, alA);
  SLOAD(SO, KVBLK); if (2 < NT) SLOAD(SE, 2 * KVBLK);
  SWAIT(); SWRITE(1, SO); __syncthreads();
  for (int j = 1; j + 1 < NT; j += 2) {
    SBAR(); qkt(pB0, pB1, (bf16*)((char*)K_lds + SHM_K), qr, r32, hi);
    finishSM(pA0, pA1, alA, l_reg, pa0, pa1, pa2, pa3); SBAR();
    SLOAD(SO, (j + 2) * KVBLK); SBAR();
    pv_d0(o, vb0, pa0, pa1, pa2, pa3); partialSM(pB0, pB1, m_reg, mnB, alB);
    __syncthreads(); SWAIT(); SWRITE(0, SE);
    RESC(alB); __syncthreads();
    SBAR(); qkt(pA0, pA1, K_lds, qr, r32, hi);
    finishSM(pB0, pB1, alB, l_reg, pa0, pa1, pa2, pa3); SBAR();
    if (j + 3 < NT) SLOAD(SE, (j + 3) * KVBLK); SBAR();
    pv_d0(o, vb0 + (int)SHM_V, pa0, pa1, pa2, pa3); partialSM(pA0, pA1, m_reg, mnA, alA);
    __syncthreads(); SWAIT(); SWRITE(1, SO);
    RESC(alA); __syncthreads();
  }
  SBAR(); qkt(pB0, pB1, (bf16*)((char*)K_lds + SHM_K), qr, r32, hi);
  finishSM(pA0, pA1, alA, l_reg, pa0, pa1, pa2, pa3); SBAR();
  pv_d0(o, vb0, pa0, pa1, pa2, pa3); partialSM(pB0, pB1, m_reg, mnB, alB);
  __syncthreads(); RESC(alB);
  finishSM(pB0, pB1, alB, l_reg, pa0, pa1, pa2, pa3); SBAR();
  pv_d0(o, vb0 + (int)SHM_V, pa0, pa1, pa2, pa3);
  if (hi == 0) li_l[r32] = l_reg; asm volatile("s_waitcnt lgkmcnt(0)" ::: "memory");
  float rli[16];
#pragma unroll
  for (int r = 0; r < 16; ++r) rli[r] = __builtin_amdgcn_rcpf(li_l[crow(r, hi)]);
  bf16* Ow = Ob + (long)(wid * QBLK) * LDO;
#pragma unroll
  for (int r = 0; r < 16; ++r) { int orow = crow(r, hi);
#pragma unroll
    for (int d0 = 0; d0 < 4; ++d0) Ow[(long)orow * LDO + d0 * 32 + r32] = (bf16)(cvtpk(o[d0][r] * rli[r], 0.f) & 0xffffu); }
  __syncthreads();
#undef SLOAD
#undef SWRITE
#undef SWAIT
#undef RESC
}
#undef KSWZ
#undef SBAR
}

constexpr int NWAVES = 8;
#ifndef MK_N_LAUNCHES
#define MK_N_LAUNCHES 1
#endif
constexpr int DM = 2048, NBATCH = 8, SEQ = 2048, CTXL = 256, TPB = SEQ + CTXL, MROWS = NBATCH * TPB;
constexpr int MLAT = NBATCH * SEQ;
constexpr int MODW = 6 * DM, NSET = 9;
constexpr int EIN = 3072, OIN = 12288, OMIX = 4096, FFN = 5632, FFN2 = 2 * FFN;
constexpr float EPS = 1e-6f;
constexpr int N_PHASES = 1 + 9 * 4;
constexpr size_t MiB = 1u << 20;
constexpr size_t WS_CTL = 0, CTL_ZERO_BYTES = 1 * MiB;
constexpr size_t WS_MOD = 1 * MiB;
constexpr size_t WS_ROPE_E = 3 * MiB, WS_ROPE_O = 3 * MiB + 65536;
constexpr size_t WS_WTC = 3 * MiB + 262144;
constexpr size_t WS_CB = 4 * MiB;
constexpr size_t WS_WTL = 5 * MiB;
constexpr size_t WS_W_INE = 21 * MiB, WS_W_OUTE = 45 * MiB, WS_W_INO = 61 * MiB, WS_W_OUTO = 157 * MiB, WS_W_FIN = 189 * MiB, WS_W_FOUT = 365 * MiB;
constexpr size_t WS_H = 453 * MiB;
constexpr size_t WS_XN = 597 * MiB;
constexpr size_t WS_P = 669 * MiB;
constexpr size_t WS_R = 1101 * MiB;
constexpr size_t WS_OF = WS_R, WS_OB = WS_R + 144 * MiB;
constexpr size_t WS_FT = WS_R, WS_FTC = WS_R + 16 * MiB, WS_Z = WS_R + 18 * MiB, WS_MIX = WS_R + 54 * MiB;
constexpr size_t WS_DELTA = 1389 * MiB;
constexpr size_t WS_SPLITTAB = 2 * MiB + 917504;
constexpr size_t WS_END = 1453 * MiB;
static_assert(WS_MIX + (size_t)MROWS * DM * 2 <= WS_END && WS_OB + (size_t)MROWS * OMIX * 2 <= WS_END && WS_P + (size_t)MROWS * OIN * 2 <= WS_R, "d_ws map");
constexpr int CW_TMO = 0, CW_CODE = 1, CW_BAR = 4096;
constexpr int RING_OFF = 0, RING_BYTES = 131072;
constexpr int LDSCTL_OFF = 158720, MISC_OFF = LDSCTL_OFF + 320;
constexpr int LDS_BYTES = 159744;
static_assert(MISC_OFF + 128 <= LDS_BYTES, "LDS map");

#define GAS __attribute__((address_space(1)))
#define LAS __attribute__((address_space(3)))
typedef unsigned short bf16;
typedef unsigned v4u __attribute__((ext_vector_type(4)));
typedef unsigned v2u __attribute__((ext_vector_type(2)));
typedef float f32x4 __attribute__((ext_vector_type(4)));
typedef short bf16x8 __attribute__((ext_vector_type(8)));
typedef short s16x4 __attribute__((ext_vector_type(4)));
typedef GAS unsigned gu32;
#define RLX_AGENT __ATOMIC_RELAXED, __HIP_MEMORY_SCOPE_AGENT
#define LDS_WAIT() asm volatile("s_waitcnt lgkmcnt(0)" ::: "memory")
#define VM_WAIT() asm volatile("s_waitcnt vmcnt(0)" ::: "memory")
typedef __bf16 bf16x2_t __attribute__((ext_vector_type(2)));
typedef float f32x2_t __attribute__((ext_vector_type(2)));
__device__ __forceinline__ unsigned pk2(float lo, float hi) { const f32x2_t v = {lo, hi}; const bf16x2_t b = __builtin_convertvector(v, bf16x2_t); return __builtin_bit_cast(unsigned, b); }
__device__ __forceinline__ float bflo(unsigned w) { return __uint_as_float(w << 16); }
__device__ __forceinline__ float bfhi(unsigned w) { return __uint_as_float(w & 0xffff0000u); }
__device__ __forceinline__ float silu(float g) { return g / (1.0f + __expf(-g)); }

#define XB_TMO      128
#define XB_XCNT(j)  (256  + 64 * (j))
#define XB_XSUB(j)  (1280 + 64 * (j))
#define XB_XGEN(j)  (2304 + 64 * (j))
#define XB_TOP      3328
#define XB_TOPGEN   3392
#define XCD_BAR_WORDS 3456
#define XB_SPIN_CAP (1u << 18)

__device__ __forceinline__ unsigned xb_ld(unsigned* p)              { return __hip_atomic_load(p, __ATOMIC_RELAXED, __HIP_MEMORY_SCOPE_AGENT); }
__device__ __forceinline__ unsigned xb_add(unsigned* p, unsigned v) { return __hip_atomic_fetch_add(p, v, __ATOMIC_RELAXED, __HIP_MEMORY_SCOPE_AGENT); }
__device__ __forceinline__ unsigned xb_xcc_id() { return (unsigned)__builtin_amdgcn_s_getreg((3 << 11) | 20) & 0xFu; }
#define XB_SPIN(cond, bar) do { unsigned _sp = 0; while (cond) { __builtin_amdgcn_s_sleep(1); \
    if ((++_sp & 255u) == 0u) { if (xb_ld(&(bar)[XB_TMO])) break; if (_sp > XB_SPIN_CAP) { atomicAdd(&(bar)[XB_TMO], 1u); break; } } } } while (0)

struct XcdBarrier {
    unsigned* bar; unsigned x;
    volatile LAS unsigned* st;
};

__device__ __forceinline__ XcdBarrier xcd_barrier_post(unsigned* bar, volatile LAS unsigned* st) {
    XcdBarrier b; b.bar = bar; b.x = xb_xcc_id(); b.st = st;
    if (threadIdx.x == 0) (void)xb_add(&bar[XB_XCNT(b.x)], 1u);
    return b;
}
__device__ __forceinline__ void xcd_barrier_complete(unsigned* bar, unsigned x, unsigned& nloc, unsigned& nx) {
    const unsigned G = gridDim.x * gridDim.y * gridDim.z;
    unsigned sum, cnt, mine, sp = 0u;
    for (;;) {
        sum = 0u; cnt = 0u; mine = 0u;
#pragma unroll
        for (unsigned j = 0; j < 16; ++j) { const unsigned c = xb_ld(&bar[XB_XCNT(j)]); sum += c; cnt += (c > 0u) ? 1u : 0u; mine = (j == x) ? c : mine; }
        if (sum == G) break;
        __builtin_amdgcn_s_sleep(1);
        if ((++sp & 255u) == 0u) { if (xb_ld(&bar[XB_TMO])) break; if (sp > XB_SPIN_CAP) { atomicAdd(&bar[XB_TMO], 1u); break; } }
    }
    nloc = mine > 0u ? mine : 1u; nx = cnt > 0u ? cnt : 1u;
}

__device__ __forceinline__ void xcd_barrier(const XcdBarrier& b) {
    asm volatile("s_waitcnt vmcnt(0)" ::: "memory");
    __syncthreads();
    if (threadIdx.x == 0) {
        unsigned* bar = b.bar;
        __builtin_amdgcn_s_waitcnt(0);
        unsigned nloc = b.st[0], nx = b.st[1];
        if (nloc == 0u) { xcd_barrier_complete(bar, b.x, nloc, nx); b.st[0] = nloc; b.st[1] = nx; }
        const unsigned old = xb_add(&bar[XB_XSUB(b.x)], 1u);
        const unsigned gen = old / nloc;
        if (old + 1u == (gen + 1u) * nloc) {
            __builtin_amdgcn_fence(__ATOMIC_RELEASE, "agent");
            asm volatile("s_waitcnt vmcnt(0)" ::: "memory");
            const unsigned og = xb_add(&bar[XB_TOP], 1u);
            const unsigned tg = og / nx;
            if (og + 1u == (tg + 1u) * nx) xb_add(&bar[XB_TOPGEN], 1u);
            else XB_SPIN(xb_ld(&bar[XB_TOPGEN]) == tg, bar);
            __builtin_amdgcn_fence(__ATOMIC_ACQUIRE, "agent");
            xb_add(&bar[XB_XGEN(b.x)], 1u);
            asm volatile("s_waitcnt vmcnt(0)" ::: "memory");
        } else {
            XB_SPIN(xb_ld(&bar[XB_XGEN(b.x)]) == gen, bar);
            __builtin_amdgcn_fence(__ATOMIC_ACQUIRE, "agent");
            asm volatile("s_waitcnt vmcnt(0)" ::: "memory");
        }
    }
    __syncthreads();
}

struct Args { const float* in[16]; float* out; unsigned char* ws; int ph_lo, ph_hi; };
static_assert(sizeof(Args) == 18 * 8 + 8, "Args has no padding");

struct Frame {
    LAS unsigned char* lds;
    volatile LAS unsigned* MISC;
    gu32* ctl;
    GAS unsigned char* ws;
    GAS float* out;
    int wave, vcu, G;
};
__device__ __forceinline__ int tid_opaque() { int t = threadIdx.x; asm volatile("" : "+v"(t)); return t; }
#define IN_X(F) ((const float*)(const GAS float*)A.in[0])
#define IN_C(F) ((const float*)(const GAS float*)A.in[1])
#define IN_CTX(F) ((const float*)(const GAS float*)A.in[2])
#define IN_CCTX(F) ((const float*)(const GAS float*)A.in[3])
#define IN_WMOD(F) ((const float*)(const GAS float*)A.in[4])
#define IN_BMOD(F) ((const float*)(const GAS float*)A.in[5])
#define IN_WINE(F) ((const float*)(const GAS float*)A.in[6])
#define IN_WOUTE(F) ((const float*)(const GAS float*)A.in[7])
#define IN_QG(F) ((const float*)(const GAS float*)A.in[8])
#define IN_KG(F) ((const float*)(const GAS float*)A.in[9])
#define IN_WINO(F) ((const float*)(const GAS float*)A.in[10])
#define IN_WOUTO(F) ((const float*)(const GAS float*)A.in[11])
#define IN_LDF(F) ((const float*)(const GAS float*)A.in[12])
#define IN_LDB(F) ((const float*)(const GAS float*)A.in[13])
#define IN_WFIN(F) ((const float*)(const GAS float*)A.in[14])
#define IN_WFOUT(F) ((const float*)(const GAS float*)A.in[15])
#define WSF(F, off) ((float*)((F).ws + (off)))
#define WSB(F, off) ((bf16*)((F).ws + (off)))
__device__ __forceinline__ float shx(float v, int k, int lane) { return __int_as_float(__builtin_amdgcn_ds_bpermute((lane ^ k) << 2, __float_as_int(v))); }
__device__ __forceinline__ float wave_sum(float v, int lane) {
#pragma unroll
    for (int o = 1; o < 64; o <<= 1) v += shx(v, o, lane);
    return v;
}
__device__ __forceinline__ void p0_transpose_item(const float* W, int K, int N, bf16* WT, int k0, int n0, int drow0, float scale, LAS float* scr, int lane) {
    const int kr = lane >> 4, c4 = (lane & 15) * 4;
    f32x4 v[16];
#pragma unroll
    for (int i = 0; i < 16; ++i) v[i] = *(const GAS f32x4*)(W + (size_t)(k0 + 4 * i + kr) * N + n0 + c4);
#pragma unroll
    for (int i = 0; i < 16; ++i) { LAS float* d = scr + (4 * i + kr) * 65 + c4; d[0] = v[i][0]; d[1] = v[i][1]; d[2] = v[i][2]; d[3] = v[i][3]; }
    LDS_WAIT(); asm volatile("" ::: "memory");
    const int c = lane & 7;
#pragma unroll
    for (int j = 0; j < 8; ++j) { const int n = (lane >> 3) + 8 * j; const LAS float* s = scr + (8 * c) * 65 + n;
        v4u o; o.x = pk2(s[0 * 65] * scale, s[1 * 65] * scale); o.y = pk2(s[2 * 65] * scale, s[3 * 65] * scale); o.z = pk2(s[4 * 65] * scale, s[5 * 65] * scale); o.w = pk2(s[6 * 65] * scale, s[7 * 65] * scale);
        *(GAS v4u*)(WT + (size_t)(drow0 + n) * K + k0 + 8 * c) = o; }
    LDS_WAIT(); asm volatile("" ::: "memory");
}
__device__ __forceinline__ void p0_conv(const float* W, bf16* WT, int K, int N, int kind, int r, LAS float* scr, int lane) {
    const int nbn = N / 64, per = (K / 64) * nbn, inst = r / per, rr = r - inst * per, kb = rr / nbn, nb = rr - kb * nbn, n0 = nb * 64;
    int drow0 = n0; float scale = 1.0f;
    if (kind == 2) { if (n0 >= 2048 && n0 < 4096) scale = 0.0625f;
        if (n0 < 4096) { const int d = n0 & 255, half = d >> 7, bj = (d >> 6) & 1; drow0 = (n0 & ~255) + 128 * bj + 64 * half; } }
    if (kind == 4) { const int bj = n0 >= FFN ? 1 : 0, hc = n0 - bj * FFN; drow0 = 256 * (hc >> 7) + 128 * bj + (hc & 127); }
    p0_transpose_item(W + (size_t)inst * K * N, K, N, WT + (size_t)inst * K * N, kb * 64, n0, drow0, scale, scr, lane);
}
#ifndef BUILD_SPLITTAB
#define BUILD_SPLITTAB 0
#endif
#ifndef PRO_GW
#define PRO_GW 3
#endif
__device__ __forceinline__ void ph_prologue(Frame& F, const Args& A) {
    const int tid = tid_opaque(), lane = tid & 63;
    constexpr int COND_BYTES = NSET * DM * 4;
    LAS float* cond = (LAS float*)(F.lds + RING_OFF);
    for (int i = tid; i < NSET * DM; i += NWAVES * 64) { const int s = i >> 11, k = i & 2047; const float v = (s < 8) ? IN_C(F)[s * DM + k] : IN_CCTX(F)[k]; cond[i] = v / (1.0f + expf(-v)); }
    LDS_WAIT(); __syncthreads();
    if (F.wave < PRO_GW) {
        for (int item = F.wave * F.G + F.vcu; item < 4 * 192; item += PRO_GW * F.G) {
            const int layer = item / 192, kk = lane >> 4, col = (item - layer * 192) * 64 + (lane & 15) * 4;
            const float* wp = IN_WMOD(F) + (size_t)layer * DM * MODW + (size_t)kk * MODW + col;
            f32x4 acc[NSET];
#pragma unroll
            for (int s = 0; s < NSET; ++s) acc[s] = (f32x4){0.f, 0.f, 0.f, 0.f};
            for (int k = 0; k < DM; k += 32) {
                f32x4 w[8];
#pragma unroll
                for (int u = 0; u < 8; ++u) w[u] = *(const GAS f32x4*)(wp + (size_t)(k + 4 * u) * MODW);
#pragma unroll
                for (int u = 0; u < 8; ++u)
#pragma unroll
                    for (int s = 0; s < NSET; ++s) acc[s] += w[u] * cond[s * DM + k + 4 * u + kk];
            }
#pragma unroll
            for (int s = 0; s < NSET; ++s)
#pragma unroll
                for (int x = 0; x < 4; ++x) { float t = acc[s][x]; t += shx(t, 16, lane); t += shx(t, 32, lane); acc[s][x] = t; }
            if (kk == 0) { const f32x4 bm = *(const GAS f32x4*)(IN_BMOD(F) + layer * MODW + col);
#pragma unroll
                for (int s = 0; s < NSET; ++s) *(GAS f32x4*)(WSF(F, WS_MOD) + (size_t)(layer * NSET + s) * MODW + col) = acc[s] + bm; }
        }
    } else {
        LAS float* scr = (LAS float*)(F.lds + RING_OFF + COND_BYTES + (F.wave - PRO_GW) * 16640);
        const int tw = (F.wave - PRO_GW) * F.G + F.vcu, NTW = (NWAVES - PRO_GW) * F.G;
        constexpr int I0 = 2 * 32 * 48, I1 = 2 * 32 * 32, I2 = 2 * 32 * 192, I3 = 2 * 64 * 32, I4 = 4 * 32 * 176, I5 = 4 * 88 * 32;
        for (int it = tw; it < I0 + I1 + I2 + I3 + I4 + I5; it += NTW) {
            int r = it;
            if (r < I0) { p0_conv(IN_WINE(F), WSB(F, WS_W_INE), DM, EIN, 0, r, scr, lane); continue; } r -= I0;
            if (r < I1) { p0_conv(IN_WOUTE(F), WSB(F, WS_W_OUTE), DM, DM, 1, r, scr, lane); continue; } r -= I1;
            if (r < I2) { p0_conv(IN_WINO(F), WSB(F, WS_W_INO), DM, OIN, 2, r, scr, lane); continue; } r -= I2;
            if (r < I3) { p0_conv(IN_WOUTO(F), WSB(F, WS_W_OUTO), OMIX, DM, 3, r, scr, lane); continue; } r -= I3;
            if (r < I4) { p0_conv(IN_WFIN(F), WSB(F, WS_W_FIN), DM, FFN2, 4, r, scr, lane); continue; } r -= I4;
            p0_conv(IN_WFOUT(F), WSB(F, WS_W_FOUT), FFN, DM, 5, r, scr, lane);
        }
    }
    const int gw = F.vcu * NWAVES + F.wave, NGW = F.G * NWAVES;
    if (BUILD_SPLITTAB && gw == 0) {
        pg8::StaticOrder so; so.init(MROWS, DM, F.G, 0); const int nfull = (so.nwg / F.G) * F.G; int* tab = (int*)(F.ws + WS_SPLITTAB);
        for (int e = lane; e < 576; e += 64) { int val = 0;
            for (int idx = nfull; idx < so.nwg; ++idx) { pg8::Unit u; so.map(idx, u); if (u.pm * 8 + u.pn == e) val = idx - nfull + 1; }
            tab[e] = val; }
    }
    const int gt = gw * 64 + lane, NGT = NGW * 64;
    for (int i = gt; i < 4096 * 256; i += NGT) {
        const int m = i >> 8, k0 = (i & 255) * 8, part = m >> 11, to = m & 2047; unsigned w[4];
#pragma unroll
        for (int u = 0; u < 4; ++u) { float s0, c0, s1, c1; sincospif((float)((to * (k0 + 2 * u)) & 2047) * (1.0f / 1024.0f), &s0, &c0); sincospif((float)((to * (k0 + 2 * u + 1)) & 2047) * (1.0f / 1024.0f), &s1, &c1);
            w[u] = pk2((part ? s0 : c0) * 0.022097086912079608f, (part ? s1 : c1) * 0.022097086912079608f); }
        *(GAS v4u*)(WSB(F, WS_WTL) + (size_t)m * 2048 + k0) = (v4u){w[0], w[1], w[2], w[3]};
    }
    for (int i = gt; i < 512 * 32; i += NGT) {
        const int m = i >> 5, k0 = (i & 31) * 8, part = m >> 8, to = m & 255; unsigned w[4];
#pragma unroll
        for (int u = 0; u < 4; ++u) { float s0, c0, s1, c1; sincospif((float)((to * (k0 + 2 * u)) & 255) * (1.0f / 128.0f), &s0, &c0); sincospif((float)((to * (k0 + 2 * u + 1)) & 255) * (1.0f / 128.0f), &s1, &c1);
            w[u] = pk2((part ? s0 : c0) * 0.0625f, (part ? s1 : c1) * 0.0625f); }
        *(GAS v4u*)(WSB(F, WS_WTC) + (size_t)m * 256 + k0) = (v4u){w[0], w[1], w[2], w[3]};
    }
    for (int i = gt; i < 512 * 128; i += NGT) {
        const int n = i >> 7, k0 = (i & 127) * 8, g = n >> 7, kq = n & 127, part = k0 >> 9, g2 = (k0 >> 7) & 3; unsigned w[4];
#pragma unroll
        for (int u = 0; u < 4; ++u) { float s0, c0, s1, c1; const int cc = (k0 & 127) + 2 * u; sincospif((float)((cc * kq) & 127) * (1.0f / 64.0f), &s0, &c0); sincospif((float)(((cc + 1) * kq) & 127) * (1.0f / 64.0f), &s1, &c1);
            const float a0 = (part ? -s0 : c0) * 0.08838834764831845f, a1 = (part ? -s1 : c1) * 0.08838834764831845f;
            w[u] = (g == g2) ? pk2(a0, a1) : 0u; }
        *(GAS v4u*)(WSB(F, WS_CB) + (size_t)n * 1024 + k0) = (v4u){w[0], w[1], w[2], w[3]};
    }
    for (int i = gt; i < 64 * 32; i += NGT) { const int pos = i >> 5, f = i & 31; const double inv = exp2(-(double)(2 * f) / 64.0 * 13.287712379549449), a = (double)pos * inv;
        WSF(F, WS_ROPE_E)[2 * i] = (float)cos(a); WSF(F, WS_ROPE_E)[2 * i + 1] = (float)sin(a); }
    for (int i = gt; i < 64 * 64; i += NGT) { const int pos = i >> 6, f = i & 63; const double inv = exp2(-(double)(2 * f) / 128.0 * 13.287712379549449), a = (double)pos * inv;
        WSF(F, WS_ROPE_O)[2 * i] = (float)cos(a); WSF(F, WS_ROPE_O)[2 * i + 1] = (float)sin(a); }
}
__device__ __forceinline__ void ph_modulate(Frame& F, const Args& A, int layer, int which, int skipctx, int merge, int from_x) {
    const int lane = tid_opaque() & 63;
    const int gw = F.vcu * NWAVES + F.wave, NGW = F.G * NWAVES, R = (MROWS + NGW - 1) / NGW;
    const int m0 = gw * R, m1 = (m0 + R < MROWS) ? m0 + R : MROWS;
    f32x4 sh[8], sc[8], v[8], vn[8]; int curset = -1;
#define MOD_SRC(m_, b_, t_) (from_x ? (const GAS f32x4*)((t_) >= SEQ ? IN_CTX(F) + (size_t)((b_) * CTXL + (t_) - SEQ) * DM : IN_X(F) + (size_t)((b_) * SEQ + (t_)) * DM) + lane : (const GAS f32x4*)(WSF(F, WS_H) + (size_t)(m_) * DM) + lane)
    if (m0 < MROWS) { const int b = m0 / TPB, t = m0 - b * TPB; const GAS f32x4* sr = MOD_SRC(m0, b, t);
#pragma unroll
        for (int j = 0; j < 8; ++j) vn[j] = sr[64 * j]; }
#pragma unroll 1
    for (int m = m0; m < m1; ++m) {
        const int b = m / TPB, t = m - b * TPB, isctx = t >= SEQ, set = isctx ? 8 : b;
#pragma unroll
        for (int j = 0; j < 8; ++j) v[j] = vn[j];
        if (m + 1 < m1) { const int b2 = (m + 1) / TPB, t2 = (m + 1) - b2 * TPB; const GAS f32x4* sr = MOD_SRC(m + 1, b2, t2);
#pragma unroll
            for (int j = 0; j < 8; ++j) vn[j] = sr[64 * j]; }
        if (skipctx && isctx) continue;
        if (set != curset) { curset = set; const float* shp = WSF(F, WS_MOD) + (size_t)(layer * NSET + set) * MODW + which * 3 * DM;
#pragma unroll
            for (int j = 0; j < 8; ++j) { sh[j] = *((const GAS f32x4*)shp + lane + 64 * j); sc[j] = *((const GAS f32x4*)(shp + DM) + lane + 64 * j) + 1.0f; } }
        if (merge) {
            GAS f32x4* hr = (GAS f32x4*)(WSF(F, WS_H) + (size_t)m * DM) + lane;
            const int pm = m >> 8; const int* tab = (const int*)(F.ws + WS_SPLITTAB) + pm * 8;
#pragma unroll
            for (int j = 0; j < 8; ++j) { const int sl = __builtin_amdgcn_readfirstlane(tab[j]);
                if (sl) { const GAS f32x4* dp = (const GAS f32x4*)(WSF(F, WS_DELTA) + (size_t)(sl - 1) * 4 * 65536 + (size_t)(m & 255) * 256) + lane;
                    const f32x4 d0 = dp[0], d1 = dp[16384], d2 = dp[32768], d3 = dp[49152];
                    v[j] = v[j] + ((d0 + d1) + (d2 + d3)); hr[64 * j] = v[j]; } }
        }
        float ss = 0.f;
#pragma unroll
        for (int j = 0; j < 8; ++j) { ss += (v[j][0] * v[j][0] + v[j][1] * v[j][1]) + (v[j][2] * v[j][2] + v[j][3] * v[j][3]); }
        const float rstd = 1.0f / sqrtf(wave_sum(ss, lane) * (1.0f / DM) + EPS);
        GAS v2u* o8 = (GAS v2u*)(WSB(F, WS_XN) + (size_t)m * DM) + lane;
#pragma unroll
        for (int j = 0; j < 8; ++j) { const f32x4 y = v[j] * rstd * sc[j] + sh[j]; o8[64 * j] = (v2u){pk2(y[0], y[1]), pk2(y[2], y[3])}; }
    }
#undef MOD_SRC
}
__device__ __forceinline__ void ph_qk_even(Frame& F, const Args& A, int j2) {
    const int gw = F.vcu * NWAVES + F.wave, NGW = F.G * NWAVES, l = tid_opaque() & 63;
    const float* qg = IN_QG(F) + j2 * 128 + (l & 15) * 8; const float* kg = IN_KG(F) + j2 * 128 + (l & 15) * 8;
    float gq[8], gk[8];
#pragma unroll
    for (int x = 0; x < 8; ++x) { gq[x] = qg[x]; gk[x] = kg[x]; }
    for (int m = gw; m < MROWS; m += NGW) {
        const int b = m / TPB, t = m - b * TPB, lat = t < SEQ;
        const int half = (l >> 3) & 1, pos = half ? (t & 63) : (t >> 6), isx2 = (l >> 2) & 1;
        f32x4 tb[4];
        if (lat) {
#pragma unroll
            for (int q = 0; q < 4; ++q) tb[q] = *(const GAS f32x4*)(WSF(F, WS_ROPE_E) + (size_t)(pos * 32 + (l & 3) * 8 + 2 * q) * 2);
        }
        GAS v4u* pr = (GAS v4u*)(WSB(F, WS_P) + (size_t)m * EIN + 512) + l;
#pragma unroll
        for (int j = 3; j < 4; ++j) {
            const v4u raw = pr[64 * j];
            float v[8] = {bflo(raw.x), bfhi(raw.x), bflo(raw.y), bfhi(raw.y), bflo(raw.z), bfhi(raw.z), bflo(raw.w), bfhi(raw.w)};
            float ss = 0.f;
#pragma unroll
            for (int x = 0; x < 8; ++x) ss += v[x] * v[x];
            ss += shx(ss, 1, l); ss += shx(ss, 2, l); ss += shx(ss, 4, l); ss += shx(ss, 8, l);
            const float rstd = 1.0f / sqrtf(ss * (1.0f / 128.0f) + EPS);
            const bool isq = (4 * j + (l >> 4)) < 12;
#pragma unroll
            for (int x = 0; x < 8; ++x) v[x] = v[x] * rstd * (isq ? gq[x] : gk[x]);
            if (lat) {
#pragma unroll
                for (int x = 0; x < 8; ++x) { const float p = shx(v[x], 4, l); const float cs = tb[x >> 1][(x & 1) * 2], sn = tb[x >> 1][(x & 1) * 2 + 1];
                    v[x] = isx2 ? (v[x] * cs + p * sn) : (v[x] * cs - p * sn); }
            }
            pr[64 * j] = (v4u){pk2(v[0], v[1]), pk2(v[2], v[3]), pk2(v[4], v[5]), pk2(v[6], v[7])};
        }
    }
    LAS bf16* scr = (LAS bf16*)(F.lds + RING_OFF + F.wave * 9216);
    for (int it = gw; it < NBATCH * 288; it += NGW) {
        const int b = it / 288, r = it - b * 288; int t0, c0, isc;
        if (r < 256) { isc = 0; t0 = (r >> 3) * 64; c0 = (r & 7) * 64; } else { isc = 1; t0 = ((r - 256) >> 3) * 64; c0 = ((r - 256) & 7) * 64; }
        const bf16* src = WSB(F, WS_P) + (size_t)(b * TPB + (isc ? SEQ : 0) + t0) * EIN + c0;
#pragma unroll
        for (int i = 0; i < 8; ++i) { const int rr = i * 8 + (l >> 3), ch = l & 7; const v4u val = *(const GAS v4u*)(src + (size_t)rr * EIN + ch * 8); *(LAS v4u*)(scr + rr * 72 + ch * 8) = val; }
        LDS_WAIT(); asm volatile("" ::: "memory");
        bf16* dst = isc ? WSB(F, WS_FTC) + (size_t)(b * 512 + c0) * CTXL + t0 : WSB(F, WS_FT) + (size_t)(b * 512 + c0) * SEQ + t0;
        const int ld = isc ? CTXL : SEQ;
#pragma unroll
        for (int i = 0; i < 8; ++i) { const int cc = i * 8 + (l >> 3), tc = (l & 7) * 8; const LAS bf16* s = scr + tc * 72 + cc;
            v4u o; o.x = (unsigned)s[0] | ((unsigned)s[72] << 16); o.y = (unsigned)s[144] | ((unsigned)s[216] << 16); o.z = (unsigned)s[288] | ((unsigned)s[360] << 16); o.w = (unsigned)s[432] | ((unsigned)s[504] << 16);
            *(GAS v4u*)(dst + (size_t)cc * ld + tc) = o; }
        LDS_WAIT(); asm volatile("" ::: "memory");
    }
}
__device__ __forceinline__ void ph_rope_odd(Frame& F) {
    const int gw = F.vcu * NWAVES + F.wave, NGW = F.G * NWAVES, l = tid_opaque() & 63;
    for (int m = gw; m < MROWS; m += NGW) {
        const int b = m / TPB, t = m - b * TPB;
        if (t >= SEQ) continue;
        const int half = (l >> 4) & 1, pos = half ? (t & 63) : (t >> 6), isx2 = (l >> 3) & 1;
        f32x4 tb[4];
#pragma unroll
        for (int q = 0; q < 4; ++q) tb[q] = *(const GAS f32x4*)(WSF(F, WS_ROPE_O) + (size_t)(pos * 64 + (l & 7) * 8 + 2 * q) * 2);
        GAS v4u* pr = (GAS v4u*)(WSB(F, WS_P) + (size_t)m * OIN) + l;
#pragma unroll
        for (int j = 0; j < 8; ++j) {
            const v4u raw = pr[64 * j];
            float v[8] = {bflo(raw.x), bfhi(raw.x), bflo(raw.y), bfhi(raw.y), bflo(raw.z), bfhi(raw.z), bflo(raw.w), bfhi(raw.w)};
#pragma unroll
            for (int x = 0; x < 8; ++x) { const float p = shx(v[x], 8, l); const float cs = tb[x >> 1][(x & 1) * 2], sn = tb[x >> 1][(x & 1) * 2 + 1];
                v[x] = isx2 ? (v[x] * cs + p * sn) : (v[x] * cs - p * sn); }
            pr[64 * j] = (v4u){pk2(v[0], v[1]), pk2(v[2], v[3]), pk2(v[4], v[5]), pk2(v[6], v[7])};
        }
    }
}
__device__ __forceinline__ void ph_comb(Frame& F, int skipctx, int dry = 0) {
    const int gw = F.vcu * NWAVES + F.wave, NGW = F.G * NWAVES, l = tid_opaque() & 63;
    for (int m = gw; m < MROWS; m += NGW) {
        const int b = m / TPB, t = m - b * TPB;
        if (skipctx && t >= SEQ) continue;
        GAS v4u* pf = (GAS v4u*)(WSB(F, WS_OF) + (size_t)m * OMIX) + l; const GAS v4u* pb = (const GAS v4u*)(WSB(F, WS_OB) + (size_t)m * OMIX) + l;
        const GAS v4u* pg = (const GAS v4u*)(WSB(F, WS_P) + (size_t)m * OIN + 8192) + l;
#pragma unroll
        for (int j = 0; j < 8; ++j) {
            const v4u a = pf[64 * j], bb = pb[64 * j], gg = pg[64 * j];
            float o[8] = {bflo(a.x) + bflo(bb.x), bfhi(a.x) + bfhi(bb.x), bflo(a.y) + bflo(bb.y), bfhi(a.y) + bfhi(bb.y), bflo(a.z) + bflo(bb.z), bfhi(a.z) + bfhi(bb.z), bflo(a.w) + bflo(bb.w), bfhi(a.w) + bfhi(bb.w)};
            const float g[8] = {bflo(gg.x), bfhi(gg.x), bflo(gg.y), bfhi(gg.y), bflo(gg.z), bfhi(gg.z), bflo(gg.w), bfhi(gg.w)};
            float ss = 0.f;
#pragma unroll
            for (int x = 0; x < 8; ++x) ss += o[x] * o[x];
            const float rstd = 1.0f / sqrtf(wave_sum(ss, l) * (1.0f / 512.0f) + EPS);
#pragma unroll
            for (int x = 0; x < 8; ++x) o[x] = silu(g[x]) * (o[x] * rstd);
            (dry ? (GAS v4u*)pb : pf)[64 * j] = (v4u){pk2(o[0], o[1]), pk2(o[2], o[3]), pk2(o[4], o[5]), pk2(o[6], o[7])};
        }
    }
}
__device__ __forceinline__ void ph_attention(Frame& F, const Args& A, int j2) {
    char* lds = (char*)(F.lds + RING_OFF);
    for (int i = 0;; ++i) {
        const int u = i * F.G + F.vcu; if (u >= 864) break;
        if (u < 768) { const int qb = u & 7, g3 = (u >> 3) % 3, bk = u / 24, kvh = bk & 3, b = bk >> 2, h = kvh * 3 + g3; const size_t rq = (size_t)(b * TPB + qb * 256);
            const bf16* Kh = WSB(F, WS_P) + (size_t)(b * TPB) * EIN + 2048 + kvh * 128;
            att::attn_dense_body(WSB(F, WS_P) + rq * EIN + 512 + h * 128, Kh, Kh + 512, WSB(F, WS_MIX) + rq * DM + 512 + h * 128, TPB, lds, IN_QG(F) + j2 * 128, WSF(F, WS_ROPE_E), qb * 256);
        } else { const int v = u - 768, b = v / 12, h = v - b * 12, kvh = h / 3; const size_t rq = (size_t)(b * TPB + SEQ);
            const bf16* Kh = WSB(F, WS_P) + rq * EIN + 2048 + kvh * 128;
            att::attn_dense_body(WSB(F, WS_P) + rq * EIN + 512 + h * 128, Kh, Kh + 512, WSB(F, WS_MIX) + rq * DM + 512 + h * 128, CTXL, lds, IN_QG(F) + j2 * 128, nullptr, 0);
        }
    }
}
namespace ret {
constexpr int K_LD = 544, V_LD = 288, ST_LD = 544, Q_LD = 544;
constexpr int K_OFF = 0, V_OFF = 64 * K_LD, ST_OFF = V_OFF + 64 * V_LD, Q_OFF = ST_OFF + 128 * ST_LD, LDS_END = Q_OFF + 64 * Q_LD;
static_assert(LDS_END <= LDSCTL_OFF, "retention LDS");
typedef short v4i16_t __attribute__((ext_vector_type(4)));
__device__ __forceinline__ bf16x8 lds16(const LAS unsigned char* p) { return *(const LAS bf16x8*)p; }
__device__ __forceinline__ s16x4 ldstr(const LAS unsigned char* p) { return __builtin_bit_cast(s16x4, __builtin_amdgcn_ds_read_tr16_b64_v4i16((LAS v4i16_t*)p)); }
__device__ __forceinline__ bf16x8 cat8(s16x4 lo, s16x4 hi) { return (bf16x8){lo[0], lo[1], lo[2], lo[3], hi[0], hi[1], hi[2], hi[3]}; }
__device__ __forceinline__ bf16x8 pack8(const float* v) { const v4u w = {pk2(v[0], v[1]), pk2(v[2], v[3]), pk2(v[4], v[5]), pk2(v[6], v[7])}; return __builtin_bit_cast(bf16x8, w); }
#ifndef PROBE_RETBAR
#define PROBE_RETBAR 0
#endif
#define RET_BAR() do { asm volatile("s_waitcnt lgkmcnt(0)" ::: "memory"); __builtin_amdgcn_s_barrier(); if (PROBE_RETBAR) __builtin_amdgcn_s_barrier(); asm volatile("" ::: "memory"); } while (0)
#ifndef RET_EARLY_LOAD
#define RET_EARLY_LOAD 1
#endif
#ifndef RET_SBMASK
#define RET_SBMASK -1
#endif
#ifndef RET_NOSB
#define RET_NOSB 0
#endif
#define RET_SB() do { if (!RET_NOSB) __builtin_amdgcn_sched_barrier(0); } while (0)
#define RET_SBX(i) do { if (RET_SBMASK >= 0 && ((i) & RET_SBMASK) == RET_SBMASK) RET_SB(); } while (0)
__device__ __forceinline__ void ret_item(LAS unsigned char* lds, const bf16* P, bf16* Odir, int b, int h, int dir, int es, float lg) {
    int tid = threadIdx.x; asm volatile("" : "+v"(tid));
    const int w = __builtin_amdgcn_readfirstlane(tid >> 6), lane = tid & 63, g = lane >> 4, c = lane & 15, wi = w & 3, we = w >> 2, q4 = c >> 2, p4 = c & 3;
    const float lg2 = lg * 1.4426950408889634f;
    const bf16* Pq = P + h * 256 + (tid & 31) * 8; const bf16* Pk = Pq + 2048; const bf16* Pv = P + 4096 + h * 512 + es * 128 + (tid & 15) * 8;
    bf16* Oo = Odir + h * 512 + es * 128 + we * 64 + c;
    { unsigned z_ = 0u; asm volatile("" : "+v"(z_));
      for (int i = tid; i < 128 * ST_LD / 16; i += NWAVES * 64) *(LAS v4u*)(lds + ST_OFF + i * 16) = (v4u){z_, z_, z_, z_}; }
    f32x4 st[2][8];
#pragma unroll
    for (int a = 0; a < 2; ++a)
#pragma unroll
        for (int e = 0; e < 8; ++e) st[a][e] = (f32x4){0.f, 0.f, 0.f, 0.f};
    const int kr = tid >> 5, vr = tid >> 4;
    const float cd = __builtin_amdgcn_exp2f(64.0f * lg2);
    v4u kreg[4], qreg[4], vreg[2];
#define RET_ROWBASE(n) (dir == 0 ? (b * TPB + ((n) < 4 ? SEQ + 64 * (n) : 64 * (n) - CTXL)) : (b * TPB + ((n) < 4 ? SEQ + 255 - 64 * (n) : 2303 - 64 * (n))))
#define RET_LOAD(n) do { const int rb_ = RET_ROWBASE(n), sg_ = dir == 0 ? 1 : -1; \
        _Pragma("unroll") for (int x = 0; x < 4; ++x) { const size_t ro_ = (size_t)(rb_ + sg_ * (kr + 16 * x)) * OIN; kreg[x] = *(const GAS v4u*)(Pk + ro_); qreg[x] = *(const GAS v4u*)(Pq + ro_); } \
        _Pragma("unroll") for (int x = 0; x < 2; ++x) vreg[x] = *(const GAS v4u*)(Pv + (size_t)(rb_ + sg_ * (vr + 32 * x)) * OIN); } while (0)
    RET_LOAD(0);
    for (int n = 0; n < 36; ++n) {
        const int rowbase = RET_ROWBASE(n), sgn = dir == 0 ? 1 : -1;
#pragma unroll
        for (int x = 0; x < 4; ++x) { *(LAS v4u*)(lds + K_OFF + (kr + 16 * x) * K_LD + (tid & 31) * 16) = kreg[x]; *(LAS v4u*)(lds + Q_OFF + (kr + 16 * x) * Q_LD + (tid & 31) * 16) = qreg[x]; }
#pragma unroll
        for (int x = 0; x < 2; ++x) { const float kd = __builtin_amdgcn_exp2f((float)(63 - (vr + 32 * x)) * lg2); const v4u r = vreg[x];
            *(LAS v4u*)(lds + V_OFF + (vr + 32 * x) * V_LD + (tid & 15) * 16) = (v4u){pk2(bflo(r.x) * kd, bfhi(r.x) * kd), pk2(bflo(r.y) * kd, bfhi(r.y) * kd), pk2(bflo(r.z) * kd, bfhi(r.z) * kd), pk2(bflo(r.w) * kd, bfhi(r.w) * kd)}; }
        RET_BAR();
#if RET_EARLY_LOAD
        if (n + 1 < 36) RET_LOAD(n + 1);
#endif
        float lg2v = lg2; int gl = g, cl = c; asm volatile("" : "+v"(lg2v), "+v"(gl), "+v"(cl));
#define RD_Q(s)    lds16(lds + Q_OFF + (16 * wi + c) * Q_LD + (32 * (s) + 8 * g) * 2)
#define RD_K(jt, s) lds16(lds + K_OFF + (16 * (jt) + c) * K_LD + (32 * (s) + 8 * g) * 2)
#define RD_ST(et, s) lds16(lds + ST_OFF + (64 * we + 16 * (et) + c) * ST_LD + (32 * (s) + 8 * g) * 2)
        f32x4 sT[4], O[4];
#pragma unroll
        for (int jt = 0; jt < 4; ++jt) { sT[jt] = (f32x4){0.f, 0.f, 0.f, 0.f}; O[jt] = (f32x4){0.f, 0.f, 0.f, 0.f}; }
        {
            bf16x8 qc = RD_Q(0), qn = qc, kf[4], sf[4];
#pragma unroll
            for (int jt = 0; jt < 4; ++jt) kf[jt] = RD_K(jt, 0);
#pragma unroll
            for (int s = 0; s < 8; ++s) {
#pragma unroll
                for (int et = 0; et < 4; ++et) sf[et] = RD_ST(et, s);
                RET_SB();
#pragma unroll
                for (int jt = 0; jt < 4; ++jt) sT[jt] = __builtin_amdgcn_mfma_f32_16x16x32_bf16(kf[jt], qc, sT[jt], 0, 0, 0);
                RET_SB();
                if (s < 7) { qn = RD_Q(s + 1);
#pragma unroll
                    for (int jt = 0; jt < 4; ++jt) kf[jt] = RD_K(jt, s + 1); }
                RET_SB();
#pragma unroll
                for (int et = 0; et < 4; ++et) O[et] = __builtin_amdgcn_mfma_f32_16x16x32_bf16(qc, sf[et], O[et], 0, 0, 0);
                RET_SB();
                qc = qn;
            }
        }
        s16x4 vlo[4][2], vhi[4][2];
#pragma unroll
        for (int et = 0; et < 4; ++et)
#pragma unroll
            for (int s2 = 0; s2 < 2; ++s2) { const LAS unsigned char* vp = lds + V_OFF + (32 * s2 + 4 * g + q4) * V_LD + (64 * we + 16 * et + 4 * p4) * 2; vlo[et][s2] = ldstr(vp); vhi[et][s2] = ldstr(vp + 16 * V_LD); }
        RET_SB();
#pragma unroll
        for (int et = 0; et < 4; ++et) O[et] = O[et] * cd;
        bf16x8 pA[2];
#pragma unroll
        for (int s2 = 0; s2 < 2; ++s2) { float v[8];
#pragma unroll
            for (int jj = 0; jj < 8; ++jj) { const int jt = 2 * s2 + (jj >> 2), r = jj & 3, diff = (16 * wi + cl) - (16 * jt + 4 * gl + r);
                const bool keep = dir == 0 ? diff >= 0 : diff > 0;
                v[jj] = keep ? sT[jt][r] : 0.f; }
            pA[s2] = pack8(v); }
        RET_SB();
        s16x4 klo[2][2], khi[2][2];
#pragma unroll
        for (int s2 = 0; s2 < 2; ++s2)
#pragma unroll
            for (int dt = 0; dt < 2; ++dt) { const LAS unsigned char* kp = lds + K_OFF + (32 * s2 + 4 * g + q4) * K_LD + (32 * w + 8 * p4 + 4 * dt) * 2; klo[s2][dt] = ldstr(kp); khi[s2][dt] = ldstr(kp + 16 * K_LD); }
        RET_SB();
#pragma unroll
        for (int et = 0; et < 4; ++et)
#pragma unroll
            for (int s2 = 0; s2 < 2; ++s2) O[et] = __builtin_amdgcn_mfma_f32_16x16x32_bf16(pA[s2], cat8(vlo[et][s2], vhi[et][s2]), O[et], 0, 0, 0);
        RET_SB();
#define RD_V4(it) cat8(ldstr(lds + V_OFF + (32 * ((it) >> 3) + 4 * g + q4) * V_LD + (16 * ((it) & 7) + 4 * p4) * 2), ldstr(lds + V_OFF + (32 * ((it) >> 3) + 4 * g + q4 + 16) * V_LD + (16 * ((it) & 7) + 4 * p4) * 2))
        bf16x8 vbc = RD_V4(0), vbn = vbc;
        RET_SB();
#pragma unroll
        for (int a = 0; a < 2; ++a)
#pragma unroll
            for (int e = 0; e < 8; ++e) st[a][e] *= cd;
        bf16x8 ka[2][2];
#pragma unroll
        for (int s2 = 0; s2 < 2; ++s2)
#pragma unroll
            for (int dt = 0; dt < 2; ++dt) ka[s2][dt] = cat8(klo[s2][dt], khi[s2][dt]);
        { bf16* ob = Oo + (size_t)(dir == 0 ? rowbase : rowbase - 63) * OMIX;
#pragma unroll
            for (int r = 0; r < 4; ++r) { const int i = 16 * wi + 4 * g + r; const float rf = __builtin_amdgcn_exp2f((float)(16 * wi + 4 * gl + r - 63) * lg2v);
                const unsigned off = (unsigned)(dir == 0 ? i : 63 - i) * OMIX;
#pragma unroll
                for (int et = 0; et < 4; ++et) ob[off + 16 * et] = (bf16)(pk2(O[et][r] * rf, 0.f) & 0xffffu); } }
        RET_SB();
#pragma unroll
        for (int it = 0; it < 16; ++it) {
            if (it < 15) vbn = RD_V4(it + 1);
            RET_SB();
            st[0][it & 7] = __builtin_amdgcn_mfma_f32_16x16x32_bf16(ka[it >> 3][0], vbc, st[0][it & 7], 0, 0, 0);
            st[1][it & 7] = __builtin_amdgcn_mfma_f32_16x16x32_bf16(ka[it >> 3][1], vbc, st[1][it & 7], 0, 0, 0);
            RET_SB();
            vbc = vbn;
        }
#undef RD_Q
#undef RD_K
#undef RD_ST
#undef RD_V4
        RET_BAR();
        if (n + 1 < 36) {
#pragma unroll
            for (int et = 0; et < 8; ++et)
                *(LAS v4u*)(lds + ST_OFF + (16 * et + c) * ST_LD + (32 * w + 8 * g) * 2) = (v4u){pk2(st[0][et][0], st[0][et][1]), pk2(st[0][et][2], st[0][et][3]), pk2(st[1][et][0], st[1][et][1]), pk2(st[1][et][2], st[1][et][3])};
        }
    }
#undef RET_LOAD
#undef RET_ROWBASE
}

__device__ __forceinline__ void ret_item_spec(LAS unsigned char* lds, const bf16* P, bf16* Odir, int b, int h, int dir, int es, float lg, int noctx) {
    int tid = threadIdx.x; asm volatile("" : "+v"(tid));
    const int w = __builtin_amdgcn_readfirstlane(tid >> 6), lane = tid & 63, g = lane >> 4, c = lane & 15, q4 = c >> 2, p4 = c & 3;
    const float lg2 = lg * 1.4426950408889634f;
    const bf16* Pq = P + h * 256 + (tid & 31) * 8; const bf16* Pk = Pq + 2048; const bf16* Pv = P + 4096 + h * 512 + es * 128 + (tid & 15) * 8;
    { unsigned z_ = 0u; asm volatile("" : "+v"(z_));
      for (int i = tid; i < 128 * ST_LD / 16; i += NWAVES * 64) *(LAS v4u*)(lds + ST_OFF + i * 16) = (v4u){z_, z_, z_, z_}; }
    const int kr = (tid & 255) >> 5, vr = (tid & 255) >> 4;
    const float cd = __builtin_amdgcn_exp2f(64.0f * lg2);
#define RET_ROWBASE(n) (dir == 0 ? (b * TPB + ((n) < 4 ? SEQ + 64 * (n) : 64 * (n) - CTXL)) : (b * TPB + ((n) < 4 ? SEQ + 255 - 64 * (n) : 2303 - 64 * (n))))
#define RET_LOADA(n) do { const int rb_ = RET_ROWBASE(n), sg_ = dir == 0 ? 1 : -1; \
        _Pragma("unroll") for (int x = 0; x < 8; ++x) { const size_t ro_ = (size_t)(rb_ + sg_ * (kr + 8 * x)) * OIN; kreg[x] = *(const GAS v4u*)(Pk + ro_); qreg[x] = *(const GAS v4u*)(Pq + ro_); } } while (0)
#define RET_STAGEA() do { \
        _Pragma("unroll") for (int x = 0; x < 8; ++x) { *(LAS v4u*)(lds + K_OFF + (kr + 8 * x) * K_LD + (tid & 31) * 16) = kreg[x]; *(LAS v4u*)(lds + Q_OFF + (kr + 8 * x) * Q_LD + (tid & 31) * 16) = qreg[x]; } } while (0)
#define RET_LOADB(n) do { const int rb_ = RET_ROWBASE(n), sg_ = dir == 0 ? 1 : -1; \
        _Pragma("unroll") for (int x = 0; x < 4; ++x) vreg[x] = *(const GAS v4u*)(Pv + (size_t)(rb_ + sg_ * (vr + 16 * x)) * OIN); } while (0)
#define RET_STAGEB() do { \
        _Pragma("unroll") for (int x = 0; x < 4; ++x) { const float kd = __builtin_amdgcn_exp2f((float)(63 - (vr + 16 * x)) * lg2); const v4u r = vreg[x]; \
            *(LAS v4u*)(lds + V_OFF + (vr + 16 * x) * V_LD + (tid & 15) * 16) = (v4u){pk2(bflo(r.x) * kd, bfhi(r.x) * kd), pk2(bflo(r.y) * kd, bfhi(r.y) * kd), pk2(bflo(r.z) * kd, bfhi(r.z) * kd), pk2(bflo(r.w) * kd, bfhi(r.w) * kd)}; } } while (0)
    if (w < 4) {
        const int wa = w;
        bf16* Oo = Odir + h * 512 + es * 128 + c;
        v4u kreg[8], qreg[8];
        RET_LOADA(0);
        for (int n = 0; n < 36; ++n) {
            const int rowbase = RET_ROWBASE(n);
            RET_STAGEA();
            RET_BAR();
            if (n + 1 < 36) RET_LOADA(n + 1);
            if (!(noctx && n < 4)) {
            float lg2v = lg2; int gl = g, cl = c; asm volatile("" : "+v"(lg2v), "+v"(gl), "+v"(cl));
#define RD_Q(s)    lds16(lds + Q_OFF + (16 * wa + c) * Q_LD + (32 * (s) + 8 * g) * 2)
#define RD_K(jt, s) lds16(lds + K_OFF + (16 * (jt) + c) * K_LD + (32 * (s) + 8 * g) * 2)
#define RD_ST(et, s) lds16(lds + ST_OFF + (16 * (et) + c) * ST_LD + (32 * (s) + 8 * g) * 2)
            f32x4 sT[4], O[8];
#pragma unroll
            for (int jt = 0; jt < 4; ++jt) sT[jt] = (f32x4){0.f, 0.f, 0.f, 0.f};
#pragma unroll
            for (int et = 0; et < 8; ++et) O[et] = (f32x4){0.f, 0.f, 0.f, 0.f};
            {
                bf16x8 q0 = RD_Q(0), q1, k0[4], k1[4], sf[8];
#pragma unroll
                for (int jt = 0; jt < 4; ++jt) k0[jt] = RD_K(jt, 0);
#pragma unroll
                for (int s = 0; s < 8; s += 2) {
                    q1 = RD_Q(s + 1);
#pragma unroll
                    for (int jt = 0; jt < 4; ++jt) k1[jt] = RD_K(jt, s + 1);
#pragma unroll
                    for (int et = 0; et < 8; ++et) sf[et] = RD_ST(et, s);
                    RET_SB();
#pragma unroll
                    for (int jt = 0; jt < 4; ++jt) sT[jt] = __builtin_amdgcn_mfma_f32_16x16x32_bf16(k0[jt], q0, sT[jt], 0, 0, 0);
                    RET_SB();
#pragma unroll
                    for (int et = 0; et < 8; ++et) O[et] = __builtin_amdgcn_mfma_f32_16x16x32_bf16(q0, sf[et], O[et], 0, 0, 0);
                    RET_SB();
                    if (s + 2 < 8) { q0 = RD_Q(s + 2);
#pragma unroll
                        for (int jt = 0; jt < 4; ++jt) k0[jt] = RD_K(jt, s + 2); }
#pragma unroll
                    for (int et = 0; et < 8; ++et) sf[et] = RD_ST(et, s + 1);
                    RET_SB();
#pragma unroll
                    for (int jt = 0; jt < 4; ++jt) sT[jt] = __builtin_amdgcn_mfma_f32_16x16x32_bf16(k1[jt], q1, sT[jt], 0, 0, 0);
                    RET_SB();
#pragma unroll
                    for (int et = 0; et < 8; ++et) O[et] = __builtin_amdgcn_mfma_f32_16x16x32_bf16(q1, sf[et], O[et], 0, 0, 0);
                    RET_SB();
                }
            }
#pragma unroll
            for (int et = 0; et < 8; ++et) O[et] = O[et] * cd;
            bf16x8 pA[2];
#pragma unroll
            for (int s2 = 0; s2 < 2; ++s2) { float v[8];
#pragma unroll
                for (int jj = 0; jj < 8; ++jj) { const int jt = 2 * s2 + (jj >> 2), r = jj & 3, diff = (16 * wa + cl) - (16 * jt + 4 * gl + r);
                    const bool keep = dir == 0 ? diff >= 0 : diff > 0;
                    v[jj] = keep ? sT[jt][r] : 0.f; }
                pA[s2] = pack8(v); }
            RET_SB();
            {
#define RD_VA(et, s2) cat8(ldstr(lds + V_OFF + (32 * (s2) + 4 * g + q4) * V_LD + (16 * (et) + 4 * p4) * 2), ldstr(lds + V_OFF + (32 * (s2) + 4 * g + q4 + 16) * V_LD + (16 * (et) + 4 * p4) * 2))
                bf16x8 va[2][2], vb[2][2];
#pragma unroll
                for (int q = 0; q < 2; ++q) { va[q][0] = RD_VA(q, 0); va[q][1] = RD_VA(q, 1); }
#pragma unroll
                for (int et = 0; et < 8; et += 4) {
#pragma unroll
                    for (int q = 0; q < 2; ++q) { vb[q][0] = RD_VA(et + 2 + q, 0); vb[q][1] = RD_VA(et + 2 + q, 1); }
                    RET_SB();
#pragma unroll
                    for (int q = 0; q < 2; ++q) { O[et + q] = __builtin_amdgcn_mfma_f32_16x16x32_bf16(pA[0], va[q][0], O[et + q], 0, 0, 0); O[et + q] = __builtin_amdgcn_mfma_f32_16x16x32_bf16(pA[1], va[q][1], O[et + q], 0, 0, 0); }
                    RET_SB();
                    if (et + 4 < 8) {
#pragma unroll
                        for (int q = 0; q < 2; ++q) { va[q][0] = RD_VA(et + 4 + q, 0); va[q][1] = RD_VA(et + 4 + q, 1); } }
                    RET_SB();
#pragma unroll
                    for (int q = 0; q < 2; ++q) { O[et + 2 + q] = __builtin_amdgcn_mfma_f32_16x16x32_bf16(pA[0], vb[q][0], O[et + 2 + q], 0, 0, 0); O[et + 2 + q] = __builtin_amdgcn_mfma_f32_16x16x32_bf16(pA[1], vb[q][1], O[et + 2 + q], 0, 0, 0); }
                    RET_SB();
                }
#undef RD_VA
            }
            {
                bf16* ob = Oo + (size_t)(dir == 0 ? rowbase : rowbase - 63) * OMIX;
#pragma unroll
                for (int r = 0; r < 4; ++r) { const int i = 16 * wa + 4 * g + r; const float rf = __builtin_amdgcn_exp2f((float)(16 * wa + 4 * gl + r - 63) * lg2v);
                    const unsigned off = (unsigned)(dir == 0 ? i : 63 - i) * OMIX;
#pragma unroll
                    for (int et = 0; et < 8; ++et) ob[off + 16 * et] = (bf16)(pk2(O[et][r] * rf, 0.f) & 0xffffu); }
            }
#undef RD_Q
#undef RD_K
#undef RD_ST
            }
            RET_BAR();
        }
    } else {
        const int wb = w - 4;
        v4u vreg[4];
        RET_LOADB(0);
        f32x4 st[2][2][8];
#pragma unroll
        for (int a = 0; a < 2; ++a)
#pragma unroll
            for (int d = 0; d < 2; ++d)
#pragma unroll
                for (int e = 0; e < 8; ++e) st[a][d][e] = (f32x4){0.f, 0.f, 0.f, 0.f};
        for (int n = 0; n < 36; ++n) {
            RET_STAGEB();
            RET_BAR();
            if (n + 1 < 36) RET_LOADB(n + 1);
            bf16x8 ka[2][2][2];
#pragma unroll
            for (int s2 = 0; s2 < 2; ++s2)
#pragma unroll
                for (int dp = 0; dp < 2; ++dp)
#pragma unroll
                    for (int dt = 0; dt < 2; ++dt) { const LAS unsigned char* kp = lds + K_OFF + (32 * s2 + 4 * g + q4) * K_LD + (64 * wb + 32 * dp + 8 * p4 + 4 * dt) * 2; ka[s2][dp][dt] = cat8(ldstr(kp), ldstr(kp + 16 * K_LD)); }
#define RD_V4(it) cat8(ldstr(lds + V_OFF + (32 * ((it) >> 3) + 4 * g + q4) * V_LD + (16 * ((it) & 7) + 4 * p4) * 2), ldstr(lds + V_OFF + (32 * ((it) >> 3) + 4 * g + q4 + 16) * V_LD + (16 * ((it) & 7) + 4 * p4) * 2))
            bf16x8 vbc = RD_V4(0), vbn = vbc;
            RET_SB();
#pragma unroll
            for (int a = 0; a < 2; ++a)
#pragma unroll
                for (int d = 0; d < 2; ++d)
#pragma unroll
                    for (int e = 0; e < 8; ++e) st[a][d][e] *= cd;
            RET_SB();
#pragma unroll
            for (int it = 0; it < 16; ++it) {
                if (it < 15) vbn = RD_V4(it + 1);
                RET_SB();
#pragma unroll
                for (int dp = 0; dp < 2; ++dp)
#pragma unroll
                    for (int dt = 0; dt < 2; ++dt) st[dp][dt][it & 7] = __builtin_amdgcn_mfma_f32_16x16x32_bf16(ka[it >> 3][dp][dt], vbc, st[dp][dt][it & 7], 0, 0, 0);
                RET_SB();
                vbc = vbn;
            }
#undef RD_V4
            RET_BAR();
            if (n + 1 < 36) {
#pragma unroll
                for (int dp = 0; dp < 2; ++dp)
#pragma unroll
                    for (int et = 0; et < 8; ++et)
                        *(LAS v4u*)(lds + ST_OFF + (16 * et + c) * ST_LD + (64 * wb + 32 * dp + 8 * g) * 2) = (v4u){pk2(st[dp][0][et][0], st[dp][0][et][1]), pk2(st[dp][0][et][2], st[dp][0][et][3]), pk2(st[dp][1][et][0], st[dp][1][et][1]), pk2(st[dp][1][et][2], st[dp][1][et][3])};
            }
        }
    }
#undef RET_LOADA
#undef RET_STAGEA
#undef RET_LOADB
#undef RET_STAGEB
#undef RET_ROWBASE
}
}
__device__ __forceinline__ void ph_retention(Frame& F, const Args& A, int j2, int noctx) {
    for (int item = F.vcu; item < 512; item += F.G) {
        const int es = item & 3, dir = (item >> 2) & 1, h = (item >> 3) & 7, b = item >> 6;
        const float lg = (dir ? IN_LDB(F) : IN_LDF(F))[j2 * 8 + h];
#ifndef RET_SPEC
#define RET_SPEC 1
#endif
#if RET_SPEC
        ret::ret_item_spec(F.lds + RING_OFF, WSB(F, WS_P), dir ? WSB(F, WS_OB) : WSB(F, WS_OF), b, h, dir, es, lg, noctx);
#else
        ret::ret_item(F.lds + RING_OFF, WSB(F, WS_P), dir ? WSB(F, WS_OB) : WSB(F, WS_OF), b, h, dir, es, lg);
#endif
    }
}
__global__ void __launch_bounds__(NWAVES * 64, 2) dit_fwd(Args args) {
    extern __shared__ __attribute__((aligned(16))) unsigned char lds[];
    Frame F0;
    F0.lds = (LAS unsigned char*)lds;
    F0.MISC = (volatile LAS unsigned*)(F0.lds + MISC_OFF);
    F0.wave = __builtin_amdgcn_readfirstlane((int)threadIdx.x >> 6);
    F0.G = gridDim.x; { const int bx = blockIdx.x; F0.vcu = (F0.G % 8 == 0) ? (bx % 8) * (F0.G / 8) + bx / 8 : bx; }
    F0.ws = (GAS unsigned char*)args.ws; F0.out = (GAS float*)args.out;
    F0.ctl = (gu32*)(F0.ws + WS_CTL);
    for (int u = threadIdx.x; u < (LDS_BYTES - LDSCTL_OFF) / 4; u += NWAVES * 64) ((LAS unsigned*)(F0.lds + LDSCTL_OFF))[u] = 0u;
    __syncthreads();
    XcdBarrier bar; bar.bar = (unsigned*)(F0.ctl + CW_BAR); bar.x = 0; bar.st = nullptr;
    if (MK_N_LAUNCHES == 1) bar = xcd_barrier_post((unsigned*)(F0.ctl + CW_BAR), F0.MISC + 8);
    const int lo = args.ph_lo, hi = args.ph_hi;
#ifndef RESID_G
#define RESID_G 0
#endif
#ifndef GEMM_SP2
#define GEMM_SP2 true
#endif
#ifndef GEMM_ALIGN
#define GEMM_ALIGN true
#endif
#ifndef PROBE_BAR2
#define PROBE_BAR2 0
#endif
#ifndef SPLITK
#define SPLITK 0
#endif
#ifndef SITE_MASK
#define SITE_MASK 0xffffffffu
#endif
#define SITE(n) (((SITE_MASK) >> (n)) & 1u)
#define IN(k) (lo <= (k) && (k) < hi)
#define SEAM(k) do { if ((k) + 1 < hi) { if (MK_N_LAUNCHES == 1) { XcdBarrier bv_ = bar; asm volatile("" : "+s"(bv_.bar)); xcd_barrier(bv_); if (PROBE_BAR2) { XcdBarrier bw_ = bar; asm volatile("" : "+s"(bw_.bar)); xcd_barrier(bw_); } } } } while (0)
#define LAUNDER(Fv) Frame Fv = F0; asm volatile("" : "+s"(Fv.ws), "+s"(Fv.out), "+s"(Fv.G), "+s"(Fv.vcu), "+s"(Fv.wave), "+s"(cid))
#define GEMM_CALL1(EPI, g_, S_, E_) pg8::gemm_phase<EPI, pg8::TokOrder, GEMM_ALIGN, GEMM_SP2>(F.lds + RING_OFF, g_, S_, E_)
#ifdef PROBE_GEMM_STORE2
#define GEMM_CALL(EPI, g_, S_, E_) do { for (int rep_ = 0; rep_ < 2; ++rep_) { GEMM_CALL1(EPI, g_, S_, E_); __syncthreads(); } } while (0)
#else
#define GEMM_CALL(EPI, g_, S_, E_) GEMM_CALL1(EPI, g_, S_, E_)
#endif
#ifdef PROBE_GEMM_RESID2
#define GEMM_CALLR(g_, S_, E_) do { pg8::EpiResid E2_ = E_; for (int rep_ = 0; rep_ < 2; ++rep_) { E2_.dry = rep_; GEMM_CALL1(pg8::EpiResid, g_, S_, E2_); __syncthreads(); } } while (0)
#else
#define GEMM_CALLR(g_, S_, E_) GEMM_CALL1(pg8::EpiResid, g_, S_, E_)
#endif
    int cid = (int)blockIdx.x;

    if (SITE(0) && IN(0)) { LAUNDER(F); ph_prologue(F, args);
#ifdef PROBE_PRO2
        __syncthreads(); { LAUNDER(F2); ph_prologue(F2, args); }
#endif
        SEAM(0); }
    for (int L = 0; L < 4; ++L) {
        const int pb = 1 + 9 * L, j2 = L >> 1, even = !(L & 1), last = (L == 3);
        if (SITE(1) && IN(pb + 0)) { LAUNDER(F); ph_modulate(F, args, L, 0, 0, SPLITK && L >= 1, L == 0);
#ifdef PROBE_MOD2
            { LAUNDER(F2); ph_modulate(F2, args, L, 0, 0, 0, L == 0); }
#endif
            SEAM(pb + 0); }
        if (SITE(2) && IN(pb + 1)) { LAUNDER(F);
            const int N = even ? EIN : OIN;
            pg8::Gemm g{WSB(F, WS_XN), even ? WSB(F, WS_W_INE) + (size_t)j2 * EIN * DM : WSB(F, WS_W_INO) + (size_t)j2 * OIN * DM, MROWS, N, DM};
            pg8::TokOrder S; if (last) S.init2(MLAT, N, DM, F.G, cid, 1, 0, 1); else S.init2(MROWS, N, DM, F.G, cid, 0, 0);
            pg8::EpiStore E{WSB(F, WS_P), N, even ? 0 : 3, WSF(F, WS_ROPE_O)};
            GEMM_CALL(pg8::EpiStore, g, S, E);
            SEAM(pb + 1);
        }
        if (even) {
            if (SITE(3) && IN(pb + 2)) { LAUNDER(F); ph_qk_even(F, args, j2); SEAM(pb + 2); }
            if (IN(pb + 3)) {
                if (SITE(4)) { LAUNDER(F); pg8::Gemm g{WSB(F, WS_WTL), WSB(F, WS_FT), 4096, 4096, 2048}; pg8::TokOrder S; S.init2(4096, 4096, 2048, F.G, cid, 0, 0); pg8::EpiStore E{WSB(F, WS_Z), 1024, 1, nullptr}; GEMM_CALL(pg8::EpiStore, g, S, E); }
                if (SITE(14)) { LAUNDER(F); pg8::Gemm g{WSB(F, WS_WTC), WSB(F, WS_FTC), 512, 4096, 256}; pg8::TokOrder S; S.init2(512, 4096, 256, F.G, cid, 0, 0); pg8::EpiStore E{WSB(F, WS_Z), 1024, 2, nullptr}; GEMM_CALL(pg8::EpiStore, g, S, E); }
                if (SITE(5)) { LAUNDER(F); ph_attention(F, args, j2); }
#ifdef PROBE_ATT2
                { LAUNDER(F); ph_attention(F, args, j2); }
#endif
                SEAM(pb + 3);
            }
            if (SITE(6) && IN(pb + 4)) { LAUNDER(F);
                pg8::Gemm g{WSB(F, WS_Z), WSB(F, WS_CB), MROWS, 512, 1024}; pg8::TokOrder S; S.init2(MROWS, 512, 1024, F.G, cid, 0, 0); pg8::EpiStore E{WSB(F, WS_MIX), DM, 0, nullptr};
                GEMM_CALL(pg8::EpiStore, g, S, E);
                SEAM(pb + 4);
            }
        } else {
            if (SITE(8) && IN(pb + 3)) { LAUNDER(F); ph_retention(F, args, j2, last);
#ifdef PROBE_RET2
                { LAUNDER(F2); ph_retention(F2, args, j2, last); }
#endif
                SEAM(pb + 3); }
            if (SITE(9) && IN(pb + 4)) { LAUNDER(F); ph_comb(F, last);
#ifdef PROBE_COMB2
                { LAUNDER(F2); ph_comb(F2, last, 1); }
#endif
                SEAM(pb + 4); }
        }
        if (SITE(10) && IN(pb + 5)) { LAUNDER(F); const float* gates = WSF(F, WS_MOD) + (size_t)L * NSET * MODW;
            const int K = even ? DM : OMIX, Ml = last ? MLAT : MROWS;
            pg8::Gemm g{even ? WSB(F, WS_MIX) : WSB(F, WS_OF), even ? WSB(F, WS_W_OUTE) + (size_t)j2 * DM * DM : WSB(F, WS_W_OUTO) + (size_t)j2 * DM * OMIX, Ml, DM, K};
            pg8::TokOrder S; S.init2(Ml, DM, K, F.G, cid, last, SPLITK && L > 0, 0, last ? 0 : RESID_G);
            pg8::EpiResid E{WSF(F, WS_H), gates, 2 * DM, nullptr, WSF(F, WS_DELTA), 0, L == 0 ? (const float*)(const GAS float*)args.in[0] : nullptr, (const float*)(const GAS float*)args.in[2]};
            GEMM_CALLR(g, S, E);
            SEAM(pb + 5);
        }
        if (SITE(11) && IN(pb + 6)) { LAUNDER(F); ph_modulate(F, args, L, 1, last, SPLITK && !last && L > 0, 0);
#ifdef PROBE_MOD2
            { LAUNDER(F2); ph_modulate(F2, args, L, 1, last, 0, 0); }
#endif
            SEAM(pb + 6); }
        if (SITE(12) && IN(pb + 7)) { LAUNDER(F);
            const int Ml = last ? MLAT : MROWS;
            pg8::Gemm g{WSB(F, WS_XN), WSB(F, WS_W_FIN) + (size_t)L * FFN2 * DM, Ml, FFN2, DM};
            pg8::TokOrder S; S.init2(Ml, FFN2, DM, F.G, cid, last, 0);
            pg8::EpiSwiglu E{WSB(F, WS_P), FFN};
            GEMM_CALL(pg8::EpiSwiglu, g, S, E);
            SEAM(pb + 7);
        }
        if (SITE(13) && IN(pb + 8)) { LAUNDER(F); const float* gates = WSF(F, WS_MOD) + (size_t)L * NSET * MODW;
            const int Ml = last ? MLAT : MROWS;
            pg8::Gemm g{WSB(F, WS_P), WSB(F, WS_W_FOUT) + (size_t)L * DM * FFN, Ml, DM, FFN};
            pg8::TokOrder S; S.init2(Ml, DM, FFN, F.G, cid, last, SPLITK, 0, last ? 0 : RESID_G);
            pg8::EpiResid E{WSF(F, WS_H), gates, 5 * DM, last ? (float*)F.out : nullptr, WSF(F, WS_DELTA), 0, nullptr, nullptr};
            GEMM_CALLR(g, S, E);
            SEAM(pb + 8);
        }
    }
#undef IN
#undef SEAM
#undef LAUNDER
#undef GEMM_CALL
}

extern "C" void kernel_launch(void* const* d_in, const int* in_sizes, int n_in, void* d_out, int out_size, void* d_ws, size_t ws_size, hipStream_t stream) {
    static int grid = 0;
    if (grid == 0) {
        if (n_in != 16 || out_size != MLAT * DM || ws_size < WS_END) { fprintf(stderr, "kernel_launch: unexpected shapes: n_in %d out %d ws %zu (need %zu)\n", n_in, out_size, ws_size, (size_t)WS_END); grid = -1; return; }
        int dev = 0, cus = 0, per_cu = 0;
        if (hipGetDevice(&dev) != hipSuccess || hipDeviceGetAttribute(&cus, hipDeviceAttributeMultiprocessorCount, dev) != hipSuccess) { fprintf(stderr, "kernel_launch: device query failed\n"); grid = -1; return; }
        if (hipFuncSetAttribute((const void*)dit_fwd, hipFuncAttributeMaxDynamicSharedMemorySize, LDS_BYTES) != hipSuccess) { fprintf(stderr, "kernel_launch: hipFuncSetAttribute failed\n"); grid = -1; return; }
        if (hipOccupancyMaxActiveBlocksPerMultiprocessor(&per_cu, (const void*)dit_fwd, NWAVES * 64, LDS_BYTES) != hipSuccess || per_cu < 1)
            fprintf(stderr, "kernel_launch: note: occupancy query reports %d workgroups per CU\n", per_cu);
        (void)hipGetLastError();
        grid = cus;
    }
    if (grid < 0) return;
    if (hipMemsetAsync((char*)d_ws + WS_CTL, 0, CTL_ZERO_BYTES, stream) != hipSuccess) { fprintf(stderr, "kernel_launch: memset failed\n"); return; }
    Args a{};
    for (int i = 0; i < 16; ++i) a.in[i] = (const float*)d_in[i];
    a.out = (float*)d_out; a.ws = (unsigned char*)d_ws;
#if MK_N_LAUNCHES == 1
    a.ph_lo = 0; a.ph_hi = N_PHASES;
    hipLaunchKernelGGL(dit_fwd, dim3(grid), dim3(NWAVES * 64), LDS_BYTES, stream, a);
#else
    for (int p = 0; p < N_PHASES; ++p) { a.ph_lo = p; a.ph_hi = p + 1; hipLaunchKernelGGL(dit_fwd, dim3(grid), dim3(NWAVES * 64), LDS_BYTES, stream, a); }
#endif
    const hipError_t le = hipPeekAtLastError();
    if (le != hipSuccess) fprintf(stderr, "kernel_launch: launch failed: %s\n", hipGetErrorName(le));
}
```

```cpp
#include <hip/hip_runtime.h>
#include <cstdio>
#include <cstdint>
#include <cmath>
#ifndef WGM_SET
#define WGM_SET 8
#endif
namespace pg8 {
#define PG8_LAS __attribute__((address_space(3)))
typedef unsigned short bf16_t;
typedef short bf16x8 __attribute__((ext_vector_type(8)));
typedef float f32x4 __attribute__((ext_vector_type(4)));
typedef unsigned u32x4 __attribute__((ext_vector_type(4)));
constexpr int BM = 256, BK = 64, HALF = 128, HTB = HALF * BK * 2  , STAGE_BYTES = 8 * HTB, NXCD = 8, WGM = WGM_SET;

__host__ __device__ __forceinline__ int lds_byte(int r, int c) { const int st = (r >> 4) * 2 + (c >> 5), rr = r & 15, cc = c & 31, ob = rr * 64 + cc * 2; return st * 1024 + (ob ^ (((ob >> 9) & 1) << 5)); }
__host__ __device__ __forceinline__ void stage_rc(int b, int& R, int& C) { const int st = b / 1024, sb = b % 1024, swz = sb ^ (((sb >> 9) & 1) << 5); R = (st >> 1) * 16 + swz / 64; C = (st & 1) * 32 + (swz % 64) / 2; }
__host__ __device__ __forceinline__ int perm32(int rho) { const int n = rho >> 4, i = rho & 15; return 8 * (i >> 2) + 4 * n + (i & 3); }

struct Unit { int pm, pn, kt0, nkt, split; };
struct Gemm { const bf16_t* A; const bf16_t* Bt; int M, N, K; };

#ifndef WGM_WIDE
#define WGM_WIDE WGM
#endif
#ifndef WGM_NARROW
#define WGM_NARROW 2
#endif
struct StaticOrder {
    int nM, nN, nwg, G, c;
    __host__ __device__ void init(int M, int N, int G_, int c_) { nM = M / BM; nN = N / BM; nwg = nM * nN; G = G_; c = c_; }
    __host__ __device__ void map(int wgid, Unit& u) const {
        { const int q = nwg / NXCD, r = nwg % NXCD, xcd = wgid % NXCD, off = wgid / NXCD; wgid = (xcd < r ? xcd * (q + 1) : r * (q + 1) + (xcd - r) * q) + off; }
        const int wgm = nN >= 12 ? WGM_WIDE : WGM_NARROW;
        const int nig = wgm * nN, gid = wgid / nig, fm = gid * wgm, gsz = (nM - fm) < wgm ? (nM - fm) : wgm;
        u.pm = fm + ((wgid % nig) % gsz); u.pn = (wgid % nig) / gsz;
    }
    __device__ __forceinline__ void a_ready(const Unit&) const {}
    __device__ __forceinline__ void done(const Unit&) const {}
};

typedef __bf16 bf16x2_cv __attribute__((ext_vector_type(2)));
typedef float f32x2_cv __attribute__((ext_vector_type(2)));
__device__ __forceinline__ unsigned cvt_pk_bf16(float lo, float hi) { const f32x2_cv v = {lo, hi}; const bf16x2_cv b = __builtin_convertvector(v, bf16x2_cv); return __builtin_bit_cast(unsigned, b); }
typedef float f32x2 __attribute__((ext_vector_type(2)));
#ifndef WT_STORES
#define WT_STORES 0
#endif
__device__ __forceinline__ void st16_wt(void* p, u32x4 v) {
#if WT_STORES
    asm volatile("global_store_dwordx4 %0, %1, off sc1" :: "v"(p), "v"(v) : "memory");
#else
    *(u32x4*)p = v;
#endif
}
__device__ __forceinline__ void st16_wt(void* p, f32x4 v) { st16_wt(p, __builtin_bit_cast(u32x4, v)); }
#ifndef WT_HID
#define WT_HID 0
#endif
__device__ __forceinline__ void st16_hid(void* p, u32x4 v) {
#if WT_HID
    asm volatile("global_store_dwordx4 %0, %1, off sc1" :: "v"(p), "v"(v) : "memory");
#else
    *(u32x4*)p = v;
#endif
}
#ifndef GEMM_G_LIMIT
#define GEMM_G_LIMIT 0
#endif
struct TokOrder : StaticOrder {
    int skip, nktfull, nfull, rem, S, nextra;
    __device__ __forceinline__ void init2(int M, int N, int K, int G_, int c_, int skip_, int allow_split, int ctxkv = 0, int glimit = 0) {
        init(M, N, G_, c_); if (glimit > 0 && glimit < G_) G = glimit;     if (GEMM_G_LIMIT > 0 && GEMM_G_LIMIT < G_) { G = GEMM_G_LIMIT; }     skip = skip_; nktfull = K / BK; nfull = (nwg / G) * G; rem = nwg - nfull; S = 1; nextra = ctxkv ? 8 * 24 : 0;
        if (allow_split && rem > 0) { const int s = G / rem; S = s >= 4 ? 4 : 1;     if ((nktfull % (2 * S)) != 0 || nktfull / S < 4) S = 1; }
    }
    __device__ __forceinline__ bool next(int i, Unit& u) const {
        if (c >= G) return false;
        const long L = (long)i * G + c; int idx;
        if (L < nfull || S == 1) {
            if (L >= nwg) { const int r = (int)(L - nwg); if (r >= nextra) return false; u.kt0 = 0; u.nkt = nktfull; u.split = 0; u.pm = 9 * (r / 24) + 8; u.pn = 8 + r % 24; return true; }
            idx = (int)L; u.kt0 = 0; u.nkt = nktfull; u.split = 0; }
        else { const int sub = (int)(L - nfull); if (sub >= rem * S) return false; idx = nfull + sub / S; u.nkt = nktfull / S; u.kt0 = (sub % S) * u.nkt; u.split = 1 + (sub / S) * 4 + (sub % S); }
        map(idx, u); if (skip) u.pm += (u.pm >> 3); return true;
    }
};
struct EpiStore {
    static constexpr bool PERM = true, AFTER_DRAIN = false;
    bf16_t* O; int ldc; int mode; const float* rope;
    __device__ __forceinline__ void operator()(const f32x4 (&acc)[2][2][4][2], const Unit& u, int wr, int wc, int fr, int fq) const {
        size_t base;
        if (mode == 0 || mode == 3) base = (size_t)u.pm * BM * (size_t)ldc + (size_t)u.pn * BM;
        else if (mode == 1) { const int part = u.pm >> 3, t0 = (u.pm & 7) * 256, b = u.pn >> 1, c0 = (u.pn & 1) * 256; base = ((size_t)(b * 2304 + t0)) * 1024 + part * 512 + c0; }
        else { const int part = u.pm, b = u.pn >> 1, c0 = (u.pn & 1) * 256; base = ((size_t)(b * 2304 + 2048)) * 1024 + part * 512 + c0; }
        const int tt = u.pm % 9;
        if (mode == 3 && u.pn < 16 && tt != 8) {
            const int half = wc >> 1, f0 = 32 * (wc & 1) + 8 * fq;
            bf16_t* p0 = O + base + (size_t)(wr * 64 + fr) * ldc + half * 128 + f0;
#pragma unroll
            for (int ai = 0; ai < 2; ++ai)
#pragma unroll
                for (int m = 0; m < 4; ++m) { const int t = tt * 256 + ai * HALF + wr * 64 + m * 16 + fr, pos = half ? (t & 63) : (t >> 6);
                    const f32x4* tb = (const f32x4*)(rope + (size_t)(pos * 64 + f0) * 2);
                    const f32x4 t0 = tb[0], t1 = tb[1], t2 = tb[2], t3 = tb[3];
                    const f32x4 a0 = acc[ai][0][m][0], a1 = acc[ai][0][m][1], b0 = acc[ai][1][m][0], b1 = acc[ai][1][m][1];
                    const f32x4 cs0 = {t0[0], t0[2], t1[0], t1[2]}, sn0 = {t0[1], t0[3], t1[1], t1[3]}, cs1 = {t2[0], t2[2], t3[0], t3[2]}, sn1 = {t2[1], t2[3], t3[1], t3[3]};
                    const f32x4 x0 = a0 * cs0 - b0 * sn0, x1 = a1 * cs1 - b1 * sn1, y0 = b0 * cs0 + a0 * sn0, y1 = b1 * cs1 + a1 * sn1;
                    bf16_t* rowp = p0 + (size_t)(ai * HALF + m * 16) * ldc;
                    u32x4 w; w.x = cvt_pk_bf16(x0[0], x0[1]); w.y = cvt_pk_bf16(x0[2], x0[3]); w.z = cvt_pk_bf16(x1[0], x1[1]); w.w = cvt_pk_bf16(x1[2], x1[3]);
                    st16_wt(rowp, w);
                    w.x = cvt_pk_bf16(y0[0], y0[1]); w.y = cvt_pk_bf16(y0[2], y0[3]); w.z = cvt_pk_bf16(y1[0], y1[1]); w.w = cvt_pk_bf16(y1[2], y1[3]);
                    st16_wt(rowp + 64, w); }
            return;
        }
        if (mode == 3 && u.pn < 16) {
            const int half = wc >> 1, f0 = 32 * (wc & 1) + 8 * fq;
            bf16_t* p0 = O + base + (size_t)(wr * 64 + fr) * ldc + half * 128 + f0;
#pragma unroll
            for (int ai = 0; ai < 2; ++ai)
#pragma unroll
                for (int m = 0; m < 4; ++m) { bf16_t* rowp = p0 + (size_t)(ai * HALF + m * 16) * ldc;
#pragma unroll
                    for (int bj = 0; bj < 2; ++bj) { const f32x4 v0 = acc[ai][bj][m][0], v1 = acc[ai][bj][m][1];
                        u32x4 w; w.x = cvt_pk_bf16(v0[0], v0[1]); w.y = cvt_pk_bf16(v0[2], v0[3]); w.z = cvt_pk_bf16(v1[0], v1[1]); w.w = cvt_pk_bf16(v1[2], v1[3]);
                        st16_wt(rowp + bj * 64, w); } }
            return;
        }
        bf16_t* p0 = O + base + (size_t)(wr * 64 + fr) * ldc + wc * 32 + 8 * fq;
#pragma unroll
        for (int ai = 0; ai < 2; ++ai)
#pragma unroll
            for (int m = 0; m < 4; ++m) { bf16_t* rowp = p0 + (size_t)(ai * HALF + m * 16) * ldc;
#pragma unroll
                for (int bj = 0; bj < 2; ++bj) { const f32x4 v0 = acc[ai][bj][m][0], v1 = acc[ai][bj][m][1];
                    u32x4 w; w.x = cvt_pk_bf16(v0[0], v0[1]); w.y = cvt_pk_bf16(v0[2], v0[3]); w.z = cvt_pk_bf16(v1[0], v1[1]); w.w = cvt_pk_bf16(v1[2], v1[3]);
                    st16_wt(rowp + bj * HALF, w); } }
    }
};
__device__ __forceinline__ float silu_f(float g) { return g * __builtin_amdgcn_rcpf(1.0f + __builtin_amdgcn_exp2f(-1.4426950408889634f * g)); }
struct EpiSwiglu {
    static constexpr bool PERM = true, AFTER_DRAIN = false;
    bf16_t* H; int ldh;
    __device__ __forceinline__ void operator()(const f32x4 (&acc)[2][2][4][2], const Unit& u, int wr, int wc, int fr, int fq) const {
        bf16_t* p0 = H + (size_t)(u.pm * BM + wr * 64 + fr) * ldh + u.pn * HALF + wc * 32 + 8 * fq;
#pragma unroll
        for (int ai = 0; ai < 2; ++ai)
#pragma unroll
            for (int m = 0; m < 4; ++m) { bf16_t* rowp = p0 + (size_t)(ai * HALF + m * 16) * ldh;
                const f32x4 g0 = acc[ai][0][m][0], g1 = acc[ai][0][m][1], u0 = acc[ai][1][m][0], u1 = acc[ai][1][m][1];
                u32x4 w; w.x = cvt_pk_bf16(silu_f(g0[0]) * u0[0], silu_f(g0[1]) * u0[1]); w.y = cvt_pk_bf16(silu_f(g0[2]) * u0[2], silu_f(g0[3]) * u0[3]);
                w.z = cvt_pk_bf16(silu_f(g1[0]) * u1[0], silu_f(g1[1]) * u1[1]); w.w = cvt_pk_bf16(silu_f(g1[2]) * u1[2], silu_f(g1[3]) * u1[3]);
                st16_hid(rowp, w); }
    }
};
#ifndef EPI_RB
#define EPI_RB 2
#endif
struct EpiResid {
    static constexpr bool PERM = true, AFTER_DRAIN = false;
    float* h; const float* gates; int goff; float* out; float* delta; int dry; const float* x0; const float* c0;
    __device__ __forceinline__ void operator()(const f32x4 (&acc)[2][2][4][2], const Unit& u, int wr, int wc, int fr, int fq) const {
        const int b = u.pm / 9, tt = u.pm - 9 * b, set = (tt == 8) ? 8 : b;
        const int col0 = u.pn * BM + wc * 32 + 8 * fq;
        const float* gp = gates + (size_t)set * 12288 + goff + col0;
        f32x4 gv[2][2];
#pragma unroll
        for (int bj = 0; bj < 2; ++bj)
#pragma unroll
            for (int n = 0; n < 2; ++n) { gv[bj][n] = *(const f32x4*)(gp + bj * HALF + n * 4); if (dry) gv[bj][n] = gv[bj][n] * 0.0f; }
        const int rl = wr * 64 + fr;
        const float* hp = (x0 && !dry) ? (tt == 8 ? c0 + (size_t)(b * 256 + rl) * 2048 + col0 : x0 + (size_t)(b * 2048 + tt * 256 + rl) * 2048 + col0) : h + (size_t)(u.pm * BM + rl) * 2048 + col0;
        float* op = (out && !dry) ? out + (size_t)(b * 2048 + tt * 256 + rl) * 2048 + col0 : h + (size_t)(u.pm * BM + rl) * 2048 + col0;
        if (u.split && dry) return;
        if (u.split) {
            float* sp = delta + (size_t)(u.split - 1) * 65536 + (size_t)rl * 256 + wc * 32 + 8 * fq;
#pragma unroll
            for (int ai = 0; ai < 2; ++ai)
#pragma unroll
                for (int m = 0; m < 4; ++m)
#pragma unroll
                    for (int bj = 0; bj < 2; ++bj)
#pragma unroll
                        for (int n = 0; n < 2; ++n) *(f32x4*)(sp + (ai * HALF + m * 16) * 256 + bj * HALF + n * 4) = gv[bj][n] * acc[ai][bj][m][n];
            return;
        }
#pragma unroll
        for (int ai = 0; ai < 2; ++ai)
#pragma unroll
            for (int mp = 0; mp < 4; mp += EPI_RB) {
                f32x4 hv[EPI_RB][2][2];
#pragma unroll
                for (int mm = 0; mm < EPI_RB; ++mm)
#pragma unroll
                    for (int bj = 0; bj < 2; ++bj)
#pragma unroll
                        for (int n = 0; n < 2; ++n) hv[mm][bj][n] = *(const f32x4*)(hp + (size_t)(ai * HALF + (mp + mm) * 16) * 2048 + bj * HALF + n * 4);
                asm volatile("" ::: "memory");
#pragma unroll
                for (int mm = 0; mm < EPI_RB; ++mm) { const int m = mp + mm; const size_t ro = (size_t)(ai * HALF + m * 16) * 2048;
#pragma unroll
                    for (int bj = 0; bj < 2; ++bj)
#pragma unroll
                        for (int n = 0; n < 2; ++n) st16_wt(op + ro + bj * HALF + n * 4, hv[mm][bj][n] + gv[bj][n] * acc[ai][bj][m][n]); }
                asm volatile("" ::: "memory"); }
    }
};

template <class Epi, class Sched, bool ALIGN_EPI = false, bool SP2 = false>
__device__ __forceinline__ void gemm_phase(PG8_LAS unsigned char* lds, const Gemm g, const Sched& S, const Epi& E) {
    int tid = threadIdx.x; asm volatile("" : "+v"(tid));
    const int wid = __builtin_amdgcn_readfirstlane(tid >> 6), lane = tid & 63, wr = wid >> 2, wc = wid & 3, fr = lane & 15, fq = lane >> 4;
    const int K = g.K;
    unsigned voffA[2], voffB[2];
#pragma unroll
    for (int i = 0; i < 2; ++i) { int R, C; stage_rc(tid * 16 + i * 8192, R, C); const int Rb = Epi::PERM ? ((R & ~31) + perm32(R & 31)) : R;
        voffA[i] = (unsigned)(R * K + C) * 2u; voffB[i] = (unsigned)(Rb * K + C) * 2u; }
    const size_t kstep = (size_t)(BK * 2);
    const size_t hstep = (size_t)HALF * K * 2;
    const size_t tstep = 2 * hstep;
    const unsigned ldsw = (unsigned)wid * 1024u;
    const int aoff = lds_byte(wr * 64 + fr, fq * 8), boff = lds_byte(wc * 32 + fr, fq * 8);
#define PG8_SA(b, h) (((b) * 2 + (h)) * HTB)
#define PG8_SB(b, h) ((4 + (b) * 2 + (h)) * HTB)
#define PG8_STAGE(bufoff, gbase, voff) do { _Pragma("unroll") for (int _i = 0; _i < 2; ++_i) \
        __builtin_amdgcn_global_load_lds((const unsigned*)((const char*)(gbase) + (voff)[_i]), (PG8_LAS unsigned*)(lds + (bufoff) + ldsw + _i * 8192), 16, 0, 0); } while (0)
#define PG8_LDA(dst, b, h) do { _Pragma("unroll") for (int m = 0; m < 4; ++m) _Pragma("unroll") for (int k = 0; k < 2; ++k) dst[m][k] = *(const PG8_LAS bf16x8*)(lds + PG8_SA(b, h) + aoff + m * 2048 + k * 1024); } while (0)
#define PG8_LDB(dst, b, h) do { _Pragma("unroll") for (int n = 0; n < 2; ++n) _Pragma("unroll") for (int k = 0; k < 2; ++k) dst[n][k] = *(const PG8_LAS bf16x8*)(lds + PG8_SB(b, h) + boff + n * 2048 + k * 1024); } while (0)
#define PG8_MMA(ai, bj, At, Bt) do { __builtin_amdgcn_s_setprio(1); _Pragma("unroll") for (int m = 0; m < 4; ++m) _Pragma("unroll") for (int n = 0; n < 2; ++n) _Pragma("unroll") for (int k = 0; k < 2; ++k) \
        acc[ai][bj][m][n] = __builtin_amdgcn_mfma_f32_16x16x32_bf16(Bt[n][k], At[m][k], acc[ai][bj][m][n], 0, 0, 0); __builtin_amdgcn_s_setprio(0); } while (0)
#define PG8_WAIT_V(n) asm volatile("s_waitcnt vmcnt(" #n ")" ::: "memory")
#define PG8_WAIT_L(n) asm volatile("s_waitcnt lgkmcnt(" #n ")" ::: "memory")
#define PG8_BAR __builtin_amdgcn_s_barrier()
#define PG8_SCHED __builtin_amdgcn_sched_barrier(0)
    Unit cur, nxt; int ui = 0;
    if (!S.next(0, cur)) return;
    f32x4 acc[2][2][4][2];
#pragma unroll
    for (int a = 0; a < 2; ++a)
#pragma unroll
        for (int b = 0; b < 2; ++b)
#pragma unroll
            for (int m = 0; m < 4; ++m)
#pragma unroll
                for (int n = 0; n < 2; ++n) acc[a][b][m][n] = (f32x4){0.f, 0.f, 0.f, 0.f};
    bf16x8 At[4][2], B0[2][2], B1[2][2];
    const char* cA = (const char*)g.A + (size_t)cur.pm * tstep + (size_t)cur.kt0 * kstep; const char* cB = (const char*)g.Bt + (size_t)cur.pn * tstep + (size_t)cur.kt0 * kstep;
    S.a_ready(cur);
    if constexpr (SP2) {
        PG8_STAGE(PG8_SB(0, 0), cB, voffB); PG8_STAGE(PG8_SB(0, 1), cB + hstep, voffB); PG8_STAGE(PG8_SA(0, 0), cA, voffA); PG8_STAGE(PG8_SA(0, 1), cA + hstep, voffA);
        if (wr == 1) PG8_BAR;
        PG8_WAIT_V(2); PG8_BAR;
        PG8_STAGE(PG8_SB(1, 0), cB + kstep, voffB); PG8_STAGE(PG8_SA(1, 0), cA + kstep, voffA); PG8_STAGE(PG8_SB(1, 1), cB + hstep + kstep, voffB);
        PG8_WAIT_V(6); PG8_BAR;
    } else {
        PG8_STAGE(PG8_SB(0, 0), cB, voffB); PG8_STAGE(PG8_SA(0, 0), cA, voffA); PG8_STAGE(PG8_SB(0, 1), cB + hstep, voffB); PG8_STAGE(PG8_SA(0, 1), cA + hstep, voffA);
        if (wr == 1) PG8_BAR;
        PG8_WAIT_V(4); PG8_BAR;
        PG8_STAGE(PG8_SB(1, 0), cB + kstep, voffB); PG8_STAGE(PG8_SA(1, 0), cA + kstep, voffA); PG8_STAGE(PG8_SB(1, 1), cB + hstep + kstep, voffB);
        PG8_WAIT_V(6); PG8_BAR;
    }
    for (;;) {
        const bool has_next = S.next(ui + 1, nxt);
        const char* nA = has_next ? (const char*)g.A + (size_t)nxt.pm * tstep + (size_t)nxt.kt0 * kstep : cA; const char* nB = has_next ? (const char*)g.Bt + (size_t)nxt.pn * tstep + (size_t)nxt.kt0 * kstep : cB;
        const int nt = cur.nkt;
        for (int t = 0; t < nt; t += 2) {
            const bool last = (t == nt - 2);
            const char* a1 = cA + (size_t)(t + 1) * kstep;
            const char* a2 = last ? nA : cA + (size_t)(t + 2) * kstep; const char* b2 = last ? nB : cB + (size_t)(t + 2) * kstep;
            const char* a3 = a2 + kstep; const char* b3 = b2 + kstep;
            if (last && has_next) S.a_ready(nxt);
            if constexpr (SP2) {
            PG8_LDB(B0, 0, 0); PG8_LDB(B1, 0, 1); PG8_SCHED; PG8_LDA(At, 0, 0); PG8_STAGE(PG8_SA(1, 1), a1 + hstep, voffA);
            PG8_WAIT_V(8); PG8_WAIT_L(0); PG8_BAR; PG8_MMA(0, 0, At, B0); PG8_MMA(0, 1, At, B1); PG8_BAR; PG8_SCHED;
            PG8_LDA(At, 0, 1); PG8_STAGE(PG8_SB(0, 0), b2, voffB); PG8_STAGE(PG8_SB(0, 1), b2 + hstep, voffB); PG8_STAGE(PG8_SA(0, 0), a2, voffA);
            PG8_WAIT_V(8); PG8_WAIT_L(0); PG8_BAR; PG8_MMA(1, 0, At, B0); PG8_MMA(1, 1, At, B1); PG8_BAR; PG8_SCHED;
            PG8_LDB(B0, 1, 0); PG8_LDB(B1, 1, 1); PG8_SCHED; PG8_LDA(At, 1, 0); PG8_STAGE(PG8_SA(0, 1), a2 + hstep, voffA);
            PG8_WAIT_V(8); PG8_WAIT_L(0); PG8_BAR; PG8_MMA(0, 0, At, B0); PG8_MMA(0, 1, At, B1); PG8_BAR; PG8_SCHED;
            PG8_LDA(At, 1, 1); PG8_STAGE(PG8_SB(1, 0), b3, voffB); PG8_STAGE(PG8_SB(1, 1), b3 + hstep, voffB); PG8_STAGE(PG8_SA(1, 0), a3, voffA);
            PG8_WAIT_V(8); PG8_WAIT_L(0); PG8_BAR; PG8_MMA(1, 0, At, B0); PG8_MMA(1, 1, At, B1); PG8_BAR; PG8_SCHED;
            } else {
            PG8_LDB(B0, 0, 0); PG8_SCHED; PG8_LDA(At, 0, 0); PG8_STAGE(PG8_SA(1, 1), a1 + hstep, voffA);
            PG8_WAIT_L(8); PG8_BAR; PG8_WAIT_L(0); PG8_MMA(0, 0, At, B0); PG8_BAR; PG8_SCHED;
            PG8_LDB(B1, 0, 1); PG8_STAGE(PG8_SB(0, 0), b2, voffB);
            PG8_BAR; PG8_WAIT_L(0); PG8_MMA(0, 1, At, B1); PG8_BAR;
            PG8_LDA(At, 0, 1); PG8_STAGE(PG8_SA(0, 0), a2, voffA);
            PG8_BAR; PG8_WAIT_L(0); PG8_MMA(1, 0, At, B0); PG8_BAR; PG8_SCHED;
            PG8_STAGE(PG8_SB(0, 1), b2 + hstep, voffB);
            PG8_WAIT_V(6); PG8_BAR; PG8_MMA(1, 1, At, B1); PG8_BAR;
            PG8_LDB(B0, 1, 0); PG8_SCHED; PG8_LDA(At, 1, 0); PG8_STAGE(PG8_SA(0, 1), a2 + hstep, voffA);
            PG8_WAIT_L(8); PG8_BAR; PG8_WAIT_L(0); PG8_MMA(0, 0, At, B0); PG8_BAR; PG8_SCHED;
            PG8_LDB(B1, 1, 1); PG8_STAGE(PG8_SB(1, 0), b3, voffB);
            PG8_BAR; PG8_WAIT_L(0); PG8_MMA(0, 1, At, B1); PG8_BAR;
            PG8_LDA(At, 1, 1); PG8_STAGE(PG8_SA(1, 0), a3, voffA);
            PG8_BAR; PG8_WAIT_L(0); PG8_MMA(1, 0, At, B0); PG8_BAR; PG8_SCHED;
            PG8_STAGE(PG8_SB(1, 1), b3 + hstep, voffB);
            PG8_WAIT_V(6); PG8_BAR; PG8_MMA(1, 1, At, B1); PG8_BAR;
            }
        }
        if constexpr (ALIGN_EPI) { if (wr == 0) PG8_BAR; }
        if constexpr (!Epi::AFTER_DRAIN) { E(acc, cur, wr, wc, fr, fq); S.done(cur); }
        if (!has_next) break;
#pragma unroll
        for (int a = 0; a < 2; ++a)
#pragma unroll
            for (int b = 0; b < 2; ++b)
#pragma unroll
                for (int m = 0; m < 4; ++m)
#pragma unroll
                    for (int n = 0; n < 2; ++n) acc[a][b][m][n] = (f32x4){0.f, 0.f, 0.f, 0.f};
        cur = nxt; cA = nA; cB = nB; ++ui;
        if constexpr (ALIGN_EPI) { if (wr == 1) PG8_BAR; }
    }
    PG8_WAIT_V(0);
    if constexpr (!ALIGN_EPI) { if (wr == 0) PG8_BAR; }
    PG8_BAR;
    if constexpr (Epi::AFTER_DRAIN) { E.fused(acc, cur, wr, wc, fr, fq, lds, wid, lane); S.done(cur); }
#undef PG8_SA
#undef PG8_SB
#undef PG8_STAGE
#undef PG8_LDA
#undef PG8_LDB
#undef PG8_MMA
#undef PG8_WAIT_V
#undef PG8_WAIT_L
#undef PG8_BAR
#undef PG8_SCHED
}
}
namespace att {
typedef unsigned short bf16;
constexpr int   D = 128, NW = 8, QBLK = 32, KVBLK = 64;
constexpr float SCALE = 0.088388347648318440f;
constexpr float THR = 8.f;
constexpr int LDQ = 3072, LDK = 3072, LDO = 2048;
constexpr size_t SHM_V = KVBLK * D * 2, SHM_K = KVBLK * D * 2, SHM_ATTN = 2 * SHM_V + 2 * SHM_K + NW * 64 * 4;
using bf16x8 = __attribute__((ext_vector_type(8))) short;
using s16x4  = __attribute__((ext_vector_type(4))) short;
using f32x16 = __attribute__((ext_vector_type(16))) float;
using u32x4  = __attribute__((ext_vector_type(4))) unsigned;
#define KSWZ(row, colB) ((row) * 256 + ((colB) ^ (((row) & 7) << 4)))
#define SBAR() __builtin_amdgcn_sched_barrier(0)
__device__ __forceinline__ int crow(int r, int hi) { return (r & 3) + 8 * (r >> 2) + 4 * hi; }
__device__ __forceinline__ unsigned cvtpk(float lo, float hi) {
  typedef __bf16 b2 __attribute__((ext_vector_type(2))); typedef float f2 __attribute__((ext_vector_type(2)));
  const f2 v = {lo, hi}; const b2 b = __builtin_convertvector(v, b2); return __builtin_bit_cast(unsigned, b);
}
__device__ __forceinline__ bf16x8 ld8(const bf16* p) { return *reinterpret_cast<const bf16x8*>(p); }
__device__ __forceinline__ void partialSM(f32x16& p0, f32x16& p1, float& m_reg, float& mn, float& alpha) {
  constexpr float C = SCALE * 1.4426950408889634f;
  float pmax = p0[0]; for (int r = 1; r < 16; ++r) pmax = fmaxf(pmax, p0[r]); for (int r = 0; r < 16; ++r) pmax = fmaxf(pmax, p1[r]);
  { auto rr = __builtin_amdgcn_permlane32_swap(__float_as_uint(pmax), __float_as_uint(pmax), false, false);
    pmax = fmaxf(__uint_as_float(rr[0]), __uint_as_float(rr[1])); }
  if (__builtin_expect(__all(pmax - m_reg <= THR / SCALE), 1)) { mn = m_reg; alpha = 1.f; }
  else { mn = fmaxf(m_reg, pmax); alpha = __builtin_amdgcn_exp2f((m_reg - mn) * C); m_reg = mn; }
  float mnC = -mn * C;
  for (int r = 0; r < 16; ++r) p0[r] = fmaf(p0[r], C, mnC); for (int r = 0; r < 16; ++r) p1[r] = fmaf(p1[r], C, mnC);
  for (int r = 0; r < 16; ++r) p0[r] = __builtin_amdgcn_exp2f(p0[r]);
}
__device__ __forceinline__ void finishSM(f32x16& p0, f32x16& p1, float alpha, float& l_reg, bf16x8& pa0, bf16x8& pa1, bf16x8& pa2, bf16x8& pa3) {
  for (int r = 0; r < 16; ++r) p1[r] = __builtin_amdgcn_exp2f(p1[r]);
  float ps = 0; for (int r = 0; r < 16; ++r) ps += p0[r]; for (int r = 0; r < 16; ++r) ps += p1[r];
  { auto rr = __builtin_amdgcn_permlane32_swap(__float_as_uint(ps), __float_as_uint(ps), false, false);
    ps = __uint_as_float(rr[0]) + __uint_as_float(rr[1]); }
  l_reg = l_reg * alpha + ps;
#define PK4(P, BASE, OUT) do { unsigned a0 = cvtpk(P[BASE + 0], P[BASE + 1]), a1 = cvtpk(P[BASE + 2], P[BASE + 3]);   \
    unsigned b0 = cvtpk(P[BASE + 4], P[BASE + 5]), b1 = cvtpk(P[BASE + 6], P[BASE + 7]);                              \
    auto r0 = __builtin_amdgcn_permlane32_swap(a0, b0, false, false); auto r1 = __builtin_amdgcn_permlane32_swap(a1, b1, false, false); \
    u32x4 w = {r0[0], r1[0], r0[1], r1[1]}; OUT = *reinterpret_cast<bf16x8*>(&w); } while (0)
  PK4(p0, 0, pa0); PK4(p0, 8, pa1); PK4(p1, 0, pa2); PK4(p1, 8, pa3);
#undef PK4
}
__device__ __forceinline__ void qkt(f32x16& p0, f32x16& p1, const bf16* Ks, const bf16x8* qr, int r32, int hi) {
  p0 = f32x16{}; p1 = f32x16{};
  for (int d0 = 0; d0 < 8; ++d0) { int cb = (d0 * 16 + hi * 8) * 2;
    bf16x8 b0 = *reinterpret_cast<const bf16x8*>((const char*)Ks + KSWZ(r32, cb));
    bf16x8 b1 = *reinterpret_cast<const bf16x8*>((const char*)Ks + KSWZ(32 + r32, cb));
    p0 = __builtin_amdgcn_mfma_f32_32x32x16_bf16(b0, qr[d0], p0, 0, 0, 0);
    p1 = __builtin_amdgcn_mfma_f32_32x32x16_bf16(b1, qr[d0], p1, 0, 0, 0); }
}
__device__ __forceinline__ int v_st(int k, int c) { const int kk = (k & ~0xC) | ((k & 4) << 1) | ((k & 8) >> 1); return ((kk >> 3) * 4 + (c >> 5)) * 512 + ((kk & 7) * 32 + (c & 31)) * 2; }
__device__ __forceinline__ int v_rd_base(int lane) { return ((lane & 3) << 3) | (((lane >> 2) & 3) << 6) | (((lane >> 4) & 1) << 5) | (((lane >> 5) & 1) << 8); }
constexpr int v_rd_off(int d0, int ks, int half) { return d0 * 512 + ks * 4096 + half * 2048; }
template <int OFF> __device__ __forceinline__ s16x4 tr_read(int vb) {
  s16x4 r; asm volatile("ds_read_b64_tr_b16 %0, %1 offset:%2" : "=&v"(r) : "v"(vb), "i"(OFF) : "memory"); return r;
}
template <int D0> __device__ __forceinline__ void pv_one(f32x16& od, int vb, bf16x8 pa0, bf16x8 pa1, bf16x8 pa2, bf16x8 pa3) {
  const s16x4 l0 = tr_read<v_rd_off(D0, 0, 0)>(vb), h0 = tr_read<v_rd_off(D0, 0, 1)>(vb), l1 = tr_read<v_rd_off(D0, 1, 0)>(vb), h1 = tr_read<v_rd_off(D0, 1, 1)>(vb);
  const s16x4 l2 = tr_read<v_rd_off(D0, 2, 0)>(vb), h2 = tr_read<v_rd_off(D0, 2, 1)>(vb), l3 = tr_read<v_rd_off(D0, 3, 0)>(vb), h3 = tr_read<v_rd_off(D0, 3, 1)>(vb);
  asm volatile("s_waitcnt lgkmcnt(0)" ::: "memory"); SBAR();
#define PK(L, H) (bf16x8){L[0], L[1], L[2], L[3], H[0], H[1], H[2], H[3]}
  od = __builtin_amdgcn_mfma_f32_32x32x16_bf16(pa0, PK(l0, h0), od, 0, 0, 0);
  od = __builtin_amdgcn_mfma_f32_32x32x16_bf16(pa1, PK(l1, h1), od, 0, 0, 0);
  od = __builtin_amdgcn_mfma_f32_32x32x16_bf16(pa2, PK(l2, h2), od, 0, 0, 0);
  od = __builtin_amdgcn_mfma_f32_32x32x16_bf16(pa3, PK(l3, h3), od, 0, 0, 0);
#undef PK
}
__device__ __forceinline__ void pv_d0(f32x16* o, int vb, bf16x8 pa0, bf16x8 pa1, bf16x8 pa2, bf16x8 pa3) {
  pv_one<0>(o[0], vb, pa0, pa1, pa2, pa3); pv_one<1>(o[1], vb, pa0, pa1, pa2, pa3); pv_one<2>(o[2], vb, pa0, pa1, pa2, pa3); pv_one<3>(o[3], vb, pa0, pa1, pa2, pa3);
}
__device__ __forceinline__ void attn_dense_body(const bf16* __restrict__ Qb, const bf16* __restrict__ Kh, const bf16* __restrict__ Vh,
                                                bf16* __restrict__ Ob, int seq, char* lds, const float* __restrict__ qgain = nullptr, const float* __restrict__ rope = nullptr, int t0 = 0) {
  int tid = threadIdx.x; asm volatile("" : "+v"(tid));
  const int wid = tid >> 6, lane = tid & 63, r32 = lane & 31, hi = lane >> 5;
  bf16* V_lds = (bf16*)lds; bf16* K_lds = (bf16*)(lds + 2 * SHM_V);
  float* ws = (float*)(lds + 2 * SHM_V + 2 * SHM_K) + wid * 64; float* li_l = ws; float* al_l = ws + 32;
  float m_reg = -1e30f, l_reg = 0; f32x16 o[4] = {}; bf16x8 qr[8];
  const bf16* Qw = Qb + (long)(wid * QBLK + r32) * LDQ + hi * 8;
#pragma unroll
  for (int d0 = 0; d0 < 8; ++d0) qr[d0] = ld8(Qw + d0 * 16);
  if (qgain) {
    float ssq = 0.f;
#pragma unroll
    for (int d0 = 0; d0 < 8; ++d0)
#pragma unroll
      for (int x = 0; x < 8; ++x) { const float v = __uint_as_float((unsigned)(unsigned short)qr[d0][x] << 16); ssq += v * v; }
    { auto rr = __builtin_amdgcn_permlane32_swap(__float_as_uint(ssq), __float_as_uint(ssq), false, false); ssq = __uint_as_float(rr[0]) + __uint_as_float(rr[1]); }
    const float rstd = 1.0f / sqrtf(ssq * (1.0f / 128.0f) + 1e-6f);
    const int t = t0 + wid * QBLK + r32;
#pragma unroll
    for (int hp = 0; hp < 2; ++hp) {
      const int pos = hp ? (t & 63) : (t >> 6);
#pragma unroll
      for (int dd = 0; dd < 2; ++dd) { const int d0 = 4 * hp + dd;
        const float* g1 = qgain + 16 * d0 + 8 * hi; const float* g2 = g1 + 32;
        const float* tb = rope ? rope + (size_t)(pos * 32 + 16 * dd + 8 * hi) * 2 : nullptr;
        float y1[8], y2[8];
#pragma unroll
        for (int x = 0; x < 8; ++x) { const float a1 = __uint_as_float((unsigned)(unsigned short)qr[d0][x] << 16) * rstd * g1[x], a2 = __uint_as_float((unsigned)(unsigned short)qr[d0 + 2][x] << 16) * rstd * g2[x];
          if (rope) { const float cs = tb[2 * x], sn = tb[2 * x + 1]; y1[x] = a1 * cs - a2 * sn; y2[x] = a2 * cs + a1 * sn; } else { y1[x] = a1; y2[x] = a2; } }
        { u32x4 w = {cvtpk(y1[0], y1[1]), cvtpk(y1[2], y1[3]), cvtpk(y1[4], y1[5]), cvtpk(y1[6], y1[7])}; qr[d0] = *reinterpret_cast<bf16x8*>(&w); }
        { u32x4 w = {cvtpk(y2[0], y2[1]), cvtpk(y2[2], y2[3]), cvtpk(y2[4], y2[5]), cvtpk(y2[6], y2[7])}; qr[d0 + 2] = *reinterpret_cast<bf16x8*>(&w); } }
    }
  }
  const int sr = tid >> 4, sc = (tid & 15) * 8, vst0 = v_st(sr, sc), vst1 = v_st(32 + sr, sc);
  const int vb0 = (int)(uintptr_t)V_lds + v_rd_base(lane);
  struct { bf16x8 vs0, vs1, ks0, ks1; } sr_[2];
#define SLOAD(i, k0) do { sr_[i].vs0 = ld8(&Vh[(long)((k0) + sr) * LDK + sc]); sr_[i].vs1 = ld8(&Vh[(long)((k0) + 32 + sr) * LDK + sc]); \
    sr_[i].ks0 = ld8(&Kh[(long)((k0) + sr) * LDK + sc]); sr_[i].ks1 = ld8(&Kh[(long)((k0) + 32 + sr) * LDK + sc]); } while (0)
#define SWRITE(b, i) do { *(bf16x8*)((char*)V_lds + (b) * SHM_V + vst0) = sr_[i].vs0;          \
    *(bf16x8*)((char*)V_lds + (b) * SHM_V + vst1) = sr_[i].vs1; int kc = sc * 2;               \
    *(bf16x8*)((char*)K_lds + (b) * SHM_K + KSWZ(sr, kc)) = sr_[i].ks0;                       \
    *(bf16x8*)((char*)K_lds + (b) * SHM_K + KSWZ(32 + sr, kc)) = sr_[i].ks1; } while (0)
#define SWAIT() asm volatile("s_waitcnt vmcnt(4)" ::: "memory")
#define RESC(a) do { if (__any((a) < 1.f)) { if (hi == 0) al_l[r32] = (a); asm volatile("s_waitcnt lgkmcnt(0)" ::: "memory"); \
    for (int d = 0; d < 4; ++d) for (int r = 0; r < 16; ++r) o[d][r] *= al_l[crow(r, hi)]; } } while (0)
  f32x16 pA0, pA1, pB0, pB1; float mnA, mnB, alA, alB; bf16x8 pa0, pa1, pa2, pa3; const int NT = seq / KVBLK;
  constexpr int SE = 0, SO = 1;
  SLOAD(SE, 0); asm volatile("s_waitcnt vmcnt(0)" ::: "memory"); SWRITE(0, SE); __syncthreads();
  qkt(pA0, pA1, K_lds, qr, r32, hi); partialSM(pA0, pA1, m_reg, mnA, alA);
  SLOAD(SO, KVBLK); if (2 < NT) SLOAD(SE, 2 * KVBLK);
  SWAIT(); SWRITE(1, SO); __syncthreads();
  for (int j = 1; j + 1 < NT; j += 2) {
    SBAR(); qkt(pB0, pB1, (bf16*)((char*)K_lds + SHM_K), qr, r32, hi);
    finishSM(pA0, pA1, alA, l_reg, pa0, pa1, pa2, pa3); SBAR();
    SLOAD(SO, (j + 2) * KVBLK); SBAR();
    pv_d0(o, vb0, pa0, pa1, pa2, pa3); partialSM(pB0, pB1, m_reg, mnB, alB);
    __syncthreads(); SWAIT(); SWRITE(0, SE);
    RESC(alB); __syncthreads();
    SBAR(); qkt(pA0, pA1, K_lds, qr, r32, hi);
    finishSM(pB0, pB1, alB, l_reg, pa0, pa1, pa2, pa3); SBAR();
    if (j + 3 < NT) SLOAD(SE, (j + 3) * KVBLK); SBAR();
    pv_d0(o, vb0 + (int)SHM_V, pa0, pa1, pa2, pa3); partialSM(pA0, pA1, m_reg, mnA, alA);
    __syncthreads(); SWAIT(); SWRITE(1, SO);
    RESC(alA); __syncthreads();
  }
  SBAR(); qkt(pB0, pB1, (bf16*)((char*)K_lds + SHM_K), qr, r32, hi);
  finishSM(pA0, pA1, alA, l_reg, pa0, pa1, pa2, pa3); SBAR();
  pv_d0(o, vb0, pa0, pa1, pa2, pa3); partialSM(pB0, pB1, m_reg, mnB, alB);
  __syncthreads(); RESC(alB);
  finishSM(pB0, pB1, alB, l_reg, pa0, pa1, pa2, pa3); SBAR();
  pv_d0(o, vb0 + (int)SHM_V, pa0, pa1, pa2, pa3);
  if (hi == 0) li_l[r32] = l_reg; asm volatile("s_waitcnt lgkmcnt(0)" ::: "memory");
  float rli[16];
#pragma unroll
  for (int r = 0; r < 16; ++r) rli[r] = __builtin_amdgcn_rcpf(li_l[crow(r, hi)]);
  bf16* Ow = Ob + (long)(wid * QBLK) * LDO;
#pragma unroll
  for (int r = 0; r < 16; ++r) { int orow = crow(r, hi);
#pragma unroll
    for (int d0 = 0; d0 < 4; ++d0) Ow[(long)orow * LDO + d0 * 32 + r32] = (bf16)(cvtpk(o[d0][r] * rli[r], 0.f) & 0xffffu); }
  __syncthreads();
#undef SLOAD
#undef SWRITE
#undef SWAIT
#undef RESC
}
#undef KSWZ
#undef SBAR
}

constexpr int NWAVES = 8;
#ifndef MK_N_LAUNCHES
#define MK_N_LAUNCHES 1
#endif
constexpr int DM = 2048, NBATCH = 8, SEQ = 2048, CTXL = 256, TPB = SEQ + CTXL, MROWS = NBATCH * TPB;
constexpr int MLAT = NBATCH * SEQ;
constexpr int MODW = 6 * DM, NSET = 9;
constexpr int EIN = 3072, OIN = 12288, OMIX = 4096, FFN = 5632, FFN2 = 2 * FFN;
constexpr float EPS = 1e-6f;
constexpr int N_PHASES = 1 + 9 * 4;
constexpr size_t MiB = 1u << 20;
constexpr size_t WS_CTL = 0, CTL_ZERO_BYTES = 1 * MiB;
constexpr size_t WS_MOD = 1 * MiB;
constexpr size_t WS_ROPE_E = 3 * MiB, WS_ROPE_O = 3 * MiB + 65536;
constexpr size_t WS_WTC = 3 * MiB + 262144;
constexpr size_t WS_CB = 4 * MiB;
constexpr size_t WS_WTL = 5 * MiB;
constexpr size_t WS_W_INE = 21 * MiB, WS_W_OUTE = 45 * MiB, WS_W_INO = 61 * MiB, WS_W_OUTO = 157 * MiB, WS_W_FIN = 189 * MiB, WS_W_FOUT = 365 * MiB;
constexpr size_t WS_H = 453 * MiB;
constexpr size_t WS_XN = 597 * MiB;
constexpr size_t WS_P = 669 * MiB;
constexpr size_t WS_R = 1101 * MiB;
constexpr size_t WS_OF = WS_R, WS_OB = WS_R + 144 * MiB;
constexpr size_t WS_FT = WS_R, WS_FTC = WS_R + 16 * MiB, WS_Z = WS_R + 18 * MiB, WS_MIX = WS_R + 54 * MiB;
constexpr size_t WS_DELTA = 1389 * MiB;
constexpr size_t WS_SPLITTAB = 2 * MiB + 917504;
constexpr size_t WS_END = 1453 * MiB;
static_assert(WS_MIX + (size_t)MROWS * DM * 2 <= WS_END && WS_OB + (size_t)MROWS * OMIX * 2 <= WS_END && WS_P + (size_t)MROWS * OIN * 2 <= WS_R, "d_ws map");
constexpr int CW_TMO = 0, CW_CODE = 1, CW_BAR = 4096;
constexpr int RING_OFF = 0, RING_BYTES = 131072;
constexpr int LDSCTL_OFF = 158720, MISC_OFF = LDSCTL_OFF + 320;
constexpr int LDS_BYTES = 159744;
static_assert(MISC_OFF + 128 <= LDS_BYTES, "LDS map");

#define GAS __attribute__((address_space(1)))
#define LAS __attribute__((address_space(3)))
typedef unsigned short bf16;
typedef unsigned v4u __attribute__((ext_vector_type(4)));
typedef unsigned v2u __attribute__((ext_vector_type(2)));
typedef float f32x4 __attribute__((ext_vector_type(4)));
typedef short bf16x8 __attribute__((ext_vector_type(8)));
typedef short s16x4 __attribute__((ext_vector_type(4)));
typedef GAS unsigned gu32;
#define RLX_AGENT __ATOMIC_RELAXED, __HIP_MEMORY_SCOPE_AGENT
#define LDS_WAIT() asm volatile("s_waitcnt lgkmcnt(0)" ::: "memory")
#define VM_WAIT() asm volatile("s_waitcnt vmcnt(0)" ::: "memory")
typedef __bf16 bf16x2_t __attribute__((ext_vector_type(2)));
typedef float f32x2_t __attribute__((ext_vector_type(2)));
__device__ __forceinline__ unsigned pk2(float lo, float hi) { const f32x2_t v = {lo, hi}; const bf16x2_t b = __builtin_convertvector(v, bf16x2_t); return __builtin_bit_cast(unsigned, b); }
__device__ __forceinline__ float bflo(unsigned w) { return __uint_as_float(w << 16); }
__device__ __forceinline__ float bfhi(unsigned w) { return __uint_as_float(w & 0xffff0000u); }
__device__ __forceinline__ float silu(float g) { return g / (1.0f + __expf(-g)); }

#define XB_TMO      128
#define XB_XCNT(j)  (256  + 64 * (j))
#define XB_XSUB(j)  (1280 + 64 * (j))
#define XB_XGEN(j)  (2304 + 64 * (j))
#define XB_TOP      3328
#define XB_TOPGEN   3392
#define XCD_BAR_WORDS 3456
#define XB_SPIN_CAP (1u << 18)

__device__ __forceinline__ unsigned xb_ld(unsigned* p)              { return __hip_atomic_load(p, __ATOMIC_RELAXED, __HIP_MEMORY_SCOPE_AGENT); }
__device__ __forceinline__ unsigned xb_add(unsigned* p, unsigned v) { return __hip_atomic_fetch_add(p, v, __ATOMIC_RELAXED, __HIP_MEMORY_SCOPE_AGENT); }
__device__ __forceinline__ unsigned xb_xcc_id() { return (unsigned)__builtin_amdgcn_s_getreg((3 << 11) | 20) & 0xFu; }
#define XB_SPIN(cond, bar) do { unsigned _sp = 0; while (cond) { __builtin_amdgcn_s_sleep(1); \
    if ((++_sp & 255u) == 0u) { if (xb_ld(&(bar)[XB_TMO])) break; if (_sp > XB_SPIN_CAP) { atomicAdd(&(bar)[XB_TMO], 1u); break; } } } } while (0)

struct XcdBarrier {
    unsigned* bar; unsigned x;
    volatile LAS unsigned* st;
};

__device__ __forceinline__ XcdBarrier xcd_barrier_post(unsigned* bar, volatile LAS unsigned* st) {
    XcdBarrier b; b.bar = bar; b.x = xb_xcc_id(); b.st = st;
    if (threadIdx.x == 0) (void)xb_add(&bar[XB_XCNT(b.x)], 1u);
    return b;
}
__device__ __forceinline__ void xcd_barrier_complete(unsigned* bar, unsigned x, unsigned& nloc, unsigned& nx) {
    const unsigned G = gridDim.x * gridDim.y * gridDim.z;
    unsigned sum, cnt, mine, sp = 0u;
    for (;;) {
        sum = 0u; cnt = 0u; mine = 0u;
#pragma unroll
        for (unsigned j = 0; j < 16; ++j) { const unsigned c = xb_ld(&bar[XB_XCNT(j)]); sum += c; cnt += (c > 0u) ? 1u : 0u; mine = (j == x) ? c : mine; }
        if (sum == G) break;
        __builtin_amdgcn_s_sleep(1);
        if ((++sp & 255u) == 0u) { if (xb_ld(&bar[XB_TMO])) break; if (sp > XB_SPIN_CAP) { atomicAdd(&bar[XB_TMO], 1u); break; } }
    }
    nloc = mine > 0u ? mine : 1u; nx = cnt > 0u ? cnt : 1u;
}

__device__ __forceinline__ void xcd_barrier(const XcdBarrier& b) {
    asm volatile("s_waitcnt vmcnt(0)" ::: "memory");
    __syncthreads();
    if (threadIdx.x == 0) {
        unsigned* bar = b.bar;
        __builtin_amdgcn_s_waitcnt(0);
        unsigned nloc = b.st[0], nx = b.st[1];
        if (nloc == 0u) { xcd_barrier_complete(bar, b.x, nloc, nx); b.st[0] = nloc; b.st[1] = nx; }
        const unsigned old = xb_add(&bar[XB_XSUB(b.x)], 1u);
        const unsigned gen = old / nloc;
        if (old + 1u == (gen + 1u) * nloc) {
            __builtin_amdgcn_fence(__ATOMIC_RELEASE, "agent");
            asm volatile("s_waitcnt vmcnt(0)" ::: "memory");
            const unsigned og = xb_add(&bar[XB_TOP], 1u);
            const unsigned tg = og / nx;
            if (og + 1u == (tg + 1u) * nx) xb_add(&bar[XB_TOPGEN], 1u);
            else XB_SPIN(xb_ld(&bar[XB_TOPGEN]) == tg, bar);
            __builtin_amdgcn_fence(__ATOMIC_ACQUIRE, "agent");
            xb_add(&bar[XB_XGEN(b.x)], 1u);
            asm volatile("s_waitcnt vmcnt(0)" ::: "memory");
        } else {
            XB_SPIN(xb_ld(&bar[XB_XGEN(b.x)]) == gen, bar);
            __builtin_amdgcn_fence(__ATOMIC_ACQUIRE, "agent");
            asm volatile("s_waitcnt vmcnt(0)" ::: "memory");
        }
    }
    __syncthreads();
}

struct Args { const float* in[16]; float* out; unsigned char* ws; int ph_lo, ph_hi; };
static_assert(sizeof(Args) == 18 * 8 + 8, "Args has no padding");

struct Frame {
    LAS unsigned char* lds;
    volatile LAS unsigned* MISC;
    gu32* ctl;
    GAS unsigned char* ws;
    GAS float* out;
    int wave, vcu, G;
};
__device__ __forceinline__ int tid_opaque() { int t = threadIdx.x; asm volatile("" : "+v"(t)); return t; }
#define IN_X(F) ((const float*)(const GAS float*)A.in[0])
#define IN_C(F) ((const float*)(const GAS float*)A.in[1])
#define IN_CTX(F) ((const float*)(const GAS float*)A.in[2])
#define IN_CCTX(F) ((const float*)(const GAS float*)A.in[3])
#define IN_WMOD(F) ((const float*)(const GAS float*)A.in[4])
#define IN_BMOD(F) ((const float*)(const GAS float*)A.in[5])
#define IN_WINE(F) ((const float*)(const GAS float*)A.in[6])
#define IN_WOUTE(F) ((const float*)(const GAS float*)A.in[7])
#define IN_QG(F) ((const float*)(const GAS float*)A.in[8])
#define IN_KG(F) ((const float*)(const GAS float*)A.in[9])
#define IN_WINO(F) ((const float*)(const GAS float*)A.in[10])
#define IN_WOUTO(F) ((const float*)(const GAS float*)A.in[11])
#define IN_LDF(F) ((const float*)(const GAS float*)A.in[12])
#define IN_LDB(F) ((const float*)(const GAS float*)A.in[13])
#define IN_WFIN(F) ((const float*)(const GAS float*)A.in[14])
#define IN_WFOUT(F) ((const float*)(const GAS float*)A.in[15])
#define WSF(F, off) ((float*)((F).ws + (off)))
#define WSB(F, off) ((bf16*)((F).ws + (off)))
__device__ __forceinline__ float shx(float v, int k, int lane) { return __int_as_float(__builtin_amdgcn_ds_bpermute((lane ^ k) << 2, __float_as_int(v))); }
__device__ __forceinline__ float wave_sum(float v, int lane) {
#pragma unroll
    for (int o = 1; o < 64; o <<= 1) v += shx(v, o, lane);
    return v;
}
__device__ __forceinline__ void p0_transpose_item(const float* W, int K, int N, bf16* WT, int k0, int n0, int drow0, float scale, LAS float* scr, int lane) {
    const int kr = lane >> 4, c4 = (lane & 15) * 4;
    f32x4 v[16];
#pragma unroll
    for (int i = 0; i < 16; ++i) v[i] = *(const GAS f32x4*)(W + (size_t)(k0 + 4 * i + kr) * N + n0 + c4);
#pragma unroll
    for (int i = 0; i < 16; ++i) { LAS float* d = scr + (4 * i + kr) * 65 + c4; d[0] = v[i][0]; d[1] = v[i][1]; d[2] = v[i][2]; d[3] = v[i][3]; }
    LDS_WAIT(); asm volatile("" ::: "memory");
    const int c = lane & 7;
#pragma unroll
    for (int j = 0; j < 8; ++j) { const int n = (lane >> 3) + 8 * j; const LAS float* s = scr + (8 * c) * 65 + n;
        v4u o; o.x = pk2(s[0 * 65] * scale, s[1 * 65] * scale); o.y = pk2(s[2 * 65] * scale, s[3 * 65] * scale); o.z = pk2(s[4 * 65] * scale, s[5 * 65] * scale); o.w = pk2(s[6 * 65] * scale, s[7 * 65] * scale);
        *(GAS v4u*)(WT + (size_t)(drow0 + n) * K + k0 + 8 * c) = o; }
    LDS_WAIT(); asm volatile("" ::: "memory");
}
__device__ __forceinline__ void p0_conv(const float* W, bf16* WT, int K, int N, int kind, int r, LAS float* scr, int lane) {
    const int nbn = N / 64, per = (K / 64) * nbn, inst = r / per, rr = r - inst * per, kb = rr / nbn, nb = rr - kb * nbn, n0 = nb * 64;
    int drow0 = n0; float scale = 1.0f;
    if (kind == 2) { if (n0 >= 2048 && n0 < 4096) scale = 0.0625f;
        if (n0 < 4096) { const int d = n0 & 255, half = d >> 7, bj = (d >> 6) & 1; drow0 = (n0 & ~255) + 128 * bj + 64 * half; } }
    if (kind == 4) { const int bj = n0 >= FFN ? 1 : 0, hc = n0 - bj * FFN; drow0 = 256 * (hc >> 7) + 128 * bj + (hc & 127); }
    p0_transpose_item(W + (size_t)inst * K * N, K, N, WT + (size_t)inst * K * N, kb * 64, n0, drow0, scale, scr, lane);
}
__device__ __forceinline__ int conv_layer_count(int L) { return (L & 1) ? (32 * 192 + 64 * 32 + 32 * 176 + 88 * 32) : (32 * 48 + 32 * 32 + 32 * 176 + 88 * 32); }
__device__ __forceinline__ void conv_layer_item(Frame& F, const Args& A, int L, int r, LAS float* scr, int lane) {
    const int j2 = L >> 1;
    if (L & 1) {
        constexpr int P0 = 32 * 192, P1 = 64 * 32;
        if (r < P0) { p0_conv(IN_WINO(F), WSB(F, WS_W_INO), DM, OIN, 2, r + j2 * P0, scr, lane); return; } r -= P0;
        if (r < P1) { p0_conv(IN_WOUTO(F), WSB(F, WS_W_OUTO), OMIX, DM, 3, r + j2 * P1, scr, lane); return; } r -= P1;
    } else {
        constexpr int P0 = 32 * 48, P1 = 32 * 32;
        if (r < P0) { p0_conv(IN_WINE(F), WSB(F, WS_W_INE), DM, EIN, 0, r + j2 * P0, scr, lane); return; } r -= P0;
        if (r < P1) { p0_conv(IN_WOUTE(F), WSB(F, WS_W_OUTE), DM, DM, 1, r + j2 * P1, scr, lane); return; } r -= P1;
    }
    constexpr int P4 = 32 * 176, P5 = 88 * 32;
    if (r < P4) { p0_conv(IN_WFIN(F), WSB(F, WS_W_FIN), DM, FFN2, 4, r + L * P4, scr, lane); return; } r -= P4;
    p0_conv(IN_WFOUT(F), WSB(F, WS_W_FOUT), FFN, DM, 5, r + L * P5, scr, lane);
}
__device__ __forceinline__ void conv_in_tail(Frame& F, const Args& A, int L, int lo, int hi, int widx, int nw) {
    const int lane = tid_opaque() & 63;
    LAS float* scr = (LAS float*)(F.lds + RING_OFF + F.wave * 16640);
    for (int r = lo + widx * NWAVES + F.wave; r < hi; r += nw * NWAVES) conv_layer_item(F, A, L, r, scr, lane);
}
#ifndef LATE_CONV
#define LATE_CONV 1
#endif
#ifndef BUILD_SPLITTAB
#define BUILD_SPLITTAB 0
#endif
#ifndef PRO_GW
#define PRO_GW 3
#endif
__device__ __forceinline__ void ph_prologue(Frame& F, const Args& A) {
    const int tid = tid_opaque(), lane = tid & 63;
    constexpr int COND_BYTES = NSET * DM * 4;
    LAS float* cond = (LAS float*)(F.lds + RING_OFF);
    for (int i = tid; i < NSET * DM; i += NWAVES * 64) { const int s = i >> 11, k = i & 2047; const float v = (s < 8) ? IN_C(F)[s * DM + k] : IN_CCTX(F)[k]; cond[i] = v / (1.0f + expf(-v)); }
    LDS_WAIT(); __syncthreads();
    if (F.wave < PRO_GW) {
        for (int item = F.wave * F.G + F.vcu; item < 4 * 192; item += PRO_GW * F.G) {
            const int layer = item / 192, kk = lane >> 4, col = (item - layer * 192) * 64 + (lane & 15) * 4;
            const float* wp = IN_WMOD(F) + (size_t)layer * DM * MODW + (size_t)kk * MODW + col;
            f32x4 acc[NSET];
#pragma unroll
            for (int s = 0; s < NSET; ++s) acc[s] = (f32x4){0.f, 0.f, 0.f, 0.f};
            for (int k = 0; k < DM; k += 32) {
                f32x4 w[8];
#pragma unroll
                for (int u = 0; u < 8; ++u) w[u] = *(const GAS f32x4*)(wp + (size_t)(k + 4 * u) * MODW);
#pragma unroll
                for (int u = 0; u < 8; ++u)
#pragma unroll
                    for (int s = 0; s < NSET; ++s) acc[s] += w[u] * cond[s * DM + k + 4 * u + kk];
            }
#pragma unroll
            for (int s = 0; s < NSET; ++s)
#pragma unroll
                for (int x = 0; x < 4; ++x) { float t = acc[s][x]; t += shx(t, 16, lane); t += shx(t, 32, lane); acc[s][x] = t; }
            if (kk == 0) { const f32x4 bm = *(const GAS f32x4*)(IN_BMOD(F) + layer * MODW + col);
#pragma unroll
                for (int s = 0; s < NSET; ++s) *(GAS f32x4*)(WSF(F, WS_MOD) + (size_t)(layer * NSET + s) * MODW + col) = acc[s] + bm; }
        }
    } else {
        LAS float* scr = (LAS float*)(F.lds + RING_OFF + COND_BYTES + (F.wave - PRO_GW) * 16640);
        const int tw = (F.wave - PRO_GW) * F.G + F.vcu, NTW = (NWAVES - PRO_GW) * F.G;
#if LATE_CONV
        for (int it = tw; it < conv_layer_count(0); it += NTW) conv_layer_item(F, A, 0, it, scr, lane);
#else
        constexpr int I0 = 2 * 32 * 48, I1 = 2 * 32 * 32, I2 = 2 * 32 * 192, I3 = 2 * 64 * 32, I4 = 4 * 32 * 176, I5 = 4 * 88 * 32;
        for (int it = tw; it < I0 + I1 + I2 + I3 + I4 + I5; it += NTW) {
            int r = it;
            if (r < I0) { p0_conv(IN_WINE(F), WSB(F, WS_W_INE), DM, EIN, 0, r, scr, lane); continue; } r -= I0;
            if (r < I1) { p0_conv(IN_WOUTE(F), WSB(F, WS_W_OUTE), DM, DM, 1, r, scr, lane); continue; } r -= I1;
            if (r < I2) { p0_conv(IN_WINO(F), WSB(F, WS_W_INO), DM, OIN, 2, r, scr, lane); continue; } r -= I2;
            if (r < I3) { p0_conv(IN_WOUTO(F), WSB(F, WS_W_OUTO), OMIX, DM, 3, r, scr, lane); continue; } r -= I3;
            if (r < I4) { p0_conv(IN_WFIN(F), WSB(F, WS_W_FIN), DM, FFN2, 4, r, scr, lane); continue; } r -= I4;
            p0_conv(IN_WFOUT(F), WSB(F, WS_W_FOUT), FFN, DM, 5, r, scr, lane);
        }
#endif
    }
    const int gw = F.vcu * NWAVES + F.wave, NGW = F.G * NWAVES;
    if (BUILD_SPLITTAB && gw == 0) {
        pg8::StaticOrder so; so.init(MROWS, DM, F.G, 0); const int nfull = (so.nwg / F.G) * F.G; int* tab = (int*)(F.ws + WS_SPLITTAB);
        for (int e = lane; e < 576; e += 64) { int val = 0;
            for (int idx = nfull; idx < so.nwg; ++idx) { pg8::Unit u; so.map(idx, u); if (u.pm * 8 + u.pn == e) val = idx - nfull + 1; }
            tab[e] = val; }
    }
    const int gt = gw * 64 + lane, NGT = NGW * 64;
    for (int i = gt; i < 4096 * 256; i += NGT) {
        const int m = i >> 8, k0 = (i & 255) * 8, part = m >> 11, to = m & 2047; unsigned w[4];
#pragma unroll
        for (int u = 0; u < 4; ++u) { float s0, c0, s1, c1; sincospif((float)((to * (k0 + 2 * u)) & 2047) * (1.0f / 1024.0f), &s0, &c0); sincospif((float)((to * (k0 + 2 * u + 1)) & 2047) * (1.0f / 1024.0f), &s1, &c1);
            w[u] = pk2((part ? s0 : c0) * 0.022097086912079608f, (part ? s1 : c1) * 0.022097086912079608f); }
        *(GAS v4u*)(WSB(F, WS_WTL) + (size_t)m * 2048 + k0) = (v4u){w[0], w[1], w[2], w[3]};
    }
    for (int i = gt; i < 512 * 32; i += NGT) {
        const int m = i >> 5, k0 = (i & 31) * 8, part = m >> 8, to = m & 255; unsigned w[4];
#pragma unroll
        for (int u = 0; u < 4; ++u) { float s0, c0, s1, c1; sincospif((float)((to * (k0 + 2 * u)) & 255) * (1.0f / 128.0f), &s0, &c0); sincospif((float)((to * (k0 + 2 * u + 1)) & 255) * (1.0f / 128.0f), &s1, &c1);
            w[u] = pk2((part ? s0 : c0) * 0.0625f, (part ? s1 : c1) * 0.0625f); }
        *(GAS v4u*)(WSB(F, WS_WTC) + (size_t)m * 256 + k0) = (v4u){w[0], w[1], w[2], w[3]};
    }
    for (int i = gt; i < 512 * 128; i += NGT) {
        const int n = i >> 7, k0 = (i & 127) * 8, g = n >> 7, kq = n & 127, part = k0 >> 9, g2 = (k0 >> 7) & 3; unsigned w[4];
#pragma unroll
        for (int u = 0; u < 4; ++u) { float s0, c0, s1, c1; const int cc = (k0 & 127) + 2 * u; sincospif((float)((cc * kq) & 127) * (1.0f / 64.0f), &s0, &c0); sincospif((float)(((cc + 1) * kq) & 127) * (1.0f / 64.0f), &s1, &c1);
            const float a0 = (part ? -s0 : c0) * 0.08838834764831845f, a1 = (part ? -s1 : c1) * 0.08838834764831845f;
            w[u] = (g == g2) ? pk2(a0, a1) : 0u; }
        *(GAS v4u*)(WSB(F, WS_CB) + (size_t)n * 1024 + k0) = (v4u){w[0], w[1], w[2], w[3]};
    }
    for (int i = gt; i < 64 * 32; i += NGT) { const int pos = i >> 5, f = i & 31; const double inv = exp2(-(double)(2 * f) / 64.0 * 13.287712379549449), a = (double)pos * inv;
        WSF(F, WS_ROPE_E)[2 * i] = (float)cos(a); WSF(F, WS_ROPE_E)[2 * i + 1] = (float)sin(a); }
    for (int i = gt; i < 64 * 64; i += NGT) { const int pos = i >> 6, f = i & 63; const double inv = exp2(-(double)(2 * f) / 128.0 * 13.287712379549449), a = (double)pos * inv;
        WSF(F, WS_ROPE_O)[2 * i] = (float)cos(a); WSF(F, WS_ROPE_O)[2 * i + 1] = (float)sin(a); }
}
__device__ __forceinline__ void ph_modulate(Frame& F, const Args& A, int layer, int which, int skipctx, int merge, int from_x) {
    const int lane = tid_opaque() & 63;
    const int gw = F.vcu * NWAVES + F.wave, NGW = F.G * NWAVES, R = (MROWS + NGW - 1) / NGW;
    const int m0 = gw * R, m1 = (m0 + R < MROWS) ? m0 + R : MROWS;
    f32x4 sh[8], sc[8], v[8], vn[8]; int curset = -1;
#define MOD_SRC(m_, b_, t_) (from_x ? (const GAS f32x4*)((t_) >= SEQ ? IN_CTX(F) + (size_t)((b_) * CTXL + (t_) - SEQ) * DM : IN_X(F) + (size_t)((b_) * SEQ + (t_)) * DM) + lane : (const GAS f32x4*)(WSF(F, WS_H) + (size_t)(m_) * DM) + lane)
    if (m0 < MROWS) { const int b = m0 / TPB, t = m0 - b * TPB; const GAS f32x4* sr = MOD_SRC(m0, b, t);
#pragma unroll
        for (int j = 0; j < 8; ++j) vn[j] = sr[64 * j]; }
#pragma unroll 1
    for (int m = m0; m < m1; ++m) {
        const int b = m / TPB, t = m - b * TPB, isctx = t >= SEQ, set = isctx ? 8 : b;
#pragma unroll
        for (int j = 0; j < 8; ++j) v[j] = vn[j];
        if (m + 1 < m1) { const int b2 = (m + 1) / TPB, t2 = (m + 1) - b2 * TPB; const GAS f32x4* sr = MOD_SRC(m + 1, b2, t2);
#pragma unroll
            for (int j = 0; j < 8; ++j) vn[j] = sr[64 * j]; }
        if (skipctx && isctx) continue;
        if (set != curset) { curset = set; const float* shp = WSF(F, WS_MOD) + (size_t)(layer * NSET + set) * MODW + which * 3 * DM;
#pragma unroll
            for (int j = 0; j < 8; ++j) { sh[j] = *((const GAS f32x4*)shp + lane + 64 * j); sc[j] = *((const GAS f32x4*)(shp + DM) + lane + 64 * j) + 1.0f; } }
        if (merge) {
            GAS f32x4* hr = (GAS f32x4*)(WSF(F, WS_H) + (size_t)m * DM) + lane;
            const int pm = m >> 8; const int* tab = (const int*)(F.ws + WS_SPLITTAB) + pm * 8;
#pragma unroll
            for (int j = 0; j < 8; ++j) { const int sl = __builtin_amdgcn_readfirstlane(tab[j]);
                if (sl) { const GAS f32x4* dp = (const GAS f32x4*)(WSF(F, WS_DELTA) + (size_t)(sl - 1) * 4 * 65536 + (size_t)(m & 255) * 256) + lane;
                    const f32x4 d0 = dp[0], d1 = dp[16384], d2 = dp[32768], d3 = dp[49152];
                    v[j] = v[j] + ((d0 + d1) + (d2 + d3)); hr[64 * j] = v[j]; } }
        }
        float ss = 0.f;
#pragma unroll
        for (int j = 0; j < 8; ++j) { ss += (v[j][0] * v[j][0] + v[j][1] * v[j][1]) + (v[j][2] * v[j][2] + v[j][3] * v[j][3]); }
        const float rstd = 1.0f / sqrtf(wave_sum(ss, lane) * (1.0f / DM) + EPS);
        GAS v2u* o8 = (GAS v2u*)(WSB(F, WS_XN) + (size_t)m * DM) + lane;
#pragma unroll
        for (int j = 0; j < 8; ++j) { const f32x4 y = v[j] * rstd * sc[j] + sh[j]; o8[64 * j] = (v2u){pk2(y[0], y[1]), pk2(y[2], y[3])}; }
    }
#undef MOD_SRC
}
__device__ __forceinline__ void ph_qk_even(Frame& F, const Args& A, int j2) {
    const int gw = F.vcu * NWAVES + F.wave, NGW = F.G * NWAVES, l = tid_opaque() & 63;
    const float* qg = IN_QG(F) + j2 * 128 + (l & 15) * 8; const float* kg = IN_KG(F) + j2 * 128 + (l & 15) * 8;
    float gq[8], gk[8];
#pragma unroll
    for (int x = 0; x < 8; ++x) { gq[x] = qg[x]; gk[x] = kg[x]; }
    for (int m = gw; m < MROWS; m += NGW) {
        const int b = m / TPB, t = m - b * TPB, lat = t < SEQ;
        const int half = (l >> 3) & 1, pos = half ? (t & 63) : (t >> 6), isx2 = (l >> 2) & 1;
        f32x4 tb[4];
        if (lat) {
#pragma unroll
            for (int q = 0; q < 4; ++q) tb[q] = *(const GAS f32x4*)(WSF(F, WS_ROPE_E) + (size_t)(pos * 32 + (l & 3) * 8 + 2 * q) * 2);
        }
        GAS v4u* pr = (GAS v4u*)(WSB(F, WS_P) + (size_t)m * EIN + 512) + l;
#pragma unroll
        for (int j = 3; j < 4; ++j) {
            const v4u raw = pr[64 * j];
            float v[8] = {bflo(raw.x), bfhi(raw.x), bflo(raw.y), bfhi(raw.y), bflo(raw.z), bfhi(raw.z), bflo(raw.w), bfhi(raw.w)};
            float ss = 0.f;
#pragma unroll
            for (int x = 0; x < 8; ++x) ss += v[x] * v[x];
            ss += shx(ss, 1, l); ss += shx(ss, 2, l); ss += shx(ss, 4, l); ss += shx(ss, 8, l);
            const float rstd = 1.0f / sqrtf(ss * (1.0f / 128.0f) + EPS);
            const bool isq = (4 * j + (l >> 4)) < 12;
#pragma unroll
            for (int x = 0; x < 8; ++x) v[x] = v[x] * rstd * (isq ? gq[x] : gk[x]);
            if (lat) {
#pragma unroll
                for (int x = 0; x < 8; ++x) { const float p = shx(v[x], 4, l); const float cs = tb[x >> 1][(x & 1) * 2], sn = tb[x >> 1][(x & 1) * 2 + 1];
                    v[x] = isx2 ? (v[x] * cs + p * sn) : (v[x] * cs - p * sn); }
            }
            pr[64 * j] = (v4u){pk2(v[0], v[1]), pk2(v[2], v[3]), pk2(v[4], v[5]), pk2(v[6], v[7])};
        }
    }
    LAS bf16* scr = (LAS bf16*)(F.lds + RING_OFF + F.wave * 9216);
    for (int it = gw; it < NBATCH * 288; it += NGW) {
        const int b = it / 288, r = it - b * 288; int t0, c0, isc;
        if (r < 256) { isc = 0; t0 = (r >> 3) * 64; c0 = (r & 7) * 64; } else { isc = 1; t0 = ((r - 256) >> 3) * 64; c0 = ((r - 256) & 7) * 64; }
        const bf16* src = WSB(F, WS_P) + (size_t)(b * TPB + (isc ? SEQ : 0) + t0) * EIN + c0;
#pragma unroll
        for (int i = 0; i < 8; ++i) { const int rr = i * 8 + (l >> 3), ch = l & 7; const v4u val = *(const GAS v4u*)(src + (size_t)rr * EIN + ch * 8); *(LAS v4u*)(scr + rr * 72 + ch * 8) = val; }
        LDS_WAIT(); asm volatile("" ::: "memory");
        bf16* dst = isc ? WSB(F, WS_FTC) + (size_t)(b * 512 + c0) * CTXL + t0 : WSB(F, WS_FT) + (size_t)(b * 512 + c0) * SEQ + t0;
        const int ld = isc ? CTXL : SEQ;
#pragma unroll
        for (int i = 0; i < 8; ++i) { const int cc = i * 8 + (l >> 3), tc = (l & 7) * 8; const LAS bf16* s = scr + tc * 72 + cc;
            v4u o; o.x = (unsigned)s[0] | ((unsigned)s[72] << 16); o.y = (unsigned)s[144] | ((unsigned)s[216] << 16); o.z = (unsigned)s[288] | ((unsigned)s[360] << 16); o.w = (unsigned)s[432] | ((unsigned)s[504] << 16);
            *(GAS v4u*)(dst + (size_t)cc * ld + tc) = o; }
        LDS_WAIT(); asm volatile("" ::: "memory");
    }
}
__device__ __forceinline__ void ph_rope_odd(Frame& F) {
    const int gw = F.vcu * NWAVES + F.wave, NGW = F.G * NWAVES, l = tid_opaque() & 63;
    for (int m = gw; m < MROWS; m += NGW) {
        const int b = m / TPB, t = m - b * TPB;
        if (t >= SEQ) continue;
        const int half = (l >> 4) & 1, pos = half ? (t & 63) : (t >> 6), isx2 = (l >> 3) & 1;
        f32x4 tb[4];
#pragma unroll
        for (int q = 0; q < 4; ++q) tb[q] = *(const GAS f32x4*)(WSF(F, WS_ROPE_O) + (size_t)(pos * 64 + (l & 7) * 8 + 2 * q) * 2);
        GAS v4u* pr = (GAS v4u*)(WSB(F, WS_P) + (size_t)m * OIN) + l;
#pragma unroll
        for (int j = 0; j < 8; ++j) {
            const v4u raw = pr[64 * j];
            float v[8] = {bflo(raw.x), bfhi(raw.x), bflo(raw.y), bfhi(raw.y), bflo(raw.z), bfhi(raw.z), bflo(raw.w), bfhi(raw.w)};
#pragma unroll
            for (int x = 0; x < 8; ++x) { const float p = shx(v[x], 8, l); const float cs = tb[x >> 1][(x & 1) * 2], sn = tb[x >> 1][(x & 1) * 2 + 1];
                v[x] = isx2 ? (v[x] * cs + p * sn) : (v[x] * cs - p * sn); }
            pr[64 * j] = (v4u){pk2(v[0], v[1]), pk2(v[2], v[3]), pk2(v[4], v[5]), pk2(v[6], v[7])};
        }
    }
}
__device__ __forceinline__ void ph_comb(Frame& F, int skipctx, int dry = 0) {
    const int gw = F.vcu * NWAVES + F.wave, NGW = F.G * NWAVES, l = tid_opaque() & 63;
    for (int m = gw; m < MROWS; m += NGW) {
        const int b = m / TPB, t = m - b * TPB;
        if (skipctx && t >= SEQ) continue;
        GAS v4u* pf = (GAS v4u*)(WSB(F, WS_OF) + (size_t)m * OMIX) + l; const GAS v4u* pb = (const GAS v4u*)(WSB(F, WS_OB) + (size_t)m * OMIX) + l;
        const GAS v4u* pg = (const GAS v4u*)(WSB(F, WS_P) + (size_t)m * OIN + 8192) + l;
#pragma unroll
        for (int j = 0; j < 8; ++j) {
            const v4u a = pf[64 * j], bb = pb[64 * j], gg = pg[64 * j];
            float o[8] = {bflo(a.x) + bflo(bb.x), bfhi(a.x) + bfhi(bb.x), bflo(a.y) + bflo(bb.y), bfhi(a.y) + bfhi(bb.y), bflo(a.z) + bflo(bb.z), bfhi(a.z) + bfhi(bb.z), bflo(a.w) + bflo(bb.w), bfhi(a.w) + bfhi(bb.w)};
            const float g[8] = {bflo(gg.x), bfhi(gg.x), bflo(gg.y), bfhi(gg.y), bflo(gg.z), bfhi(gg.z), bflo(gg.w), bfhi(gg.w)};
            float ss = 0.f;
#pragma unroll
            for (int x = 0; x < 8; ++x) ss += o[x] * o[x];
            const float rstd = 1.0f / sqrtf(wave_sum(ss, l) * (1.0f / 512.0f) + EPS);
#pragma unroll
            for (int x = 0; x < 8; ++x) o[x] = silu(g[x]) * (o[x] * rstd);
            (dry ? (GAS v4u*)pb : pf)[64 * j] = (v4u){pk2(o[0], o[1]), pk2(o[2], o[3]), pk2(o[4], o[5]), pk2(o[6], o[7])};
        }
    }
}
__device__ __forceinline__ void ph_attention(Frame& F, const Args& A, int j2) {
    char* lds = (char*)(F.lds + RING_OFF);
    for (int i = 0;; ++i) {
        const int u = i * F.G + F.vcu; if (u >= 864) break;
        if (u < 768) { const int qb = u & 7, g3 = (u >> 3) % 3, bk = u / 24, kvh = bk & 3, b = bk >> 2, h = kvh * 3 + g3; const size_t rq = (size_t)(b * TPB + qb * 256);
            const bf16* Kh = WSB(F, WS_P) + (size_t)(b * TPB) * EIN + 2048 + kvh * 128;
            att::attn_dense_body(WSB(F, WS_P) + rq * EIN + 512 + h * 128, Kh, Kh + 512, WSB(F, WS_MIX) + rq * DM + 512 + h * 128, TPB, lds, IN_QG(F) + j2 * 128, WSF(F, WS_ROPE_E), qb * 256);
        } else { const int v = u - 768, b = v / 12, h = v - b * 12, kvh = h / 3; const size_t rq = (size_t)(b * TPB + SEQ);
            const bf16* Kh = WSB(F, WS_P) + rq * EIN + 2048 + kvh * 128;
            att::attn_dense_body(WSB(F, WS_P) + rq * EIN + 512 + h * 128, Kh, Kh + 512, WSB(F, WS_MIX) + rq * DM + 512 + h * 128, CTXL, lds, IN_QG(F) + j2 * 128, nullptr, 0);
        }
    }
}
namespace ret {
constexpr int K_LD = 544, V_LD = 288, ST_LD = 544, Q_LD = 544;
constexpr int K_OFF = 0, V_OFF = 64 * K_LD, ST_OFF = V_OFF + 64 * V_LD, Q_OFF = ST_OFF + 128 * ST_LD, LDS_END = Q_OFF + 64 * Q_LD;
static_assert(LDS_END <= LDSCTL_OFF, "retention LDS");
typedef short v4i16_t __attribute__((ext_vector_type(4)));
__device__ __forceinline__ bf16x8 lds16(const LAS unsigned char* p) { return *(const LAS bf16x8*)p; }
__device__ __forceinline__ s16x4 ldstr(const LAS unsigned char* p) { return __builtin_bit_cast(s16x4, __builtin_amdgcn_ds_read_tr16_b64_v4i16((LAS v4i16_t*)p)); }
__device__ __forceinline__ bf16x8 cat8(s16x4 lo, s16x4 hi) { return (bf16x8){lo[0], lo[1], lo[2], lo[3], hi[0], hi[1], hi[2], hi[3]}; }
__device__ __forceinline__ bf16x8 pack8(const float* v) { const v4u w = {pk2(v[0], v[1]), pk2(v[2], v[3]), pk2(v[4], v[5]), pk2(v[6], v[7])}; return __builtin_bit_cast(bf16x8, w); }
#ifndef PROBE_RETBAR
#define PROBE_RETBAR 0
#endif
#define RET_BAR() do { asm volatile("s_waitcnt lgkmcnt(0)" ::: "memory"); __builtin_amdgcn_s_barrier(); if (PROBE_RETBAR) __builtin_amdgcn_s_barrier(); asm volatile("" ::: "memory"); } while (0)
#ifndef RET_EARLY_LOAD
#define RET_EARLY_LOAD 1
#endif
#ifndef RET_SBMASK
#define RET_SBMASK -1
#endif
#ifndef RET_NOSB
#define RET_NOSB 0
#endif
#define RET_SB() do { if (!RET_NOSB) __builtin_amdgcn_sched_barrier(0); } while (0)
#define RET_SBX(i) do { if (RET_SBMASK >= 0 && ((i) & RET_SBMASK) == RET_SBMASK) RET_SB(); } while (0)
__device__ __forceinline__ void ret_item(LAS unsigned char* lds, const bf16* P, bf16* Odir, int b, int h, int dir, int es, float lg) {
    int tid = threadIdx.x; asm volatile("" : "+v"(tid));
    const int w = __builtin_amdgcn_readfirstlane(tid >> 6), lane = tid & 63, g = lane >> 4, c = lane & 15, wi = w & 3, we = w >> 2, q4 = c >> 2, p4 = c & 3;
    const float lg2 = lg * 1.4426950408889634f;
    const bf16* Pq = P + h * 256 + (tid & 31) * 8; const bf16* Pk = Pq + 2048; const bf16* Pv = P + 4096 + h * 512 + es * 128 + (tid & 15) * 8;
    bf16* Oo = Odir + h * 512 + es * 128 + we * 64 + c;
    { unsigned z_ = 0u; asm volatile("" : "+v"(z_));
      for (int i = tid; i < 128 * ST_LD / 16; i += NWAVES * 64) *(LAS v4u*)(lds + ST_OFF + i * 16) = (v4u){z_, z_, z_, z_}; }
    f32x4 st[2][8];
#pragma unroll
    for (int a = 0; a < 2; ++a)
#pragma unroll
        for (int e = 0; e < 8; ++e) st[a][e] = (f32x4){0.f, 0.f, 0.f, 0.f};
    const int kr = tid >> 5, vr = tid >> 4;
    const float cd = __builtin_amdgcn_exp2f(64.0f * lg2);
    v4u kreg[4], qreg[4], vreg[2];
#define RET_ROWBASE(n) (dir == 0 ? (b * TPB + ((n) < 4 ? SEQ + 64 * (n) : 64 * (n) - CTXL)) : (b * TPB + ((n) < 4 ? SEQ + 255 - 64 * (n) : 2303 - 64 * (n))))
#define RET_LOAD(n) do { const int rb_ = RET_ROWBASE(n), sg_ = dir == 0 ? 1 : -1; \
        _Pragma("unroll") for (int x = 0; x < 4; ++x) { const size_t ro_ = (size_t)(rb_ + sg_ * (kr + 16 * x)) * OIN; kreg[x] = *(const GAS v4u*)(Pk + ro_); qreg[x] = *(const GAS v4u*)(Pq + ro_); } \
        _Pragma("unroll") for (int x = 0; x < 2; ++x) vreg[x] = *(const GAS v4u*)(Pv + (size_t)(rb_ + sg_ * (vr + 32 * x)) * OIN); } while (0)
    RET_LOAD(0);
    for (int n = 0; n < 36; ++n) {
        const int rowbase = RET_ROWBASE(n), sgn = dir == 0 ? 1 : -1;
#pragma unroll
        for (int x = 0; x < 4; ++x) { *(LAS v4u*)(lds + K_OFF + (kr + 16 * x) * K_LD + (tid & 31) * 16) = kreg[x]; *(LAS v4u*)(lds + Q_OFF + (kr + 16 * x) * Q_LD + (tid & 31) * 16) = qreg[x]; }
#pragma unroll
        for (int x = 0; x < 2; ++x) { const float kd = __builtin_amdgcn_exp2f((float)(63 - (vr + 32 * x)) * lg2); const v4u r = vreg[x];
            *(LAS v4u*)(lds + V_OFF + (vr + 32 * x) * V_LD + (tid & 15) * 16) = (v4u){pk2(bflo(r.x) * kd, bfhi(r.x) * kd), pk2(bflo(r.y) * kd, bfhi(r.y) * kd), pk2(bflo(r.z) * kd, bfhi(r.z) * kd), pk2(bflo(r.w) * kd, bfhi(r.w) * kd)}; }
        RET_BAR();
#if RET_EARLY_LOAD
        if (n + 1 < 36) RET_LOAD(n + 1);
#endif
        float lg2v = lg2; int gl = g, cl = c; asm volatile("" : "+v"(lg2v), "+v"(gl), "+v"(cl));
#define RD_Q(s)    lds16(lds + Q_OFF + (16 * wi + c) * Q_LD + (32 * (s) + 8 * g) * 2)
#define RD_K(jt, s) lds16(lds + K_OFF + (16 * (jt) + c) * K_LD + (32 * (s) + 8 * g) * 2)
#define RD_ST(et, s) lds16(lds + ST_OFF + (64 * we + 16 * (et) + c) * ST_LD + (32 * (s) + 8 * g) * 2)
        f32x4 sT[4], O[4];
#pragma unroll
        for (int jt = 0; jt < 4; ++jt) { sT[jt] = (f32x4){0.f, 0.f, 0.f, 0.f}; O[jt] = (f32x4){0.f, 0.f, 0.f, 0.f}; }
        {
            bf16x8 qc = RD_Q(0), qn = qc, kf[4], sf[4];
#pragma unroll
            for (int jt = 0; jt < 4; ++jt) kf[jt] = RD_K(jt, 0);
#pragma unroll
            for (int s = 0; s < 8; ++s) {
#pragma unroll
                for (int et = 0; et < 4; ++et) sf[et] = RD_ST(et, s);
                RET_SB();
#pragma unroll
                for (int jt = 0; jt < 4; ++jt) sT[jt] = __builtin_amdgcn_mfma_f32_16x16x32_bf16(kf[jt], qc, sT[jt], 0, 0, 0);
                RET_SB();
                if (s < 7) { qn = RD_Q(s + 1);
#pragma unroll
                    for (int jt = 0; jt < 4; ++jt) kf[jt] = RD_K(jt, s + 1); }
                RET_SB();
#pragma unroll
                for (int et = 0; et < 4; ++et) O[et] = __builtin_amdgcn_mfma_f32_16x16x32_bf16(qc, sf[et], O[et], 0, 0, 0);
                RET_SB();
                qc = qn;
            }
        }
        s16x4 vlo[4][2], vhi[4][2];
#pragma unroll
        for (int et = 0; et < 4; ++et)
#pragma unroll
            for (int s2 = 0; s2 < 2; ++s2) { const LAS unsigned char* vp = lds + V_OFF + (32 * s2 + 4 * g + q4) * V_LD + (64 * we + 16 * et + 4 * p4) * 2; vlo[et][s2] = ldstr(vp); vhi[et][s2] = ldstr(vp + 16 * V_LD); }
        RET_SB();
#pragma unroll
        for (int et = 0; et < 4; ++et) O[et] = O[et] * cd;
        bf16x8 pA[2];
#pragma unroll
        for (int s2 = 0; s2 < 2; ++s2) { float v[8];
#pragma unroll
            for (int jj = 0; jj < 8; ++jj) { const int jt = 2 * s2 + (jj >> 2), r = jj & 3, diff = (16 * wi + cl) - (16 * jt + 4 * gl + r);
                const bool keep = dir == 0 ? diff >= 0 : diff > 0;
                v[jj] = keep ? sT[jt][r] : 0.f; }
            pA[s2] = pack8(v); }
        RET_SB();
        s16x4 klo[2][2], khi[2][2];
#pragma unroll
        for (int s2 = 0; s2 < 2; ++s2)
#pragma unroll
            for (int dt = 0; dt < 2; ++dt) { const LAS unsigned char* kp = lds + K_OFF + (32 * s2 + 4 * g + q4) * K_LD + (32 * w + 8 * p4 + 4 * dt) * 2; klo[s2][dt] = ldstr(kp); khi[s2][dt] = ldstr(kp + 16 * K_LD); }
        RET_SB();
#pragma unroll
        for (int et = 0; et < 4; ++et)
#pragma unroll
            for (int s2 = 0; s2 < 2; ++s2) O[et] = __builtin_amdgcn_mfma_f32_16x16x32_bf16(pA[s2], cat8(vlo[et][s2], vhi[et][s2]), O[et], 0, 0, 0);
        RET_SB();
#define RD_V4(it) cat8(ldstr(lds + V_OFF + (32 * ((it) >> 3) + 4 * g + q4) * V_LD + (16 * ((it) & 7) + 4 * p4) * 2), ldstr(lds + V_OFF + (32 * ((it) >> 3) + 4 * g + q4 + 16) * V_LD + (16 * ((it) & 7) + 4 * p4) * 2))
        bf16x8 vbc = RD_V4(0), vbn = vbc;
        RET_SB();
#pragma unroll
        for (int a = 0; a < 2; ++a)
#pragma unroll
            for (int e = 0; e < 8; ++e) st[a][e] *= cd;
        bf16x8 ka[2][2];
#pragma unroll
        for (int s2 = 0; s2 < 2; ++s2)
#pragma unroll
            for (int dt = 0; dt < 2; ++dt) ka[s2][dt] = cat8(klo[s2][dt], khi[s2][dt]);
        { bf16* ob = Oo + (size_t)(dir == 0 ? rowbase : rowbase - 63) * OMIX;
#pragma unroll
            for (int r = 0; r < 4; ++r) { const int i = 16 * wi + 4 * g + r; const float rf = __builtin_amdgcn_exp2f((float)(16 * wi + 4 * gl + r - 63) * lg2v);
                const unsigned off = (unsigned)(dir == 0 ? i : 63 - i) * OMIX;
#pragma unroll
                for (int et = 0; et < 4; ++et) ob[off + 16 * et] = (bf16)(pk2(O[et][r] * rf, 0.f) & 0xffffu); } }
        RET_SB();
#pragma unroll
        for (int it = 0; it < 16; ++it) {
            if (it < 15) vbn = RD_V4(it + 1);
            RET_SB();
            st[0][it & 7] = __builtin_amdgcn_mfma_f32_16x16x32_bf16(ka[it >> 3][0], vbc, st[0][it & 7], 0, 0, 0);
            st[1][it & 7] = __builtin_amdgcn_mfma_f32_16x16x32_bf16(ka[it >> 3][1], vbc, st[1][it & 7], 0, 0, 0);
            RET_SB();
            vbc = vbn;
        }
#undef RD_Q
#undef RD_K
#undef RD_ST
#undef RD_V4
        RET_BAR();
        if (n + 1 < 36) {
#pragma unroll
            for (int et = 0; et < 8; ++et)
                *(LAS v4u*)(lds + ST_OFF + (16 * et + c) * ST_LD + (32 * w + 8 * g) * 2) = (v4u){pk2(st[0][et][0], st[0][et][1]), pk2(st[0][et][2], st[0][et][3]), pk2(st[1][et][0], st[1][et][1]), pk2(st[1][et][2], st[1][et][3])};
        }
    }
#undef RET_LOAD
#undef RET_ROWBASE
}

__device__ __forceinline__ void ret_item_spec(LAS unsigned char* lds, const bf16* P, bf16* Odir, int b, int h, int dir, int es, float lg, int noctx) {
    int tid = threadIdx.x; asm volatile("" : "+v"(tid));
    const int w = __builtin_amdgcn_readfirstlane(tid >> 6), lane = tid & 63, g = lane >> 4, c = lane & 15, q4 = c >> 2, p4 = c & 3;
    const float lg2 = lg * 1.4426950408889634f;
    const bf16* Pq = P + h * 256 + (tid & 31) * 8; const bf16* Pk = Pq + 2048; const bf16* Pv = P + 4096 + h * 512 + es * 128 + (tid & 15) * 8;
    { unsigned z_ = 0u; asm volatile("" : "+v"(z_));
      for (int i = tid; i < 128 * ST_LD / 16; i += NWAVES * 64) *(LAS v4u*)(lds + ST_OFF + i * 16) = (v4u){z_, z_, z_, z_}; }
    const int kr = (tid & 255) >> 5, vr = (tid & 255) >> 4;
    const float cd = __builtin_amdgcn_exp2f(64.0f * lg2);
#define RET_ROWBASE(n) (dir == 0 ? (b * TPB + ((n) < 4 ? SEQ + 64 * (n) : 64 * (n) - CTXL)) : (b * TPB + ((n) < 4 ? SEQ + 255 - 64 * (n) : 2303 - 64 * (n))))
#define RET_LOADA(n) do { const int rb_ = RET_ROWBASE(n), sg_ = dir == 0 ? 1 : -1; \
        _Pragma("unroll") for (int x = 0; x < 8; ++x) { const size_t ro_ = (size_t)(rb_ + sg_ * (kr + 8 * x)) * OIN; kreg[x] = *(const GAS v4u*)(Pk + ro_); qreg[x] = *(const GAS v4u*)(Pq + ro_); } } while (0)
#define RET_STAGEA() do { \
        _Pragma("unroll") for (int x = 0; x < 8; ++x) { *(LAS v4u*)(lds + K_OFF + (kr + 8 * x) * K_LD + (tid & 31) * 16) = kreg[x]; *(LAS v4u*)(lds + Q_OFF + (kr + 8 * x) * Q_LD + (tid & 31) * 16) = qreg[x]; } } while (0)
#define RET_LOADB(n) do { const int rb_ = RET_ROWBASE(n), sg_ = dir == 0 ? 1 : -1; \
        _Pragma("unroll") for (int x = 0; x < 4; ++x) vreg[x] = *(const GAS v4u*)(Pv + (size_t)(rb_ + sg_ * (vr + 16 * x)) * OIN); } while (0)
#define RET_STAGEB() do { \
        _Pragma("unroll") for (int x = 0; x < 4; ++x) { const float kd = __builtin_amdgcn_exp2f((float)(63 - (vr + 16 * x)) * lg2); const v4u r = vreg[x]; \
            *(LAS v4u*)(lds + V_OFF + (vr + 16 * x) * V_LD + (tid & 15) * 16) = (v4u){pk2(bflo(r.x) * kd, bfhi(r.x) * kd), pk2(bflo(r.y) * kd, bfhi(r.y) * kd), pk2(bflo(r.z) * kd, bfhi(r.z) * kd), pk2(bflo(r.w) * kd, bfhi(r.w) * kd)}; } } while (0)
    if (w < 4) {
        const int wa = w;
        bf16* Oo = Odir + h * 512 + es * 128 + c;
        v4u kreg[8], qreg[8];
        RET_LOADA(0);
        for (int n = 0; n < 36; ++n) {
            const int rowbase = RET_ROWBASE(n);
            RET_STAGEA();
            RET_BAR();
            if (n + 1 < 36) RET_LOADA(n + 1);
            if (!(noctx && n < 4)) {
            float lg2v = lg2; int gl = g, cl = c; asm volatile("" : "+v"(lg2v), "+v"(gl), "+v"(cl));
#define RD_Q(s)    lds16(lds + Q_OFF + (16 * wa + c) * Q_LD + (32 * (s) + 8 * g) * 2)
#define RD_K(jt, s) lds16(lds + K_OFF + (16 * (jt) + c) * K_LD + (32 * (s) + 8 * g) * 2)
#define RD_ST(et, s) lds16(lds + ST_OFF + (16 * (et) + c) * ST_LD + (32 * (s) + 8 * g) * 2)
            f32x4 sT[4], O[8];
#pragma unroll
            for (int jt = 0; jt < 4; ++jt) sT[jt] = (f32x4){0.f, 0.f, 0.f, 0.f};
#pragma unroll
            for (int et = 0; et < 8; ++et) O[et] = (f32x4){0.f, 0.f, 0.f, 0.f};
            {
                bf16x8 q0 = RD_Q(0), q1, k0[4], k1[4], sf[8];
#pragma unroll
                for (int jt = 0; jt < 4; ++jt) k0[jt] = RD_K(jt, 0);
#pragma unroll
                for (int s = 0; s < 8; s += 2) {
                    q1 = RD_Q(s + 1);
#pragma unroll
                    for (int jt = 0; jt < 4; ++jt) k1[jt] = RD_K(jt, s + 1);
#pragma unroll
                    for (int et = 0; et < 8; ++et) sf[et] = RD_ST(et, s);
                    RET_SB();
#pragma unroll
                    for (int jt = 0; jt < 4; ++jt) sT[jt] = __builtin_amdgcn_mfma_f32_16x16x32_bf16(k0[jt], q0, sT[jt], 0, 0, 0);
                    RET_SB();
#pragma unroll
                    for (int et = 0; et < 8; ++et) O[et] = __builtin_amdgcn_mfma_f32_16x16x32_bf16(q0, sf[et], O[et], 0, 0, 0);
                    RET_SB();
                    if (s + 2 < 8) { q0 = RD_Q(s + 2);
#pragma unroll
                        for (int jt = 0; jt < 4; ++jt) k0[jt] = RD_K(jt, s + 2); }
#pragma unroll
                    for (int et = 0; et < 8; ++et) sf[et] = RD_ST(et, s + 1);
                    RET_SB();
#pragma unroll
                    for (int jt = 0; jt < 4; ++jt) sT[jt] = __builtin_amdgcn_mfma_f32_16x16x32_bf16(k1[jt], q1, sT[jt], 0, 0, 0);
                    RET_SB();
#pragma unroll
                    for (int et = 0; et < 8; ++et) O[et] = __builtin_amdgcn_mfma_f32_16x16x32_bf16(q1, sf[et], O[et], 0, 0, 0);
                    RET_SB();
                }
            }
#pragma unroll
            for (int et = 0; et < 8; ++et) O[et] = O[et] * cd;
            bf16x8 pA[2];
#pragma unroll
            for (int s2 = 0; s2 < 2; ++s2) { float v[8];
#pragma unroll
                for (int jj = 0; jj < 8; ++jj) { const int jt = 2 * s2 + (jj >> 2), r = jj & 3, diff = (16 * wa + cl) - (16 * jt + 4 * gl + r);
                    const bool keep = dir == 0 ? diff >= 0 : diff > 0;
                    v[jj] = keep ? sT[jt][r] : 0.f; }
                pA[s2] = pack8(v); }
            RET_SB();
            {
#define RD_VA(et, s2) cat8(ldstr(lds + V_OFF + (32 * (s2) + 4 * g + q4) * V_LD + (16 * (et) + 4 * p4) * 2), ldstr(lds + V_OFF + (32 * (s2) + 4 * g + q4 + 16) * V_LD + (16 * (et) + 4 * p4) * 2))
                bf16x8 va[2][2], vb[2][2];
#pragma unroll
                for (int q = 0; q < 2; ++q) { va[q][0] = RD_VA(q, 0); va[q][1] = RD_VA(q, 1); }
#pragma unroll
                for (int et = 0; et < 8; et += 4) {
#pragma unroll
                    for (int q = 0; q < 2; ++q) { vb[q][0] = RD_VA(et + 2 + q, 0); vb[q][1] = RD_VA(et + 2 + q, 1); }
                    RET_SB();
#pragma unroll
                    for (int q = 0; q < 2; ++q) { O[et + q] = __builtin_amdgcn_mfma_f32_16x16x32_bf16(pA[0], va[q][0], O[et + q], 0, 0, 0); O[et + q] = __builtin_amdgcn_mfma_f32_16x16x32_bf16(pA[1], va[q][1], O[et + q], 0, 0, 0); }
                    RET_SB();
                    if (et + 4 < 8) {
#pragma unroll
                        for (int q = 0; q < 2; ++q) { va[q][0] = RD_VA(et + 4 + q, 0); va[q][1] = RD_VA(et + 4 + q, 1); } }
                    RET_SB();
#pragma unroll
                    for (int q = 0; q < 2; ++q) { O[et + 2 + q] = __builtin_amdgcn_mfma_f32_16x16x32_bf16(pA[0], vb[q][0], O[et + 2 + q], 0, 0, 0); O[et + 2 + q] = __builtin_amdgcn_mfma_f32_16x16x32_bf16(pA[1], vb[q][1], O[et + 2 + q], 0, 0, 0); }
                    RET_SB();
                }
#undef RD_VA
            }
            {
                bf16* ob = Oo + (size_t)(dir == 0 ? rowbase : rowbase - 63) * OMIX;
#pragma unroll
                for (int r = 0; r < 4; ++r) { const int i = 16 * wa + 4 * g + r; const float rf = __builtin_amdgcn_exp2f((float)(16 * wa + 4 * gl + r - 63) * lg2v);
                    const unsigned off = (unsigned)(dir == 0 ? i : 63 - i) * OMIX;
#pragma unroll
                    for (int et = 0; et < 8; ++et) ob[off + 16 * et] = (bf16)(pk2(O[et][r] * rf, 0.f) & 0xffffu); }
            }
#undef RD_Q
#undef RD_K
#undef RD_ST
            }
            RET_BAR();
        }
    } else {
        const int wb = w - 4;
        v4u vreg[4];
        RET_LOADB(0);
        f32x4 st[2][2][8];
#pragma unroll
        for (int a = 0; a < 2; ++a)
#pragma unroll
            for (int d = 0; d < 2; ++d)
#pragma unroll
                for (int e = 0; e < 8; ++e) st[a][d][e] = (f32x4){0.f, 0.f, 0.f, 0.f};
        for (int n = 0; n < 36; ++n) {
            RET_STAGEB();
            RET_BAR();
            if (n + 1 < 36) RET_LOADB(n + 1);
            bf16x8 ka[2][2][2];
#pragma unroll
            for (int s2 = 0; s2 < 2; ++s2)
#pragma unroll
                for (int dp = 0; dp < 2; ++dp)
#pragma unroll
                    for (int dt = 0; dt < 2; ++dt) { const LAS unsigned char* kp = lds + K_OFF + (32 * s2 + 4 * g + q4) * K_LD + (64 * wb + 32 * dp + 8 * p4 + 4 * dt) * 2; ka[s2][dp][dt] = cat8(ldstr(kp), ldstr(kp + 16 * K_LD)); }
#define RD_V4(it) cat8(ldstr(lds + V_OFF + (32 * ((it) >> 3) + 4 * g + q4) * V_LD + (16 * ((it) & 7) + 4 * p4) * 2), ldstr(lds + V_OFF + (32 * ((it) >> 3) + 4 * g + q4 + 16) * V_LD + (16 * ((it) & 7) + 4 * p4) * 2))
            bf16x8 vbc = RD_V4(0), vbn = vbc;
            RET_SB();
#pragma unroll
            for (int a = 0; a < 2; ++a)
#pragma unroll
                for (int d = 0; d < 2; ++d)
#pragma unroll
                    for (int e = 0; e < 8; ++e) st[a][d][e] *= cd;
            RET_SB();
#pragma unroll
            for (int it = 0; it < 16; ++it) {
                if (it < 15) vbn = RD_V4(it + 1);
                RET_SB();
#pragma unroll
                for (int dp = 0; dp < 2; ++dp)
#pragma unroll
                    for (int dt = 0; dt < 2; ++dt) st[dp][dt][it & 7] = __builtin_amdgcn_mfma_f32_16x16x32_bf16(ka[it >> 3][dp][dt], vbc, st[dp][dt][it & 7], 0, 0, 0);
                RET_SB();
                vbc = vbn;
            }
#undef RD_V4
            RET_BAR();
            if (n + 1 < 36) {
#pragma unroll
                for (int dp = 0; dp < 2; ++dp)
#pragma unroll
                    for (int et = 0; et < 8; ++et)
                        *(LAS v4u*)(lds + ST_OFF + (16 * et + c) * ST_LD + (64 * wb + 32 * dp + 8 * g) * 2) = (v4u){pk2(st[dp][0][et][0], st[dp][0][et][1]), pk2(st[dp][0][et][2], st[dp][0][et][3]), pk2(st[dp][1][et][0], st[dp][1][et][1]), pk2(st[dp][1][et][2], st[dp][1][et][3])};
            }
        }
    }
#undef RET_LOADA
#undef RET_STAGEA
#undef RET_LOADB
#undef RET_STAGEB
#undef RET_ROWBASE
}
}
__device__ __forceinline__ void ph_retention(Frame& F, const Args& A, int j2, int noctx) {
    for (int item = F.vcu; item < 512; item += F.G) {
        const int es = item & 3, dir = (item >> 2) & 1, h = (item >> 3) & 7, b = item >> 6;
        const float lg = (dir ? IN_LDB(F) : IN_LDF(F))[j2 * 8 + h];
#ifndef RET_SPEC
#define RET_SPEC 1
#endif
#if RET_SPEC
        ret::ret_item_spec(F.lds + RING_OFF, WSB(F, WS_P), dir ? WSB(F, WS_OB) : WSB(F, WS_OF), b, h, dir, es, lg, noctx);
#else
        ret::ret_item(F.lds + RING_OFF, WSB(F, WS_P), dir ? WSB(F, WS_OB) : WSB(F, WS_OF), b, h, dir, es, lg);
#endif
    }
}
__global__ void __launch_bounds__(NWAVES * 64, 2) dit_fwd(Args args) {
    extern __shared__ __attribute__((aligned(16))) unsigned char lds[];
    Frame F0;
    F0.lds = (LAS unsigned char*)lds;
    F0.MISC = (volatile LAS unsigned*)(F0.lds + MISC_OFF);
    F0.wave = __builtin_amdgcn_readfirstlane((int)threadIdx.x >> 6);
    F0.G = gridDim.x; { const int bx = blockIdx.x; F0.vcu = (F0.G % 8 == 0) ? (bx % 8) * (F0.G / 8) + bx / 8 : bx; }
    F0.ws = (GAS unsigned char*)args.ws; F0.out = (GAS float*)args.out;
    F0.ctl = (gu32*)(F0.ws + WS_CTL);
    for (int u = threadIdx.x; u < (LDS_BYTES - LDSCTL_OFF) / 4; u += NWAVES * 64) ((LAS unsigned*)(F0.lds + LDSCTL_OFF))[u] = 0u;
    __syncthreads();
    XcdBarrier bar; bar.bar = (unsigned*)(F0.ctl + CW_BAR); bar.x = 0; bar.st = nullptr;
    if (MK_N_LAUNCHES == 1) bar = xcd_barrier_post((unsigned*)(F0.ctl + CW_BAR), F0.MISC + 8);
    const int lo = args.ph_lo, hi = args.ph_hi;
#ifndef LATE_F_FIN
#define LATE_F_FIN 0
#endif
#ifndef LATE_F_EVEN
#define LATE_F_EVEN 15
#endif
#ifndef LATE_F_ODD
#define LATE_F_ODD 30
#endif
#ifndef RESID_G
#define RESID_G 0
#endif
#ifndef GEMM_SP2
#define GEMM_SP2 true
#endif
#ifndef GEMM_ALIGN
#define GEMM_ALIGN true
#endif
#ifndef PROBE_BAR2
#define PROBE_BAR2 0
#endif
#ifndef SPLITK
#define SPLITK 0
#endif
#ifndef SITE_MASK
#define SITE_MASK 0xffffffffu
#endif
#define SITE(n) (((SITE_MASK) >> (n)) & 1u)
#define IN(k) (lo <= (k) && (k) < hi)
#define SEAM(k) do { if ((k) + 1 < hi) { if (MK_N_LAUNCHES == 1) { XcdBarrier bv_ = bar; asm volatile("" : "+s"(bv_.bar)); xcd_barrier(bv_); if (PROBE_BAR2) { XcdBarrier bw_ = bar; asm volatile("" : "+s"(bw_.bar)); xcd_barrier(bw_); } } } } while (0)
#define LAUNDER(Fv) Frame Fv = F0; asm volatile("" : "+s"(Fv.ws), "+s"(Fv.out), "+s"(Fv.G), "+s"(Fv.vcu), "+s"(Fv.wave), "+s"(cid))
#define GEMM_CALL1(EPI, g_, S_, E_) pg8::gemm_phase<EPI, pg8::TokOrder, GEMM_ALIGN, GEMM_SP2>(F.lds + RING_OFF, g_, S_, E_)
#ifdef PROBE_GEMM_STORE2
#define GEMM_CALL(EPI, g_, S_, E_) do { for (int rep_ = 0; rep_ < 2; ++rep_) { GEMM_CALL1(EPI, g_, S_, E_); __syncthreads(); } } while (0)
#else
#define GEMM_CALL(EPI, g_, S_, E_) GEMM_CALL1(EPI, g_, S_, E_)
#endif
#ifdef PROBE_GEMM_RESID2
#define GEMM_CALLR(g_, S_, E_) do { pg8::EpiResid E2_ = E_; for (int rep_ = 0; rep_ < 2; ++rep_) { E2_.dry = rep_; GEMM_CALL1(pg8::EpiResid, g_, S_, E2_); __syncthreads(); } } while (0)
#else
#define GEMM_CALLR(g_, S_, E_) GEMM_CALL1(pg8::EpiResid, g_, S_, E_)
#endif
    int cid = (int)blockIdx.x;

    if (SITE(0) && IN(0)) { LAUNDER(F); ph_prologue(F, args);
#ifdef PROBE_PRO2
        __syncthreads(); { LAUNDER(F2); ph_prologue(F2, args); }
#endif
        SEAM(0); }
    for (int L = 0; L < 4; ++L) {
        const int pb = 1 + 9 * L, j2 = L >> 1, even = !(L & 1), last = (L == 3);
        if (SITE(1) && IN(pb + 0)) { LAUNDER(F); ph_modulate(F, args, L, 0, 0, SPLITK && L >= 1, L == 0);
#ifdef PROBE_MOD2
            { LAUNDER(F2); ph_modulate(F2, args, L, 0, 0, 0, L == 0); }
#endif
            SEAM(pb + 0); }
        if (SITE(2) && IN(pb + 1)) { LAUNDER(F);
            const int N = even ? EIN : OIN;
            pg8::Gemm g{WSB(F, WS_XN), even ? WSB(F, WS_W_INE) + (size_t)j2 * EIN * DM : WSB(F, WS_W_INO) + (size_t)j2 * OIN * DM, MROWS, N, DM};
            pg8::TokOrder S; if (last) S.init2(MLAT, N, DM, F.G, cid, 1, 0, 1); else S.init2(MROWS, N, DM, F.G, cid, 0, 0);
            pg8::EpiStore E{WSB(F, WS_P), N, even ? 0 : 3, WSF(F, WS_ROPE_O)};
            GEMM_CALL(pg8::EpiStore, g, S, E);
            SEAM(pb + 1);
        }
        if (even) {
            if (SITE(3) && IN(pb + 2)) { LAUNDER(F); ph_qk_even(F, args, j2); SEAM(pb + 2); }
            if (IN(pb + 3)) {
                if (SITE(4)) { LAUNDER(F); pg8::Gemm g{WSB(F, WS_WTL), WSB(F, WS_FT), 4096, 4096, 2048}; pg8::TokOrder S; S.init2(4096, 4096, 2048, F.G, cid, 0, 0); pg8::EpiStore E{WSB(F, WS_Z), 1024, 1, nullptr}; GEMM_CALL(pg8::EpiStore, g, S, E); }
                if (SITE(14)) { LAUNDER(F); pg8::Gemm g{WSB(F, WS_WTC), WSB(F, WS_FTC), 512, 4096, 256}; pg8::TokOrder S; S.init2(512, 4096, 256, F.G, cid, 0, 0); pg8::EpiStore E{WSB(F, WS_Z), 1024, 2, nullptr}; GEMM_CALL(pg8::EpiStore, g, S, E); }
                if (SITE(5)) { LAUNDER(F); ph_attention(F, args, j2); }
#ifdef PROBE_ATT2
                { LAUNDER(F); ph_attention(F, args, j2); }
#endif
                SEAM(pb + 3);
            }
            if (SITE(6) && IN(pb + 4)) { LAUNDER(F);
                pg8::Gemm g{WSB(F, WS_Z), WSB(F, WS_CB), MROWS, 512, 1024}; pg8::TokOrder S; S.init2(MROWS, 512, 1024, F.G, cid, 0, 0); pg8::EpiStore E{WSB(F, WS_MIX), DM, 0, nullptr};
                GEMM_CALL(pg8::EpiStore, g, S, E);
                SEAM(pb + 4);
            }
        } else {
            if (SITE(8) && IN(pb + 3)) { LAUNDER(F); ph_retention(F, args, j2, last);
#ifdef PROBE_RET2
                { LAUNDER(F2); ph_retention(F2, args, j2, last); }
#endif
                SEAM(pb + 3); }
            if (SITE(9) && IN(pb + 4)) { LAUNDER(F); ph_comb(F, last);
#ifdef PROBE_COMB2
                { LAUNDER(F2); ph_comb(F2, last, 1); }
#endif
                SEAM(pb + 4); }
        }
        if (SITE(10) && IN(pb + 5)) { LAUNDER(F); const float* gates = WSF(F, WS_MOD) + (size_t)L * NSET * MODW;
            const int K = even ? DM : OMIX, Ml = last ? MLAT : MROWS;
            pg8::Gemm g{even ? WSB(F, WS_MIX) : WSB(F, WS_OF), even ? WSB(F, WS_W_OUTE) + (size_t)j2 * DM * DM : WSB(F, WS_W_OUTO) + (size_t)j2 * DM * OMIX, Ml, DM, K};
            pg8::TokOrder S; S.init2(Ml, DM, K, F.G, cid, last, SPLITK && L > 0, 0, last ? 0 : RESID_G);
            pg8::EpiResid E{WSF(F, WS_H), gates, 2 * DM, nullptr, WSF(F, WS_DELTA), 0, L == 0 ? (const float*)(const GAS float*)args.in[0] : nullptr, (const float*)(const GAS float*)args.in[2]};
            GEMM_CALLR(g, S, E);
#if LATE_CONV
            if (!last && cid >= S.rem && S.rem > 0) { const int cnt = conv_layer_count(L + 1), c0 = (cnt * LATE_F_FIN) / 100, c1 = c0 + (cnt * (even ? LATE_F_EVEN : LATE_F_ODD)) / 100;
                conv_in_tail(F, args, L + 1, c0, c1, cid - S.rem, F.G - S.rem); }
#endif
            SEAM(pb + 5);
        }
        if (SITE(11) && IN(pb + 6)) { LAUNDER(F); ph_modulate(F, args, L, 1, last, SPLITK && !last && L > 0, 0);
#ifdef PROBE_MOD2
            { LAUNDER(F2); ph_modulate(F2, args, L, 1, last, 0, 0); }
#endif
            SEAM(pb + 6); }
        if (SITE(12) && IN(pb + 7)) { LAUNDER(F);
            const int Ml = last ? MLAT : MROWS;
            pg8::Gemm g{WSB(F, WS_XN), WSB(F, WS_W_FIN) + (size_t)L * FFN2 * DM, Ml, FFN2, DM};
            pg8::TokOrder S; S.init2(Ml, FFN2, DM, F.G, cid, last, 0);
            pg8::EpiSwiglu E{WSB(F, WS_P), FFN};
            GEMM_CALL(pg8::EpiSwiglu, g, S, E);
#if LATE_CONV
            if (!last && LATE_F_FIN > 0 && cid >= S.rem && S.rem > 0) { const int cnt = conv_layer_count(L + 1), c0 = (cnt * LATE_F_FIN) / 100;
                conv_in_tail(F, args, L + 1, 0, c0, cid - S.rem, F.G - S.rem); }
#endif
            SEAM(pb + 7);
        }
        if (SITE(13) && IN(pb + 8)) { LAUNDER(F); const float* gates = WSF(F, WS_MOD) + (size_t)L * NSET * MODW;
            const int Ml = last ? MLAT : MROWS;
            pg8::Gemm g{WSB(F, WS_P), WSB(F, WS_W_FOUT) + (size_t)L * DM * FFN, Ml, DM, FFN};
            pg8::TokOrder S; S.init2(Ml, DM, FFN, F.G, cid, last, SPLITK, 0, last ? 0 : RESID_G);
            pg8::EpiResid E{WSF(F, WS_H), gates, 5 * DM, last ? (float*)F.out : nullptr, WSF(F, WS_DELTA), 0, nullptr, nullptr};
            GEMM_CALLR(g, S, E);
#if LATE_CONV
            if (!last && cid >= S.rem && S.rem > 0) { const int cnt = conv_layer_count(L + 1), c1 = (cnt * LATE_F_FIN) / 100 + (cnt * (even ? LATE_F_EVEN : LATE_F_ODD)) / 100;
                conv_in_tail(F, args, L + 1, c1, cnt, cid - S.rem, F.G - S.rem); }
#endif
            SEAM(pb + 8);
        }
    }
#undef IN
#undef SEAM
#undef LAUNDER
#undef GEMM_CALL
}

extern "C" void kernel_launch(void* const* d_in, const int* in_sizes, int n_in, void* d_out, int out_size, void* d_ws, size_t ws_size, hipStream_t stream) {
    static int grid = 0;
    if (grid == 0) {
        if (n_in != 16 || out_size != MLAT * DM || ws_size < WS_END) { fprintf(stderr, "kernel_launch: unexpected shapes: n_in %d out %d ws %zu (need %zu)\n", n_in, out_size, ws_size, (size_t)WS_END); grid = -1; return; }
        int dev = 0, cus = 0, per_cu = 0;
        if (hipGetDevice(&dev) != hipSuccess || hipDeviceGetAttribute(&cus, hipDeviceAttributeMultiprocessorCount, dev) != hipSuccess) { fprintf(stderr, "kernel_launch: device query failed\n"); grid = -1; return; }
        if (hipFuncSetAttribute((const void*)dit_fwd, hipFuncAttributeMaxDynamicSharedMemorySize, LDS_BYTES) != hipSuccess) { fprintf(stderr, "kernel_launch: hipFuncSetAttribute failed\n"); grid = -1; return; }
        if (hipOccupancyMaxActiveBlocksPerMultiprocessor(&per_cu, (const void*)dit_fwd, NWAVES * 64, LDS_BYTES) != hipSuccess || per_cu < 1)
            fprintf(stderr, "kernel_launch: note: occupancy query reports %d workgroups per CU\n", per_cu);
        (void)hipGetLastError();
        grid = cus;
    }
    if (grid < 0) return;
    if (hipMemsetAsync((char*)d_ws + WS_CTL, 0, CTL_ZERO_BYTES, stream) != hipSuccess) { fprintf(stderr, "kernel_launch: memset failed\n"); return; }
    Args a{};
    for (int i = 0; i < 16; ++i) a.in[i] = (const float*)d_in[i];
    a.out = (float*)d_out; a.ws = (unsigned char*)d_ws;
#if MK_N_LAUNCHES == 1
    a.ph_lo = 0; a.ph_hi = N_PHASES;
    hipLaunchKernelGGL(dit_fwd, dim3(grid), dim3(NWAVES * 64), LDS_BYTES, stream, a);
#else
    for (int p = 0; p < N_PHASES; ++p) { a.ph_lo = p; a.ph_hi = p + 1; hipLaunchKernelGGL(dit_fwd, dim3(grid), dim3(NWAVES * 64), LDS_BYTES, stream, a); }
#endif
    const hipError_t le = hipPeekAtLastError();
    if (le != hipSuccess) fprintf(stderr, "kernel_launch: launch failed: %s\n", hipGetErrorName(le));
}
```

```cpp
#include <hip/hip_runtime.h>
#include <cstdio>
#include <cstdint>
#include <cmath>
#ifndef WGM_SET
#define WGM_SET 8
#endif
namespace pg8 {
#define PG8_LAS __attribute__((address_space(3)))
typedef unsigned short bf16_t;
typedef short bf16x8 __attribute__((ext_vector_type(8)));
typedef float f32x4 __attribute__((ext_vector_type(4)));
typedef unsigned u32x4 __attribute__((ext_vector_type(4)));
constexpr int BM = 256, BK = 64, HALF = 128, HTB = HALF * BK * 2  , STAGE_BYTES = 8 * HTB, NXCD = 8, WGM = WGM_SET;

__host__ __device__ __forceinline__ int lds_byte(int r, int c) { const int st = (r >> 4) * 2 + (c >> 5), rr = r & 15, cc = c & 31, ob = rr * 64 + cc * 2; return st * 1024 + (ob ^ (((ob >> 9) & 1) << 5)); }
__host__ __device__ __forceinline__ void stage_rc(int b, int& R, int& C) { const int st = b / 1024, sb = b % 1024, swz = sb ^ (((sb >> 9) & 1) << 5); R = (st >> 1) * 16 + swz / 64; C = (st & 1) * 32 + (swz % 64) / 2; }
__host__ __device__ __forceinline__ int perm32(int rho) { const int n = rho >> 4, i = rho & 15; return 8 * (i >> 2) + 4 * n + (i & 3); }

struct Unit { int pm, pn, kt0, nkt, split; };
struct Gemm { const bf16_t* A; const bf16_t* Bt; int M, N, K; };

#ifndef WGM_WIDE
#define WGM_WIDE WGM
#endif
#ifndef WGM_NARROW
#define WGM_NARROW 2
#endif
struct StaticOrder {
    int nM, nN, nwg, G, c;
    __host__ __device__ void init(int M, int N, int G_, int c_) { nM = M / BM; nN = N / BM; nwg = nM * nN; G = G_; c = c_; }
    __host__ __device__ void map(int wgid, Unit& u) const {
        { const int q = nwg / NXCD, r = nwg % NXCD, xcd = wgid % NXCD, off = wgid / NXCD; wgid = (xcd < r ? xcd * (q + 1) : r * (q + 1) + (xcd - r) * q) + off; }
        const int wgm = nN >= 12 ? WGM_WIDE : WGM_NARROW;
        const int nig = wgm * nN, gid = wgid / nig, fm = gid * wgm, gsz = (nM - fm) < wgm ? (nM - fm) : wgm;
        u.pm = fm + ((wgid % nig) % gsz); u.pn = (wgid % nig) / gsz;
    }
    __device__ __forceinline__ void a_ready(const Unit&) const {}
    __device__ __forceinline__ void done(const Unit&) const {}
};

typedef __bf16 bf16x2_cv __attribute__((ext_vector_type(2)));
typedef float f32x2_cv __attribute__((ext_vector_type(2)));
__device__ __forceinline__ unsigned cvt_pk_bf16(float lo, float hi) { const f32x2_cv v = {lo, hi}; const bf16x2_cv b = __builtin_convertvector(v, bf16x2_cv); return __builtin_bit_cast(unsigned, b); }
typedef float f32x2 __attribute__((ext_vector_type(2)));
#ifndef WT_STORES
#define WT_STORES 0
#endif
__device__ __forceinline__ void st16_wt(void* p, u32x4 v) {
#if WT_STORES
    asm volatile("global_store_dwordx4 %0, %1, off sc1" :: "v"(p), "v"(v) : "memory");
#else
    *(u32x4*)p = v;
#endif
}
__device__ __forceinline__ void st16_wt(void* p, f32x4 v) { st16_wt(p, __builtin_bit_cast(u32x4, v)); }
#ifndef WT_HID
#define WT_HID 0
#endif
__device__ __forceinline__ void st16_hid(void* p, u32x4 v) {
#if WT_HID
    asm volatile("global_store_dwordx4 %0, %1, off sc1" :: "v"(p), "v"(v) : "memory");
#else
    *(u32x4*)p = v;
#endif
}
#ifndef GEMM_G_LIMIT
#define GEMM_G_LIMIT 0
#endif
struct TokOrder : StaticOrder {
    int skip, nktfull, nfull, rem, S, nextra;
    __device__ __forceinline__ void init2(int M, int N, int K, int G_, int c_, int skip_, int allow_split, int ctxkv = 0, int glimit = 0) {
        init(M, N, G_, c_); if (glimit > 0 && glimit < G_) G = glimit;     if (GEMM_G_LIMIT > 0 && GEMM_G_LIMIT < G_) { G = GEMM_G_LIMIT; }     skip = skip_; nktfull = K / BK; nfull = (nwg / G) * G; rem = nwg - nfull; S = 1; nextra = ctxkv ? 8 * 24 : 0;
        if (allow_split && rem > 0) { const int s = G / rem; S = s >= 4 ? 4 : 1;     if ((nktfull % (2 * S)) != 0 || nktfull / S < 4) S = 1; }
    }
    __device__ __forceinline__ bool next(int i, Unit& u) const {
        if (c >= G) return false;
        const long L = (long)i * G + c; int idx;
        if (L < nfull || S == 1) {
            if (L >= nwg) { const int r = (int)(L - nwg); if (r >= nextra) return false; u.kt0 = 0; u.nkt = nktfull; u.split = 0; u.pm = 9 * (r / 24) + 8; u.pn = 8 + r % 24; return true; }
            idx = (int)L; u.kt0 = 0; u.nkt = nktfull; u.split = 0; }
        else { const int sub = (int)(L - nfull); if (sub >= rem * S) return false; idx = nfull + sub / S; u.nkt = nktfull / S; u.kt0 = (sub % S) * u.nkt; u.split = 1 + (sub / S) * 4 + (sub % S); }
        map(idx, u); if (skip) u.pm += (u.pm >> 3); return true;
    }
};
struct EpiStore {
    static constexpr bool PERM = true, AFTER_DRAIN = false;
    bf16_t* O; int ldc; int mode; const float* rope;
    __device__ __forceinline__ void operator()(const f32x4 (&acc)[2][2][4][2], const Unit& u, int wr, int wc, int fr, int fq) const {
        size_t base;
        if (mode == 0 || mode == 3) base = (size_t)u.pm * BM * (size_t)ldc + (size_t)u.pn * BM;
        else if (mode == 1) { const int part = u.pm >> 3, t0 = (u.pm & 7) * 256, b = u.pn >> 1, c0 = (u.pn & 1) * 256; base = ((size_t)(b * 2304 + t0)) * 1024 + part * 512 + c0; }
        else { const int part = u.pm, b = u.pn >> 1, c0 = (u.pn & 1) * 256; base = ((size_t)(b * 2304 + 2048)) * 1024 + part * 512 + c0; }
        const int tt = u.pm % 9;
        if (mode == 3 && u.pn < 16 && tt != 8) {
            const int half = wc >> 1, f0 = 32 * (wc & 1) + 8 * fq;
            bf16_t* p0 = O + base + (size_t)(wr * 64 + fr) * ldc + half * 128 + f0;
#pragma unroll
            for (int ai = 0; ai < 2; ++ai)
#pragma unroll
                for (int m = 0; m < 4; ++m) { const int t = tt * 256 + ai * HALF + wr * 64 + m * 16 + fr, pos = half ? (t & 63) : (t >> 6);
                    const f32x4* tb = (const f32x4*)(rope + (size_t)(pos * 64 + f0) * 2);
                    const f32x4 t0 = tb[0], t1 = tb[1], t2 = tb[2], t3 = tb[3];
                    const f32x4 a0 = acc[ai][0][m][0], a1 = acc[ai][0][m][1], b0 = acc[ai][1][m][0], b1 = acc[ai][1][m][1];
                    const f32x4 cs0 = {t0[0], t0[2], t1[0], t1[2]}, sn0 = {t0[1], t0[3], t1[1], t1[3]}, cs1 = {t2[0], t2[2], t3[0], t3[2]}, sn1 = {t2[1], t2[3], t3[1], t3[3]};
                    const f32x4 x0 = a0 * cs0 - b0 * sn0, x1 = a1 * cs1 - b1 * sn1, y0 = b0 * cs0 + a0 * sn0, y1 = b1 * cs1 + a1 * sn1;
                    bf16_t* rowp = p0 + (size_t)(ai * HALF + m * 16) * ldc;
                    u32x4 w; w.x = cvt_pk_bf16(x0[0], x0[1]); w.y = cvt_pk_bf16(x0[2], x0[3]); w.z = cvt_pk_bf16(x1[0], x1[1]); w.w = cvt_pk_bf16(x1[2], x1[3]);
                    st16_wt(rowp, w);
                    w.x = cvt_pk_bf16(y0[0], y0[1]); w.y = cvt_pk_bf16(y0[2], y0[3]); w.z = cvt_pk_bf16(y1[0], y1[1]); w.w = cvt_pk_bf16(y1[2], y1[3]);
                    st16_wt(rowp + 64, w); }
            return;
        }
        if (mode == 3 && u.pn < 16) {
            const int half = wc >> 1, f0 = 32 * (wc & 1) + 8 * fq;
            bf16_t* p0 = O + base + (size_t)(wr * 64 + fr) * ldc + half * 128 + f0;
#pragma unroll
            for (int ai = 0; ai < 2; ++ai)
#pragma unroll
                for (int m = 0; m < 4; ++m) { bf16_t* rowp = p0 + (size_t)(ai * HALF + m * 16) * ldc;
#pragma unroll
                    for (int bj = 0; bj < 2; ++bj) { const f32x4 v0 = acc[ai][bj][m][0], v1 = acc[ai][bj][m][1];
                        u32x4 w; w.x = cvt_pk_bf16(v0[0], v0[1]); w.y = cvt_pk_bf16(v0[2], v0[3]); w.z = cvt_pk_bf16(v1[0], v1[1]); w.w = cvt_pk_bf16(v1[2], v1[3]);
                        st16_wt(rowp + bj * 64, w); } }
            return;
        }
        bf16_t* p0 = O + base + (size_t)(wr * 64 + fr) * ldc + wc * 32 + 8 * fq;
#pragma unroll
        for (int ai = 0; ai < 2; ++ai)
#pragma unroll
            for (int m = 0; m < 4; ++m) { bf16_t* rowp = p0 + (size_t)(ai * HALF + m * 16) * ldc;
#pragma unroll
                for (int bj = 0; bj < 2; ++bj) { const f32x4 v0 = acc[ai][bj][m][0], v1 = acc[ai][bj][m][1];
                    u32x4 w; w.x = cvt_pk_bf16(v0[0], v0[1]); w.y = cvt_pk_bf16(v0[2], v0[3]); w.z = cvt_pk_bf16(v1[0], v1[1]); w.w = cvt_pk_bf16(v1[2], v1[3]);
                    st16_wt(rowp + bj * HALF, w); } }
    }
};
__device__ __forceinline__ float silu_f(float g) { return g * __builtin_amdgcn_rcpf(1.0f + __builtin_amdgcn_exp2f(-1.4426950408889634f * g)); }
struct EpiSwiglu {
    static constexpr bool PERM = true, AFTER_DRAIN = false;
    bf16_t* H; int ldh;
    __device__ __forceinline__ void operator()(const f32x4 (&acc)[2][2][4][2], const Unit& u, int wr, int wc, int fr, int fq) const {
        bf16_t* p0 = H + (size_t)(u.pm * BM + wr * 64 + fr) * ldh + u.pn * HALF + wc * 32 + 8 * fq;
#pragma unroll
        for (int ai = 0; ai < 2; ++ai)
#pragma unroll
            for (int m = 0; m < 4; ++m) { bf16_t* rowp = p0 + (size_t)(ai * HALF + m * 16) * ldh;
                const f32x4 g0 = acc[ai][0][m][0], g1 = acc[ai][0][m][1], u0 = acc[ai][1][m][0], u1 = acc[ai][1][m][1];
                u32x4 w; w.x = cvt_pk_bf16(silu_f(g0[0]) * u0[0], silu_f(g0[1]) * u0[1]); w.y = cvt_pk_bf16(silu_f(g0[2]) * u0[2], silu_f(g0[3]) * u0[3]);
                w.z = cvt_pk_bf16(silu_f(g1[0]) * u1[0], silu_f(g1[1]) * u1[1]); w.w = cvt_pk_bf16(silu_f(g1[2]) * u1[2], silu_f(g1[3]) * u1[3]);
                st16_hid(rowp, w); }
    }
};
#ifndef EPI_RB
#define EPI_RB 2
#endif
struct EpiResid {
    static constexpr bool PERM = true, AFTER_DRAIN = false;
    float* h; const float* gates; int goff; float* out; float* delta; int dry; const float* x0; const float* c0;
    __device__ __forceinline__ void operator()(const f32x4 (&acc)[2][2][4][2], const Unit& u, int wr, int wc, int fr, int fq) const {
        const int b = u.pm / 9, tt = u.pm - 9 * b, set = (tt == 8) ? 8 : b;
        const int col0 = u.pn * BM + wc * 32 + 8 * fq;
        const float* gp = gates + (size_t)set * 12288 + goff + col0;
        f32x4 gv[2][2];
#pragma unroll
        for (int bj = 0; bj < 2; ++bj)
#pragma unroll
            for (int n = 0; n < 2; ++n) { gv[bj][n] = *(const f32x4*)(gp + bj * HALF + n * 4); if (dry) gv[bj][n] = gv[bj][n] * 0.0f; }
        const int rl = wr * 64 + fr;
        const float* hp = (x0 && !dry) ? (tt == 8 ? c0 + (size_t)(b * 256 + rl) * 2048 + col0 : x0 + (size_t)(b * 2048 + tt * 256 + rl) * 2048 + col0) : h + (size_t)(u.pm * BM + rl) * 2048 + col0;
        float* op = (out && !dry) ? out + (size_t)(b * 2048 + tt * 256 + rl) * 2048 + col0 : h + (size_t)(u.pm * BM + rl) * 2048 + col0;
        if (u.split && dry) return;
        if (u.split) {
            float* sp = delta + (size_t)(u.split - 1) * 65536 + (size_t)rl * 256 + wc * 32 + 8 * fq;
#pragma unroll
            for (int ai = 0; ai < 2; ++ai)
#pragma unroll
                for (int m = 0; m < 4; ++m)
#pragma unroll
                    for (int bj = 0; bj < 2; ++bj)
#pragma unroll
                        for (int n = 0; n < 2; ++n) *(f32x4*)(sp + (ai * HALF + m * 16) * 256 + bj * HALF + n * 4) = gv[bj][n] * acc[ai][bj][m][n];
            return;
        }
#pragma unroll
        for (int ai = 0; ai < 2; ++ai)
#pragma unroll
            for (int mp = 0; mp < 4; mp += EPI_RB) {
                f32x4 hv[EPI_RB][2][2];
#pragma unroll
                for (int mm = 0; mm < EPI_RB; ++mm)
#pragma unroll
                    for (int bj = 0; bj < 2; ++bj)
#pragma unroll
                        for (int n = 0; n < 2; ++n) hv[mm][bj][n] = *(const f32x4*)(hp + (size_t)(ai * HALF + (mp + mm) * 16) * 2048 + bj * HALF + n * 4);
                asm volatile("" ::: "memory");
#pragma unroll
                for (int mm = 0; mm < EPI_RB; ++mm) { const int m = mp + mm; const size_t ro = (size_t)(ai * HALF + m * 16) * 2048;
#pragma unroll
                    for (int bj = 0; bj < 2; ++bj)
#pragma unroll
                        for (int n = 0; n < 2; ++n) st16_wt(op + ro + bj * HALF + n * 4, hv[mm][bj][n] + gv[bj][n] * acc[ai][bj][m][n]); }
                asm volatile("" ::: "memory"); }
    }
};

template <class Epi, class Sched, bool ALIGN_EPI = false, bool SP2 = false>
__device__ __forceinline__ void gemm_phase(PG8_LAS unsigned char* lds, const Gemm g, const Sched& S, const Epi& E) {
    int tid = threadIdx.x; asm volatile("" : "+v"(tid));
    const int wid = __builtin_amdgcn_readfirstlane(tid >> 6), lane = tid & 63, wr = wid >> 2, wc = wid & 3, fr = lane & 15, fq = lane >> 4;
    const int K = g.K;
    unsigned voffA[2], voffB[2];
#pragma unroll
    for (int i = 0; i < 2; ++i) { int R, C; stage_rc(tid * 16 + i * 8192, R, C); const int Rb = Epi::PERM ? ((R & ~31) + perm32(R & 31)) : R;
        voffA[i] = (unsigned)(R * K + C) * 2u; voffB[i] = (unsigned)(Rb * K + C) * 2u; }
    const size_t kstep = (size_t)(BK * 2);
    const size_t hstep = (size_t)HALF * K * 2;
    const size_t tstep = 2 * hstep;
    const unsigned ldsw = (unsigned)wid * 1024u;
    const int aoff = lds_byte(wr * 64 + fr, fq * 8), boff = lds_byte(wc * 32 + fr, fq * 8);
#define PG8_SA(b, h) (((b) * 2 + (h)) * HTB)
#define PG8_SB(b, h) ((4 + (b) * 2 + (h)) * HTB)
#define PG8_STAGE(bufoff, gbase, voff) do { _Pragma("unroll") for (int _i = 0; _i < 2; ++_i) \
        __builtin_amdgcn_global_load_lds((const unsigned*)((const char*)(gbase) + (voff)[_i]), (PG8_LAS unsigned*)(lds + (bufoff) + ldsw + _i * 8192), 16, 0, 0); } while (0)
#define PG8_LDA(dst, b, h) do { _Pragma("unroll") for (int m = 0; m < 4; ++m) _Pragma("unroll") for (int k = 0; k < 2; ++k) dst[m][k] = *(const PG8_LAS bf16x8*)(lds + PG8_SA(b, h) + aoff + m * 2048 + k * 1024); } while (0)
#define PG8_LDB(dst, b, h) do { _Pragma("unroll") for (int n = 0; n < 2; ++n) _Pragma("unroll") for (int k = 0; k < 2; ++k) dst[n][k] = *(const PG8_LAS bf16x8*)(lds + PG8_SB(b, h) + boff + n * 2048 + k * 1024); } while (0)
#define PG8_MMA(ai, bj, At, Bt) do { __builtin_amdgcn_s_setprio(1); _Pragma("unroll") for (int m = 0; m < 4; ++m) _Pragma("unroll") for (int n = 0; n < 2; ++n) _Pragma("unroll") for (int k = 0; k < 2; ++k) \
        acc[ai][bj][m][n] = __builtin_amdgcn_mfma_f32_16x16x32_bf16(Bt[n][k], At[m][k], acc[ai][bj][m][n], 0, 0, 0); __builtin_amdgcn_s_setprio(0); } while (0)
#define PG8_WAIT_V(n) asm volatile("s_waitcnt vmcnt(" #n ")" ::: "memory")
#define PG8_WAIT_L(n) asm volatile("s_waitcnt lgkmcnt(" #n ")" ::: "memory")
#define PG8_BAR __builtin_amdgcn_s_barrier()
#define PG8_SCHED __builtin_amdgcn_sched_barrier(0)
    Unit cur, nxt; int ui = 0;
    if (!S.next(0, cur)) return;
    f32x4 acc[2][2][4][2];
#pragma unroll
    for (int a = 0; a < 2; ++a)
#pragma unroll
        for (int b = 0; b < 2; ++b)
#pragma unroll
            for (int m = 0; m < 4; ++m)
#pragma unroll
                for (int n = 0; n < 2; ++n) acc[a][b][m][n] = (f32x4){0.f, 0.f, 0.f, 0.f};
    bf16x8 At[4][2], B0[2][2], B1[2][2];
    const char* cA = (const char*)g.A + (size_t)cur.pm * tstep + (size_t)cur.kt0 * kstep; const char* cB = (const char*)g.Bt + (size_t)cur.pn * tstep + (size_t)cur.kt0 * kstep;
    S.a_ready(cur);
    if constexpr (SP2) {
        PG8_STAGE(PG8_SB(0, 0), cB, voffB); PG8_STAGE(PG8_SB(0, 1), cB + hstep, voffB); PG8_STAGE(PG8_SA(0, 0), cA, voffA); PG8_STAGE(PG8_SA(0, 1), cA + hstep, voffA);
        if (wr == 1) PG8_BAR;
        PG8_WAIT_V(2); PG8_BAR;
        PG8_STAGE(PG8_SB(1, 0), cB + kstep, voffB); PG8_STAGE(PG8_SA(1, 0), cA + kstep, voffA); PG8_STAGE(PG8_SB(1, 1), cB + hstep + kstep, voffB);
        PG8_WAIT_V(6); PG8_BAR;
    } else {
        PG8_STAGE(PG8_SB(0, 0), cB, voffB); PG8_STAGE(PG8_SA(0, 0), cA, voffA); PG8_STAGE(PG8_SB(0, 1), cB + hstep, voffB); PG8_STAGE(PG8_SA(0, 1), cA + hstep, voffA);
        if (wr == 1) PG8_BAR;
        PG8_WAIT_V(4); PG8_BAR;
        PG8_STAGE(PG8_SB(1, 0), cB + kstep, voffB); PG8_STAGE(PG8_SA(1, 0), cA + kstep, voffA); PG8_STAGE(PG8_SB(1, 1), cB + hstep + kstep, voffB);
        PG8_WAIT_V(6); PG8_BAR;
    }
    for (;;) {
        const bool has_next = S.next(ui + 1, nxt);
        const char* nA = has_next ? (const char*)g.A + (size_t)nxt.pm * tstep + (size_t)nxt.kt0 * kstep : cA; const char* nB = has_next ? (const char*)g.Bt + (size_t)nxt.pn * tstep + (size_t)nxt.kt0 * kstep : cB;
        const int nt = cur.nkt;
        for (int t = 0; t < nt; t += 2) {
            const bool last = (t == nt - 2);
            const char* a1 = cA + (size_t)(t + 1) * kstep;
            const char* a2 = last ? nA : cA + (size_t)(t + 2) * kstep; const char* b2 = last ? nB : cB + (size_t)(t + 2) * kstep;
            const char* a3 = a2 + kstep; const char* b3 = b2 + kstep;
            if (last && has_next) S.a_ready(nxt);
            if constexpr (SP2) {
            PG8_LDB(B0, 0, 0); PG8_LDB(B1, 0, 1); PG8_SCHED; PG8_LDA(At, 0, 0); PG8_STAGE(PG8_SA(1, 1), a1 + hstep, voffA);
            PG8_WAIT_V(8); PG8_WAIT_L(0); PG8_BAR; PG8_MMA(0, 0, At, B0); PG8_MMA(0, 1, At, B1); PG8_BAR; PG8_SCHED;
            PG8_LDA(At, 0, 1); PG8_STAGE(PG8_SB(0, 0), b2, voffB); PG8_STAGE(PG8_SB(0, 1), b2 + hstep, voffB); PG8_STAGE(PG8_SA(0, 0), a2, voffA);
            PG8_WAIT_V(8); PG8_WAIT_L(0); PG8_BAR; PG8_MMA(1, 0, At, B0); PG8_MMA(1, 1, At, B1); PG8_BAR; PG8_SCHED;
            PG8_LDB(B0, 1, 0); PG8_LDB(B1, 1, 1); PG8_SCHED; PG8_LDA(At, 1, 0); PG8_STAGE(PG8_SA(0, 1), a2 + hstep, voffA);
            PG8_WAIT_V(8); PG8_WAIT_L(0); PG8_BAR; PG8_MMA(0, 0, At, B0); PG8_MMA(0, 1, At, B1); PG8_BAR; PG8_SCHED;
            PG8_LDA(At, 1, 1); PG8_STAGE(PG8_SB(1, 0), b3, voffB); PG8_STAGE(PG8_SB(1, 1), b3 + hstep, voffB); PG8_STAGE(PG8_SA(1, 0), a3, voffA);
            PG8_WAIT_V(8); PG8_WAIT_L(0); PG8_BAR; PG8_MMA(1, 0, At, B0); PG8_MMA(1, 1, At, B1); PG8_BAR; PG8_SCHED;
            } else {
            PG8_LDB(B0, 0, 0); PG8_SCHED; PG8_LDA(At, 0, 0); PG8_STAGE(PG8_SA(1, 1), a1 + hstep, voffA);
            PG8_WAIT_L(8); PG8_BAR; PG8_WAIT_L(0); PG8_MMA(0, 0, At, B0); PG8_BAR; PG8_SCHED;
            PG8_LDB(B1, 0, 1); PG8_STAGE(PG8_SB(0, 0), b2, voffB);
            PG8_BAR; PG8_WAIT_L(0); PG8_MMA(0, 1, At, B1); PG8_BAR;
            PG8_LDA(At, 0, 1); PG8_STAGE(PG8_SA(0, 0), a2, voffA);
            PG8_BAR; PG8_WAIT_L(0); PG8_MMA(1, 0, At, B0); PG8_BAR; PG8_SCHED;
            PG8_STAGE(PG8_SB(0, 1), b2 + hstep, voffB);
            PG8_WAIT_V(6); PG8_BAR; PG8_MMA(1, 1, At, B1); PG8_BAR;
            PG8_LDB(B0, 1, 0); PG8_SCHED; PG8_LDA(At, 1, 0); PG8_STAGE(PG8_SA(0, 1), a2 + hstep, voffA);
            PG8_WAIT_L(8); PG8_BAR; PG8_WAIT_L(0); PG8_MMA(0, 0, At, B0); PG8_BAR; PG8_SCHED;
            PG8_LDB(B1, 1, 1); PG8_STAGE(PG8_SB(1, 0), b3, voffB);
            PG8_BAR; PG8_WAIT_L(0); PG8_MMA(0, 1, At, B1); PG8_BAR;
            PG8_LDA(At, 1, 1); PG8_STAGE(PG8_SA(1, 0), a3, voffA);
            PG8_BAR; PG8_WAIT_L(0); PG8_MMA(1, 0, At, B0); PG8_BAR; PG8_SCHED;
            PG8_STAGE(PG8_SB(1, 1), b3 + hstep, voffB);
            PG8_WAIT_V(6); PG8_BAR; PG8_MMA(1, 1, At, B1); PG8_BAR;
            }
        }
        if constexpr (ALIGN_EPI) { if (wr == 0) PG8_BAR; }
        if constexpr (!Epi::AFTER_DRAIN) { E(acc, cur, wr, wc, fr, fq); S.done(cur); }
        if (!has_next) break;
#pragma unroll
        for (int a = 0; a < 2; ++a)
#pragma unroll
            for (int b = 0; b < 2; ++b)
#pragma unroll
                for (int m = 0; m < 4; ++m)
#pragma unroll
                    for (int n = 0; n < 2; ++n) acc[a][b][m][n] = (f32x4){0.f, 0.f, 0.f, 0.f};
        cur = nxt; cA = nA; cB = nB; ++ui;
        if constexpr (ALIGN_EPI) { if (wr == 1) PG8_BAR; }
    }
    PG8_WAIT_V(0);
    if constexpr (!ALIGN_EPI) { if (wr == 0) PG8_BAR; }
    PG8_BAR;
    if constexpr (Epi::AFTER_DRAIN) { E.fused(acc, cur, wr, wc, fr, fq, lds, wid, lane); S.done(cur); }
#undef PG8_SA
#undef PG8_SB
#undef PG8_STAGE
#undef PG8_LDA
#undef PG8_LDB
#undef PG8_MMA
#undef PG8_WAIT_V
#undef PG8_WAIT_L
#undef PG8_BAR
#undef PG8_SCHED
}
}
namespace att {
typedef unsigned short bf16;
constexpr int   D = 128, NW = 8, QBLK = 32, KVBLK = 64;
constexpr float SCALE = 0.088388347648318440f;
constexpr float THR = 8.f;
constexpr int LDQ = 3072, LDK = 3072, LDO = 2048;
constexpr size_t SHM_V = KVBLK * D * 2, SHM_K = KVBLK * D * 2, SHM_ATTN = 2 * SHM_V + 2 * SHM_K + NW * 64 * 4;
using bf16x8 = __attribute__((ext_vector_type(8))) short;
using s16x4  = __attribute__((ext_vector_type(4))) short;
using f32x16 = __attribute__((ext_vector_type(16))) float;
using u32x4  = __attribute__((ext_vector_type(4))) unsigned;
#define KSWZ(row, colB) ((row) * 256 + ((colB) ^ (((row) & 7) << 4)))
#define SBAR() __builtin_amdgcn_sched_barrier(0)
__device__ __forceinline__ int crow(int r, int hi) { return (r & 3) + 8 * (r >> 2) + 4 * hi; }
__device__ __forceinline__ unsigned cvtpk(float lo, float hi) {
  typedef __bf16 b2 __attribute__((ext_vector_type(2))); typedef float f2 __attribute__((ext_vector_type(2)));
  const f2 v = {lo, hi}; const b2 b = __builtin_convertvector(v, b2); return __builtin_bit_cast(unsigned, b);
}
__device__ __forceinline__ bf16x8 ld8(const bf16* p) { return *reinterpret_cast<const bf16x8*>(p); }
__device__ __forceinline__ void partialSM(f32x16& p0, f32x16& p1, float& m_reg, float& mn, float& alpha) {
  constexpr float C = SCALE * 1.4426950408889634f;
  float pmax = p0[0]; for (int r = 1; r < 16; ++r) pmax = fmaxf(pmax, p0[r]); for (int r = 0; r < 16; ++r) pmax = fmaxf(pmax, p1[r]);
  { auto rr = __builtin_amdgcn_permlane32_swap(__float_as_uint(pmax), __float_as_uint(pmax), false, false);
    pmax = fmaxf(__uint_as_float(rr[0]), __uint_as_float(rr[1])); }
  if (__builtin_expect(__all(pmax - m_reg <= THR / SCALE), 1)) { mn = m_reg; alpha = 1.f; }
  else { mn = fmaxf(m_reg, pmax); alpha = __builtin_amdgcn_exp2f((m_reg - mn) * C); m_reg = mn; }
  float mnC = -mn * C;
  for (int r = 0; r < 16; ++r) p0[r] = fmaf(p0[r], C, mnC); for (int r = 0; r < 16; ++r) p1[r] = fmaf(p1[r], C, mnC);
  for (int r = 0; r < 16; ++r) p0[r] = __builtin_amdgcn_exp2f(p0[r]);
}
__device__ __forceinline__ void finishSM(f32x16& p0, f32x16& p1, float alpha, float& l_reg, bf16x8& pa0, bf16x8& pa1, bf16x8& pa2, bf16x8& pa3) {
  for (int r = 0; r < 16; ++r) p1[r] = __builtin_amdgcn_exp2f(p1[r]);
  float ps = 0; for (int r = 0; r < 16; ++r) ps += p0[r]; for (int r = 0; r < 16; ++r) ps += p1[r];
  { auto rr = __builtin_amdgcn_permlane32_swap(__float_as_uint(ps), __float_as_uint(ps), false, false);
    ps = __uint_as_float(rr[0]) + __uint_as_float(rr[1]); }
  l_reg = l_reg * alpha + ps;
#define PK4(P, BASE, OUT) do { unsigned a0 = cvtpk(P[BASE + 0], P[BASE + 1]), a1 = cvtpk(P[BASE + 2], P[BASE + 3]);   \
    unsigned b0 = cvtpk(P[BASE + 4], P[BASE + 5]), b1 = cvtpk(P[BASE + 6], P[BASE + 7]);                              \
    auto r0 = __builtin_amdgcn_permlane32_swap(a0, b0, false, false); auto r1 = __builtin_amdgcn_permlane32_swap(a1, b1, false, false); \
    u32x4 w = {r0[0], r1[0], r0[1], r1[1]}; OUT = *reinterpret_cast<bf16x8*>(&w); } while (0)
  PK4(p0, 0, pa0); PK4(p0, 8, pa1); PK4(p1, 0, pa2); PK4(p1, 8, pa3);
#undef PK4
}
__device__ __forceinline__ void qkt(f32x16& p0, f32x16& p1, const bf16* Ks, const bf16x8* qr, int r32, int hi) {
  p0 = f32x16{}; p1 = f32x16{};
  for (int d0 = 0; d0 < 8; ++d0) { int cb = (d0 * 16 + hi * 8) * 2;
    bf16x8 b0 = *reinterpret_cast<const bf16x8*>((const char*)Ks + KSWZ(r32, cb));
    bf16x8 b1 = *reinterpret_cast<const bf16x8*>((const char*)Ks + KSWZ(32 + r32, cb));
    p0 = __builtin_amdgcn_mfma_f32_32x32x16_bf16(b0, qr[d0], p0, 0, 0, 0);
    p1 = __builtin_amdgcn_mfma_f32_32x32x16_bf16(b1, qr[d0], p1, 0, 0, 0); }
}
__device__ __forceinline__ int v_st(int k, int c) { const int kk = (k & ~0xC) | ((k & 4) << 1) | ((k & 8) >> 1); return ((kk >> 3) * 4 + (c >> 5)) * 512 + ((kk & 7) * 32 + (c & 31)) * 2; }
__device__ __forceinline__ int v_rd_base(int lane) { return ((lane & 3) << 3) | (((lane >> 2) & 3) << 6) | (((lane >> 4) & 1) << 5) | (((lane >> 5) & 1) << 8); }
constexpr int v_rd_off(int d0, int ks, int half) { return d0 * 512 + ks * 4096 + half * 2048; }
template <int OFF> __device__ __forceinline__ s16x4 tr_read(int vb) {
  s16x4 r; asm volatile("ds_read_b64_tr_b16 %0, %1 offset:%2" : "=&v"(r) : "v"(vb), "i"(OFF) : "memory"); return r;
}
template <int D0> __device__ __forceinline__ void pv_one(f32x16& od, int vb, bf16x8 pa0, bf16x8 pa1, bf16x8 pa2, bf16x8 pa3) {
  const s16x4 l0 = tr_read<v_rd_off(D0, 0, 0)>(vb), h0 = tr_read<v_rd_off(D0, 0, 1)>(vb), l1 = tr_read<v_rd_off(D0, 1, 0)>(vb), h1 = tr_read<v_rd_off(D0, 1, 1)>(vb);
  const s16x4 l2 = tr_read<v_rd_off(D0, 2, 0)>(vb), h2 = tr_read<v_rd_off(D0, 2, 1)>(vb), l3 = tr_read<v_rd_off(D0, 3, 0)>(vb), h3 = tr_read<v_rd_off(D0, 3, 1)>(vb);
  asm volatile("s_waitcnt lgkmcnt(0)" ::: "memory"); SBAR();
#define PK(L, H) (bf16x8){L[0], L[1], L[2], L[3], H[0], H[1], H[2], H[3]}
  od = __builtin_amdgcn_mfma_f32_32x32x16_bf16(pa0, PK(l0, h0), od, 0, 0, 0);
  od = __builtin_amdgcn_mfma_f32_32x32x16_bf16(pa1, PK(l1, h1), od, 0, 0, 0);
  od = __builtin_amdgcn_mfma_f32_32x32x16_bf16(pa2, PK(l2, h2), od, 0, 0, 0);
  od = __builtin_amdgcn_mfma_f32_32x32x16_bf16(pa3, PK(l3, h3), od, 0, 0, 0);
#undef PK
}
__device__ __forceinline__ void pv_d0(f32x16* o, int vb, bf16x8 pa0, bf16x8 pa1, bf16x8 pa2, bf16x8 pa3) {
  pv_one<0>(o[0], vb, pa0, pa1, pa2, pa3); pv_one<1>(o[1], vb, pa0, pa1, pa2, pa3); pv_one<2>(o[2], vb, pa0, pa1, pa2, pa3); pv_one<3>(o[3], vb, pa0, pa1, pa2, pa3);
}
__device__ __forceinline__ void attn_dense_body(const bf16* __restrict__ Qb, const bf16* __restrict__ Kh, const bf16* __restrict__ Vh,
                                                bf16* __restrict__ Ob, int seq, char* lds, const float* __restrict__ qgain = nullptr, const float* __restrict__ rope = nullptr, int t0 = 0) {
  int tid = threadIdx.x; asm volatile("" : "+v"(tid));
  const int wid = tid >> 6, lane = tid & 63, r32 = lane & 31, hi = lane >> 5;
  bf16* V_lds = (bf16*)lds; bf16* K_lds = (bf16*)(lds + 2 * SHM_V);
  float* ws = (float*)(lds + 2 * SHM_V + 2 * SHM_K) + wid * 64; float* li_l = ws; float* al_l = ws + 32;
  float m_reg = -1e30f, l_reg = 0; f32x16 o[4] = {}; bf16x8 qr[8];
  const bf16* Qw = Qb + (long)(wid * QBLK + r32) * LDQ + hi * 8;
#pragma unroll
  for (int d0 = 0; d0 < 8; ++d0) qr[d0] = ld8(Qw + d0 * 16);
  if (qgain) {
    float ssq = 0.f;
#pragma unroll
    for (int d0 = 0; d0 < 8; ++d0)
#pragma unroll
      for (int x = 0; x < 8; ++x) { const float v = __uint_as_float((unsigned)(unsigned short)qr[d0][x] << 16); ssq += v * v; }
    { auto rr = __builtin_amdgcn_permlane32_swap(__float_as_uint(ssq), __float_as_uint(ssq), false, false); ssq = __uint_as_float(rr[0]) + __uint_as_float(rr[1]); }
    const float rstd = 1.0f / sqrtf(ssq * (1.0f / 128.0f) + 1e-6f);
    const int t = t0 + wid * QBLK + r32;
#pragma unroll
    for (int hp = 0; hp < 2; ++hp) {
      const int pos = hp ? (t & 63) : (t >> 6);
#pragma unroll
      for (int dd = 0; dd < 2; ++dd) { const int d0 = 4 * hp + dd;
        const float* g1 = qgain + 16 * d0 + 8 * hi; const float* g2 = g1 + 32;
        const float* tb = rope ? rope + (size_t)(pos * 32 + 16 * dd + 8 * hi) * 2 : nullptr;
        float y1[8], y2[8];
#pragma unroll
        for (int x = 0; x < 8; ++x) { const float a1 = __uint_as_float((unsigned)(unsigned short)qr[d0][x] << 16) * rstd * g1[x], a2 = __uint_as_float((unsigned)(unsigned short)qr[d0 + 2][x] << 16) * rstd * g2[x];
          if (rope) { const float cs = tb[2 * x], sn = tb[2 * x + 1]; y1[x] = a1 * cs - a2 * sn; y2[x] = a2 * cs + a1 * sn; } else { y1[x] = a1; y2[x] = a2; } }
        { u32x4 w = {cvtpk(y1[0], y1[1]), cvtpk(y1[2], y1[3]), cvtpk(y1[4], y1[5]), cvtpk(y1[6], y1[7])}; qr[d0] = *reinterpret_cast<bf16x8*>(&w); }
        { u32x4 w = {cvtpk(y2[0], y2[1]), cvtpk(y2[2], y2[3]), cvtpk(y2[4], y2[5]), cvtpk(y2[6], y2[7])}; qr[d0 + 2] = *reinterpret_cast<bf16x8*>(&w); } }
    }
  }
  const int sr = tid >> 4, sc = (tid & 15) * 8, vst0 = v_st(sr, sc), vst1 = v_st(32 + sr, sc);
  const int vb0 = (int)(uintptr_t)V_lds + v_rd_base(lane);
  struct { bf16x8 vs0, vs1, ks0, ks1; } sr_[2];
#define SLOAD(i, k0) do { sr_[i].vs0 = ld8(&Vh[(long)((k0) + sr) * LDK + sc]); sr_[i].vs1 = ld8(&Vh[(long)((k0) + 32 + sr) * LDK + sc]); \
    sr_[i].ks0 = ld8(&Kh[(long)((k0) + sr) * LDK + sc]); sr_[i].ks1 = ld8(&Kh[(long)((k0) + 32 + sr) * LDK + sc]); } while (0)
#define SWRITE(b, i) do { *(bf16x8*)((char*)V_lds + (b) * SHM_V + vst0) = sr_[i].vs0;          \
    *(bf16x8*)((char*)V_lds + (b) * SHM_V + vst1) = sr_[i].vs1; int kc = sc * 2;               \
    *(bf16x8*)((char*)K_lds + (b) * SHM_K + KSWZ(sr, kc)) = sr_[i].ks0;                       \
    *(bf16x8*)((char*)K_lds + (b) * SHM_K + KSWZ(32 + sr, kc)) = sr_[i].ks1; } while (0)
#define SWAIT() asm volatile("s_waitcnt vmcnt(4)" ::: "memory")
#define RESC(a) do { if (__any((a) < 1.f)) { if (hi == 0) al_l[r32] = (a); asm volatile("s_waitcnt lgkmcnt(0)" ::: "memory"); \
    for (int d = 0; d < 4; ++d) for (int r = 0; r < 16; ++r) o[d][r] *= al_l[crow(r, hi)]; } } while (0)
  f32x16 pA0, pA1, pB0, pB1; float mnA, mnB, alA, alB; bf16x8 pa0, pa1, pa2, pa3; const int NT = seq / KVBLK;
  constexpr int SE = 0, SO = 1;
  SLOAD(SE, 0); asm volatile("s_waitcnt vmcnt(0)" ::: "memory"); SWRITE(0, SE); __syncthreads();
  qkt(pA0, pA1, K_lds, qr, r32, hi); partialSM(pA0, pA1, m_reg, mnA, alA);
  SLOAD(SO, KVBLK); if (2 < NT) SLOAD(SE, 2 * KVBLK);
  SWAIT(); SWRITE(1, SO); __syncthreads();
  for (int j = 1; j + 1 < NT; j += 2) {
    SBAR(); qkt(pB0, pB1, (bf16*)((char*)K_lds + SHM_K), qr, r32, hi);
    finishSM(pA0, pA1, alA, l_reg, pa0, pa1, pa2, pa3); SBAR();
    SLOAD(SO, (j + 2) * KVBLK); SBAR();
    pv_d0(o, vb0, pa0, pa1, pa2, pa3); partialSM(pB0, pB1, m_reg, mnB, alB);
    __syncthreads(); SWAIT(); SWRITE(0, SE);
    RESC(alB); __syncthreads();
    SBAR(); qkt(pA0, pA1, K_lds, qr, r32, hi);
    finishSM(pB0, pB1, alB, l_reg, pa0, pa1, pa2, pa3); SBAR();
    if (j + 3 < NT) SLOAD(SE, (j + 3) * KVBLK); SBAR();
    pv_d0(o, vb0 + (int)SHM_V, pa0, pa1, pa2, pa3); partialSM(pA0, pA1, m_reg, mnA, alA);
    __syncthreads(); SWAIT(); SWRITE(1, SO);
    RESC(alA); __syncthreads();
  }
  SBAR(); qkt(pB0, pB1, (bf16*)((char*)K_lds + SHM_K), qr, r32, hi);
  finishSM(pA0, pA1, alA, l_reg, pa0, pa1, pa2, pa3); SBAR();
  pv_d0(o, vb0, pa0, pa1, pa2, pa3); partialSM(pB0, pB1, m_reg, mnB, alB);
  __syncthreads(); RESC(alB);
  finishSM(pB0, pB1, alB, l_reg, pa0, pa1, pa2, pa3); SBAR();
  pv_d0(o, vb0 + (int)SHM_V, pa0, pa1, pa2, pa3);
  if (hi == 0) li_l[r32] = l_reg; asm volatile("s_waitcnt lgkmcnt(0)" ::: "memory");
  float rli[16];
#pragma unroll
  for (int r = 0; r < 16; ++r) rli[r] = __builtin_amdgcn_rcpf(li_l[crow(r, hi)]);
  bf16* Ow = Ob + (long)(wid * QBLK) * LDO;
#pragma unroll
  for (int r = 0; r < 16; ++r) { int orow = crow(r, hi);
#pragma unroll
    for (int d0 = 0; d0 < 4; ++d0) Ow[(long)orow * LDO + d0 * 32 + r32] = (bf16)(cvtpk(o[d0][r] * rli[r], 0.f) & 0xffffu); }
  __syncthreads();
#undef SLOAD
#undef SWRITE
#undef SWAIT
#undef RESC
}
#undef KSWZ
#undef SBAR
}

constexpr int NWAVES = 8;
#ifndef MK_N_LAUNCHES
#define MK_N_LAUNCHES 1
#endif
constexpr int DM = 2048, NBATCH = 8, SEQ = 2048, CTXL = 256, TPB = SEQ + CTXL, MROWS = NBATCH * TPB;
constexpr int MLAT = NBATCH * SEQ;
constexpr int MODW = 6 * DM, NSET = 9;
constexpr int EIN = 3072, OIN = 12288, OMIX = 4096, FFN = 5632, FFN2 = 2 * FFN;
constexpr float EPS = 1e-6f;
constexpr int N_PHASES = 1 + 9 * 4;
constexpr size_t MiB = 1u << 20;
constexpr size_t WS_CTL = 0, CTL_ZERO_BYTES = 1 * MiB;
constexpr size_t WS_MOD = 1 * MiB;
constexpr size_t WS_ROPE_E = 3 * MiB, WS_ROPE_O = 3 * MiB + 65536;
constexpr size_t WS_WTC = 3 * MiB + 262144;
constexpr size_t WS_CB = 4 * MiB;
constexpr size_t WS_WTL = 5 * MiB;
constexpr size_t WS_W_INE = 21 * MiB, WS_W_OUTE = 45 * MiB, WS_W_INO = 61 * MiB, WS_W_OUTO = 157 * MiB, WS_W_FIN = 189 * MiB, WS_W_FOUT = 365 * MiB;
constexpr size_t WS_H = 453 * MiB;
constexpr size_t WS_XN = 597 * MiB;
constexpr size_t WS_P = 669 * MiB;
constexpr size_t WS_R = 1101 * MiB;
constexpr size_t WS_OF = WS_R, WS_OB = WS_R + 144 * MiB;
constexpr size_t WS_FT = WS_R, WS_FTC = WS_R + 16 * MiB, WS_Z = WS_R + 18 * MiB, WS_MIX = WS_R + 54 * MiB;
constexpr size_t WS_DELTA = 1389 * MiB;
constexpr size_t WS_SPLITTAB = 2 * MiB + 917504;
constexpr size_t WS_END = 1453 * MiB;
static_assert(WS_MIX + (size_t)MROWS * DM * 2 <= WS_END && WS_OB + (size_t)MROWS * OMIX * 2 <= WS_END && WS_P + (size_t)MROWS * OIN * 2 <= WS_R, "d_ws map");
constexpr int CW_TMO = 0, CW_CODE = 1, CW_BAR = 4096;
constexpr int RING_OFF = 0, RING_BYTES = 131072;
constexpr int LDSCTL_OFF = 158720, MISC_OFF = LDSCTL_OFF + 320;
constexpr int LDS_BYTES = 159744;
static_assert(MISC_OFF + 128 <= LDS_BYTES, "LDS map");

#define GAS __attribute__((address_space(1)))
#define LAS __attribute__((address_space(3)))
typedef unsigned short bf16;
typedef unsigned v4u __attribute__((ext_vector_type(4)));
typedef unsigned v2u __attribute__((ext_vector_type(2)));
typedef float f32x4 __attribute__((ext_vector_type(4)));
typedef short bf16x8 __attribute__((ext_vector_type(8)));
typedef short s16x4 __attribute__((ext_vector_type(4)));
typedef GAS unsigned gu32;
#define RLX_AGENT __ATOMIC_RELAXED, __HIP_MEMORY_SCOPE_AGENT
#define LDS_WAIT() asm volatile("s_waitcnt lgkmcnt(0)" ::: "memory")
#define VM_WAIT() asm volatile("s_waitcnt vmcnt(0)" ::: "memory")
typedef __bf16 bf16x2_t __attribute__((ext_vector_type(2)));
typedef float f32x2_t __attribute__((ext_vector_type(2)));
__device__ __forceinline__ unsigned pk2(float lo, float hi) { const f32x2_t v = {lo, hi}; const bf16x2_t b = __builtin_convertvector(v, bf16x2_t); return __builtin_bit_cast(unsigned, b); }
__device__ __forceinline__ float bflo(unsigned w) { return __uint_as_float(w << 16); }
__device__ __forceinline__ float bfhi(unsigned w) { return __uint_as_float(w & 0xffff0000u); }
__device__ __forceinline__ float silu(float g) { return g / (1.0f + __expf(-g)); }

#define XB_TMO      128
#define XB_XCNT(j)  (256  + 64 * (j))
#define XB_XSUB(j)  (1280 + 64 * (j))
#define XB_XGEN(j)  (2304 + 64 * (j))
#define XB_TOP      3328
#define XB_TOPGEN   3392
#define XCD_BAR_WORDS 3456
#define XB_SPIN_CAP (1u << 18)

__device__ __forceinline__ unsigned xb_ld(unsigned* p)              { return __hip_atomic_load(p, __ATOMIC_RELAXED, __HIP_MEMORY_SCOPE_AGENT); }
__device__ __forceinline__ unsigned xb_add(unsigned* p, unsigned v) { return __hip_atomic_fetch_add(p, v, __ATOMIC_RELAXED, __HIP_MEMORY_SCOPE_AGENT); }
__device__ __forceinline__ unsigned xb_xcc_id() { return (unsigned)__builtin_amdgcn_s_getreg((3 << 11) | 20) & 0xFu; }
#define XB_SPIN(cond, bar) do { unsigned _sp = 0; while (cond) { __builtin_amdgcn_s_sleep(1); \
    if ((++_sp & 255u) == 0u) { if (xb_ld(&(bar)[XB_TMO])) break; if (_sp > XB_SPIN_CAP) { atomicAdd(&(bar)[XB_TMO], 1u); break; } } } } while (0)

struct XcdBarrier {
    unsigned* bar; unsigned x;
    volatile LAS unsigned* st;
};

__device__ __forceinline__ XcdBarrier xcd_barrier_post(unsigned* bar, volatile LAS unsigned* st) {
    XcdBarrier b; b.bar = bar; b.x = xb_xcc_id(); b.st = st;
    if (threadIdx.x == 0) (void)xb_add(&bar[XB_XCNT(b.x)], 1u);
    return b;
}
__device__ __forceinline__ void xcd_barrier_complete(unsigned* bar, unsigned x, unsigned& nloc, unsigned& nx) {
    const unsigned G = gridDim.x * gridDim.y * gridDim.z;
    unsigned sum, cnt, mine, sp = 0u;
    for (;;) {
        sum = 0u; cnt = 0u; mine = 0u;
#pragma unroll
        for (unsigned j = 0; j < 16; ++j) { const unsigned c = xb_ld(&bar[XB_XCNT(j)]); sum += c; cnt += (c > 0u) ? 1u : 0u; mine = (j == x) ? c : mine; }
        if (sum == G) break;
        __builtin_amdgcn_s_sleep(1);
        if ((++sp & 255u) == 0u) { if (xb_ld(&bar[XB_TMO])) break; if (sp > XB_SPIN_CAP) { atomicAdd(&bar[XB_TMO], 1u); break; } }
    }
    nloc = mine > 0u ? mine : 1u; nx = cnt > 0u ? cnt : 1u;
}

__device__ __forceinline__ void xcd_barrier(const XcdBarrier& b) {
    asm volatile("s_waitcnt vmcnt(0)" ::: "memory");
    __syncthreads();
    if (threadIdx.x == 0) {
        unsigned* bar = b.bar;
        __builtin_amdgcn_s_waitcnt(0);
        unsigned nloc = b.st[0], nx = b.st[1];
        if (nloc == 0u) { xcd_barrier_complete(bar, b.x, nloc, nx); b.st[0] = nloc; b.st[1] = nx; }
        const unsigned old = xb_add(&bar[XB_XSUB(b.x)], 1u);
        const unsigned gen = old / nloc;
        if (old + 1u == (gen + 1u) * nloc) {
            __builtin_amdgcn_fence(__ATOMIC_RELEASE, "agent");
            asm volatile("s_waitcnt vmcnt(0)" ::: "memory");
            const unsigned og = xb_add(&bar[XB_TOP], 1u);
            const unsigned tg = og / nx;
            if (og + 1u == (tg + 1u) * nx) xb_add(&bar[XB_TOPGEN], 1u);
            else XB_SPIN(xb_ld(&bar[XB_TOPGEN]) == tg, bar);
            __builtin_amdgcn_fence(__ATOMIC_ACQUIRE, "agent");
            xb_add(&bar[XB_XGEN(b.x)], 1u);
            asm volatile("s_waitcnt vmcnt(0)" ::: "memory");
        } else {
            XB_SPIN(xb_ld(&bar[XB_XGEN(b.x)]) == gen, bar);
            __builtin_amdgcn_fence(__ATOMIC_ACQUIRE, "agent");
            asm volatile("s_waitcnt vmcnt(0)" ::: "memory");
        }
    }
    __syncthreads();
}

struct Args { const float* in[16]; float* out; unsigned char* ws; int ph_lo, ph_hi; };
static_assert(sizeof(Args) == 18 * 8 + 8, "Args has no padding");

struct Frame {
    LAS unsigned char* lds;
    volatile LAS unsigned* MISC;
    gu32* ctl;
    GAS unsigned char* ws;
    GAS float* out;
    int wave, vcu, G;
};
__device__ __forceinline__ int tid_opaque() { int t = threadIdx.x; asm volatile("" : "+v"(t)); return t; }
#define IN_X(F) ((const float*)(const GAS float*)A.in[0])
#define IN_C(F) ((const float*)(const GAS float*)A.in[1])
#define IN_CTX(F) ((const float*)(const GAS float*)A.in[2])
#define IN_CCTX(F) ((const float*)(const GAS float*)A.in[3])
#define IN_WMOD(F) ((const float*)(const GAS float*)A.in[4])
#define IN_BMOD(F) ((const float*)(const GAS float*)A.in[5])
#define IN_WINE(F) ((const float*)(const GAS float*)A.in[6])
#define IN_WOUTE(F) ((const float*)(const GAS float*)A.in[7])
#define IN_QG(F) ((const float*)(const GAS float*)A.in[8])
#define IN_KG(F) ((const float*)(const GAS float*)A.in[9])
#define IN_WINO(F) ((const float*)(const GAS float*)A.in[10])
#define IN_WOUTO(F) ((const float*)(const GAS float*)A.in[11])
#define IN_LDF(F) ((const float*)(const GAS float*)A.in[12])
#define IN_LDB(F) ((const float*)(const GAS float*)A.in[13])
#define IN_WFIN(F) ((const float*)(const GAS float*)A.in[14])
#define IN_WFOUT(F) ((const float*)(const GAS float*)A.in[15])
#define WSF(F, off) ((float*)((F).ws + (off)))
#define WSB(F, off) ((bf16*)((F).ws + (off)))
__device__ __forceinline__ float shx(float v, int k, int lane) { return __int_as_float(__builtin_amdgcn_ds_bpermute((lane ^ k) << 2, __float_as_int(v))); }
__device__ __forceinline__ float wave_sum(float v, int lane) {
#pragma unroll
    for (int o = 1; o < 64; o <<= 1) v += shx(v, o, lane);
    return v;
}
__device__ __forceinline__ void p0_transpose_item(const float* W, int K, int N, bf16* WT, int k0, int n0, int drow0, float scale, LAS float* scr, int lane) {
    const int kr = lane >> 4, c4 = (lane & 15) * 4;
    f32x4 v[16];
#pragma unroll
    for (int i = 0; i < 16; ++i) v[i] = *(const GAS f32x4*)(W + (size_t)(k0 + 4 * i + kr) * N + n0 + c4);
#pragma unroll
    for (int i = 0; i < 16; ++i) { LAS float* d = scr + (4 * i + kr) * 65 + c4; d[0] = v[i][0]; d[1] = v[i][1]; d[2] = v[i][2]; d[3] = v[i][3]; }
    LDS_WAIT(); asm volatile("" ::: "memory");
    const int c = lane & 7;
#pragma unroll
    for (int j = 0; j < 8; ++j) { const int n = (lane >> 3) + 8 * j; const LAS float* s = scr + (8 * c) * 65 + n;
        v4u o; o.x = pk2(s[0 * 65] * scale, s[1 * 65] * scale); o.y = pk2(s[2 * 65] * scale, s[3 * 65] * scale); o.z = pk2(s[4 * 65] * scale, s[5 * 65] * scale); o.w = pk2(s[6 * 65] * scale, s[7 * 65] * scale);
        *(GAS v4u*)(WT + (size_t)(drow0 + n) * K + k0 + 8 * c) = o; }
    LDS_WAIT(); asm volatile("" ::: "memory");
}
__device__ __forceinline__ void p0_conv(const float* W, bf16* WT, int K, int N, int kind, int r, LAS float* scr, int lane) {
    const int nbn = N / 64, per = (K / 64) * nbn, inst = r / per, rr = r - inst * per, kb = rr / nbn, nb = rr - kb * nbn, n0 = nb * 64;
    int drow0 = n0; float scale = 1.0f;
    if (kind == 2) { if (n0 >= 2048 && n0 < 4096) scale = 0.0625f;
        if (n0 < 4096) { const int d = n0 & 255, half = d >> 7, bj = (d >> 6) & 1; drow0 = (n0 & ~255) + 128 * bj + 64 * half; } }
    if (kind == 4) { const int bj = n0 >= FFN ? 1 : 0, hc = n0 - bj * FFN; drow0 = 256 * (hc >> 7) + 128 * bj + (hc & 127); }
    p0_transpose_item(W + (size_t)inst * K * N, K, N, WT + (size_t)inst * K * N, kb * 64, n0, drow0, scale, scr, lane);
}
__device__ __forceinline__ int conv_layer_count(int L) { return (L & 1) ? (32 * 192 + 64 * 32 + 32 * 176 + 88 * 32) : (32 * 48 + 32 * 32 + 32 * 176 + 88 * 32); }
__device__ __forceinline__ void conv_layer_item(Frame& F, const Args& A, int L, int r, LAS float* scr, int lane) {
    const int j2 = L >> 1;
    if (L & 1) {
        constexpr int P0 = 32 * 192, P1 = 64 * 32;
        if (r < P0) { p0_conv(IN_WINO(F), WSB(F, WS_W_INO), DM, OIN, 2, r + j2 * P0, scr, lane); return; } r -= P0;
        if (r < P1) { p0_conv(IN_WOUTO(F), WSB(F, WS_W_OUTO), OMIX, DM, 3, r + j2 * P1, scr, lane); return; } r -= P1;
    } else {
        constexpr int P0 = 32 * 48, P1 = 32 * 32;
        if (r < P0) { p0_conv(IN_WINE(F), WSB(F, WS_W_INE), DM, EIN, 0, r + j2 * P0, scr, lane); return; } r -= P0;
        if (r < P1) { p0_conv(IN_WOUTE(F), WSB(F, WS_W_OUTE), DM, DM, 1, r + j2 * P1, scr, lane); return; } r -= P1;
    }
    constexpr int P4 = 32 * 176, P5 = 88 * 32;
    if (r < P4) { p0_conv(IN_WFIN(F), WSB(F, WS_W_FIN), DM, FFN2, 4, r + L * P4, scr, lane); return; } r -= P4;
    p0_conv(IN_WFOUT(F), WSB(F, WS_W_FOUT), FFN, DM, 5, r + L * P5, scr, lane);
}
__device__ __forceinline__ void conv_in_tail(Frame& F, const Args& A, int L, int lo, int hi, int widx, int nw) {
    const int lane = tid_opaque() & 63;
    LAS float* scr = (LAS float*)(F.lds + RING_OFF + F.wave * 16640);
    for (int r = lo + widx * NWAVES + F.wave; r < hi; r += nw * NWAVES) conv_layer_item(F, A, L, r, scr, lane);
}
#ifndef LATE_CONV
#define LATE_CONV 1
#endif
#ifndef BUILD_SPLITTAB
#define BUILD_SPLITTAB 0
#endif
#ifndef PRO_GW
#define PRO_GW 3
#endif
__device__ __forceinline__ void ph_prologue(Frame& F, const Args& A) {
    const int tid = tid_opaque(), lane = tid & 63;
    constexpr int COND_BYTES = NSET * DM * 4;
    LAS float* cond = (LAS float*)(F.lds + RING_OFF);
    for (int i = tid; i < NSET * DM; i += NWAVES * 64) { const int s = i >> 11, k = i & 2047; const float v = (s < 8) ? IN_C(F)[s * DM + k] : IN_CCTX(F)[k]; cond[i] = v / (1.0f + expf(-v)); }
    LDS_WAIT(); __syncthreads();
    if (F.wave < PRO_GW) {
        for (int item = F.wave * F.G + F.vcu; item < 4 * 192; item += PRO_GW * F.G) {
            const int layer = item / 192, kk = lane >> 4, col = (item - layer * 192) * 64 + (lane & 15) * 4;
            const float* wp = IN_WMOD(F) + (size_t)layer * DM * MODW + (size_t)kk * MODW + col;
            f32x4 acc[NSET];
#pragma unroll
            for (int s = 0; s < NSET; ++s) acc[s] = (f32x4){0.f, 0.f, 0.f, 0.f};
            for (int k = 0; k < DM; k += 32) {
                f32x4 w[8];
#pragma unroll
                for (int u = 0; u < 8; ++u) w[u] = *(const GAS f32x4*)(wp + (size_t)(k + 4 * u) * MODW);
#pragma unroll
                for (int u = 0; u < 8; ++u)
#pragma unroll
                    for (int s = 0; s < NSET; ++s) acc[s] += w[u] * cond[s * DM + k + 4 * u + kk];
            }
#pragma unroll
            for (int s = 0; s < NSET; ++s)
#pragma unroll
                for (int x = 0; x < 4; ++x) { float t = acc[s][x]; t += shx(t, 16, lane); t += shx(t, 32, lane); acc[s][x] = t; }
            if (kk == 0) { const f32x4 bm = *(const GAS f32x4*)(IN_BMOD(F) + layer * MODW + col);
#pragma unroll
                for (int s = 0; s < NSET; ++s) *(GAS f32x4*)(WSF(F, WS_MOD) + (size_t)(layer * NSET + s) * MODW + col) = acc[s] + bm; }
        }
    } else {
        LAS float* scr = (LAS float*)(F.lds + RING_OFF + COND_BYTES + (F.wave - PRO_GW) * 16640);
        const int tw = (F.wave - PRO_GW) * F.G + F.vcu, NTW = (NWAVES - PRO_GW) * F.G;
#if LATE_CONV
        for (int it = tw; it < conv_layer_count(0); it += NTW) conv_layer_item(F, A, 0, it, scr, lane);
#else
        constexpr int I0 = 2 * 32 * 48, I1 = 2 * 32 * 32, I2 = 2 * 32 * 192, I3 = 2 * 64 * 32, I4 = 4 * 32 * 176, I5 = 4 * 88 * 32;
        for (int it = tw; it < I0 + I1 + I2 + I3 + I4 + I5; it += NTW) {
            int r = it;
            if (r < I0) { p0_conv(IN_WINE(F), WSB(F, WS_W_INE), DM, EIN, 0, r, scr, lane); continue; } r -= I0;
            if (r < I1) { p0_conv(IN_WOUTE(F), WSB(F, WS_W_OUTE), DM, DM, 1, r, scr, lane); continue; } r -= I1;
            if (r < I2) { p0_conv(IN_WINO(F), WSB(F, WS_W_INO), DM, OIN, 2, r, scr, lane); continue; } r -= I2;
            if (r < I3) { p0_conv(IN_WOUTO(F), WSB(F, WS_W_OUTO), OMIX, DM, 3, r, scr, lane); continue; } r -= I3;
            if (r < I4) { p0_conv(IN_WFIN(F), WSB(F, WS_W_FIN), DM, FFN2, 4, r, scr, lane); continue; } r -= I4;
            p0_conv(IN_WFOUT(F), WSB(F, WS_W_FOUT), FFN, DM, 5, r, scr, lane);
        }
#endif
    }
    const int gw = F.vcu * NWAVES + F.wave, NGW = F.G * NWAVES;
    if (BUILD_SPLITTAB && gw == 0) {
        pg8::StaticOrder so; so.init(MROWS, DM, F.G, 0); const int nfull = (so.nwg / F.G) * F.G; int* tab = (int*)(F.ws + WS_SPLITTAB);
        for (int e = lane; e < 576; e += 64) { int val = 0;
            for (int idx = nfull; idx < so.nwg; ++idx) { pg8::Unit u; so.map(idx, u); if (u.pm * 8 + u.pn == e) val = idx - nfull + 1; }
            tab[e] = val; }
    }
    const int gt = gw * 64 + lane, NGT = NGW * 64;
    for (int i = gt; i < 4096 * 256; i += NGT) {
        const int m = i >> 8, k0 = (i & 255) * 8, part = m >> 11, to = m & 2047; unsigned w[4];
#pragma unroll
        for (int u = 0; u < 4; ++u) { float s0, c0, s1, c1; sincospif((float)((to * (k0 + 2 * u)) & 2047) * (1.0f / 1024.0f), &s0, &c0); sincospif((float)((to * (k0 + 2 * u + 1)) & 2047) * (1.0f / 1024.0f), &s1, &c1);
            w[u] = pk2((part ? s0 : c0) * 0.022097086912079608f, (part ? s1 : c1) * 0.022097086912079608f); }
        *(GAS v4u*)(WSB(F, WS_WTL) + (size_t)m * 2048 + k0) = (v4u){w[0], w[1], w[2], w[3]};
    }
    for (int i = gt; i < 512 * 32; i += NGT) {
        const int m = i >> 5, k0 = (i & 31) * 8, part = m >> 8, to = m & 255; unsigned w[4];
#pragma unroll
        for (int u = 0; u < 4; ++u) { float s0, c0, s1, c1; sincospif((float)((to * (k0 + 2 * u)) & 255) * (1.0f / 128.0f), &s0, &c0); sincospif((float)((to * (k0 + 2 * u + 1)) & 255) * (1.0f / 128.0f), &s1, &c1);
            w[u] = pk2((part ? s0 : c0) * 0.0625f, (part ? s1 : c1) * 0.0625f); }
        *(GAS v4u*)(WSB(F, WS_WTC) + (size_t)m * 256 + k0) = (v4u){w[0], w[1], w[2], w[3]};
    }
    for (int i = gt; i < 512 * 128; i += NGT) {
        const int n = i >> 7, k0 = (i & 127) * 8, g = n >> 7, kq = n & 127, part = k0 >> 9, g2 = (k0 >> 7) & 3; unsigned w[4];
#pragma unroll
        for (int u = 0; u < 4; ++u) { float s0, c0, s1, c1; const int cc = (k0 & 127) + 2 * u; sincospif((float)((cc * kq) & 127) * (1.0f / 64.0f), &s0, &c0); sincospif((float)(((cc + 1) * kq) & 127) * (1.0f / 64.0f), &s1, &c1);
            const float a0 = (part ? -s0 : c0) * 0.08838834764831845f, a1 = (part ? -s1 : c1) * 0.08838834764831845f;
            w[u] = (g == g2) ? pk2(a0, a1) : 0u; }
        *(GAS v4u*)(WSB(F, WS_CB) + (size_t)n * 1024 + k0) = (v4u){w[0], w[1], w[2], w[3]};
    }
    for (int i = gt; i < 64 * 32; i += NGT) { const int pos = i >> 5, f = i & 31; const double inv = exp2(-(double)(2 * f) / 64.0 * 13.287712379549449), a = (double)pos * inv;
        WSF(F, WS_ROPE_E)[2 * i] = (float)cos(a); WSF(F, WS_ROPE_E)[2 * i + 1] = (float)sin(a); }
    for (int i = gt; i < 64 * 64; i += NGT) { const int pos = i >> 6, f = i & 63; const double inv = exp2(-(double)(2 * f) / 128.0 * 13.287712379549449), a = (double)pos * inv;
        WSF(F, WS_ROPE_O)[2 * i] = (float)cos(a); WSF(F, WS_ROPE_O)[2 * i + 1] = (float)sin(a); }
}
__device__ __forceinline__ void ph_modulate(Frame& F, const Args& A, int layer, int which, int skipctx, int merge, int from_x) {
    const int lane = tid_opaque() & 63;
    const int gw = F.vcu * NWAVES + F.wave, NGW = F.G * NWAVES, R = (MROWS + NGW - 1) / NGW;
    const int m0 = gw * R, m1 = (m0 + R < MROWS) ? m0 + R : MROWS;
    f32x4 sh[8], sc[8], v[8], vn[8]; int curset = -1;
#define MOD_SRC(m_, b_, t_) (from_x ? (const GAS f32x4*)((t_) >= SEQ ? IN_CTX(F) + (size_t)((b_) * CTXL + (t_) - SEQ) * DM : IN_X(F) + (size_t)((b_) * SEQ + (t_)) * DM) + lane : (const GAS f32x4*)(WSF(F, WS_H) + (size_t)(m_) * DM) + lane)
    if (m0 < MROWS) { const int b = m0 / TPB, t = m0 - b * TPB; const GAS f32x4* sr = MOD_SRC(m0, b, t);
#pragma unroll
        for (int j = 0; j < 8; ++j) vn[j] = sr[64 * j]; }
#pragma unroll 1
    for (int m = m0; m < m1; ++m) {
        const int b = m / TPB, t = m - b * TPB, isctx = t >= SEQ, set = isctx ? 8 : b;
#pragma unroll
        for (int j = 0; j < 8; ++j) v[j] = vn[j];
        if (m + 1 < m1) { const int b2 = (m + 1) / TPB, t2 = (m + 1) - b2 * TPB; const GAS f32x4* sr = MOD_SRC(m + 1, b2, t2);
#pragma unroll
            for (int j = 0; j < 8; ++j) vn[j] = sr[64 * j]; }
        if (skipctx && isctx) continue;
        if (set != curset) { curset = set; const float* shp = WSF(F, WS_MOD) + (size_t)(layer * NSET + set) * MODW + which * 3 * DM;
#pragma unroll
            for (int j = 0; j < 8; ++j) { sh[j] = *((const GAS f32x4*)shp + lane + 64 * j); sc[j] = *((const GAS f32x4*)(shp + DM) + lane + 64 * j) + 1.0f; } }
        if (merge) {
            GAS f32x4* hr = (GAS f32x4*)(WSF(F, WS_H) + (size_t)m * DM) + lane;
            const int pm = m >> 8; const int* tab = (const int*)(F.ws + WS_SPLITTAB) + pm * 8;
#pragma unroll
            for (int j = 0; j < 8; ++j) { const int sl = __builtin_amdgcn_readfirstlane(tab[j]);
                if (sl) { const GAS f32x4* dp = (const GAS f32x4*)(WSF(F, WS_DELTA) + (size_t)(sl - 1) * 4 * 65536 + (size_t)(m & 255) * 256) + lane;
                    const f32x4 d0 = dp[0], d1 = dp[16384], d2 = dp[32768], d3 = dp[49152];
                    v[j] = v[j] + ((d0 + d1) + (d2 + d3)); hr[64 * j] = v[j]; } }
        }
        float ss = 0.f;
#pragma unroll
        for (int j = 0; j < 8; ++j) { ss += (v[j][0] * v[j][0] + v[j][1] * v[j][1]) + (v[j][2] * v[j][2] + v[j][3] * v[j][3]); }
        const float rstd = 1.0f / sqrtf(wave_sum(ss, lane) * (1.0f / DM) + EPS);
        GAS v2u* o8 = (GAS v2u*)(WSB(F, WS_XN) + (size_t)m * DM) + lane;
#pragma unroll
        for (int j = 0; j < 8; ++j) { const f32x4 y = v[j] * rstd * sc[j] + sh[j]; o8[64 * j] = (v2u){pk2(y[0], y[1]), pk2(y[2], y[3])}; }
    }
#undef MOD_SRC
}
__device__ __forceinline__ void ph_qk_even(Frame& F, const Args& A, int j2) {
    const int gw = F.vcu * NWAVES + F.wave, NGW = F.G * NWAVES, l = tid_opaque() & 63;
    const float* qg = IN_QG(F) + j2 * 128 + (l & 15) * 8; const float* kg = IN_KG(F) + j2 * 128 + (l & 15) * 8;
    float gq[8], gk[8];
#pragma unroll
    for (int x = 0; x < 8; ++x) { gq[x] = qg[x]; gk[x] = kg[x]; }
    for (int m = gw; m < MROWS; m += NGW) {
        const int b = m / TPB, t = m - b * TPB, lat = t < SEQ;
        const int half = (l >> 3) & 1, pos = half ? (t & 63) : (t >> 6), isx2 = (l >> 2) & 1;
        f32x4 tb[4];
        if (lat) {
#pragma unroll
            for (int q = 0; q < 4; ++q) tb[q] = *(const GAS f32x4*)(WSF(F, WS_ROPE_E) + (size_t)(pos * 32 + (l & 3) * 8 + 2 * q) * 2);
        }
        GAS v4u* pr = (GAS v4u*)(WSB(F, WS_P) + (size_t)m * EIN + 512) + l;
#pragma unroll
        for (int j = 3; j < 4; ++j) {
            const v4u raw = pr[64 * j];
            float v[8] = {bflo(raw.x), bfhi(raw.x), bflo(raw.y), bfhi(raw.y), bflo(raw.z), bfhi(raw.z), bflo(raw.w), bfhi(raw.w)};
            float ss = 0.f;
#pragma unroll
            for (int x = 0; x < 8; ++x) ss += v[x] * v[x];
            ss += shx(ss, 1, l); ss += shx(ss, 2, l); ss += shx(ss, 4, l); ss += shx(ss, 8, l);
            const float rstd = 1.0f / sqrtf(ss * (1.0f / 128.0f) + EPS);
            const bool isq = (4 * j + (l >> 4)) < 12;
#pragma unroll
            for (int x = 0; x < 8; ++x) v[x] = v[x] * rstd * (isq ? gq[x] : gk[x]);
            if (lat) {
#pragma unroll
                for (int x = 0; x < 8; ++x) { const float p = shx(v[x], 4, l); const float cs = tb[x >> 1][(x & 1) * 2], sn = tb[x >> 1][(x & 1) * 2 + 1];
                    v[x] = isx2 ? (v[x] * cs + p * sn) : (v[x] * cs - p * sn); }
            }
            pr[64 * j] = (v4u){pk2(v[0], v[1]), pk2(v[2], v[3]), pk2(v[4], v[5]), pk2(v[6], v[7])};
        }
    }
    LAS bf16* scr = (LAS bf16*)(F.lds + RING_OFF + F.wave * 9216);
    for (int it = gw; it < NBATCH * 288; it += NGW) {
        const int b = it / 288, r = it - b * 288; int t0, c0, isc;
        if (r < 256) { isc = 0; t0 = (r >> 3) * 64; c0 = (r & 7) * 64; } else { isc = 1; t0 = ((r - 256) >> 3) * 64; c0 = ((r - 256) & 7) * 64; }
        const bf16* src = WSB(F, WS_P) + (size_t)(b * TPB + (isc ? SEQ : 0) + t0) * EIN + c0;
#pragma unroll
        for (int i = 0; i < 8; ++i) { const int rr = i * 8 + (l >> 3), ch = l & 7; const v4u val = *(const GAS v4u*)(src + (size_t)rr * EIN + ch * 8); *(LAS v4u*)(scr + rr * 72 + ch * 8) = val; }
        LDS_WAIT(); asm volatile("" ::: "memory");
        bf16* dst = isc ? WSB(F, WS_FTC) + (size_t)(b * 512 + c0) * CTXL + t0 : WSB(F, WS_FT) + (size_t)(b * 512 + c0) * SEQ + t0;
        const int ld = isc ? CTXL : SEQ;
#pragma unroll
        for (int i = 0; i < 8; ++i) { const int cc = i * 8 + (l >> 3), tc = (l & 7) * 8; const LAS bf16* s = scr + tc * 72 + cc;
            v4u o; o.x = (unsigned)s[0] | ((unsigned)s[72] << 16); o.y = (unsigned)s[144] | ((unsigned)s[216] << 16); o.z = (unsigned)s[288] | ((unsigned)s[360] << 16); o.w = (unsigned)s[432] | ((unsigned)s[504] << 16);
            *(GAS v4u*)(dst + (size_t)cc * ld + tc) = o; }
        LDS_WAIT(); asm volatile("" ::: "memory");
    }
}
__device__ __forceinline__ void ph_rope_odd(Frame& F) {
    const int gw = F.vcu * NWAVES + F.wave, NGW = F.G * NWAVES, l = tid_opaque() & 63;
    for (int m = gw; m < MROWS; m += NGW) {
        const int b = m / TPB, t = m - b * TPB;
        if (t >= SEQ) continue;
        const int half = (l >> 4) & 1, pos = half ? (t & 63) : (t >> 6), isx2 = (l >> 3) & 1;
        f32x4 tb[4];
#pragma unroll
        for (int q = 0; q < 4; ++q) tb[q] = *(const GAS f32x4*)(WSF(F, WS_ROPE_O) + (size_t)(pos * 64 + (l & 7) * 8 + 2 * q) * 2);
        GAS v4u* pr = (GAS v4u*)(WSB(F, WS_P) + (size_t)m * OIN) + l;
#pragma unroll
        for (int j = 0; j < 8; ++j) {
            const v4u raw = pr[64 * j];
            float v[8] = {bflo(raw.x), bfhi(raw.x), bflo(raw.y), bfhi(raw.y), bflo(raw.z), bfhi(raw.z), bflo(raw.w), bfhi(raw.w)};
#pragma unroll
            for (int x = 0; x < 8; ++x) { const float p = shx(v[x], 8, l); const float cs = tb[x >> 1][(x & 1) * 2], sn = tb[x >> 1][(x & 1) * 2 + 1];
                v[x] = isx2 ? (v[x] * cs + p * sn) : (v[x] * cs - p * sn); }
            pr[64 * j] = (v4u){pk2(v[0], v[1]), pk2(v[2], v[3]), pk2(v[4], v[5]), pk2(v[6], v[7])};
        }
    }
}
__device__ __forceinline__ void ph_comb(Frame& F, int skipctx, int dry = 0) {
    const int gw = F.vcu * NWAVES + F.wave, NGW = F.G * NWAVES, l = tid_opaque() & 63;
    for (int m = gw; m < MROWS; m += NGW) {
        const int b = m / TPB, t = m - b * TPB;
        if (skipctx && t >= SEQ) continue;
        GAS v4u* pf = (GAS v4u*)(WSB(F, WS_OF) + (size_t)m * OMIX) + l; const GAS v4u* pb = (const GAS v4u*)(WSB(F, WS_OB) + (size_t)m * OMIX) + l;
        const GAS v4u* pg = (const GAS v4u*)(WSB(F, WS_P) + (size_t)m * OIN + 8192) + l;
#pragma unroll
        for (int j = 0; j < 8; ++j) {
            const v4u a = pf[64 * j], bb = pb[64 * j], gg = pg[64 * j];
            float o[8] = {bflo(a.x) + bflo(bb.x), bfhi(a.x) + bfhi(bb.x), bflo(a.y) + bflo(bb.y), bfhi(a.y) + bfhi(bb.y), bflo(a.z) + bflo(bb.z), bfhi(a.z) + bfhi(bb.z), bflo(a.w) + bflo(bb.w), bfhi(a.w) + bfhi(bb.w)};
            const float g[8] = {bflo(gg.x), bfhi(gg.x), bflo(gg.y), bfhi(gg.y), bflo(gg.z), bfhi(gg.z), bflo(gg.w), bfhi(gg.w)};
            float ss = 0.f;
#pragma unroll
            for (int x = 0; x < 8; ++x) ss += o[x] * o[x];
            const float rstd = 1.0f / sqrtf(wave_sum(ss, l) * (1.0f / 512.0f) + EPS);
#pragma unroll
            for (int x = 0; x < 8; ++x) o[x] = silu(g[x]) * (o[x] * rstd);
            (dry ? (GAS v4u*)pb : pf)[64 * j] = (v4u){pk2(o[0], o[1]), pk2(o[2], o[3]), pk2(o[4], o[5]), pk2(o[6], o[7])};
        }
    }
}
__device__ __forceinline__ void ph_attention(Frame& F, const Args& A, int j2) {
    char* lds = (char*)(F.lds + RING_OFF);
    for (int i = 0;; ++i) {
        const int u = i * F.G + F.vcu; if (u >= 864) break;
        if (u < 768) { const int qb = u & 7, g3 = (u >> 3) % 3, bk = u / 24, kvh = bk & 3, b = bk >> 2, h = kvh * 3 + g3; const size_t rq = (size_t)(b * TPB + qb * 256);
            const bf16* Kh = WSB(F, WS_P) + (size_t)(b * TPB) * EIN + 2048 + kvh * 128;
            att::attn_dense_body(WSB(F, WS_P) + rq * EIN + 512 + h * 128, Kh, Kh + 512, WSB(F, WS_MIX) + rq * DM + 512 + h * 128, TPB, lds, IN_QG(F) + j2 * 128, WSF(F, WS_ROPE_E), qb * 256);
        } else { const int v = u - 768, b = v / 12, h = v - b * 12, kvh = h / 3; const size_t rq = (size_t)(b * TPB + SEQ);
            const bf16* Kh = WSB(F, WS_P) + rq * EIN + 2048 + kvh * 128;
            att::attn_dense_body(WSB(F, WS_P) + rq * EIN + 512 + h * 128, Kh, Kh + 512, WSB(F, WS_MIX) + rq * DM + 512 + h * 128, CTXL, lds, IN_QG(F) + j2 * 128, nullptr, 0);
        }
    }
}
namespace ret {
constexpr int K_LD = 544, V_LD = 288, ST_LD = 544, Q_LD = 544;
constexpr int K_OFF = 0, V_OFF = 64 * K_LD, ST_OFF = V_OFF + 64 * V_LD, Q_OFF = ST_OFF + 128 * ST_LD, LDS_END = Q_OFF + 64 * Q_LD;
static_assert(LDS_END <= LDSCTL_OFF, "retention LDS");
typedef short v4i16_t __attribute__((ext_vector_type(4)));
__device__ __forceinline__ bf16x8 lds16(const LAS unsigned char* p) { return *(const LAS bf16x8*)p; }
__device__ __forceinline__ s16x4 ldstr(const LAS unsigned char* p) { return __builtin_bit_cast(s16x4, __builtin_amdgcn_ds_read_tr16_b64_v4i16((LAS v4i16_t*)p)); }
__device__ __forceinline__ bf16x8 cat8(s16x4 lo, s16x4 hi) { return (bf16x8){lo[0], lo[1], lo[2], lo[3], hi[0], hi[1], hi[2], hi[3]}; }
__device__ __forceinline__ bf16x8 pack8(const float* v) { const v4u w = {pk2(v[0], v[1]), pk2(v[2], v[3]), pk2(v[4], v[5]), pk2(v[6], v[7])}; return __builtin_bit_cast(bf16x8, w); }
#ifndef PROBE_RETBAR
#define PROBE_RETBAR 0
#endif
#define RET_BAR() do { asm volatile("s_waitcnt lgkmcnt(0)" ::: "memory"); __builtin_amdgcn_s_barrier(); if (PROBE_RETBAR) __builtin_amdgcn_s_barrier(); asm volatile("" ::: "memory"); } while (0)
#ifndef RET_EARLY_LOAD
#define RET_EARLY_LOAD 1
#endif
#ifndef RET_SBMASK
#define RET_SBMASK -1
#endif
#ifndef RET_NOSB
#define RET_NOSB 0
#endif
#define RET_SB() do { if (!RET_NOSB) __builtin_amdgcn_sched_barrier(0); } while (0)
#define RET_SBX(i) do { if (RET_SBMASK >= 0 && ((i) & RET_SBMASK) == RET_SBMASK) RET_SB(); } while (0)
__device__ __forceinline__ void ret_item(LAS unsigned char* lds, const bf16* P, bf16* Odir, int b, int h, int dir, int es, float lg) {
    int tid = threadIdx.x; asm volatile("" : "+v"(tid));
    const int w = __builtin_amdgcn_readfirstlane(tid >> 6), lane = tid & 63, g = lane >> 4, c = lane & 15, wi = w & 3, we = w >> 2, q4 = c >> 2, p4 = c & 3;
    const float lg2 = lg * 1.4426950408889634f;
    const bf16* Pq = P + h * 256 + (tid & 31) * 8; const bf16* Pk = Pq + 2048; const bf16* Pv = P + 4096 + h * 512 + es * 128 + (tid & 15) * 8;
    bf16* Oo = Odir + h * 512 + es * 128 + we * 64 + c;
    { unsigned z_ = 0u; asm volatile("" : "+v"(z_));
      for (int i = tid; i < 128 * ST_LD / 16; i += NWAVES * 64) *(LAS v4u*)(lds + ST_OFF + i * 16) = (v4u){z_, z_, z_, z_}; }
    f32x4 st[2][8];
#pragma unroll
    for (int a = 0; a < 2; ++a)
#pragma unroll
        for (int e = 0; e < 8; ++e) st[a][e] = (f32x4){0.f, 0.f, 0.f, 0.f};
    const int kr = tid >> 5, vr = tid >> 4;
    const float cd = __builtin_amdgcn_exp2f(64.0f * lg2);
    v4u kreg[4], qreg[4], vreg[2];
#define RET_ROWBASE(n) (dir == 0 ? (b * TPB + ((n) < 4 ? SEQ + 64 * (n) : 64 * (n) - CTXL)) : (b * TPB + ((n) < 4 ? SEQ + 255 - 64 * (n) : 2303 - 64 * (n))))
#define RET_LOAD(n) do { const int rb_ = RET_ROWBASE(n), sg_ = dir == 0 ? 1 : -1; \
        _Pragma("unroll") for (int x = 0; x < 4; ++x) { const size_t ro_ = (size_t)(rb_ + sg_ * (kr + 16 * x)) * OIN; kreg[x] = *(const GAS v4u*)(Pk + ro_); qreg[x] = *(const GAS v4u*)(Pq + ro_); } \
        _Pragma("unroll") for (int x = 0; x < 2; ++x) vreg[x] = *(const GAS v4u*)(Pv + (size_t)(rb_ + sg_ * (vr + 32 * x)) * OIN); } while (0)
    RET_LOAD(0);
    for (int n = 0; n < 36; ++n) {
        const int rowbase = RET_ROWBASE(n), sgn = dir == 0 ? 1 : -1;
#pragma unroll
        for (int x = 0; x < 4; ++x) { *(LAS v4u*)(lds + K_OFF + (kr + 16 * x) * K_LD + (tid & 31) * 16) = kreg[x]; *(LAS v4u*)(lds + Q_OFF + (kr + 16 * x) * Q_LD + (tid & 31) * 16) = qreg[x]; }
#pragma unroll
        for (int x = 0; x < 2; ++x) { const float kd = __builtin_amdgcn_exp2f((float)(63 - (vr + 32 * x)) * lg2); const v4u r = vreg[x];
            *(LAS v4u*)(lds + V_OFF + (vr + 32 * x) * V_LD + (tid & 15) * 16) = (v4u){pk2(bflo(r.x) * kd, bfhi(r.x) * kd), pk2(bflo(r.y) * kd, bfhi(r.y) * kd), pk2(bflo(r.z) * kd, bfhi(r.z) * kd), pk2(bflo(r.w) * kd, bfhi(r.w) * kd)}; }
        RET_BAR();
#if RET_EARLY_LOAD
        if (n + 1 < 36) RET_LOAD(n + 1);
#endif
        float lg2v = lg2; int gl = g, cl = c; asm volatile("" : "+v"(lg2v), "+v"(gl), "+v"(cl));
#define RD_Q(s)    lds16(lds + Q_OFF + (16 * wi + c) * Q_LD + (32 * (s) + 8 * g) * 2)
#define RD_K(jt, s) lds16(lds + K_OFF + (16 * (jt) + c) * K_LD + (32 * (s) + 8 * g) * 2)
#define RD_ST(et, s) lds16(lds + ST_OFF + (64 * we + 16 * (et) + c) * ST_LD + (32 * (s) + 8 * g) * 2)
        f32x4 sT[4], O[4];
#pragma unroll
        for (int jt = 0; jt < 4; ++jt) { sT[jt] = (f32x4){0.f, 0.f, 0.f, 0.f}; O[jt] = (f32x4){0.f, 0.f, 0.f, 0.f}; }
        {
            bf16x8 qc = RD_Q(0), qn = qc, kf[4], sf[4];
#pragma unroll
            for (int jt = 0; jt < 4; ++jt) kf[jt] = RD_K(jt, 0);
#pragma unroll
            for (int s = 0; s < 8; ++s) {
#pragma unroll
                for (int et = 0; et < 4; ++et) sf[et] = RD_ST(et, s);
                RET_SB();
#pragma unroll
                for (int jt = 0; jt < 4; ++jt) sT[jt] = __builtin_amdgcn_mfma_f32_16x16x32_bf16(kf[jt], qc, sT[jt], 0, 0, 0);
                RET_SB();
                if (s < 7) { qn = RD_Q(s + 1);
#pragma unroll
                    for (int jt = 0; jt < 4; ++jt) kf[jt] = RD_K(jt, s + 1); }
                RET_SB();
#pragma unroll
                for (int et = 0; et < 4; ++et) O[et] = __builtin_amdgcn_mfma_f32_16x16x32_bf16(qc, sf[et], O[et], 0, 0, 0);
                RET_SB();
                qc = qn;
            }
        }
        s16x4 vlo[4][2], vhi[4][2];
#pragma unroll
        for (int et = 0; et < 4; ++et)
#pragma unroll
            for (int s2 = 0; s2 < 2; ++s2) { const LAS unsigned char* vp = lds + V_OFF + (32 * s2 + 4 * g + q4) * V_LD + (64 * we + 16 * et + 4 * p4) * 2; vlo[et][s2] = ldstr(vp); vhi[et][s2] = ldstr(vp + 16 * V_LD); }
        RET_SB();
#pragma unroll
        for (int et = 0; et < 4; ++et) O[et] = O[et] * cd;
        bf16x8 pA[2];
#pragma unroll
        for (int s2 = 0; s2 < 2; ++s2) { float v[8];
#pragma unroll
            for (int jj = 0; jj < 8; ++jj) { const int jt = 2 * s2 + (jj >> 2), r = jj & 3, diff = (16 * wi + cl) - (16 * jt + 4 * gl + r);
                const bool keep = dir == 0 ? diff >= 0 : diff > 0;
                v[jj] = keep ? sT[jt][r] : 0.f; }
            pA[s2] = pack8(v); }
        RET_SB();
        s16x4 klo[2][2], khi[2][2];
#pragma unroll
        for (int s2 = 0; s2 < 2; ++s2)
#pragma unroll
            for (int dt = 0; dt < 2; ++dt) { const LAS unsigned char* kp = lds + K_OFF + (32 * s2 + 4 * g + q4) * K_LD + (32 * w + 8 * p4 + 4 * dt) * 2; klo[s2][dt] = ldstr(kp); khi[s2][dt] = ldstr(kp + 16 * K_LD); }
        RET_SB();
#pragma unroll
        for (int et = 0; et < 4; ++et)
#pragma unroll
            for (int s2 = 0; s2 < 2; ++s2) O[et] = __builtin_amdgcn_mfma_f32_16x16x32_bf16(pA[s2], cat8(vlo[et][s2], vhi[et][s2]), O[et], 0, 0, 0);
        RET_SB();
#define RD_V4(it) cat8(ldstr(lds + V_OFF + (32 * ((it) >> 3) + 4 * g + q4) * V_LD + (16 * ((it) & 7) + 4 * p4) * 2), ldstr(lds + V_OFF + (32 * ((it) >> 3) + 4 * g + q4 + 16) * V_LD + (16 * ((it) & 7) + 4 * p4) * 2))
        bf16x8 vbc = RD_V4(0), vbn = vbc;
        RET_SB();
#pragma unroll
        for (int a = 0; a < 2; ++a)
#pragma unroll
            for (int e = 0; e < 8; ++e) st[a][e] *= cd;
        bf16x8 ka[2][2];
#pragma unroll
        for (int s2 = 0; s2 < 2; ++s2)
#pragma unroll
            for (int dt = 0; dt < 2; ++dt) ka[s2][dt] = cat8(klo[s2][dt], khi[s2][dt]);
        { bf16* ob = Oo + (size_t)(dir == 0 ? rowbase : rowbase - 63) * OMIX;
#pragma unroll
            for (int r = 0; r < 4; ++r) { const int i = 16 * wi + 4 * g + r; const float rf = __builtin_amdgcn_exp2f((float)(16 * wi + 4 * gl + r - 63) * lg2v);
                const unsigned off = (unsigned)(dir == 0 ? i : 63 - i) * OMIX;
#pragma unroll
                for (int et = 0; et < 4; ++et) ob[off + 16 * et] = (bf16)(pk2(O[et][r] * rf, 0.f) & 0xffffu); } }
        RET_SB();
#pragma unroll
        for (int it = 0; it < 16; ++it) {
            if (it < 15) vbn = RD_V4(it + 1);
            RET_SB();
            st[0][it & 7] = __builtin_amdgcn_mfma_f32_16x16x32_bf16(ka[it >> 3][0], vbc, st[0][it & 7], 0, 0, 0);
            st[1][it & 7] = __builtin_amdgcn_mfma_f32_16x16x32_bf16(ka[it >> 3][1], vbc, st[1][it & 7], 0, 0, 0);
            RET_SB();
            vbc = vbn;
        }
#undef RD_Q
#undef RD_K
#undef RD_ST
#undef RD_V4
        RET_BAR();
        if (n + 1 < 36) {
#pragma unroll
            for (int et = 0; et < 8; ++et)
                *(LAS v4u*)(lds + ST_OFF + (16 * et + c) * ST_LD + (32 * w + 8 * g) * 2) = (v4u){pk2(st[0][et][0], st[0][et][1]), pk2(st[0][et][2], st[0][et][3]), pk2(st[1][et][0], st[1][et][1]), pk2(st[1][et][2], st[1][et][3])};
        }
    }
#undef RET_LOAD
#undef RET_ROWBASE
}

__device__ __forceinline__ void ret_item_spec(LAS unsigned char* lds, const bf16* P, bf16* Odir, int b, int h, int dir, int es, float lg, int noctx) {
    int tid = threadIdx.x; asm volatile("" : "+v"(tid));
    const int w = __builtin_amdgcn_readfirstlane(tid >> 6), lane = tid & 63, g = lane >> 4, c = lane & 15, q4 = c >> 2, p4 = c & 3;
    const float lg2 = lg * 1.4426950408889634f;
    const bf16* Pq = P + h * 256 + (tid & 31) * 8; const bf16* Pk = Pq + 2048; const bf16* Pv = P + 4096 + h * 512 + es * 128 + (tid & 15) * 8;
    { unsigned z_ = 0u; asm volatile("" : "+v"(z_));
      for (int i = tid; i < 128 * ST_LD / 16; i += NWAVES * 64) *(LAS v4u*)(lds + ST_OFF + i * 16) = (v4u){z_, z_, z_, z_}; }
    const int kr = (tid & 255) >> 5, vr = (tid & 255) >> 4;
    const float cd = __builtin_amdgcn_exp2f(64.0f * lg2);
#define RET_ROWBASE(n) (dir == 0 ? (b * TPB + ((n) < 4 ? SEQ + 64 * (n) : 64 * (n) - CTXL)) : (b * TPB + ((n) < 4 ? SEQ + 255 - 64 * (n) : 2303 - 64 * (n))))
#define RET_LOADA(n) do { const int rb_ = RET_ROWBASE(n), sg_ = dir == 0 ? 1 : -1; \
        _Pragma("unroll") for (int x = 0; x < 8; ++x) { const size_t ro_ = (size_t)(rb_ + sg_ * (kr + 8 * x)) * OIN; kreg[x] = *(const GAS v4u*)(Pk + ro_); qreg[x] = *(const GAS v4u*)(Pq + ro_); } } while (0)
#define RET_STAGEA() do { \
        _Pragma("unroll") for (int x = 0; x < 8; ++x) { *(LAS v4u*)(lds + K_OFF + (kr + 8 * x) * K_LD + (tid & 31) * 16) = kreg[x]; *(LAS v4u*)(lds + Q_OFF + (kr + 8 * x) * Q_LD + (tid & 31) * 16) = qreg[x]; } } while (0)
#define RET_LOADB(n) do { const int rb_ = RET_ROWBASE(n), sg_ = dir == 0 ? 1 : -1; \
        _Pragma("unroll") for (int x = 0; x < 4; ++x) vreg[x] = *(const GAS v4u*)(Pv + (size_t)(rb_ + sg_ * (vr + 16 * x)) * OIN); } while (0)
#define RET_STAGEB() do { \
        _Pragma("unroll") for (int x = 0; x < 4; ++x) { const float kd = __builtin_amdgcn_exp2f((float)(63 - (vr + 16 * x)) * lg2); const v4u r = vreg[x]; \
            *(LAS v4u*)(lds + V_OFF + (vr + 16 * x) * V_LD + (tid & 15) * 16) = (v4u){pk2(bflo(r.x) * kd, bfhi(r.x) * kd), pk2(bflo(r.y) * kd, bfhi(r.y) * kd), pk2(bflo(r.z) * kd, bfhi(r.z) * kd), pk2(bflo(r.w) * kd, bfhi(r.w) * kd)}; } } while (0)
    if (w < 4) {
        const int wa = w;
        bf16* Oo = Odir + h * 512 + es * 128 + c;
        v4u kreg[8], qreg[8];
        RET_LOADA(0);
        for (int n = 0; n < 36; ++n) {
            const int rowbase = RET_ROWBASE(n);
            RET_STAGEA();
            RET_BAR();
            if (n + 1 < 36) RET_LOADA(n + 1);
            if (!(noctx && n < 4)) {
            float lg2v = lg2; int gl = g, cl = c; asm volatile("" : "+v"(lg2v), "+v"(gl), "+v"(cl));
#define RD_Q(s)    lds16(lds + Q_OFF + (16 * wa + c) * Q_LD + (32 * (s) + 8 * g) * 2)
#define RD_K(jt, s) lds16(lds + K_OFF + (16 * (jt) + c) * K_LD + (32 * (s) + 8 * g) * 2)
#define RD_ST(et, s) lds16(lds + ST_OFF + (16 * (et) + c) * ST_LD + (32 * (s) + 8 * g) * 2)
            f32x4 sT[4], O[8];
#pragma unroll
            for (int jt = 0; jt < 4; ++jt) sT[jt] = (f32x4){0.f, 0.f, 0.f, 0.f};
#pragma unroll
            for (int et = 0; et < 8; ++et) O[et] = (f32x4){0.f, 0.f, 0.f, 0.f};
            {
                bf16x8 q0 = RD_Q(0), q1, k0[4], k1[4], sf[8];
#pragma unroll
                for (int jt = 0; jt < 4; ++jt) k0[jt] = RD_K(jt, 0);
#pragma unroll
                for (int s = 0; s < 8; s += 2) {
                    q1 = RD_Q(s + 1);
#pragma unroll
                    for (int jt = 0; jt < 4; ++jt) k1[jt] = RD_K(jt, s + 1);
#pragma unroll
                    for (int et = 0; et < 8; ++et) sf[et] = RD_ST(et, s);
                    RET_SB();
#pragma unroll
                    for (int jt = 0; jt < 4; ++jt) sT[jt] = __builtin_amdgcn_mfma_f32_16x16x32_bf16(k0[jt], q0, sT[jt], 0, 0, 0);
                    RET_SB();
#pragma unroll
                    for (int et = 0; et < 8; ++et) O[et] = __builtin_amdgcn_mfma_f32_16x16x32_bf16(q0, sf[et], O[et], 0, 0, 0);
                    RET_SB();
                    if (s + 2 < 8) { q0 = RD_Q(s + 2);
#pragma unroll
                        for (int jt = 0; jt < 4; ++jt) k0[jt] = RD_K(jt, s + 2); }
#pragma unroll
                    for (int et = 0; et < 8; ++et) sf[et] = RD_ST(et, s + 1);
                    RET_SB();
#pragma unroll
                    for (int jt = 0; jt < 4; ++jt) sT[jt] = __builtin_amdgcn_mfma_f32_16x16x32_bf16(k1[jt], q1, sT[jt], 0, 0, 0);
                    RET_SB();
#pragma unroll
                    for (int et = 0; et < 8; ++et) O[et] = __builtin_amdgcn_mfma_f32_16x16x32_bf16(q1, sf[et], O[et], 0, 0, 0);
                    RET_SB();
                }
            }
#pragma unroll
            for (int et = 0; et < 8; ++et) O[et] = O[et] * cd;
            bf16x8 pA[2];
#pragma unroll
            for (int s2 = 0; s2 < 2; ++s2) { float v[8];
#pragma unroll
                for (int jj = 0; jj < 8; ++jj) { const int jt = 2 * s2 + (jj >> 2), r = jj & 3, diff = (16 * wa + cl) - (16 * jt + 4 * gl + r);
                    const bool keep = dir == 0 ? diff >= 0 : diff > 0;
                    v[jj] = keep ? sT[jt][r] : 0.f; }
                pA[s2] = pack8(v); }
            RET_SB();
            {
#define RD_VA(et, s2) cat8(ldstr(lds + V_OFF + (32 * (s2) + 4 * g + q4) * V_LD + (16 * (et) + 4 * p4) * 2), ldstr(lds + V_OFF + (32 * (s2) + 4 * g + q4 + 16) * V_LD + (16 * (et) + 4 * p4) * 2))
                bf16x8 va[2][2], vb[2][2];
#pragma unroll
                for (int q = 0; q < 2; ++q) { va[q][0] = RD_VA(q, 0); va[q][1] = RD_VA(q, 1); }
#pragma unroll
                for (int et = 0; et < 8; et += 4) {
#pragma unroll
                    for (int q = 0; q < 2; ++q) { vb[q][0] = RD_VA(et + 2 + q, 0); vb[q][1] = RD_VA(et + 2 + q, 1); }
                    RET_SB();
#pragma unroll
                    for (int q = 0; q < 2; ++q) { O[et + q] = __builtin_amdgcn_mfma_f32_16x16x32_bf16(pA[0], va[q][0], O[et + q], 0, 0, 0); O[et + q] = __builtin_amdgcn_mfma_f32_16x16x32_bf16(pA[1], va[q][1], O[et + q], 0, 0, 0); }
                    RET_SB();
                    if (et + 4 < 8) {
#pragma unroll
                        for (int q = 0; q < 2; ++q) { va[q][0] = RD_VA(et + 4 + q, 0); va[q][1] = RD_VA(et + 4 + q, 1); } }
                    RET_SB();
#pragma unroll
                    for (int q = 0; q < 2; ++q) { O[et + 2 + q] = __builtin_amdgcn_mfma_f32_16x16x32_bf16(pA[0], vb[q][0], O[et + 2 + q], 0, 0, 0); O[et + 2 + q] = __builtin_amdgcn_mfma_f32_16x16x32_bf16(pA[1], vb[q][1], O[et + 2 + q], 0, 0, 0); }
                    RET_SB();
                }
#undef RD_VA
            }
            {
                bf16* ob = Oo + (size_t)(dir == 0 ? rowbase : rowbase - 63) * OMIX;
#pragma unroll
                for (int r = 0; r < 4; ++r) { const int i = 16 * wa + 4 * g + r; const float rf = __builtin_amdgcn_exp2f((float)(16 * wa + 4 * gl + r - 63) * lg2v);
                    const unsigned off = (unsigned)(dir == 0 ? i : 63 - i) * OMIX;
#pragma unroll
                    for (int et = 0; et < 8; ++et) ob[off + 16 * et] = (bf16)(pk2(O[et][r] * rf, 0.f) & 0xffffu); }
            }
#undef RD_Q
#undef RD_K
#undef RD_ST
            }
            RET_BAR();
        }
    } else {
        const int wb = w - 4;
        v4u vreg[4];
        RET_LOADB(0);
        f32x4 st[2][2][8];
#pragma unroll
        for (int a = 0; a < 2; ++a)
#pragma unroll
            for (int d = 0; d < 2; ++d)
#pragma unroll
                for (int e = 0; e < 8; ++e) st[a][d][e] = (f32x4){0.f, 0.f, 0.f, 0.f};
        for (int n = 0; n < 36; ++n) {
            RET_STAGEB();
            RET_BAR();
            if (n + 1 < 36) RET_LOADB(n + 1);
            bf16x8 ka[2][2][2];
#pragma unroll
            for (int s2 = 0; s2 < 2; ++s2)
#pragma unroll
                for (int dp = 0; dp < 2; ++dp)
#pragma unroll
                    for (int dt = 0; dt < 2; ++dt) { const LAS unsigned char* kp = lds + K_OFF + (32 * s2 + 4 * g + q4) * K_LD + (64 * wb + 32 * dp + 8 * p4 + 4 * dt) * 2; ka[s2][dp][dt] = cat8(ldstr(kp), ldstr(kp + 16 * K_LD)); }
#define RD_V4(it) cat8(ldstr(lds + V_OFF + (32 * ((it) >> 3) + 4 * g + q4) * V_LD + (16 * ((it) & 7) + 4 * p4) * 2), ldstr(lds + V_OFF + (32 * ((it) >> 3) + 4 * g + q4 + 16) * V_LD + (16 * ((it) & 7) + 4 * p4) * 2))
            bf16x8 vbc = RD_V4(0), vbn = vbc;
            RET_SB();
#pragma unroll
            for (int a = 0; a < 2; ++a)
#pragma unroll
                for (int d = 0; d < 2; ++d)
#pragma unroll
                    for (int e = 0; e < 8; ++e) st[a][d][e] *= cd;
            RET_SB();
#pragma unroll
            for (int it = 0; it < 16; ++it) {
                if (it < 15) vbn = RD_V4(it + 1);
                RET_SB();
#pragma unroll
                for (int dp = 0; dp < 2; ++dp)
#pragma unroll
                    for (int dt = 0; dt < 2; ++dt) st[dp][dt][it & 7] = __builtin_amdgcn_mfma_f32_16x16x32_bf16(ka[it >> 3][dp][dt], vbc, st[dp][dt][it & 7], 0, 0, 0);
                RET_SB();
                vbc = vbn;
            }
#undef RD_V4
            RET_BAR();
            if (n + 1 < 36) {
#pragma unroll
                for (int dp = 0; dp < 2; ++dp)
#pragma unroll
                    for (int et = 0; et < 8; ++et)
                        *(LAS v4u*)(lds + ST_OFF + (16 * et + c) * ST_LD + (64 * wb + 32 * dp + 8 * g) * 2) = (v4u){pk2(st[dp][0][et][0], st[dp][0][et][1]), pk2(st[dp][0][et][2], st[dp][0][et][3]), pk2(st[dp][1][et][0], st[dp][1][et][1]), pk2(st[dp][1][et][2], st[dp][1][et][3])};
            }
        }
    }
#undef RET_LOADA
#undef RET_STAGEA
#undef RET_LOADB
#undef RET_STAGEB
#undef RET_ROWBASE
}

constexpr int S_OFF = ST_OFF, S_LD = 144;
static_assert(S_OFF + 64 * S_LD <= Q_OFF, "retention score image");
__device__ __forceinline__ void ret_item_regst(LAS unsigned char* lds, const bf16* P, bf16* Odir, int b, int h, int dir, int es, float lg, int noctx) {
    int tid = threadIdx.x; asm volatile("" : "+v"(tid));
    const int w = __builtin_amdgcn_readfirstlane(tid >> 6), lane = tid & 63, g = lane >> 4, c = lane & 15, q4 = c >> 2, p4 = c & 3;
    const float lg2 = lg * 1.4426950408889634f;
    const bf16* Pq = P + h * 256 + (tid & 31) * 8; const bf16* Pk = Pq + 2048; const bf16* Pv = P + 4096 + h * 512 + es * 128 + (tid & 15) * 8;
    const int kr = (tid & 255) >> 5, vr = (tid & 255) >> 4;
    const float cd = __builtin_amdgcn_exp2f(64.0f * lg2);
#define RET_ROWBASE(n) (dir == 0 ? (b * TPB + ((n) < 4 ? SEQ + 64 * (n) : 64 * (n) - CTXL)) : (b * TPB + ((n) < 4 ? SEQ + 255 - 64 * (n) : 2303 - 64 * (n))))
#define RET_LOADA(n) do { const int rb_ = RET_ROWBASE(n), sg_ = dir == 0 ? 1 : -1; \
        _Pragma("unroll") for (int x = 0; x < 8; ++x) { const size_t ro_ = (size_t)(rb_ + sg_ * (kr + 8 * x)) * OIN; kreg[x] = *(const GAS v4u*)(Pk + ro_); qreg[x] = *(const GAS v4u*)(Pq + ro_); } } while (0)
#define RET_STAGEA() do { \
        _Pragma("unroll") for (int x = 0; x < 8; ++x) { *(LAS v4u*)(lds + K_OFF + (kr + 8 * x) * K_LD + (tid & 31) * 16) = kreg[x]; *(LAS v4u*)(lds + Q_OFF + (kr + 8 * x) * Q_LD + (tid & 31) * 16) = qreg[x]; } } while (0)
#define RET_LOADB(n) do { const int rb_ = RET_ROWBASE(n), sg_ = dir == 0 ? 1 : -1; \
        _Pragma("unroll") for (int x = 0; x < 4; ++x) vreg[x] = *(const GAS v4u*)(Pv + (size_t)(rb_ + sg_ * (vr + 16 * x)) * OIN); } while (0)
#define RET_STAGEB() do { \
        _Pragma("unroll") for (int x = 0; x < 4; ++x) { const float kd = __builtin_amdgcn_exp2f((float)(63 - (vr + 16 * x)) * lg2); const v4u r = vreg[x]; \
            *(LAS v4u*)(lds + V_OFF + (vr + 16 * x) * V_LD + (tid & 15) * 16) = (v4u){pk2(bflo(r.x) * kd, bfhi(r.x) * kd), pk2(bflo(r.y) * kd, bfhi(r.y) * kd), pk2(bflo(r.z) * kd, bfhi(r.z) * kd), pk2(bflo(r.w) * kd, bfhi(r.w) * kd)}; } } while (0)
    RET_BAR();
    if (w < 4) {
        const int wa = w;
        v4u kreg[8], qreg[8], vreg[4];
        RET_LOADA(0); RET_LOADB(0);
        for (int n = 0; n < 36; ++n) {
            RET_STAGEA(); RET_STAGEB();
            RET_BAR();
            if (n + 1 < 36) { RET_LOADA(n + 1); RET_LOADB(n + 1); }
            if (!(noctx && n < 4)) {
                int gl = g, cl = c; asm volatile("" : "+v"(gl), "+v"(cl));
#define RD_Q(s)    lds16(lds + Q_OFF + (16 * wa + c) * Q_LD + (32 * (s) + 8 * g) * 2)
#define RD_K(jt, s) lds16(lds + K_OFF + (16 * (jt) + c) * K_LD + (32 * (s) + 8 * g) * 2)
                f32x4 sT[4];
#pragma unroll
                for (int jt = 0; jt < 4; ++jt) sT[jt] = (f32x4){0.f, 0.f, 0.f, 0.f};
                bf16x8 q0 = RD_Q(0), q1, k0[4], k1[4];
#pragma unroll
                for (int jt = 0; jt < 4; ++jt) k0[jt] = RD_K(jt, 0);
#pragma unroll
                for (int s = 0; s < 8; s += 2) {
                    q1 = RD_Q(s + 1);
#pragma unroll
                    for (int jt = 0; jt < 4; ++jt) k1[jt] = RD_K(jt, s + 1);
                    RET_SB();
#pragma unroll
                    for (int jt = 0; jt < 4; ++jt) sT[jt] = __builtin_amdgcn_mfma_f32_16x16x32_bf16(k0[jt], q0, sT[jt], 0, 0, 0);
                    RET_SB();
                    if (s + 2 < 8) { q0 = RD_Q(s + 2);
#pragma unroll
                        for (int jt = 0; jt < 4; ++jt) k0[jt] = RD_K(jt, s + 2); }
                    RET_SB();
#pragma unroll
                    for (int jt = 0; jt < 4; ++jt) sT[jt] = __builtin_amdgcn_mfma_f32_16x16x32_bf16(k1[jt], q1, sT[jt], 0, 0, 0);
                    RET_SB();
                }
#undef RD_Q
#undef RD_K
#pragma unroll
                for (int jt = 0; jt < 4; ++jt) { float v[4];
#pragma unroll
                    for (int r = 0; r < 4; ++r) { const int diff = (16 * wa + cl) - (16 * jt + 4 * gl + r); const bool keep = dir == 0 ? diff >= 0 : diff > 0; v[r] = keep ? sT[jt][r] : 0.f; }
                    *(LAS v2u*)(lds + S_OFF + (16 * wa + c) * S_LD + (16 * jt + 4 * g) * 2) = (v2u){pk2(v[0], v[1]), pk2(v[2], v[3])}; }
            }
            RET_BAR();
        }
    } else {
        const int wb = w - 4;
        bf16* Oo = Odir + h * 512 + es * 128 + 32 * wb + 4 * g;
        f32x4 st[8][2][2];
#pragma unroll
        for (int a = 0; a < 8; ++a)
#pragma unroll
            for (int d = 0; d < 2; ++d)
#pragma unroll
                for (int e = 0; e < 2; ++e) st[a][d][e] = (f32x4){0.f, 0.f, 0.f, 0.f};
        for (int n = 0; n < 36; ++n) {
            const int rowbase = RET_ROWBASE(n);
            const bool doO = !(noctx && n < 4);
            RET_BAR();
            f32x4 OT[2][4];
#pragma unroll
            for (int et = 0; et < 2; ++et)
#pragma unroll
                for (int it = 0; it < 4; ++it) OT[et][it] = (f32x4){0.f, 0.f, 0.f, 0.f};
            if (doO) {
#define RD_QB(it, dq) lds16(lds + Q_OFF + (16 * (it) + c) * Q_LD + (32 * (dq) + 8 * g) * 2)
                bf16x8 qf[4], qn[4];
#pragma unroll
                for (int it = 0; it < 4; ++it) { qf[it] = RD_QB(it, 0); qn[it] = qf[it]; }
#pragma unroll
                for (int dq = 0; dq < 8; ++dq) {
                    if (dq + 1 < 8) {
#pragma unroll
                        for (int it = 0; it < 4; ++it) qn[it] = RD_QB(it, dq + 1); }
                    bf16x8 sa[2];
#pragma unroll
                    for (int et = 0; et < 2; ++et) { const v4u pw = {pk2(st[dq][0][et][0], st[dq][0][et][1]), pk2(st[dq][0][et][2], st[dq][0][et][3]), pk2(st[dq][1][et][0], st[dq][1][et][1]), pk2(st[dq][1][et][2], st[dq][1][et][3])};
                        sa[et] = __builtin_bit_cast(bf16x8, pw); }
                    RET_SB();
#pragma unroll
                    for (int it = 0; it < 4; ++it) { OT[0][it] = __builtin_amdgcn_mfma_f32_16x16x32_bf16(sa[0], qf[it], OT[0][it], 0, 0, 0); OT[1][it] = __builtin_amdgcn_mfma_f32_16x16x32_bf16(sa[1], qf[it], OT[1][it], 0, 0, 0); }
                    RET_SB();
#pragma unroll
                    for (int it = 0; it < 4; ++it) qf[it] = qn[it];
                }
#undef RD_QB
#pragma unroll
                for (int et = 0; et < 2; ++et)
#pragma unroll
                    for (int it = 0; it < 4; ++it) OT[et][it] = OT[et][it] * cd;
            }
            bf16x8 vb[2][2];
#pragma unroll
            for (int s2 = 0; s2 < 2; ++s2)
#pragma unroll
                for (int et = 0; et < 2; ++et) { const LAS unsigned char* vp = lds + V_OFF + (32 * s2 + 4 * g + q4) * V_LD + (32 * wb + 16 * et + 4 * p4) * 2; vb[s2][et] = cat8(ldstr(vp), ldstr(vp + 16 * V_LD)); }
#define RD_KA(s2, dq, dt) cat8(ldstr(lds + K_OFF + (32 * (s2) + 4 * g + q4) * K_LD + (32 * (dq) + 8 * p4 + 4 * (dt)) * 2), ldstr(lds + K_OFF + (32 * (s2) + 4 * g + q4 + 16) * K_LD + (32 * (dq) + 8 * p4 + 4 * (dt)) * 2))
            bf16x8 kc[2][2], kn[2][2];
#pragma unroll
            for (int dt = 0; dt < 2; ++dt)
#pragma unroll
                for (int s2 = 0; s2 < 2; ++s2) { kc[dt][s2] = RD_KA(s2, 0, dt); kn[dt][s2] = kc[dt][s2]; }
            RET_SB();
#pragma unroll
            for (int dq = 0; dq < 8; ++dq) {
                if (dq + 1 < 8) {
#pragma unroll
                    for (int dt = 0; dt < 2; ++dt)
#pragma unroll
                        for (int s2 = 0; s2 < 2; ++s2) kn[dt][s2] = RD_KA(s2, dq + 1, dt); }
#pragma unroll
                for (int dt = 0; dt < 2; ++dt)
#pragma unroll
                    for (int et = 0; et < 2; ++et) st[dq][dt][et] = st[dq][dt][et] * cd;
                RET_SB();
#pragma unroll
                for (int s2 = 0; s2 < 2; ++s2)
#pragma unroll
                    for (int dt = 0; dt < 2; ++dt)
#pragma unroll
                        for (int et = 0; et < 2; ++et) st[dq][dt][et] = __builtin_amdgcn_mfma_f32_16x16x32_bf16(kc[dt][s2], vb[s2][et], st[dq][dt][et], 0, 0, 0);
                RET_SB();
#pragma unroll
                for (int dt = 0; dt < 2; ++dt)
#pragma unroll
                    for (int s2 = 0; s2 < 2; ++s2) kc[dt][s2] = kn[dt][s2];
            }
#undef RD_KA
            RET_BAR();
            if (doO) {
                float lg2v = lg2; int cl = c; asm volatile("" : "+v"(lg2v), "+v"(cl));
#pragma unroll
                for (int it = 0; it < 4; ++it) {
                    bf16x8 sf[2];
#pragma unroll
                    for (int s2 = 0; s2 < 2; ++s2) { const LAS unsigned char* sp = lds + S_OFF + (16 * it + c) * S_LD + (32 * s2 + 4 * g) * 2; const v2u lo = *(const LAS v2u*)sp, hi = *(const LAS v2u*)(sp + 32);
                        const v4u pw = {lo.x, lo.y, hi.x, hi.y}; sf[s2] = __builtin_bit_cast(bf16x8, pw); }
#pragma unroll
                    for (int s2 = 0; s2 < 2; ++s2)
#pragma unroll
                        for (int et = 0; et < 2; ++et) OT[et][it] = __builtin_amdgcn_mfma_f32_16x16x32_bf16(vb[s2][et], sf[s2], OT[et][it], 0, 0, 0);
                }
#pragma unroll
                for (int it = 0; it < 4; ++it) { const int i = 16 * it + c; const float rf = __builtin_amdgcn_exp2f((float)(16 * it + cl - 63) * lg2v);
                    bf16* ob = Oo + (size_t)(dir == 0 ? rowbase + i : rowbase - i) * OMIX;
#pragma unroll
                    for (int et = 0; et < 2; ++et) *(GAS v2u*)(ob + 16 * et) = (v2u){pk2(OT[et][it][0] * rf, OT[et][it][1] * rf), pk2(OT[et][it][2] * rf, OT[et][it][3] * rf)}; }
            }
        }
    }
#undef RET_LOADA
#undef RET_STAGEA
#undef RET_LOADB
#undef RET_STAGEB
#undef RET_ROWBASE
}
}
__device__ __forceinline__ void ph_retention(Frame& F, const Args& A, int j2, int noctx) {
    for (int item = F.vcu; item < 512; item += F.G) {
        const int es = item & 3, dir = (item >> 2) & 1, h = (item >> 3) & 7, b = item >> 6;
        const float lg = (dir ? IN_LDB(F) : IN_LDF(F))[j2 * 8 + h];
#ifndef RET_SPEC
#define RET_SPEC 2
#endif
#if RET_SPEC == 2
        ret::ret_item_regst(F.lds + RING_OFF, WSB(F, WS_P), dir ? WSB(F, WS_OB) : WSB(F, WS_OF), b, h, dir, es, lg, noctx);
#elif RET_SPEC
        ret::ret_item_spec(F.lds + RING_OFF, WSB(F, WS_P), dir ? WSB(F, WS_OB) : WSB(F, WS_OF), b, h, dir, es, lg, noctx);
#else
        ret::ret_item(F.lds + RING_OFF, WSB(F, WS_P), dir ? WSB(F, WS_OB) : WSB(F, WS_OF), b, h, dir, es, lg);
#endif
    }
}
__global__ void __launch_bounds__(NWAVES * 64, 2) dit_fwd(Args args) {
    extern __shared__ __attribute__((aligned(16))) unsigned char lds[];
    Frame F0;
    F0.lds = (LAS unsigned char*)lds;
    F0.MISC = (volatile LAS unsigned*)(F0.lds + MISC_OFF);
    F0.wave = __builtin_amdgcn_readfirstlane((int)threadIdx.x >> 6);
    F0.G = gridDim.x; { const int bx = blockIdx.x; F0.vcu = (F0.G % 8 == 0) ? (bx % 8) * (F0.G / 8) + bx / 8 : bx; }
    F0.ws = (GAS unsigned char*)args.ws; F0.out = (GAS float*)args.out;
    F0.ctl = (gu32*)(F0.ws + WS_CTL);
    for (int u = threadIdx.x; u < (LDS_BYTES - LDSCTL_OFF) / 4; u += NWAVES * 64) ((LAS unsigned*)(F0.lds + LDSCTL_OFF))[u] = 0u;
    __syncthreads();
    XcdBarrier bar; bar.bar = (unsigned*)(F0.ctl + CW_BAR); bar.x = 0; bar.st = nullptr;
    if (MK_N_LAUNCHES == 1) bar = xcd_barrier_post((unsigned*)(F0.ctl + CW_BAR), F0.MISC + 8);
    const int lo = args.ph_lo, hi = args.ph_hi;
#ifndef LATE_F_FIN
#define LATE_F_FIN 0
#endif
#ifndef LATE_F_EVEN
#define LATE_F_EVEN 15
#endif
#ifndef LATE_F_ODD
#define LATE_F_ODD 30
#endif
#ifndef RESID_G
#define RESID_G 0
#endif
#ifndef GEMM_SP2
#define GEMM_SP2 true
#endif
#ifndef GEMM_ALIGN
#define GEMM_ALIGN true
#endif
#ifndef PROBE_BAR2
#define PROBE_BAR2 0
#endif
#ifndef SPLITK
#define SPLITK 0
#endif
#ifndef SITE_MASK
#define SITE_MASK 0xffffffffu
#endif
#define SITE(n) (((SITE_MASK) >> (n)) & 1u)
#define IN(k) (lo <= (k) && (k) < hi)
#define SEAM(k) do { if ((k) + 1 < hi) { if (MK_N_LAUNCHES == 1) { XcdBarrier bv_ = bar; asm volatile("" : "+s"(bv_.bar)); xcd_barrier(bv_); if (PROBE_BAR2) { XcdBarrier bw_ = bar; asm volatile("" : "+s"(bw_.bar)); xcd_barrier(bw_); } } } } while (0)
#define LAUNDER(Fv) Frame Fv = F0; asm volatile("" : "+s"(Fv.ws), "+s"(Fv.out), "+s"(Fv.G), "+s"(Fv.vcu), "+s"(Fv.wave), "+s"(cid))
#define GEMM_CALL1(EPI, g_, S_, E_) pg8::gemm_phase<EPI, pg8::TokOrder, GEMM_ALIGN, GEMM_SP2>(F.lds + RING_OFF, g_, S_, E_)
#ifdef PROBE_GEMM_STORE2
#define GEMM_CALL(EPI, g_, S_, E_) do { for (int rep_ = 0; rep_ < 2; ++rep_) { GEMM_CALL1(EPI, g_, S_, E_); __syncthreads(); } } while (0)
#else
#define GEMM_CALL(EPI, g_, S_, E_) GEMM_CALL1(EPI, g_, S_, E_)
#endif
#ifdef PROBE_GEMM_RESID2
#define GEMM_CALLR(g_, S_, E_) do { pg8::EpiResid E2_ = E_; for (int rep_ = 0; rep_ < 2; ++rep_) { E2_.dry = rep_; GEMM_CALL1(pg8::EpiResid, g_, S_, E2_); __syncthreads(); } } while (0)
#else
#define GEMM_CALLR(g_, S_, E_) GEMM_CALL1(pg8::EpiResid, g_, S_, E_)
#endif
    int cid = (int)blockIdx.x;

    if (SITE(0) && IN(0)) { LAUNDER(F); ph_prologue(F, args);
#ifdef PROBE_PRO2
        __syncthreads(); { LAUNDER(F2); ph_prologue(F2, args); }
#endif
        SEAM(0); }
    for (int L = 0; L < 4; ++L) {
        const int pb = 1 + 9 * L, j2 = L >> 1, even = !(L & 1), last = (L == 3);
        if (SITE(1) && IN(pb + 0)) { LAUNDER(F); ph_modulate(F, args, L, 0, 0, SPLITK && L >= 1, L == 0);
#ifdef PROBE_MOD2
            { LAUNDER(F2); ph_modulate(F2, args, L, 0, 0, 0, L == 0); }
#endif
            SEAM(pb + 0); }
        if (SITE(2) && IN(pb + 1)) { LAUNDER(F);
            const int N = even ? EIN : OIN;
            pg8::Gemm g{WSB(F, WS_XN), even ? WSB(F, WS_W_INE) + (size_t)j2 * EIN * DM : WSB(F, WS_W_INO) + (size_t)j2 * OIN * DM, MROWS, N, DM};
            pg8::TokOrder S; if (last) S.init2(MLAT, N, DM, F.G, cid, 1, 0, 1); else S.init2(MROWS, N, DM, F.G, cid, 0, 0);
            pg8::EpiStore E{WSB(F, WS_P), N, even ? 0 : 3, WSF(F, WS_ROPE_O)};
            GEMM_CALL(pg8::EpiStore, g, S, E);
            SEAM(pb + 1);
        }
        if (even) {
            if (SITE(3) && IN(pb + 2)) { LAUNDER(F); ph_qk_even(F, args, j2); SEAM(pb + 2); }
            if (IN(pb + 3)) {
                if (SITE(4)) { LAUNDER(F); pg8::Gemm g{WSB(F, WS_WTL), WSB(F, WS_FT), 4096, 4096, 2048}; pg8::TokOrder S; S.init2(4096, 4096, 2048, F.G, cid, 0, 0); pg8::EpiStore E{WSB(F, WS_Z), 1024, 1, nullptr}; GEMM_CALL(pg8::EpiStore, g, S, E); }
                if (SITE(14)) { LAUNDER(F); pg8::Gemm g{WSB(F, WS_WTC), WSB(F, WS_FTC), 512, 4096, 256}; pg8::TokOrder S; S.init2(512, 4096, 256, F.G, cid, 0, 0); pg8::EpiStore E{WSB(F, WS_Z), 1024, 2, nullptr}; GEMM_CALL(pg8::EpiStore, g, S, E); }
                if (SITE(5)) { LAUNDER(F); ph_attention(F, args, j2); }
#ifdef PROBE_ATT2
                { LAUNDER(F); ph_attention(F, args, j2); }
#endif
                SEAM(pb + 3);
            }
            if (SITE(6) && IN(pb + 4)) { LAUNDER(F);
                pg8::Gemm g{WSB(F, WS_Z), WSB(F, WS_CB), MROWS, 512, 1024}; pg8::TokOrder S; S.init2(MROWS, 512, 1024, F.G, cid, 0, 0); pg8::EpiStore E{WSB(F, WS_MIX), DM, 0, nullptr};
                GEMM_CALL(pg8::EpiStore, g, S, E);
                SEAM(pb + 4);
            }
        } else {
            if (SITE(8) && IN(pb + 3)) { LAUNDER(F); ph_retention(F, args, j2, last);
#ifdef PROBE_RET2
                { LAUNDER(F2); ph_retention(F2, args, j2, last); }
#endif
                SEAM(pb + 3); }
            if (SITE(9) && IN(pb + 4)) { LAUNDER(F); ph_comb(F, last);
#ifdef PROBE_COMB2
                { LAUNDER(F2); ph_comb(F2, last, 1); }
#endif
                SEAM(pb + 4); }
        }
        if (SITE(10) && IN(pb + 5)) { LAUNDER(F); const float* gates = WSF(F, WS_MOD) + (size_t)L * NSET * MODW;
            const int K = even ? DM : OMIX, Ml = last ? MLAT : MROWS;
            pg8::Gemm g{even ? WSB(F, WS_MIX) : WSB(F, WS_OF), even ? WSB(F, WS_W_OUTE) + (size_t)j2 * DM * DM : WSB(F, WS_W_OUTO) + (size_t)j2 * DM * OMIX, Ml, DM, K};
            pg8::TokOrder S; S.init2(Ml, DM, K, F.G, cid, last, SPLITK && L > 0, 0, last ? 0 : RESID_G);
            pg8::EpiResid E{WSF(F, WS_H), gates, 2 * DM, nullptr, WSF(F, WS_DELTA), 0, L == 0 ? (const float*)(const GAS float*)args.in[0] : nullptr, (const float*)(const GAS float*)args.in[2]};
            GEMM_CALLR(g, S, E);
#if LATE_CONV
            if (!last && cid >= S.rem && S.rem > 0) { const int cnt = conv_layer_count(L + 1), c0 = (cnt * LATE_F_FIN) / 100, c1 = c0 + (cnt * (even ? LATE_F_EVEN : LATE_F_ODD)) / 100;
                conv_in_tail(F, args, L + 1, c0, c1, cid - S.rem, F.G - S.rem); }
#endif
            SEAM(pb + 5);
        }
        if (SITE(11) && IN(pb + 6)) { LAUNDER(F); ph_modulate(F, args, L, 1, last, SPLITK && !last && L > 0, 0);
#ifdef PROBE_MOD2
            { LAUNDER(F2); ph_modulate(F2, args, L, 1, last, 0, 0); }
#endif
            SEAM(pb + 6); }
        if (SITE(12) && IN(pb + 7)) { LAUNDER(F);
            const int Ml = last ? MLAT : MROWS;
            pg8::Gemm g{WSB(F, WS_XN), WSB(F, WS_W_FIN) + (size_t)L * FFN2 * DM, Ml, FFN2, DM};
            pg8::TokOrder S; S.init2(Ml, FFN2, DM, F.G, cid, last, 0);
            pg8::EpiSwiglu E{WSB(F, WS_P), FFN};
            GEMM_CALL(pg8::EpiSwiglu, g, S, E);
#if LATE_CONV
            if (!last && LATE_F_FIN > 0 && cid >= S.rem && S.rem > 0) { const int cnt = conv_layer_count(L + 1), c0 = (cnt * LATE_F_FIN) / 100;
                conv_in_tail(F, args, L + 1, 0, c0, cid - S.rem, F.G - S.rem); }
#endif
            SEAM(pb + 7);
        }
        if (SITE(13) && IN(pb + 8)) { LAUNDER(F); const float* gates = WSF(F, WS_MOD) + (size_t)L * NSET * MODW;
            const int Ml = last ? MLAT : MROWS;
            pg8::Gemm g{WSB(F, WS_P), WSB(F, WS_W_FOUT) + (size_t)L * DM * FFN, Ml, DM, FFN};
            pg8::TokOrder S; S.init2(Ml, DM, FFN, F.G, cid, last, SPLITK, 0, last ? 0 : RESID_G);
            pg8::EpiResid E{WSF(F, WS_H), gates, 5 * DM, last ? (float*)F.out : nullptr, WSF(F, WS_DELTA), 0, nullptr, nullptr};
            GEMM_CALLR(g, S, E);
#if LATE_CONV
            if (!last && cid >= S.rem && S.rem > 0) { const int cnt = conv_layer_count(L + 1), c1 = (cnt * LATE_F_FIN) / 100 + (cnt * (even ? LATE_F_EVEN : LATE_F_ODD)) / 100;
                conv_in_tail(F, args, L + 1, c1, cnt, cid - S.rem, F.G - S.rem); }
#endif
            SEAM(pb + 8);
        }
    }
#undef IN
#undef SEAM
#undef LAUNDER
#undef GEMM_CALL
}

extern "C" void kernel_launch(void* const* d_in, const int* in_sizes, int n_in, void* d_out, int out_size, void* d_ws, size_t ws_size, hipStream_t stream) {
    static int grid = 0;
    if (grid == 0) {
        if (n_in != 16 || out_size != MLAT * DM || ws_size < WS_END) { fprintf(stderr, "kernel_launch: unexpected shapes: n_in %d out %d ws %zu (need %zu)\n", n_in, out_size, ws_size, (size_t)WS_END); grid = -1; return; }
        int dev = 0, cus = 0, per_cu = 0;
        if (hipGetDevice(&dev) != hipSuccess || hipDeviceGetAttribute(&cus, hipDeviceAttributeMultiprocessorCount, dev) != hipSuccess) { fprintf(stderr, "kernel_launch: device query failed\n"); grid = -1; return; }
        if (hipFuncSetAttribute((const void*)dit_fwd, hipFuncAttributeMaxDynamicSharedMemorySize, LDS_BYTES) != hipSuccess) { fprintf(stderr, "kernel_launch: hipFuncSetAttribute failed\n"); grid = -1; return; }
        if (hipOccupancyMaxActiveBlocksPerMultiprocessor(&per_cu, (const void*)dit_fwd, NWAVES * 64, LDS_BYTES) != hipSuccess || per_cu < 1)
            fprintf(stderr, "kernel_launch: note: occupancy query reports %d workgroups per CU\n", per_cu);
        (void)hipGetLastError();
        grid = cus;
    }
    if (grid < 0) return;
    if (hipMemsetAsync((char*)d_ws + WS_CTL, 0, CTL_ZERO_BYTES, stream) != hipSuccess) { fprintf(stderr, "kernel_launch: memset failed\n"); return; }
    Args a{};
    for (int i = 0; i < 16; ++i) a.in[i] = (const float*)d_in[i];
    a.out = (float*)d_out; a.ws = (unsigned char*)d_ws;
#if MK_N_LAUNCHES == 1
    a.ph_lo = 0; a.ph_hi = N_PHASES;
    hipLaunchKernelGGL(dit_fwd, dim3(grid), dim3(NWAVES * 64), LDS_BYTES, stream, a);
#else
    for (int p = 0; p < N_PHASES; ++p) { a.ph_lo = p; a.ph_hi = p + 1; hipLaunchKernelGGL(dit_fwd, dim3(grid), dim3(NWAVES * 64), LDS_BYTES, stream, a); }
#endif
    const hipError_t le = hipPeekAtLastError();
    if (le != hipSuccess) fprintf(stderr, "kernel_launch: launch failed: %s\n", hipGetErrorName(le));
}
```

```cpp
#include <hip/hip_runtime.h>
#include <cstdio>
#include <cstdint>
#include <cmath>
#ifndef WGM_SET
#define WGM_SET 8
#endif
namespace pg8 {
#define PG8_LAS __attribute__((address_space(3)))
typedef unsigned short bf16_t;
typedef short bf16x8 __attribute__((ext_vector_type(8)));
typedef float f32x4 __attribute__((ext_vector_type(4)));
typedef unsigned u32x4 __attribute__((ext_vector_type(4)));
constexpr int BM = 256, BK = 64, HALF = 128, HTB = HALF * BK * 2  , STAGE_BYTES = 8 * HTB, NXCD = 8, WGM = WGM_SET;

__host__ __device__ __forceinline__ int lds_byte(int r, int c) { const int st = (r >> 4) * 2 + (c >> 5), rr = r & 15, cc = c & 31, ob = rr * 64 + cc * 2; return st * 1024 + (ob ^ (((ob >> 9) & 1) << 5)); }
__host__ __device__ __forceinline__ void stage_rc(int b, int& R, int& C) { const int st = b / 1024, sb = b % 1024, swz = sb ^ (((sb >> 9) & 1) << 5); R = (st >> 1) * 16 + swz / 64; C = (st & 1) * 32 + (swz % 64) / 2; }
__host__ __device__ __forceinline__ int perm32(int rho) { const int n = rho >> 4, i = rho & 15; return 8 * (i >> 2) + 4 * n + (i & 3); }

struct Unit { int pm, pn, kt0, nkt, split; };
struct Gemm { const bf16_t* A; const bf16_t* Bt; int M, N, K; };

#ifndef WGM_WIDE
#define WGM_WIDE WGM
#endif
#ifndef WGM_NARROW
#define WGM_NARROW 2
#endif
struct StaticOrder {
    int nM, nN, nwg, G, c;
    __host__ __device__ void init(int M, int N, int G_, int c_) { nM = M / BM; nN = N / BM; nwg = nM * nN; G = G_; c = c_; }
    __host__ __device__ void map(int wgid, Unit& u) const {
        { const int q = nwg / NXCD, r = nwg % NXCD, xcd = wgid % NXCD, off = wgid / NXCD; wgid = (xcd < r ? xcd * (q + 1) : r * (q + 1) + (xcd - r) * q) + off; }
        const int wgm = nN >= 12 ? WGM_WIDE : WGM_NARROW;
        const int nig = wgm * nN, gid = wgid / nig, fm = gid * wgm, gsz = (nM - fm) < wgm ? (nM - fm) : wgm;
        u.pm = fm + ((wgid % nig) % gsz); u.pn = (wgid % nig) / gsz;
    }
    __device__ __forceinline__ void a_ready(const Unit&) const {}
    __device__ __forceinline__ void done(const Unit&) const {}
};

typedef __bf16 bf16x2_cv __attribute__((ext_vector_type(2)));
typedef float f32x2_cv __attribute__((ext_vector_type(2)));
__device__ __forceinline__ unsigned cvt_pk_bf16(float lo, float hi) { const f32x2_cv v = {lo, hi}; const bf16x2_cv b = __builtin_convertvector(v, bf16x2_cv); return __builtin_bit_cast(unsigned, b); }
typedef float f32x2 __attribute__((ext_vector_type(2)));
#ifndef WT_STORES
#define WT_STORES 0
#endif
__device__ __forceinline__ void st16_wt(void* p, u32x4 v) {
#if WT_STORES
    asm volatile("global_store_dwordx4 %0, %1, off sc1" :: "v"(p), "v"(v) : "memory");
#else
    *(u32x4*)p = v;
#endif
}
__device__ __forceinline__ void st16_wt(void* p, f32x4 v) { st16_wt(p, __builtin_bit_cast(u32x4, v)); }
#ifndef WT_HID
#define WT_HID 0
#endif
__device__ __forceinline__ void st16_hid(void* p, u32x4 v) {
#if WT_HID
    asm volatile("global_store_dwordx4 %0, %1, off sc1" :: "v"(p), "v"(v) : "memory");
#else
    *(u32x4*)p = v;
#endif
}
#ifndef GEMM_G_LIMIT
#define GEMM_G_LIMIT 0
#endif
struct TokOrder : StaticOrder {
    int skip, nktfull, nfull, rem, S, nextra;
    __device__ __forceinline__ void init2(int M, int N, int K, int G_, int c_, int skip_, int allow_split, int ctxkv = 0, int glimit = 0) {
        init(M, N, G_, c_); if (glimit > 0 && glimit < G_) G = glimit;     if (GEMM_G_LIMIT > 0 && GEMM_G_LIMIT < G_) { G = GEMM_G_LIMIT; }     skip = skip_; nktfull = K / BK; nfull = (nwg / G) * G; rem = nwg - nfull; S = 1; nextra = ctxkv ? 8 * 24 : 0;
        if (allow_split && rem > 0) { const int s = G / rem; S = s >= 4 ? 4 : 1;     if ((nktfull % (2 * S)) != 0 || nktfull / S < 4) S = 1; }
    }
    __device__ __forceinline__ bool next(int i, Unit& u) const {
        if (c >= G) return false;
        const long L = (long)i * G + c; int idx;
        if (L < nfull || S == 1) {
            if (L >= nwg) { const int r = (int)(L - nwg); if (r >= nextra) return false; u.kt0 = 0; u.nkt = nktfull; u.split = 0; u.pm = 9 * (r / 24) + 8; u.pn = 8 + r % 24; return true; }
            idx = (int)L; u.kt0 = 0; u.nkt = nktfull; u.split = 0; }
        else { const int sub = (int)(L - nfull); if (sub >= rem * S) return false; idx = nfull + sub / S; u.nkt = nktfull / S; u.kt0 = (sub % S) * u.nkt; u.split = 1 + (sub / S) * 4 + (sub % S); }
        map(idx, u); if (skip) u.pm += (u.pm >> 3); return true;
    }
};
struct EpiStore {
    static constexpr bool PERM = true, AFTER_DRAIN = false;
    bf16_t* O; int ldc; int mode; const float* rope;
    __device__ __forceinline__ void operator()(const f32x4 (&acc)[2][2][4][2], const Unit& u, int wr, int wc, int fr, int fq) const {
        size_t base, bjs = HALF; int ld = ldc;
        if (mode == 3) {
            constexpr size_t RP = (size_t)18432 * 256;
            if (u.pn < 32) { ld = u.pn < 16 ? 256 : 128; base = (size_t)u.pn * RP + (size_t)u.pm * BM * (size_t)ld; if (u.pn >= 16) bjs = RP / 2; }
            else { ld = 4096; base = 32 * RP + (size_t)u.pm * BM * (size_t)4096 + (size_t)(u.pn - 32) * BM; }
        }
        else if (mode == 0) base = (size_t)u.pm * BM * (size_t)ldc + (size_t)u.pn * BM;
        else if (mode == 1) { const int part = u.pm >> 3, t0 = (u.pm & 7) * 256, b = u.pn >> 1, c0 = (u.pn & 1) * 256; base = ((size_t)(b * 2304 + t0)) * 1024 + part * 512 + c0; }
        else { const int part = u.pm, b = u.pn >> 1, c0 = (u.pn & 1) * 256; base = ((size_t)(b * 2304 + 2048)) * 1024 + part * 512 + c0; }
        const int tt = u.pm % 9;
        if (mode == 3 && u.pn < 16 && tt != 8) {
            const int half = wc >> 1, f0 = 32 * (wc & 1) + 8 * fq;
            bf16_t* p0 = O + base + (size_t)(wr * 64 + fr) * ld + half * 128 + f0;
#pragma unroll
            for (int ai = 0; ai < 2; ++ai)
#pragma unroll
                for (int m = 0; m < 4; ++m) { const int t = tt * 256 + ai * HALF + wr * 64 + m * 16 + fr, pos = half ? (t & 63) : (t >> 6);
                    const f32x4* tb = (const f32x4*)(rope + (size_t)(pos * 64 + f0) * 2);
                    const f32x4 t0 = tb[0], t1 = tb[1], t2 = tb[2], t3 = tb[3];
                    const f32x4 a0 = acc[ai][0][m][0], a1 = acc[ai][0][m][1], b0 = acc[ai][1][m][0], b1 = acc[ai][1][m][1];
                    const f32x4 cs0 = {t0[0], t0[2], t1[0], t1[2]}, sn0 = {t0[1], t0[3], t1[1], t1[3]}, cs1 = {t2[0], t2[2], t3[0], t3[2]}, sn1 = {t2[1], t2[3], t3[1], t3[3]};
                    const f32x4 x0 = a0 * cs0 - b0 * sn0, x1 = a1 * cs1 - b1 * sn1, y0 = b0 * cs0 + a0 * sn0, y1 = b1 * cs1 + a1 * sn1;
                    bf16_t* rowp = p0 + (size_t)(ai * HALF + m * 16) * ld;
                    u32x4 w; w.x = cvt_pk_bf16(x0[0], x0[1]); w.y = cvt_pk_bf16(x0[2], x0[3]); w.z = cvt_pk_bf16(x1[0], x1[1]); w.w = cvt_pk_bf16(x1[2], x1[3]);
                    st16_wt(rowp, w);
                    w.x = cvt_pk_bf16(y0[0], y0[1]); w.y = cvt_pk_bf16(y0[2], y0[3]); w.z = cvt_pk_bf16(y1[0], y1[1]); w.w = cvt_pk_bf16(y1[2], y1[3]);
                    st16_wt(rowp + 64, w); }
            return;
        }
        if (mode == 3 && u.pn < 16) {
            const int half = wc >> 1, f0 = 32 * (wc & 1) + 8 * fq;
            bf16_t* p0 = O + base + (size_t)(wr * 64 + fr) * ld + half * 128 + f0;
#pragma unroll
            for (int ai = 0; ai < 2; ++ai)
#pragma unroll
                for (int m = 0; m < 4; ++m) { bf16_t* rowp = p0 + (size_t)(ai * HALF + m * 16) * ld;
#pragma unroll
                    for (int bj = 0; bj < 2; ++bj) { const f32x4 v0 = acc[ai][bj][m][0], v1 = acc[ai][bj][m][1];
                        u32x4 w; w.x = cvt_pk_bf16(v0[0], v0[1]); w.y = cvt_pk_bf16(v0[2], v0[3]); w.z = cvt_pk_bf16(v1[0], v1[1]); w.w = cvt_pk_bf16(v1[2], v1[3]);
                        st16_wt(rowp + bj * 64, w); } }
            return;
        }
        bf16_t* p0 = O + base + (size_t)(wr * 64 + fr) * ld + wc * 32 + 8 * fq;
#pragma unroll
        for (int ai = 0; ai < 2; ++ai)
#pragma unroll
            for (int m = 0; m < 4; ++m) { bf16_t* rowp = p0 + (size_t)(ai * HALF + m * 16) * ld;
#pragma unroll
                for (int bj = 0; bj < 2; ++bj) { const f32x4 v0 = acc[ai][bj][m][0], v1 = acc[ai][bj][m][1];
                    u32x4 w; w.x = cvt_pk_bf16(v0[0], v0[1]); w.y = cvt_pk_bf16(v0[2], v0[3]); w.z = cvt_pk_bf16(v1[0], v1[1]); w.w = cvt_pk_bf16(v1[2], v1[3]);
                    st16_wt(rowp + bj * bjs, w); } }
    }
};
__device__ __forceinline__ float silu_f(float g) { return g * __builtin_amdgcn_rcpf(1.0f + __builtin_amdgcn_exp2f(-1.4426950408889634f * g)); }
struct EpiSwiglu {
    static constexpr bool PERM = true, AFTER_DRAIN = false;
    bf16_t* H; int ldh;
    __device__ __forceinline__ void operator()(const f32x4 (&acc)[2][2][4][2], const Unit& u, int wr, int wc, int fr, int fq) const {
        bf16_t* p0 = H + (size_t)(u.pm * BM + wr * 64 + fr) * ldh + u.pn * HALF + wc * 32 + 8 * fq;
#pragma unroll
        for (int ai = 0; ai < 2; ++ai)
#pragma unroll
            for (int m = 0; m < 4; ++m) { bf16_t* rowp = p0 + (size_t)(ai * HALF + m * 16) * ldh;
                const f32x4 g0 = acc[ai][0][m][0], g1 = acc[ai][0][m][1], u0 = acc[ai][1][m][0], u1 = acc[ai][1][m][1];
                u32x4 w; w.x = cvt_pk_bf16(silu_f(g0[0]) * u0[0], silu_f(g0[1]) * u0[1]); w.y = cvt_pk_bf16(silu_f(g0[2]) * u0[2], silu_f(g0[3]) * u0[3]);
                w.z = cvt_pk_bf16(silu_f(g1[0]) * u1[0], silu_f(g1[1]) * u1[1]); w.w = cvt_pk_bf16(silu_f(g1[2]) * u1[2], silu_f(g1[3]) * u1[3]);
                st16_hid(rowp, w); }
    }
};
#ifndef EPI_RB
#define EPI_RB 2
#endif
struct EpiResid {
    static constexpr bool PERM = true, AFTER_DRAIN = false;
    float* h; const float* gates; int goff; float* out; float* delta; int dry; const float* x0; const float* c0;
    __device__ __forceinline__ void operator()(const f32x4 (&acc)[2][2][4][2], const Unit& u, int wr, int wc, int fr, int fq) const {
        const int b = u.pm / 9, tt = u.pm - 9 * b, set = (tt == 8) ? 8 : b;
        const int col0 = u.pn * BM + wc * 32 + 8 * fq;
        const float* gp = gates + (size_t)set * 12288 + goff + col0;
        f32x4 gv[2][2];
#pragma unroll
        for (int bj = 0; bj < 2; ++bj)
#pragma unroll
            for (int n = 0; n < 2; ++n) { gv[bj][n] = *(const f32x4*)(gp + bj * HALF + n * 4); if (dry) gv[bj][n] = gv[bj][n] * 0.0f; }
        const int rl = wr * 64 + fr;
        const float* hp = (x0 && !dry) ? (tt == 8 ? c0 + (size_t)(b * 256 + rl) * 2048 + col0 : x0 + (size_t)(b * 2048 + tt * 256 + rl) * 2048 + col0) : h + (size_t)(u.pm * BM + rl) * 2048 + col0;
        float* op = (out && !dry) ? out + (size_t)(b * 2048 + tt * 256 + rl) * 2048 + col0 : h + (size_t)(u.pm * BM + rl) * 2048 + col0;
        if (u.split && dry) return;
        if (u.split) {
            float* sp = delta + (size_t)(u.split - 1) * 65536 + (size_t)rl * 256 + wc * 32 + 8 * fq;
#pragma unroll
            for (int ai = 0; ai < 2; ++ai)
#pragma unroll
                for (int m = 0; m < 4; ++m)
#pragma unroll
                    for (int bj = 0; bj < 2; ++bj)
#pragma unroll
                        for (int n = 0; n < 2; ++n) *(f32x4*)(sp + (ai * HALF + m * 16) * 256 + bj * HALF + n * 4) = gv[bj][n] * acc[ai][bj][m][n];
            return;
        }
#pragma unroll
        for (int ai = 0; ai < 2; ++ai)
#pragma unroll
            for (int mp = 0; mp < 4; mp += EPI_RB) {
                f32x4 hv[EPI_RB][2][2];
#pragma unroll
                for (int mm = 0; mm < EPI_RB; ++mm)
#pragma unroll
                    for (int bj = 0; bj < 2; ++bj)
#pragma unroll
                        for (int n = 0; n < 2; ++n) hv[mm][bj][n] = *(const f32x4*)(hp + (size_t)(ai * HALF + (mp + mm) * 16) * 2048 + bj * HALF + n * 4);
                asm volatile("" ::: "memory");
#pragma unroll
                for (int mm = 0; mm < EPI_RB; ++mm) { const int m = mp + mm; const size_t ro = (size_t)(ai * HALF + m * 16) * 2048;
#pragma unroll
                    for (int bj = 0; bj < 2; ++bj)
#pragma unroll
                        for (int n = 0; n < 2; ++n) st16_wt(op + ro + bj * HALF + n * 4, hv[mm][bj][n] + gv[bj][n] * acc[ai][bj][m][n]); }
                asm volatile("" ::: "memory"); }
    }
};

template <class Epi, class Sched, bool ALIGN_EPI = false, bool SP2 = false>
__device__ __forceinline__ void gemm_phase(PG8_LAS unsigned char* lds, const Gemm g, const Sched& S, const Epi& E) {
    int tid = threadIdx.x; asm volatile("" : "+v"(tid));
    const int wid = __builtin_amdgcn_readfirstlane(tid >> 6), lane = tid & 63, wr = wid >> 2, wc = wid & 3, fr = lane & 15, fq = lane >> 4;
    const int K = g.K;
    unsigned voffA[2], voffB[2];
#pragma unroll
    for (int i = 0; i < 2; ++i) { int R, C; stage_rc(tid * 16 + i * 8192, R, C); const int Rb = Epi::PERM ? ((R & ~31) + perm32(R & 31)) : R;
        voffA[i] = (unsigned)(R * K + C) * 2u; voffB[i] = (unsigned)(Rb * K + C) * 2u; }
    const size_t kstep = (size_t)(BK * 2);
    const size_t hstep = (size_t)HALF * K * 2;
    const size_t tstep = 2 * hstep;
    const unsigned ldsw = (unsigned)wid * 1024u;
    const int aoff = lds_byte(wr * 64 + fr, fq * 8), boff = lds_byte(wc * 32 + fr, fq * 8);
#define PG8_SA(b, h) (((b) * 2 + (h)) * HTB)
#define PG8_SB(b, h) ((4 + (b) * 2 + (h)) * HTB)
#define PG8_STAGE(bufoff, gbase, voff) do { _Pragma("unroll") for (int _i = 0; _i < 2; ++_i) \
        __builtin_amdgcn_global_load_lds((const unsigned*)((const char*)(gbase) + (voff)[_i]), (PG8_LAS unsigned*)(lds + (bufoff) + ldsw + _i * 8192), 16, 0, 0); } while (0)
#define PG8_LDA(dst, b, h) do { _Pragma("unroll") for (int m = 0; m < 4; ++m) _Pragma("unroll") for (int k = 0; k < 2; ++k) dst[m][k] = *(const PG8_LAS bf16x8*)(lds + PG8_SA(b, h) + aoff + m * 2048 + k * 1024); } while (0)
#define PG8_LDB(dst, b, h) do { _Pragma("unroll") for (int n = 0; n < 2; ++n) _Pragma("unroll") for (int k = 0; k < 2; ++k) dst[n][k] = *(const PG8_LAS bf16x8*)(lds + PG8_SB(b, h) + boff + n * 2048 + k * 1024); } while (0)
#define PG8_MMA(ai, bj, At, Bt) do { __builtin_amdgcn_s_setprio(1); _Pragma("unroll") for (int m = 0; m < 4; ++m) _Pragma("unroll") for (int n = 0; n < 2; ++n) _Pragma("unroll") for (int k = 0; k < 2; ++k) \
        acc[ai][bj][m][n] = __builtin_amdgcn_mfma_f32_16x16x32_bf16(Bt[n][k], At[m][k], acc[ai][bj][m][n], 0, 0, 0); __builtin_amdgcn_s_setprio(0); } while (0)
#define PG8_WAIT_V(n) asm volatile("s_waitcnt vmcnt(" #n ")" ::: "memory")
#define PG8_WAIT_L(n) asm volatile("s_waitcnt lgkmcnt(" #n ")" ::: "memory")
#define PG8_BAR __builtin_amdgcn_s_barrier()
#define PG8_SCHED __builtin_amdgcn_sched_barrier(0)
    Unit cur, nxt; int ui = 0;
    if (!S.next(0, cur)) return;
    f32x4 acc[2][2][4][2];
#pragma unroll
    for (int a = 0; a < 2; ++a)
#pragma unroll
        for (int b = 0; b < 2; ++b)
#pragma unroll
            for (int m = 0; m < 4; ++m)
#pragma unroll
                for (int n = 0; n < 2; ++n) acc[a][b][m][n] = (f32x4){0.f, 0.f, 0.f, 0.f};
    bf16x8 At[4][2], B0[2][2], B1[2][2];
    const char* cA = (const char*)g.A + (size_t)cur.pm * tstep + (size_t)cur.kt0 * kstep; const char* cB = (const char*)g.Bt + (size_t)cur.pn * tstep + (size_t)cur.kt0 * kstep;
    S.a_ready(cur);
    if constexpr (SP2) {
        PG8_STAGE(PG8_SB(0, 0), cB, voffB); PG8_STAGE(PG8_SB(0, 1), cB + hstep, voffB); PG8_STAGE(PG8_SA(0, 0), cA, voffA); PG8_STAGE(PG8_SA(0, 1), cA + hstep, voffA);
        if (wr == 1) PG8_BAR;
        PG8_WAIT_V(2); PG8_BAR;
        PG8_STAGE(PG8_SB(1, 0), cB + kstep, voffB); PG8_STAGE(PG8_SA(1, 0), cA + kstep, voffA); PG8_STAGE(PG8_SB(1, 1), cB + hstep + kstep, voffB);
        PG8_WAIT_V(6); PG8_BAR;
    } else {
        PG8_STAGE(PG8_SB(0, 0), cB, voffB); PG8_STAGE(PG8_SA(0, 0), cA, voffA); PG8_STAGE(PG8_SB(0, 1), cB + hstep, voffB); PG8_STAGE(PG8_SA(0, 1), cA + hstep, voffA);
        if (wr == 1) PG8_BAR;
        PG8_WAIT_V(4); PG8_BAR;
        PG8_STAGE(PG8_SB(1, 0), cB + kstep, voffB); PG8_STAGE(PG8_SA(1, 0), cA + kstep, voffA); PG8_STAGE(PG8_SB(1, 1), cB + hstep + kstep, voffB);
        PG8_WAIT_V(6); PG8_BAR;
    }
    for (;;) {
        const bool has_next = S.next(ui + 1, nxt);
        const char* nA = has_next ? (const char*)g.A + (size_t)nxt.pm * tstep + (size_t)nxt.kt0 * kstep : cA; const char* nB = has_next ? (const char*)g.Bt + (size_t)nxt.pn * tstep + (size_t)nxt.kt0 * kstep : cB;
        const int nt = cur.nkt;
        for (int t = 0; t < nt; t += 2) {
            const bool last = (t == nt - 2);
            const char* a1 = cA + (size_t)(t + 1) * kstep;
            const char* a2 = last ? nA : cA + (size_t)(t + 2) * kstep; const char* b2 = last ? nB : cB + (size_t)(t + 2) * kstep;
            const char* a3 = a2 + kstep; const char* b3 = b2 + kstep;
            if (last && has_next) S.a_ready(nxt);
            if constexpr (SP2) {
            PG8_LDB(B0, 0, 0); PG8_LDB(B1, 0, 1); PG8_SCHED; PG8_LDA(At, 0, 0); PG8_STAGE(PG8_SA(1, 1), a1 + hstep, voffA);
            PG8_WAIT_V(8); PG8_WAIT_L(0); PG8_BAR; PG8_MMA(0, 0, At, B0); PG8_MMA(0, 1, At, B1); PG8_BAR; PG8_SCHED;
            PG8_LDA(At, 0, 1); PG8_STAGE(PG8_SB(0, 0), b2, voffB); PG8_STAGE(PG8_SB(0, 1), b2 + hstep, voffB); PG8_STAGE(PG8_SA(0, 0), a2, voffA);
            PG8_WAIT_V(8); PG8_WAIT_L(0); PG8_BAR; PG8_MMA(1, 0, At, B0); PG8_MMA(1, 1, At, B1); PG8_BAR; PG8_SCHED;
            PG8_LDB(B0, 1, 0); PG8_LDB(B1, 1, 1); PG8_SCHED; PG8_LDA(At, 1, 0); PG8_STAGE(PG8_SA(0, 1), a2 + hstep, voffA);
            PG8_WAIT_V(8); PG8_WAIT_L(0); PG8_BAR; PG8_MMA(0, 0, At, B0); PG8_MMA(0, 1, At, B1); PG8_BAR; PG8_SCHED;
            PG8_LDA(At, 1, 1); PG8_STAGE(PG8_SB(1, 0), b3, voffB); PG8_STAGE(PG8_SB(1, 1), b3 + hstep, voffB); PG8_STAGE(PG8_SA(1, 0), a3, voffA);
            PG8_WAIT_V(8); PG8_WAIT_L(0); PG8_BAR; PG8_MMA(1, 0, At, B0); PG8_MMA(1, 1, At, B1); PG8_BAR; PG8_SCHED;
            } else {
            PG8_LDB(B0, 0, 0); PG8_SCHED; PG8_LDA(At, 0, 0); PG8_STAGE(PG8_SA(1, 1), a1 + hstep, voffA);
            PG8_WAIT_L(8); PG8_BAR; PG8_WAIT_L(0); PG8_MMA(0, 0, At, B0); PG8_BAR; PG8_SCHED;
            PG8_LDB(B1, 0, 1); PG8_STAGE(PG8_SB(0, 0), b2, voffB);
            PG8_BAR; PG8_WAIT_L(0); PG8_MMA(0, 1, At, B1); PG8_BAR;
            PG8_LDA(At, 0, 1); PG8_STAGE(PG8_SA(0, 0), a2, voffA);
            PG8_BAR; PG8_WAIT_L(0); PG8_MMA(1, 0, At, B0); PG8_BAR; PG8_SCHED;
            PG8_STAGE(PG8_SB(0, 1), b2 + hstep, voffB);
            PG8_WAIT_V(6); PG8_BAR; PG8_MMA(1, 1, At, B1); PG8_BAR;
            PG8_LDB(B0, 1, 0); PG8_SCHED; PG8_LDA(At, 1, 0); PG8_STAGE(PG8_SA(0, 1), a2 + hstep, voffA);
            PG8_WAIT_L(8); PG8_BAR; PG8_WAIT_L(0); PG8_MMA(0, 0, At, B0); PG8_BAR; PG8_SCHED;
            PG8_LDB(B1, 1, 1); PG8_STAGE(PG8_SB(1, 0), b3, voffB);
            PG8_BAR; PG8_WAIT_L(0); PG8_MMA(0, 1, At, B1); PG8_BAR;
            PG8_LDA(At, 1, 1); PG8_STAGE(PG8_SA(1, 0), a3, voffA);
            PG8_BAR; PG8_WAIT_L(0); PG8_MMA(1, 0, At, B0); PG8_BAR; PG8_SCHED;
            PG8_STAGE(PG8_SB(1, 1), b3 + hstep, voffB);
            PG8_WAIT_V(6); PG8_BAR; PG8_MMA(1, 1, At, B1); PG8_BAR;
            }
        }
        if constexpr (ALIGN_EPI) { if (wr == 0) PG8_BAR; }
        if constexpr (!Epi::AFTER_DRAIN) { E(acc, cur, wr, wc, fr, fq); S.done(cur); }
        if (!has_next) break;
#pragma unroll
        for (int a = 0; a < 2; ++a)
#pragma unroll
            for (int b = 0; b < 2; ++b)
#pragma unroll
                for (int m = 0; m < 4; ++m)
#pragma unroll
                    for (int n = 0; n < 2; ++n) acc[a][b][m][n] = (f32x4){0.f, 0.f, 0.f, 0.f};
        cur = nxt; cA = nA; cB = nB; ++ui;
        if constexpr (ALIGN_EPI) { if (wr == 1) PG8_BAR; }
    }
    PG8_WAIT_V(0);
    if constexpr (!ALIGN_EPI) { if (wr == 0) PG8_BAR; }
    PG8_BAR;
    if constexpr (Epi::AFTER_DRAIN) { E.fused(acc, cur, wr, wc, fr, fq, lds, wid, lane); S.done(cur); }
#undef PG8_SA
#undef PG8_SB
#undef PG8_STAGE
#undef PG8_LDA
#undef PG8_LDB
#undef PG8_MMA
#undef PG8_WAIT_V
#undef PG8_WAIT_L
#undef PG8_BAR
#undef PG8_SCHED
}
}
namespace att {
typedef unsigned short bf16;
constexpr int   D = 128, NW = 8, QBLK = 32, KVBLK = 64;
constexpr float SCALE = 0.088388347648318440f;
constexpr float THR = 8.f;
constexpr int LDQ = 3072, LDK = 3072, LDO = 2048;
constexpr size_t SHM_V = KVBLK * D * 2, SHM_K = KVBLK * D * 2, SHM_ATTN = 2 * SHM_V + 2 * SHM_K + NW * 64 * 4;
using bf16x8 = __attribute__((ext_vector_type(8))) short;
using s16x4  = __attribute__((ext_vector_type(4))) short;
using f32x16 = __attribute__((ext_vector_type(16))) float;
using u32x4  = __attribute__((ext_vector_type(4))) unsigned;
#define KSWZ(row, colB) ((row) * 256 + ((colB) ^ (((row) & 7) << 4)))
#define SBAR() __builtin_amdgcn_sched_barrier(0)
__device__ __forceinline__ int crow(int r, int hi) { return (r & 3) + 8 * (r >> 2) + 4 * hi; }
__device__ __forceinline__ unsigned cvtpk(float lo, float hi) {
  typedef __bf16 b2 __attribute__((ext_vector_type(2))); typedef float f2 __attribute__((ext_vector_type(2)));
  const f2 v = {lo, hi}; const b2 b = __builtin_convertvector(v, b2); return __builtin_bit_cast(unsigned, b);
}
__device__ __forceinline__ bf16x8 ld8(const bf16* p) { return *reinterpret_cast<const bf16x8*>(p); }
__device__ __forceinline__ void partialSM(f32x16& p0, f32x16& p1, float& m_reg, float& mn, float& alpha) {
  constexpr float C = SCALE * 1.4426950408889634f;
  float pmax = p0[0]; for (int r = 1; r < 16; ++r) pmax = fmaxf(pmax, p0[r]); for (int r = 0; r < 16; ++r) pmax = fmaxf(pmax, p1[r]);
  { auto rr = __builtin_amdgcn_permlane32_swap(__float_as_uint(pmax), __float_as_uint(pmax), false, false);
    pmax = fmaxf(__uint_as_float(rr[0]), __uint_as_float(rr[1])); }
  if (__builtin_expect(__all(pmax - m_reg <= THR / SCALE), 1)) { mn = m_reg; alpha = 1.f; }
  else { mn = fmaxf(m_reg, pmax); alpha = __builtin_amdgcn_exp2f((m_reg - mn) * C); m_reg = mn; }
  float mnC = -mn * C;
  for (int r = 0; r < 16; ++r) p0[r] = fmaf(p0[r], C, mnC); for (int r = 0; r < 16; ++r) p1[r] = fmaf(p1[r], C, mnC);
  for (int r = 0; r < 16; ++r) p0[r] = __builtin_amdgcn_exp2f(p0[r]);
}
__device__ __forceinline__ void finishSM(f32x16& p0, f32x16& p1, float alpha, float& l_reg, bf16x8& pa0, bf16x8& pa1, bf16x8& pa2, bf16x8& pa3) {
  for (int r = 0; r < 16; ++r) p1[r] = __builtin_amdgcn_exp2f(p1[r]);
  float ps = 0; for (int r = 0; r < 16; ++r) ps += p0[r]; for (int r = 0; r < 16; ++r) ps += p1[r];
  { auto rr = __builtin_amdgcn_permlane32_swap(__float_as_uint(ps), __float_as_uint(ps), false, false);
    ps = __uint_as_float(rr[0]) + __uint_as_float(rr[1]); }
  l_reg = l_reg * alpha + ps;
#define PK4(P, BASE, OUT) do { unsigned a0 = cvtpk(P[BASE + 0], P[BASE + 1]), a1 = cvtpk(P[BASE + 2], P[BASE + 3]);   \
    unsigned b0 = cvtpk(P[BASE + 4], P[BASE + 5]), b1 = cvtpk(P[BASE + 6], P[BASE + 7]);                              \
    auto r0 = __builtin_amdgcn_permlane32_swap(a0, b0, false, false); auto r1 = __builtin_amdgcn_permlane32_swap(a1, b1, false, false); \
    u32x4 w = {r0[0], r1[0], r0[1], r1[1]}; OUT = *reinterpret_cast<bf16x8*>(&w); } while (0)
  PK4(p0, 0, pa0); PK4(p0, 8, pa1); PK4(p1, 0, pa2); PK4(p1, 8, pa3);
#undef PK4
}
__device__ __forceinline__ void qkt(f32x16& p0, f32x16& p1, const bf16* Ks, const bf16x8* qr, int r32, int hi) {
  p0 = f32x16{}; p1 = f32x16{};
  for (int d0 = 0; d0 < 8; ++d0) { int cb = (d0 * 16 + hi * 8) * 2;
    bf16x8 b0 = *reinterpret_cast<const bf16x8*>((const char*)Ks + KSWZ(r32, cb));
    bf16x8 b1 = *reinterpret_cast<const bf16x8*>((const char*)Ks + KSWZ(32 + r32, cb));
    p0 = __builtin_amdgcn_mfma_f32_32x32x16_bf16(b0, qr[d0], p0, 0, 0, 0);
    p1 = __builtin_amdgcn_mfma_f32_32x32x16_bf16(b1, qr[d0], p1, 0, 0, 0); }
}
__device__ __forceinline__ int v_st(int k, int c) { const int kk = (k & ~0xC) | ((k & 4) << 1) | ((k & 8) >> 1); return ((kk >> 3) * 4 + (c >> 5)) * 512 + ((kk & 7) * 32 + (c & 31)) * 2; }
__device__ __forceinline__ int v_rd_base(int lane) { return ((lane & 3) << 3) | (((lane >> 2) & 3) << 6) | (((lane >> 4) & 1) << 5) | (((lane >> 5) & 1) << 8); }
constexpr int v_rd_off(int d0, int ks, int half) { return d0 * 512 + ks * 4096 + half * 2048; }
template <int OFF> __device__ __forceinline__ s16x4 tr_read(int vb) {
  s16x4 r; asm volatile("ds_read_b64_tr_b16 %0, %1 offset:%2" : "=&v"(r) : "v"(vb), "i"(OFF) : "memory"); return r;
}
template <int D0> __device__ __forceinline__ void pv_one(f32x16& od, int vb, bf16x8 pa0, bf16x8 pa1, bf16x8 pa2, bf16x8 pa3) {
  const s16x4 l0 = tr_read<v_rd_off(D0, 0, 0)>(vb), h0 = tr_read<v_rd_off(D0, 0, 1)>(vb), l1 = tr_read<v_rd_off(D0, 1, 0)>(vb), h1 = tr_read<v_rd_off(D0, 1, 1)>(vb);
  const s16x4 l2 = tr_read<v_rd_off(D0, 2, 0)>(vb), h2 = tr_read<v_rd_off(D0, 2, 1)>(vb), l3 = tr_read<v_rd_off(D0, 3, 0)>(vb), h3 = tr_read<v_rd_off(D0, 3, 1)>(vb);
  asm volatile("s_waitcnt lgkmcnt(0)" ::: "memory"); SBAR();
#define PK(L, H) (bf16x8){L[0], L[1], L[2], L[3], H[0], H[1], H[2], H[3]}
  od = __builtin_amdgcn_mfma_f32_32x32x16_bf16(pa0, PK(l0, h0), od, 0, 0, 0);
  od = __builtin_amdgcn_mfma_f32_32x32x16_bf16(pa1, PK(l1, h1), od, 0, 0, 0);
  od = __builtin_amdgcn_mfma_f32_32x32x16_bf16(pa2, PK(l2, h2), od, 0, 0, 0);
  od = __builtin_amdgcn_mfma_f32_32x32x16_bf16(pa3, PK(l3, h3), od, 0, 0, 0);
#undef PK
}
__device__ __forceinline__ void pv_d0(f32x16* o, int vb, bf16x8 pa0, bf16x8 pa1, bf16x8 pa2, bf16x8 pa3) {
  pv_one<0>(o[0], vb, pa0, pa1, pa2, pa3); pv_one<1>(o[1], vb, pa0, pa1, pa2, pa3); pv_one<2>(o[2], vb, pa0, pa1, pa2, pa3); pv_one<3>(o[3], vb, pa0, pa1, pa2, pa3);
}
__device__ __forceinline__ void attn_dense_body(const bf16* __restrict__ Qb, const bf16* __restrict__ Kh, const bf16* __restrict__ Vh,
                                                bf16* __restrict__ Ob, int seq, char* lds, const float* __restrict__ qgain = nullptr, const float* __restrict__ rope = nullptr, int t0 = 0) {
  int tid = threadIdx.x; asm volatile("" : "+v"(tid));
  const int wid = tid >> 6, lane = tid & 63, r32 = lane & 31, hi = lane >> 5;
  bf16* V_lds = (bf16*)lds; bf16* K_lds = (bf16*)(lds + 2 * SHM_V);
  float* ws = (float*)(lds + 2 * SHM_V + 2 * SHM_K) + wid * 64; float* li_l = ws; float* al_l = ws + 32;
  float m_reg = -1e30f, l_reg = 0; f32x16 o[4] = {}; bf16x8 qr[8];
  const bf16* Qw = Qb + (long)(wid * QBLK + r32) * LDQ + hi * 8;
#pragma unroll
  for (int d0 = 0; d0 < 8; ++d0) qr[d0] = ld8(Qw + d0 * 16);
  if (qgain) {
    float ssq = 0.f;
#pragma unroll
    for (int d0 = 0; d0 < 8; ++d0)
#pragma unroll
      for (int x = 0; x < 8; ++x) { const float v = __uint_as_float((unsigned)(unsigned short)qr[d0][x] << 16); ssq += v * v; }
    { auto rr = __builtin_amdgcn_permlane32_swap(__float_as_uint(ssq), __float_as_uint(ssq), false, false); ssq = __uint_as_float(rr[0]) + __uint_as_float(rr[1]); }
    const float rstd = 1.0f / sqrtf(ssq * (1.0f / 128.0f) + 1e-6f);
    const int t = t0 + wid * QBLK + r32;
#pragma unroll
    for (int hp = 0; hp < 2; ++hp) {
      const int pos = hp ? (t & 63) : (t >> 6);
#pragma unroll
      for (int dd = 0; dd < 2; ++dd) { const int d0 = 4 * hp + dd;
        const float* g1 = qgain + 16 * d0 + 8 * hi; const float* g2 = g1 + 32;
        const float* tb = rope ? rope + (size_t)(pos * 32 + 16 * dd + 8 * hi) * 2 : nullptr;
        float y1[8], y2[8];
#pragma unroll
        for (int x = 0; x < 8; ++x) { const float a1 = __uint_as_float((unsigned)(unsigned short)qr[d0][x] << 16) * rstd * g1[x], a2 = __uint_as_float((unsigned)(unsigned short)qr[d0 + 2][x] << 16) * rstd * g2[x];
          if (rope) { const float cs = tb[2 * x], sn = tb[2 * x + 1]; y1[x] = a1 * cs - a2 * sn; y2[x] = a2 * cs + a1 * sn; } else { y1[x] = a1; y2[x] = a2; } }
        { u32x4 w = {cvtpk(y1[0], y1[1]), cvtpk(y1[2], y1[3]), cvtpk(y1[4], y1[5]), cvtpk(y1[6], y1[7])}; qr[d0] = *reinterpret_cast<bf16x8*>(&w); }
        { u32x4 w = {cvtpk(y2[0], y2[1]), cvtpk(y2[2], y2[3]), cvtpk(y2[4], y2[5]), cvtpk(y2[6], y2[7])}; qr[d0 + 2] = *reinterpret_cast<bf16x8*>(&w); } }
    }
  }
  const int sr = tid >> 4, sc = (tid & 15) * 8, vst0 = v_st(sr, sc), vst1 = v_st(32 + sr, sc);
  const int vb0 = (int)(uintptr_t)V_lds + v_rd_base(lane);
  struct { bf16x8 vs0, vs1, ks0, ks1; } sr_[2];
#define SLOAD(i, k0) do { sr_[i].vs0 = ld8(&Vh[(long)((k0) + sr) * LDK + sc]); sr_[i].vs1 = ld8(&Vh[(long)((k0) + 32 + sr) * LDK + sc]); \
    sr_[i].ks0 = ld8(&Kh[(long)((k0) + sr) * LDK + sc]); sr_[i].ks1 = ld8(&Kh[(long)((k0) + 32 + sr) * LDK + sc]); } while (0)
#define SWRITE(b, i) do { *(bf16x8*)((char*)V_lds + (b) * SHM_V + vst0) = sr_[i].vs0;          \
    *(bf16x8*)((char*)V_lds + (b) * SHM_V + vst1) = sr_[i].vs1; int kc = sc * 2;               \
    *(bf16x8*)((char*)K_lds + (b) * SHM_K + KSWZ(sr, kc)) = sr_[i].ks0;                       \
    *(bf16x8*)((char*)K_lds + (b) * SHM_K + KSWZ(32 + sr, kc)) = sr_[i].ks1; } while (0)
#define SWAIT() asm volatile("s_waitcnt vmcnt(4)" ::: "memory")
#define RESC(a) do { if (__any((a) < 1.f)) { if (hi == 0) al_l[r32] = (a); asm volatile("s_waitcnt lgkmcnt(0)" ::: "memory"); \
    for (int d = 0; d < 4; ++d) for (int r = 0; r < 16; ++r) o[d][r] *= al_l[crow(r, hi)]; } } while (0)
  f32x16 pA0, pA1, pB0, pB1; float mnA, mnB, alA, alB; bf16x8 pa0, pa1, pa2, pa3; const int NT = seq / KVBLK;
  constexpr int SE = 0, SO = 1;
  SLOAD(SE, 0); asm volatile("s_waitcnt vmcnt(0)" ::: "memory"); SWRITE(0, SE); __syncthreads();
  qkt(pA0, pA1, K_lds, qr, r32, hi); partialSM(pA0, pA1, m_reg, mnA, alA);
  SLOAD(SO, KVBLK); if (2 < NT) SLOAD(SE, 2 * KVBLK);
  SWAIT(); SWRITE(1, SO); __syncthreads();
  for (int j = 1; j + 1 < NT; j += 2) {
    SBAR(); qkt(pB0, pB1, (bf16*)((char*)K_lds + SHM_K), qr, r32, hi);
    finishSM(pA0, pA1, alA, l_reg, pa0, pa1, pa2, pa3); SBAR();
    SLOAD(SO, (j + 2) * KVBLK); SBAR();
    pv_d0(o, vb0, pa0, pa1, pa2, pa3); partialSM(pB0, pB1, m_reg, mnB, alB);
    __syncthreads(); SWAIT(); SWRITE(0, SE);
    RESC(alB); __syncthreads();
    SBAR(); qkt(pA0, pA1, K_lds, qr, r32, hi);
    finishSM(pB0, pB1, alB, l_reg, pa0, pa1, pa2, pa3); SBAR();
    if (j + 3 < NT) SLOAD(SE, (j + 3) * KVBLK); SBAR();
    pv_d0(o, vb0 + (int)SHM_V, pa0, pa1, pa2, pa3); partialSM(pA0, pA1, m_reg, mnA, alA);
    __syncthreads(); SWAIT(); SWRITE(1, SO);
    RESC(alA); __syncthreads();
  }
  SBAR(); qkt(pB0, pB1, (bf16*)((char*)K_lds + SHM_K), qr, r32, hi);
  finishSM(pA0, pA1, alA, l_reg, pa0, pa1, pa2, pa3); SBAR();
  pv_d0(o, vb0, pa0, pa1, pa2, pa3); partialSM(pB0, pB1, m_reg, mnB, alB);
  __syncthreads(); RESC(alB);
  finishSM(pB0, pB1, alB, l_reg, pa0, pa1, pa2, pa3); SBAR();
  pv_d0(o, vb0 + (int)SHM_V, pa0, pa1, pa2, pa3);
  if (hi == 0) li_l[r32] = l_reg; asm volatile("s_waitcnt lgkmcnt(0)" ::: "memory");
  float rli[16];
#pragma unroll
  for (int r = 0; r < 16; ++r) rli[r] = __builtin_amdgcn_rcpf(li_l[crow(r, hi)]);
  bf16* Ow = Ob + (long)(wid * QBLK) * LDO;
#pragma unroll
  for (int r = 0; r < 16; ++r) { int orow = crow(r, hi);
#pragma unroll
    for (int d0 = 0; d0 < 4; ++d0) Ow[(long)orow * LDO + d0 * 32 + r32] = (bf16)(cvtpk(o[d0][r] * rli[r], 0.f) & 0xffffu); }
  __syncthreads();
#undef SLOAD
#undef SWRITE
#undef SWAIT
#undef RESC
}
#undef KSWZ
#undef SBAR
}

constexpr int NWAVES = 8;
#ifndef MK_N_LAUNCHES
#define MK_N_LAUNCHES 1
#endif
constexpr int DM = 2048, NBATCH = 8, SEQ = 2048, CTXL = 256, TPB = SEQ + CTXL, MROWS = NBATCH * TPB;
constexpr int MLAT = NBATCH * SEQ;
constexpr int MODW = 6 * DM, NSET = 9;
constexpr int EIN = 3072, OIN = 12288, OMIX = 4096, FFN = 5632, FFN2 = 2 * FFN;
constexpr size_t RP_PLANE = (size_t)MROWS * 256, RP_V = 16 * RP_PLANE, RP_G = 32 * RP_PLANE;
constexpr float EPS = 1e-6f;
constexpr int N_PHASES = 1 + 9 * 4;
constexpr size_t MiB = 1u << 20;
constexpr size_t WS_CTL = 0, CTL_ZERO_BYTES = 1 * MiB;
constexpr size_t WS_MOD = 1 * MiB;
constexpr size_t WS_ROPE_E = 3 * MiB, WS_ROPE_O = 3 * MiB + 65536;
constexpr size_t WS_WTC = 3 * MiB + 262144;
constexpr size_t WS_CB = 4 * MiB;
constexpr size_t WS_WTL = 5 * MiB;
constexpr size_t WS_W_INE = 21 * MiB, WS_W_OUTE = 45 * MiB, WS_W_INO = 61 * MiB, WS_W_OUTO = 157 * MiB, WS_W_FIN = 189 * MiB, WS_W_FOUT = 365 * MiB;
constexpr size_t WS_H = 453 * MiB;
constexpr size_t WS_XN = 597 * MiB;
constexpr size_t WS_P = 669 * MiB;
constexpr size_t WS_R = 1101 * MiB;
constexpr size_t WS_OF = WS_R, WS_OB = WS_R + 144 * MiB;
constexpr size_t WS_FT = WS_R, WS_FTC = WS_R + 16 * MiB, WS_Z = WS_R + 18 * MiB, WS_MIX = WS_R + 54 * MiB;
constexpr size_t WS_DELTA = 1389 * MiB;
constexpr size_t WS_SPLITTAB = 2 * MiB + 917504;
constexpr size_t WS_END = 1453 * MiB;
static_assert(WS_MIX + (size_t)MROWS * DM * 2 <= WS_END && WS_OB + (size_t)MROWS * OMIX * 2 <= WS_END && WS_P + (size_t)MROWS * OIN * 2 <= WS_R, "d_ws map");
constexpr int CW_TMO = 0, CW_CODE = 1, CW_BAR = 4096;
constexpr int RING_OFF = 0, RING_BYTES = 131072;
constexpr int LDSCTL_OFF = 158720, MISC_OFF = LDSCTL_OFF + 320;
constexpr int LDS_BYTES = 159744;
static_assert(MISC_OFF + 128 <= LDS_BYTES, "LDS map");

#define GAS __attribute__((address_space(1)))
#define LAS __attribute__((address_space(3)))
typedef unsigned short bf16;
typedef unsigned v4u __attribute__((ext_vector_type(4)));
typedef unsigned v2u __attribute__((ext_vector_type(2)));
typedef float f32x4 __attribute__((ext_vector_type(4)));
typedef short bf16x8 __attribute__((ext_vector_type(8)));
typedef short s16x4 __attribute__((ext_vector_type(4)));
typedef GAS unsigned gu32;
#define RLX_AGENT __ATOMIC_RELAXED, __HIP_MEMORY_SCOPE_AGENT
#define LDS_WAIT() asm volatile("s_waitcnt lgkmcnt(0)" ::: "memory")
#define VM_WAIT() asm volatile("s_waitcnt vmcnt(0)" ::: "memory")
typedef __bf16 bf16x2_t __attribute__((ext_vector_type(2)));
typedef float f32x2_t __attribute__((ext_vector_type(2)));
__device__ __forceinline__ unsigned pk2(float lo, float hi) { const f32x2_t v = {lo, hi}; const bf16x2_t b = __builtin_convertvector(v, bf16x2_t); return __builtin_bit_cast(unsigned, b); }
__device__ __forceinline__ float bflo(unsigned w) { return __uint_as_float(w << 16); }
__device__ __forceinline__ float bfhi(unsigned w) { return __uint_as_float(w & 0xffff0000u); }
__device__ __forceinline__ float silu(float g) { return g / (1.0f + __expf(-g)); }

#define XB_TMO      128
#define XB_XCNT(j)  (256  + 64 * (j))
#define XB_XSUB(j)  (1280 + 64 * (j))
#define XB_XGEN(j)  (2304 + 64 * (j))
#define XB_TOP      3328
#define XB_TOPGEN   3392
#define XCD_BAR_WORDS 3456
#define XB_SPIN_CAP (1u << 18)

__device__ __forceinline__ unsigned xb_ld(unsigned* p)              { return __hip_atomic_load(p, __ATOMIC_RELAXED, __HIP_MEMORY_SCOPE_AGENT); }
__device__ __forceinline__ unsigned xb_add(unsigned* p, unsigned v) { return __hip_atomic_fetch_add(p, v, __ATOMIC_RELAXED, __HIP_MEMORY_SCOPE_AGENT); }
__device__ __forceinline__ unsigned xb_xcc_id() { return (unsigned)__builtin_amdgcn_s_getreg((3 << 11) | 20) & 0xFu; }
#define XB_SPIN(cond, bar) do { unsigned _sp = 0; while (cond) { __builtin_amdgcn_s_sleep(1); \
    if ((++_sp & 255u) == 0u) { if (xb_ld(&(bar)[XB_TMO])) break; if (_sp > XB_SPIN_CAP) { atomicAdd(&(bar)[XB_TMO], 1u); break; } } } } while (0)

struct XcdBarrier {
    unsigned* bar; unsigned x;
    volatile LAS unsigned* st;
};

__device__ __forceinline__ XcdBarrier xcd_barrier_post(unsigned* bar, volatile LAS unsigned* st) {
    XcdBarrier b; b.bar = bar; b.x = xb_xcc_id(); b.st = st;
    if (threadIdx.x == 0) (void)xb_add(&bar[XB_XCNT(b.x)], 1u);
    return b;
}
__device__ __forceinline__ void xcd_barrier_complete(unsigned* bar, unsigned x, unsigned& nloc, unsigned& nx) {
    const unsigned G = gridDim.x * gridDim.y * gridDim.z;
    unsigned sum, cnt, mine, sp = 0u;
    for (;;) {
        sum = 0u; cnt = 0u; mine = 0u;
#pragma unroll
        for (unsigned j = 0; j < 16; ++j) { const unsigned c = xb_ld(&bar[XB_XCNT(j)]); sum += c; cnt += (c > 0u) ? 1u : 0u; mine = (j == x) ? c : mine; }
        if (sum == G) break;
        __builtin_amdgcn_s_sleep(1);
        if ((++sp & 255u) == 0u) { if (xb_ld(&bar[XB_TMO])) break; if (sp > XB_SPIN_CAP) { atomicAdd(&bar[XB_TMO], 1u); break; } }
    }
    nloc = mine > 0u ? mine : 1u; nx = cnt > 0u ? cnt : 1u;
}

__device__ __forceinline__ void xcd_barrier(const XcdBarrier& b) {
    asm volatile("s_waitcnt vmcnt(0)" ::: "memory");
    __syncthreads();
    if (threadIdx.x == 0) {
        unsigned* bar = b.bar;
        __builtin_amdgcn_s_waitcnt(0);
        unsigned nloc = b.st[0], nx = b.st[1];
        if (nloc == 0u) { xcd_barrier_complete(bar, b.x, nloc, nx); b.st[0] = nloc; b.st[1] = nx; }
        const unsigned old = xb_add(&bar[XB_XSUB(b.x)], 1u);
        const unsigned gen = old / nloc;
        if (old + 1u == (gen + 1u) * nloc) {
            __builtin_amdgcn_fence(__ATOMIC_RELEASE, "agent");
            asm volatile("s_waitcnt vmcnt(0)" ::: "memory");
            const unsigned og = xb_add(&bar[XB_TOP], 1u);
            const unsigned tg = og / nx;
            if (og + 1u == (tg + 1u) * nx) xb_add(&bar[XB_TOPGEN], 1u);
            else XB_SPIN(xb_ld(&bar[XB_TOPGEN]) == tg, bar);
            __builtin_amdgcn_fence(__ATOMIC_ACQUIRE, "agent");
            xb_add(&bar[XB_XGEN(b.x)], 1u);
            asm volatile("s_waitcnt vmcnt(0)" ::: "memory");
        } else {
            XB_SPIN(xb_ld(&bar[XB_XGEN(b.x)]) == gen, bar);
            __builtin_amdgcn_fence(__ATOMIC_ACQUIRE, "agent");
            asm volatile("s_waitcnt vmcnt(0)" ::: "memory");
        }
    }
    __syncthreads();
}

struct Args { const float* in[16]; float* out; unsigned char* ws; int ph_lo, ph_hi; };
static_assert(sizeof(Args) == 18 * 8 + 8, "Args has no padding");

struct Frame {
    LAS unsigned char* lds;
    volatile LAS unsigned* MISC;
    gu32* ctl;
    GAS unsigned char* ws;
    GAS float* out;
    int wave, vcu, G;
};
__device__ __forceinline__ int tid_opaque() { int t = threadIdx.x; asm volatile("" : "+v"(t)); return t; }
#define IN_X(F) ((const float*)(const GAS float*)A.in[0])
#define IN_C(F) ((const float*)(const GAS float*)A.in[1])
#define IN_CTX(F) ((const float*)(const GAS float*)A.in[2])
#define IN_CCTX(F) ((const float*)(const GAS float*)A.in[3])
#define IN_WMOD(F) ((const float*)(const GAS float*)A.in[4])
#define IN_BMOD(F) ((const float*)(const GAS float*)A.in[5])
#define IN_WINE(F) ((const float*)(const GAS float*)A.in[6])
#define IN_WOUTE(F) ((const float*)(const GAS float*)A.in[7])
#define IN_QG(F) ((const float*)(const GAS float*)A.in[8])
#define IN_KG(F) ((const float*)(const GAS float*)A.in[9])
#define IN_WINO(F) ((const float*)(const GAS float*)A.in[10])
#define IN_WOUTO(F) ((const float*)(const GAS float*)A.in[11])
#define IN_LDF(F) ((const float*)(const GAS float*)A.in[12])
#define IN_LDB(F) ((const float*)(const GAS float*)A.in[13])
#define IN_WFIN(F) ((const float*)(const GAS float*)A.in[14])
#define IN_WFOUT(F) ((const float*)(const GAS float*)A.in[15])
#define WSF(F, off) ((float*)((F).ws + (off)))
#define WSB(F, off) ((bf16*)((F).ws + (off)))
__device__ __forceinline__ float shx(float v, int k, int lane) { return __int_as_float(__builtin_amdgcn_ds_bpermute((lane ^ k) << 2, __float_as_int(v))); }
__device__ __forceinline__ float wave_sum(float v, int lane) {
#pragma unroll
    for (int o = 1; o < 64; o <<= 1) v += shx(v, o, lane);
    return v;
}
__device__ __forceinline__ void p0_transpose_item(const float* W, int K, int N, bf16* WT, int k0, int n0, int drow0, float scale, LAS float* scr, int lane) {
    const int kr = lane >> 4, c4 = (lane & 15) * 4;
    f32x4 v[16];
#pragma unroll
    for (int i = 0; i < 16; ++i) v[i] = *(const GAS f32x4*)(W + (size_t)(k0 + 4 * i + kr) * N + n0 + c4);
#pragma unroll
    for (int i = 0; i < 16; ++i) { LAS float* d = scr + (4 * i + kr) * 65 + c4; d[0] = v[i][0]; d[1] = v[i][1]; d[2] = v[i][2]; d[3] = v[i][3]; }
    LDS_WAIT(); asm volatile("" ::: "memory");
    const int c = lane & 7;
#pragma unroll
    for (int j = 0; j < 8; ++j) { const int n = (lane >> 3) + 8 * j; const LAS float* s = scr + (8 * c) * 65 + n;
        v4u o; o.x = pk2(s[0 * 65] * scale, s[1 * 65] * scale); o.y = pk2(s[2 * 65] * scale, s[3 * 65] * scale); o.z = pk2(s[4 * 65] * scale, s[5 * 65] * scale); o.w = pk2(s[6 * 65] * scale, s[7 * 65] * scale);
        *(GAS v4u*)(WT + (size_t)(drow0 + n) * K + k0 + 8 * c) = o; }
    LDS_WAIT(); asm volatile("" ::: "memory");
}
__device__ __forceinline__ void p0_conv(const float* W, bf16* WT, int K, int N, int kind, int r, LAS float* scr, int lane) {
    const int nbn = N / 64, per = (K / 64) * nbn, inst = r / per, rr = r - inst * per, kb = rr / nbn, nb = rr - kb * nbn, n0 = nb * 64;
    int drow0 = n0; float scale = 1.0f;
    if (kind == 2) { if (n0 >= 2048 && n0 < 4096) scale = 0.0625f;
        if (n0 < 4096) { const int d = n0 & 255, half = d >> 7, bj = (d >> 6) & 1; drow0 = (n0 & ~255) + 128 * bj + 64 * half; } }
    if (kind == 4) { const int bj = n0 >= FFN ? 1 : 0, hc = n0 - bj * FFN; drow0 = 256 * (hc >> 7) + 128 * bj + (hc & 127); }
    p0_transpose_item(W + (size_t)inst * K * N, K, N, WT + (size_t)inst * K * N, kb * 64, n0, drow0, scale, scr, lane);
}
__device__ __forceinline__ int conv_layer_count(int L) { return (L & 1) ? (32 * 192 + 64 * 32 + 32 * 176 + 88 * 32) : (32 * 48 + 32 * 32 + 32 * 176 + 88 * 32); }
__device__ __forceinline__ void conv_layer_item(Frame& F, const Args& A, int L, int r, LAS float* scr, int lane) {
    const int j2 = L >> 1;
    if (L & 1) {
        constexpr int P0 = 32 * 192, P1 = 64 * 32;
        if (r < P0) { p0_conv(IN_WINO(F), WSB(F, WS_W_INO), DM, OIN, 2, r + j2 * P0, scr, lane); return; } r -= P0;
        if (r < P1) { p0_conv(IN_WOUTO(F), WSB(F, WS_W_OUTO), OMIX, DM, 3, r + j2 * P1, scr, lane); return; } r -= P1;
    } else {
        constexpr int P0 = 32 * 48, P1 = 32 * 32;
        if (r < P0) { p0_conv(IN_WINE(F), WSB(F, WS_W_INE), DM, EIN, 0, r + j2 * P0, scr, lane); return; } r -= P0;
        if (r < P1) { p0_conv(IN_WOUTE(F), WSB(F, WS_W_OUTE), DM, DM, 1, r + j2 * P1, scr, lane); return; } r -= P1;
    }
    constexpr int P4 = 32 * 176, P5 = 88 * 32;
    if (r < P4) { p0_conv(IN_WFIN(F), WSB(F, WS_W_FIN), DM, FFN2, 4, r + L * P4, scr, lane); return; } r -= P4;
    p0_conv(IN_WFOUT(F), WSB(F, WS_W_FOUT), FFN, DM, 5, r + L * P5, scr, lane);
}
__device__ __forceinline__ void conv_in_tail(Frame& F, const Args& A, int L, int lo, int hi, int widx, int nw) {
    const int lane = tid_opaque() & 63;
    LAS float* scr = (LAS float*)(F.lds + RING_OFF + F.wave * 16640);
    for (int r = lo + widx * NWAVES + F.wave; r < hi; r += nw * NWAVES) conv_layer_item(F, A, L, r, scr, lane);
}
#ifndef LATE_CONV
#define LATE_CONV 1
#endif
#ifndef BUILD_SPLITTAB
#define BUILD_SPLITTAB 0
#endif
#ifndef PRO_GW
#define PRO_GW 3
#endif
__device__ __forceinline__ void ph_prologue(Frame& F, const Args& A) {
    const int tid = tid_opaque(), lane = tid & 63;
    constexpr int COND_BYTES = NSET * DM * 4;
    LAS float* cond = (LAS float*)(F.lds + RING_OFF);
    for (int i = tid; i < NSET * DM; i += NWAVES * 64) { const int s = i >> 11, k = i & 2047; const float v = (s < 8) ? IN_C(F)[s * DM + k] : IN_CCTX(F)[k]; cond[i] = v / (1.0f + expf(-v)); }
    LDS_WAIT(); __syncthreads();
    if (F.wave < PRO_GW) {
        for (int item = F.wave * F.G + F.vcu; item < 4 * 192; item += PRO_GW * F.G) {
            const int layer = item / 192, kk = lane >> 4, col = (item - layer * 192) * 64 + (lane & 15) * 4;
            const float* wp = IN_WMOD(F) + (size_t)layer * DM * MODW + (size_t)kk * MODW + col;
            f32x4 acc[NSET];
#pragma unroll
            for (int s = 0; s < NSET; ++s) acc[s] = (f32x4){0.f, 0.f, 0.f, 0.f};
            for (int k = 0; k < DM; k += 32) {
                f32x4 w[8];
#pragma unroll
                for (int u = 0; u < 8; ++u) w[u] = *(const GAS f32x4*)(wp + (size_t)(k + 4 * u) * MODW);
#pragma unroll
                for (int u = 0; u < 8; ++u)
#pragma unroll
                    for (int s = 0; s < NSET; ++s) acc[s] += w[u] * cond[s * DM + k + 4 * u + kk];
            }
#pragma unroll
            for (int s = 0; s < NSET; ++s)
#pragma unroll
                for (int x = 0; x < 4; ++x) { float t = acc[s][x]; t += shx(t, 16, lane); t += shx(t, 32, lane); acc[s][x] = t; }
            if (kk == 0) { const f32x4 bm = *(const GAS f32x4*)(IN_BMOD(F) + layer * MODW + col);
#pragma unroll
                for (int s = 0; s < NSET; ++s) *(GAS f32x4*)(WSF(F, WS_MOD) + (size_t)(layer * NSET + s) * MODW + col) = acc[s] + bm; }
        }
    } else {
        LAS float* scr = (LAS float*)(F.lds + RING_OFF + COND_BYTES + (F.wave - PRO_GW) * 16640);
        const int tw = (F.wave - PRO_GW) * F.G + F.vcu, NTW = (NWAVES - PRO_GW) * F.G;
#if LATE_CONV
        for (int it = tw; it < conv_layer_count(0); it += NTW) conv_layer_item(F, A, 0, it, scr, lane);
#else
        constexpr int I0 = 2 * 32 * 48, I1 = 2 * 32 * 32, I2 = 2 * 32 * 192, I3 = 2 * 64 * 32, I4 = 4 * 32 * 176, I5 = 4 * 88 * 32;
        for (int it = tw; it < I0 + I1 + I2 + I3 + I4 + I5; it += NTW) {
            int r = it;
            if (r < I0) { p0_conv(IN_WINE(F), WSB(F, WS_W_INE), DM, EIN, 0, r, scr, lane); continue; } r -= I0;
            if (r < I1) { p0_conv(IN_WOUTE(F), WSB(F, WS_W_OUTE), DM, DM, 1, r, scr, lane); continue; } r -= I1;
            if (r < I2) { p0_conv(IN_WINO(F), WSB(F, WS_W_INO), DM, OIN, 2, r, scr, lane); continue; } r -= I2;
            if (r < I3) { p0_conv(IN_WOUTO(F), WSB(F, WS_W_OUTO), OMIX, DM, 3, r, scr, lane); continue; } r -= I3;
            if (r < I4) { p0_conv(IN_WFIN(F), WSB(F, WS_W_FIN), DM, FFN2, 4, r, scr, lane); continue; } r -= I4;
            p0_conv(IN_WFOUT(F), WSB(F, WS_W_FOUT), FFN, DM, 5, r, scr, lane);
        }
#endif
    }
    const int gw = F.vcu * NWAVES + F.wave, NGW = F.G * NWAVES;
    if (BUILD_SPLITTAB && gw == 0) {
        pg8::StaticOrder so; so.init(MROWS, DM, F.G, 0); const int nfull = (so.nwg / F.G) * F.G; int* tab = (int*)(F.ws + WS_SPLITTAB);
        for (int e = lane; e < 576; e += 64) { int val = 0;
            for (int idx = nfull; idx < so.nwg; ++idx) { pg8::Unit u; so.map(idx, u); if (u.pm * 8 + u.pn == e) val = idx - nfull + 1; }
            tab[e] = val; }
    }
    const int gt = gw * 64 + lane, NGT = NGW * 64;
    for (int i = gt; i < 4096 * 256; i += NGT) {
        const int m = i >> 8, k0 = (i & 255) * 8, part = m >> 11, to = m & 2047; unsigned w[4];
#pragma unroll
        for (int u = 0; u < 4; ++u) { float s0, c0, s1, c1; sincospif((float)((to * (k0 + 2 * u)) & 2047) * (1.0f / 1024.0f), &s0, &c0); sincospif((float)((to * (k0 + 2 * u + 1)) & 2047) * (1.0f / 1024.0f), &s1, &c1);
            w[u] = pk2((part ? s0 : c0) * 0.022097086912079608f, (part ? s1 : c1) * 0.022097086912079608f); }
        *(GAS v4u*)(WSB(F, WS_WTL) + (size_t)m * 2048 + k0) = (v4u){w[0], w[1], w[2], w[3]};
    }
    for (int i = gt; i < 512 * 32; i += NGT) {
        const int m = i >> 5, k0 = (i & 31) * 8, part = m >> 8, to = m & 255; unsigned w[4];
#pragma unroll
        for (int u = 0; u < 4; ++u) { float s0, c0, s1, c1; sincospif((float)((to * (k0 + 2 * u)) & 255) * (1.0f / 128.0f), &s0, &c0); sincospif((float)((to * (k0 + 2 * u + 1)) & 255) * (1.0f / 128.0f), &s1, &c1);
            w[u] = pk2((part ? s0 : c0) * 0.0625f, (part ? s1 : c1) * 0.0625f); }
        *(GAS v4u*)(WSB(F, WS_WTC) + (size_t)m * 256 + k0) = (v4u){w[0], w[1], w[2], w[3]};
    }
    for (int i = gt; i < 512 * 128; i += NGT) {
        const int n = i >> 7, k0 = (i & 127) * 8, g = n >> 7, kq = n & 127, part = k0 >> 9, g2 = (k0 >> 7) & 3; unsigned w[4];
#pragma unroll
        for (int u = 0; u < 4; ++u) { float s0, c0, s1, c1; const int cc = (k0 & 127) + 2 * u; sincospif((float)((cc * kq) & 127) * (1.0f / 64.0f), &s0, &c0); sincospif((float)(((cc + 1) * kq) & 127) * (1.0f / 64.0f), &s1, &c1);
            const float a0 = (part ? -s0 : c0) * 0.08838834764831845f, a1 = (part ? -s1 : c1) * 0.08838834764831845f;
            w[u] = (g == g2) ? pk2(a0, a1) : 0u; }
        *(GAS v4u*)(WSB(F, WS_CB) + (size_t)n * 1024 + k0) = (v4u){w[0], w[1], w[2], w[3]};
    }
    for (int i = gt; i < 64 * 32; i += NGT) { const int pos = i >> 5, f = i & 31; const double inv = exp2(-(double)(2 * f) / 64.0 * 13.287712379549449), a = (double)pos * inv;
        WSF(F, WS_ROPE_E)[2 * i] = (float)cos(a); WSF(F, WS_ROPE_E)[2 * i + 1] = (float)sin(a); }
    for (int i = gt; i < 64 * 64; i += NGT) { const int pos = i >> 6, f = i & 63; const double inv = exp2(-(double)(2 * f) / 128.0 * 13.287712379549449), a = (double)pos * inv;
        WSF(F, WS_ROPE_O)[2 * i] = (float)cos(a); WSF(F, WS_ROPE_O)[2 * i + 1] = (float)sin(a); }
}
__device__ __forceinline__ void ph_modulate(Frame& F, const Args& A, int layer, int which, int skipctx, int merge, int from_x) {
    const int lane = tid_opaque() & 63;
    const int gw = F.vcu * NWAVES + F.wave, NGW = F.G * NWAVES, R = (MROWS + NGW - 1) / NGW;
    const int m0 = gw * R, m1 = (m0 + R < MROWS) ? m0 + R : MROWS;
    f32x4 sh[8], sc[8], v[8], vn[8]; int curset = -1;
#define MOD_SRC(m_, b_, t_) (from_x ? (const GAS f32x4*)((t_) >= SEQ ? IN_CTX(F) + (size_t)((b_) * CTXL + (t_) - SEQ) * DM : IN_X(F) + (size_t)((b_) * SEQ + (t_)) * DM) + lane : (const GAS f32x4*)(WSF(F, WS_H) + (size_t)(m_) * DM) + lane)
    if (m0 < MROWS) { const int b = m0 / TPB, t = m0 - b * TPB; const GAS f32x4* sr = MOD_SRC(m0, b, t);
#pragma unroll
        for (int j = 0; j < 8; ++j) vn[j] = sr[64 * j]; }
#pragma unroll 1
    for (int m = m0; m < m1; ++m) {
        const int b = m / TPB, t = m - b * TPB, isctx = t >= SEQ, set = isctx ? 8 : b;
#pragma unroll
        for (int j = 0; j < 8; ++j) v[j] = vn[j];
        if (m + 1 < m1) { const int b2 = (m + 1) / TPB, t2 = (m + 1) - b2 * TPB; const GAS f32x4* sr = MOD_SRC(m + 1, b2, t2);
#pragma unroll
            for (int j = 0; j < 8; ++j) vn[j] = sr[64 * j]; }
        if (skipctx && isctx) continue;
        if (set != curset) { curset = set; const float* shp = WSF(F, WS_MOD) + (size_t)(layer * NSET + set) * MODW + which * 3 * DM;
#pragma unroll
            for (int j = 0; j < 8; ++j) { sh[j] = *((const GAS f32x4*)shp + lane + 64 * j); sc[j] = *((const GAS f32x4*)(shp + DM) + lane + 64 * j) + 1.0f; } }
        if (merge) {
            GAS f32x4* hr = (GAS f32x4*)(WSF(F, WS_H) + (size_t)m * DM) + lane;
            const int pm = m >> 8; const int* tab = (const int*)(F.ws + WS_SPLITTAB) + pm * 8;
#pragma unroll
            for (int j = 0; j < 8; ++j) { const int sl = __builtin_amdgcn_readfirstlane(tab[j]);
                if (sl) { const GAS f32x4* dp = (const GAS f32x4*)(WSF(F, WS_DELTA) + (size_t)(sl - 1) * 4 * 65536 + (size_t)(m & 255) * 256) + lane;
                    const f32x4 d0 = dp[0], d1 = dp[16384], d2 = dp[32768], d3 = dp[49152];
                    v[j] = v[j] + ((d0 + d1) + (d2 + d3)); hr[64 * j] = v[j]; } }
        }
        float ss = 0.f;
#pragma unroll
        for (int j = 0; j < 8; ++j) { ss += (v[j][0] * v[j][0] + v[j][1] * v[j][1]) + (v[j][2] * v[j][2] + v[j][3] * v[j][3]); }
        const float rstd = 1.0f / sqrtf(wave_sum(ss, lane) * (1.0f / DM) + EPS);
        GAS v2u* o8 = (GAS v2u*)(WSB(F, WS_XN) + (size_t)m * DM) + lane;
#pragma unroll
        for (int j = 0; j < 8; ++j) { const f32x4 y = v[j] * rstd * sc[j] + sh[j]; o8[64 * j] = (v2u){pk2(y[0], y[1]), pk2(y[2], y[3])}; }
    }
#undef MOD_SRC
}
__device__ __forceinline__ void ph_qk_even(Frame& F, const Args& A, int j2) {
    const int gw = F.vcu * NWAVES + F.wave, NGW = F.G * NWAVES, l = tid_opaque() & 63;
    const float* qg = IN_QG(F) + j2 * 128 + (l & 15) * 8; const float* kg = IN_KG(F) + j2 * 128 + (l & 15) * 8;
    float gq[8], gk[8];
#pragma unroll
    for (int x = 0; x < 8; ++x) { gq[x] = qg[x]; gk[x] = kg[x]; }
    for (int m = gw; m < MROWS; m += NGW) {
        const int b = m / TPB, t = m - b * TPB, lat = t < SEQ;
        const int half = (l >> 3) & 1, pos = half ? (t & 63) : (t >> 6), isx2 = (l >> 2) & 1;
        f32x4 tb[4];
        if (lat) {
#pragma unroll
            for (int q = 0; q < 4; ++q) tb[q] = *(const GAS f32x4*)(WSF(F, WS_ROPE_E) + (size_t)(pos * 32 + (l & 3) * 8 + 2 * q) * 2);
        }
        GAS v4u* pr = (GAS v4u*)(WSB(F, WS_P) + (size_t)m * EIN + 512) + l;
#pragma unroll
        for (int j = 3; j < 4; ++j) {
            const v4u raw = pr[64 * j];
            float v[8] = {bflo(raw.x), bfhi(raw.x), bflo(raw.y), bfhi(raw.y), bflo(raw.z), bfhi(raw.z), bflo(raw.w), bfhi(raw.w)};
            float ss = 0.f;
#pragma unroll
            for (int x = 0; x < 8; ++x) ss += v[x] * v[x];
            ss += shx(ss, 1, l); ss += shx(ss, 2, l); ss += shx(ss, 4, l); ss += shx(ss, 8, l);
            const float rstd = 1.0f / sqrtf(ss * (1.0f / 128.0f) + EPS);
            const bool isq = (4 * j + (l >> 4)) < 12;
#pragma unroll
            for (int x = 0; x < 8; ++x) v[x] = v[x] * rstd * (isq ? gq[x] : gk[x]);
            if (lat) {
#pragma unroll
                for (int x = 0; x < 8; ++x) { const float p = shx(v[x], 4, l); const float cs = tb[x >> 1][(x & 1) * 2], sn = tb[x >> 1][(x & 1) * 2 + 1];
                    v[x] = isx2 ? (v[x] * cs + p * sn) : (v[x] * cs - p * sn); }
            }
            pr[64 * j] = (v4u){pk2(v[0], v[1]), pk2(v[2], v[3]), pk2(v[4], v[5]), pk2(v[6], v[7])};
        }
    }
    LAS bf16* scr = (LAS bf16*)(F.lds + RING_OFF + F.wave * 9216);
    for (int it = gw; it < NBATCH * 288; it += NGW) {
        const int b = it / 288, r = it - b * 288; int t0, c0, isc;
        if (r < 256) { isc = 0; t0 = (r >> 3) * 64; c0 = (r & 7) * 64; } else { isc = 1; t0 = ((r - 256) >> 3) * 64; c0 = ((r - 256) & 7) * 64; }
        const bf16* src = WSB(F, WS_P) + (size_t)(b * TPB + (isc ? SEQ : 0) + t0) * EIN + c0;
#pragma unroll
        for (int i = 0; i < 8; ++i) { const int rr = i * 8 + (l >> 3), ch = l & 7; const v4u val = *(const GAS v4u*)(src + (size_t)rr * EIN + ch * 8); *(LAS v4u*)(scr + rr * 72 + ch * 8) = val; }
        LDS_WAIT(); asm volatile("" ::: "memory");
        bf16* dst = isc ? WSB(F, WS_FTC) + (size_t)(b * 512 + c0) * CTXL + t0 : WSB(F, WS_FT) + (size_t)(b * 512 + c0) * SEQ + t0;
        const int ld = isc ? CTXL : SEQ;
#pragma unroll
        for (int i = 0; i < 8; ++i) { const int cc = i * 8 + (l >> 3), tc = (l & 7) * 8; const LAS bf16* s = scr + tc * 72 + cc;
            v4u o; o.x = (unsigned)s[0] | ((unsigned)s[72] << 16); o.y = (unsigned)s[144] | ((unsigned)s[216] << 16); o.z = (unsigned)s[288] | ((unsigned)s[360] << 16); o.w = (unsigned)s[432] | ((unsigned)s[504] << 16);
            *(GAS v4u*)(dst + (size_t)cc * ld + tc) = o; }
        LDS_WAIT(); asm volatile("" ::: "memory");
    }
}
__device__ __forceinline__ void ph_rope_odd(Frame& F) {
    const int gw = F.vcu * NWAVES + F.wave, NGW = F.G * NWAVES, l = tid_opaque() & 63;
    for (int m = gw; m < MROWS; m += NGW) {
        const int b = m / TPB, t = m - b * TPB;
        if (t >= SEQ) continue;
        const int half = (l >> 4) & 1, pos = half ? (t & 63) : (t >> 6), isx2 = (l >> 3) & 1;
        f32x4 tb[4];
#pragma unroll
        for (int q = 0; q < 4; ++q) tb[q] = *(const GAS f32x4*)(WSF(F, WS_ROPE_O) + (size_t)(pos * 64 + (l & 7) * 8 + 2 * q) * 2);
        GAS v4u* pr = (GAS v4u*)(WSB(F, WS_P) + (size_t)m * OIN) + l;
#pragma unroll
        for (int j = 0; j < 8; ++j) {
            const v4u raw = pr[64 * j];
            float v[8] = {bflo(raw.x), bfhi(raw.x), bflo(raw.y), bfhi(raw.y), bflo(raw.z), bfhi(raw.z), bflo(raw.w), bfhi(raw.w)};
#pragma unroll
            for (int x = 0; x < 8; ++x) { const float p = shx(v[x], 8, l); const float cs = tb[x >> 1][(x & 1) * 2], sn = tb[x >> 1][(x & 1) * 2 + 1];
                v[x] = isx2 ? (v[x] * cs + p * sn) : (v[x] * cs - p * sn); }
            pr[64 * j] = (v4u){pk2(v[0], v[1]), pk2(v[2], v[3]), pk2(v[4], v[5]), pk2(v[6], v[7])};
        }
    }
}
__device__ __forceinline__ void ph_comb(Frame& F, int skipctx, int dry = 0) {
    const int gw = F.vcu * NWAVES + F.wave, NGW = F.G * NWAVES, l = tid_opaque() & 63;
    for (int m = gw; m < MROWS; m += NGW) {
        const int b = m / TPB, t = m - b * TPB;
        if (skipctx && t >= SEQ) continue;
        GAS v4u* pf = (GAS v4u*)(WSB(F, WS_OF) + (size_t)m * OMIX) + l; const GAS v4u* pb = (const GAS v4u*)(WSB(F, WS_OB) + (size_t)m * OMIX) + l;
        const GAS v4u* pg = (const GAS v4u*)(WSB(F, WS_P) + RP_G + (size_t)m * 4096) + l;
#pragma unroll
        for (int j = 0; j < 8; ++j) {
            const v4u a = pf[64 * j], bb = pb[64 * j], gg = pg[64 * j];
            float o[8] = {bflo(a.x) + bflo(bb.x), bfhi(a.x) + bfhi(bb.x), bflo(a.y) + bflo(bb.y), bfhi(a.y) + bfhi(bb.y), bflo(a.z) + bflo(bb.z), bfhi(a.z) + bfhi(bb.z), bflo(a.w) + bflo(bb.w), bfhi(a.w) + bfhi(bb.w)};
            const float g[8] = {bflo(gg.x), bfhi(gg.x), bflo(gg.y), bfhi(gg.y), bflo(gg.z), bfhi(gg.z), bflo(gg.w), bfhi(gg.w)};
            float ss = 0.f;
#pragma unroll
            for (int x = 0; x < 8; ++x) ss += o[x] * o[x];
            const float rstd = 1.0f / sqrtf(wave_sum(ss, l) * (1.0f / 512.0f) + EPS);
#pragma unroll
            for (int x = 0; x < 8; ++x) o[x] = silu(g[x]) * (o[x] * rstd);
            (dry ? (GAS v4u*)pb : pf)[64 * j] = (v4u){pk2(o[0], o[1]), pk2(o[2], o[3]), pk2(o[4], o[5]), pk2(o[6], o[7])};
        }
    }
}
__device__ __forceinline__ void ph_attention(Frame& F, const Args& A, int j2) {
    char* lds = (char*)(F.lds + RING_OFF);
    for (int i = 0;; ++i) {
        const int u = i * F.G + F.vcu; if (u >= 864) break;
        if (u < 768) { const int qb = u & 7, g3 = (u >> 3) % 3, bk = u / 24, kvh = bk & 3, b = bk >> 2, h = kvh * 3 + g3; const size_t rq = (size_t)(b * TPB + qb * 256);
            const bf16* Kh = WSB(F, WS_P) + (size_t)(b * TPB) * EIN + 2048 + kvh * 128;
            att::attn_dense_body(WSB(F, WS_P) + rq * EIN + 512 + h * 128, Kh, Kh + 512, WSB(F, WS_MIX) + rq * DM + 512 + h * 128, TPB, lds, IN_QG(F) + j2 * 128, WSF(F, WS_ROPE_E), qb * 256);
        } else { const int v = u - 768, b = v / 12, h = v - b * 12, kvh = h / 3; const size_t rq = (size_t)(b * TPB + SEQ);
            const bf16* Kh = WSB(F, WS_P) + rq * EIN + 2048 + kvh * 128;
            att::attn_dense_body(WSB(F, WS_P) + rq * EIN + 512 + h * 128, Kh, Kh + 512, WSB(F, WS_MIX) + rq * DM + 512 + h * 128, CTXL, lds, IN_QG(F) + j2 * 128, nullptr, 0);
        }
    }
}
namespace ret {
constexpr int K_LD = 544, V_LD = 288, ST_LD = 544, Q_LD = 544;
constexpr int K_OFF = 0, V_OFF = 64 * K_LD, ST_OFF = V_OFF + 64 * V_LD, Q_OFF = ST_OFF + 128 * ST_LD, LDS_END = Q_OFF + 64 * Q_LD;
static_assert(LDS_END <= LDSCTL_OFF, "retention LDS");
typedef short v4i16_t __attribute__((ext_vector_type(4)));
__device__ __forceinline__ bf16x8 lds16(const LAS unsigned char* p) { return *(const LAS bf16x8*)p; }
__device__ __forceinline__ s16x4 ldstr(const LAS unsigned char* p) { return __builtin_bit_cast(s16x4, __builtin_amdgcn_ds_read_tr16_b64_v4i16((LAS v4i16_t*)p)); }
__device__ __forceinline__ bf16x8 cat8v(v2u lo, v2u hi) { const v4u w = {lo.x, lo.y, hi.x, hi.y}; return __builtin_bit_cast(bf16x8, w); }
__device__ __forceinline__ bf16x8 cat8(s16x4 lo, s16x4 hi) { return (bf16x8){lo[0], lo[1], lo[2], lo[3], hi[0], hi[1], hi[2], hi[3]}; }
__device__ __forceinline__ bf16x8 pack8(const float* v) { const v4u w = {pk2(v[0], v[1]), pk2(v[2], v[3]), pk2(v[4], v[5]), pk2(v[6], v[7])}; return __builtin_bit_cast(bf16x8, w); }
#ifndef PROBE_RETBAR
#define PROBE_RETBAR 0
#endif
#define RET_BAR() do { asm volatile("s_waitcnt lgkmcnt(0)" ::: "memory"); __builtin_amdgcn_s_barrier(); if (PROBE_RETBAR) __builtin_amdgcn_s_barrier(); asm volatile("" ::: "memory"); } while (0)
#ifndef RET_EARLY_LOAD
#define RET_EARLY_LOAD 1
#endif
#ifndef RET_SBMASK
#define RET_SBMASK -1
#endif
#ifndef RET_NOSB
#define RET_NOSB 0
#endif
#define RET_SB() do { if (!RET_NOSB) __builtin_amdgcn_sched_barrier(0); } while (0)
#define RET_SBX(i) do { if (RET_SBMASK >= 0 && ((i) & RET_SBMASK) == RET_SBMASK) RET_SB(); } while (0)
__device__ __forceinline__ void ret_item(LAS unsigned char* lds, const bf16* P, bf16* Odir, int b, int h, int dir, int es, float lg) {
    int tid = threadIdx.x; asm volatile("" : "+v"(tid));
    const int w = __builtin_amdgcn_readfirstlane(tid >> 6), lane = tid & 63, g = lane >> 4, c = lane & 15, wi = w & 3, we = w >> 2, q4 = c >> 2, p4 = c & 3;
    const float lg2 = lg * 1.4426950408889634f;
    const bf16* Pq = P + h * 256 + (tid & 31) * 8; const bf16* Pk = Pq + 2048; const bf16* Pv = P + 4096 + h * 512 + es * 128 + (tid & 15) * 8;
    bf16* Oo = Odir + h * 512 + es * 128 + we * 64 + c;
    { unsigned z_ = 0u; asm volatile("" : "+v"(z_));
      for (int i = tid; i < 128 * ST_LD / 16; i += NWAVES * 64) *(LAS v4u*)(lds + ST_OFF + i * 16) = (v4u){z_, z_, z_, z_}; }
    f32x4 st[2][8];
#pragma unroll
    for (int a = 0; a < 2; ++a)
#pragma unroll
        for (int e = 0; e < 8; ++e) st[a][e] = (f32x4){0.f, 0.f, 0.f, 0.f};
    const int kr = tid >> 5, vr = tid >> 4;
    const float cd = __builtin_amdgcn_exp2f(64.0f * lg2);
    v4u kreg[4], qreg[4], vreg[2];
#define RET_ROWBASE(n) (dir == 0 ? (b * TPB + ((n) < 4 ? SEQ + 64 * (n) : 64 * (n) - CTXL)) : (b * TPB + ((n) < 4 ? SEQ + 255 - 64 * (n) : 2303 - 64 * (n))))
#define RET_LOAD(n) do { const int rb_ = RET_ROWBASE(n), sg_ = dir == 0 ? 1 : -1; \
        _Pragma("unroll") for (int x = 0; x < 4; ++x) { const size_t ro_ = (size_t)(rb_ + sg_ * (kr + 16 * x)) * OIN; kreg[x] = *(const GAS v4u*)(Pk + ro_); qreg[x] = *(const GAS v4u*)(Pq + ro_); } \
        _Pragma("unroll") for (int x = 0; x < 2; ++x) vreg[x] = *(const GAS v4u*)(Pv + (size_t)(rb_ + sg_ * (vr + 32 * x)) * OIN); } while (0)
    RET_LOAD(0);
    for (int n = 0; n < 36; ++n) {
        const int rowbase = RET_ROWBASE(n), sgn = dir == 0 ? 1 : -1;
#pragma unroll
        for (int x = 0; x < 4; ++x) { *(LAS v4u*)(lds + K_OFF + (kr + 16 * x) * K_LD + (tid & 31) * 16) = kreg[x]; *(LAS v4u*)(lds + Q_OFF + (kr + 16 * x) * Q_LD + (tid & 31) * 16) = qreg[x]; }
#pragma unroll
        for (int x = 0; x < 2; ++x) { const float kd = __builtin_amdgcn_exp2f((float)(63 - (vr + 32 * x)) * lg2); const v4u r = vreg[x];
            *(LAS v4u*)(lds + V_OFF + (vr + 32 * x) * V_LD + (tid & 15) * 16) = (v4u){pk2(bflo(r.x) * kd, bfhi(r.x) * kd), pk2(bflo(r.y) * kd, bfhi(r.y) * kd), pk2(bflo(r.z) * kd, bfhi(r.z) * kd), pk2(bflo(r.w) * kd, bfhi(r.w) * kd)}; }
        RET_BAR();
#if RET_EARLY_LOAD
        if (n + 1 < 36) RET_LOAD(n + 1);
#endif
        float lg2v = lg2; int gl = g, cl = c; asm volatile("" : "+v"(lg2v), "+v"(gl), "+v"(cl));
#define RD_Q(s)    lds16(lds + Q_OFF + (16 * wi + c) * Q_LD + (32 * (s) + 8 * g) * 2)
#define RD_K(jt, s) lds16(lds + K_OFF + (16 * (jt) + c) * K_LD + (32 * (s) + 8 * g) * 2)
#define RD_ST(et, s) lds16(lds + ST_OFF + (64 * we + 16 * (et) + c) * ST_LD + (32 * (s) + 8 * g) * 2)
        f32x4 sT[4], O[4];
#pragma unroll
        for (int jt = 0; jt < 4; ++jt) { sT[jt] = (f32x4){0.f, 0.f, 0.f, 0.f}; O[jt] = (f32x4){0.f, 0.f, 0.f, 0.f}; }
        {
            bf16x8 qc = RD_Q(0), qn = qc, kf[4], sf[4];
#pragma unroll
            for (int jt = 0; jt < 4; ++jt) kf[jt] = RD_K(jt, 0);
#pragma unroll
            for (int s = 0; s < 8; ++s) {
#pragma unroll
                for (int et = 0; et < 4; ++et) sf[et] = RD_ST(et, s);
                RET_SB();
#pragma unroll
                for (int jt = 0; jt < 4; ++jt) sT[jt] = __builtin_amdgcn_mfma_f32_16x16x32_bf16(kf[jt], qc, sT[jt], 0, 0, 0);
                RET_SB();
                if (s < 7) { qn = RD_Q(s + 1);
#pragma unroll
                    for (int jt = 0; jt < 4; ++jt) kf[jt] = RD_K(jt, s + 1); }
                RET_SB();
#pragma unroll
                for (int et = 0; et < 4; ++et) O[et] = __builtin_amdgcn_mfma_f32_16x16x32_bf16(qc, sf[et], O[et], 0, 0, 0);
                RET_SB();
                qc = qn;
            }
        }
        s16x4 vlo[4][2], vhi[4][2];
#pragma unroll
        for (int et = 0; et < 4; ++et)
#pragma unroll
            for (int s2 = 0; s2 < 2; ++s2) { const LAS unsigned char* vp = lds + V_OFF + (32 * s2 + 4 * g + q4) * V_LD + (64 * we + 16 * et + 4 * p4) * 2; vlo[et][s2] = ldstr(vp); vhi[et][s2] = ldstr(vp + 16 * V_LD); }
        RET_SB();
#pragma unroll
        for (int et = 0; et < 4; ++et) O[et] = O[et] * cd;
        bf16x8 pA[2];
#pragma unroll
        for (int s2 = 0; s2 < 2; ++s2) { float v[8];
#pragma unroll
            for (int jj = 0; jj < 8; ++jj) { const int jt = 2 * s2 + (jj >> 2), r = jj & 3, diff = (16 * wi + cl) - (16 * jt + 4 * gl + r);
                const bool keep = dir == 0 ? diff >= 0 : diff > 0;
                v[jj] = keep ? sT[jt][r] : 0.f; }
            pA[s2] = pack8(v); }
        RET_SB();
        s16x4 klo[2][2], khi[2][2];
#pragma unroll
        for (int s2 = 0; s2 < 2; ++s2)
#pragma unroll
            for (int dt = 0; dt < 2; ++dt) { const LAS unsigned char* kp = lds + K_OFF + (32 * s2 + 4 * g + q4) * K_LD + (32 * w + 8 * p4 + 4 * dt) * 2; klo[s2][dt] = ldstr(kp); khi[s2][dt] = ldstr(kp + 16 * K_LD); }
        RET_SB();
#pragma unroll
        for (int et = 0; et < 4; ++et)
#pragma unroll
            for (int s2 = 0; s2 < 2; ++s2) O[et] = __builtin_amdgcn_mfma_f32_16x16x32_bf16(pA[s2], cat8(vlo[et][s2], vhi[et][s2]), O[et], 0, 0, 0);
        RET_SB();
#define RD_V4(it) cat8(ldstr(lds + V_OFF + (32 * ((it) >> 3) + 4 * g + q4) * V_LD + (16 * ((it) & 7) + 4 * p4) * 2), ldstr(lds + V_OFF + (32 * ((it) >> 3) + 4 * g + q4 + 16) * V_LD + (16 * ((it) & 7) + 4 * p4) * 2))
        bf16x8 vbc = RD_V4(0), vbn = vbc;
        RET_SB();
#pragma unroll
        for (int a = 0; a < 2; ++a)
#pragma unroll
            for (int e = 0; e < 8; ++e) st[a][e] *= cd;
        bf16x8 ka[2][2];
#pragma unroll
        for (int s2 = 0; s2 < 2; ++s2)
#pragma unroll
            for (int dt = 0; dt < 2; ++dt) ka[s2][dt] = cat8(klo[s2][dt], khi[s2][dt]);
        { bf16* ob = Oo + (size_t)(dir == 0 ? rowbase : rowbase - 63) * OMIX;
#pragma unroll
            for (int r = 0; r < 4; ++r) { const int i = 16 * wi + 4 * g + r; const float rf = __builtin_amdgcn_exp2f((float)(16 * wi + 4 * gl + r - 63) * lg2v);
                const unsigned off = (unsigned)(dir == 0 ? i : 63 - i) * OMIX;
#pragma unroll
                for (int et = 0; et < 4; ++et) ob[off + 16 * et] = (bf16)(pk2(O[et][r] * rf, 0.f) & 0xffffu); } }
        RET_SB();
#pragma unroll
        for (int it = 0; it < 16; ++it) {
            if (it < 15) vbn = RD_V4(it + 1);
            RET_SB();
            st[0][it & 7] = __builtin_amdgcn_mfma_f32_16x16x32_bf16(ka[it >> 3][0], vbc, st[0][it & 7], 0, 0, 0);
            st[1][it & 7] = __builtin_amdgcn_mfma_f32_16x16x32_bf16(ka[it >> 3][1], vbc, st[1][it & 7], 0, 0, 0);
            RET_SB();
            vbc = vbn;
        }
#undef RD_Q
#undef RD_K
#undef RD_ST
#undef RD_V4
        RET_BAR();
        if (n + 1 < 36) {
#pragma unroll
            for (int et = 0; et < 8; ++et)
                *(LAS v4u*)(lds + ST_OFF + (16 * et + c) * ST_LD + (32 * w + 8 * g) * 2) = (v4u){pk2(st[0][et][0], st[0][et][1]), pk2(st[0][et][2], st[0][et][3]), pk2(st[1][et][0], st[1][et][1]), pk2(st[1][et][2], st[1][et][3])};
        }
    }
#undef RET_LOAD
#undef RET_ROWBASE
}

__device__ __forceinline__ void ret_item_spec(LAS unsigned char* lds, const bf16* P, bf16* Odir, int b, int h, int dir, int es, float lg, int noctx) {
    int tid = threadIdx.x; asm volatile("" : "+v"(tid));
    const int w = __builtin_amdgcn_readfirstlane(tid >> 6), lane = tid & 63, g = lane >> 4, c = lane & 15, q4 = c >> 2, p4 = c & 3;
    const float lg2 = lg * 1.4426950408889634f;
    const bf16* Pq = P + h * 256 + (tid & 31) * 8; const bf16* Pk = Pq + 2048; const bf16* Pv = P + 4096 + h * 512 + es * 128 + (tid & 15) * 8;
    { unsigned z_ = 0u; asm volatile("" : "+v"(z_));
      for (int i = tid; i < 128 * ST_LD / 16; i += NWAVES * 64) *(LAS v4u*)(lds + ST_OFF + i * 16) = (v4u){z_, z_, z_, z_}; }
    const int kr = (tid & 255) >> 5, vr = (tid & 255) >> 4;
    const float cd = __builtin_amdgcn_exp2f(64.0f * lg2);
#define RET_ROWBASE(n) (dir == 0 ? (b * TPB + ((n) < 4 ? SEQ + 64 * (n) : 64 * (n) - CTXL)) : (b * TPB + ((n) < 4 ? SEQ + 255 - 64 * (n) : 2303 - 64 * (n))))
#define RET_LOADA(n) do { const int rb_ = RET_ROWBASE(n), sg_ = dir == 0 ? 1 : -1; \
        _Pragma("unroll") for (int x = 0; x < 8; ++x) { const size_t ro_ = (size_t)(rb_ + sg_ * (kr + 8 * x)) * OIN; kreg[x] = *(const GAS v4u*)(Pk + ro_); qreg[x] = *(const GAS v4u*)(Pq + ro_); } } while (0)
#define RET_STAGEA() do { \
        _Pragma("unroll") for (int x = 0; x < 8; ++x) { *(LAS v4u*)(lds + K_OFF + (kr + 8 * x) * K_LD + (tid & 31) * 16) = kreg[x]; *(LAS v4u*)(lds + Q_OFF + (kr + 8 * x) * Q_LD + (tid & 31) * 16) = qreg[x]; } } while (0)
#define RET_LOADB(n) do { const int rb_ = RET_ROWBASE(n), sg_ = dir == 0 ? 1 : -1; \
        _Pragma("unroll") for (int x = 0; x < 4; ++x) vreg[x] = *(const GAS v4u*)(Pv + (size_t)(rb_ + sg_ * (vr + 16 * x)) * OIN); } while (0)
#define RET_STAGEB() do { \
        _Pragma("unroll") for (int x = 0; x < 4; ++x) { const float kd = __builtin_amdgcn_exp2f((float)(63 - (vr + 16 * x)) * lg2); const v4u r = vreg[x]; \
            *(LAS v4u*)(lds + V_OFF + (vr + 16 * x) * V_LD + (tid & 15) * 16) = (v4u){pk2(bflo(r.x) * kd, bfhi(r.x) * kd), pk2(bflo(r.y) * kd, bfhi(r.y) * kd), pk2(bflo(r.z) * kd, bfhi(r.z) * kd), pk2(bflo(r.w) * kd, bfhi(r.w) * kd)}; } } while (0)
    if (w < 4) {
        const int wa = w;
        bf16* Oo = Odir + h * 512 + es * 128 + c;
        v4u kreg[8], qreg[8];
        RET_LOADA(0);
        for (int n = 0; n < 36; ++n) {
            const int rowbase = RET_ROWBASE(n);
            RET_STAGEA();
            RET_BAR();
            if (n + 1 < 36) RET_LOADA(n + 1);
            if (!(noctx && n < 4)) {
            float lg2v = lg2; int gl = g, cl = c; asm volatile("" : "+v"(lg2v), "+v"(gl), "+v"(cl));
#define RD_Q(s)    lds16(lds + Q_OFF + (16 * wa + c) * Q_LD + (32 * (s) + 8 * g) * 2)
#define RD_K(jt, s) lds16(lds + K_OFF + (16 * (jt) + c) * K_LD + (32 * (s) + 8 * g) * 2)
#define RD_ST(et, s) lds16(lds + ST_OFF + (16 * (et) + c) * ST_LD + (32 * (s) + 8 * g) * 2)
            f32x4 sT[4], O[8];
#pragma unroll
            for (int jt = 0; jt < 4; ++jt) sT[jt] = (f32x4){0.f, 0.f, 0.f, 0.f};
#pragma unroll
            for (int et = 0; et < 8; ++et) O[et] = (f32x4){0.f, 0.f, 0.f, 0.f};
            {
                bf16x8 q0 = RD_Q(0), q1, k0[4], k1[4], sf[8];
#pragma unroll
                for (int jt = 0; jt < 4; ++jt) k0[jt] = RD_K(jt, 0);
#pragma unroll
                for (int s = 0; s < 8; s += 2) {
                    q1 = RD_Q(s + 1);
#pragma unroll
                    for (int jt = 0; jt < 4; ++jt) k1[jt] = RD_K(jt, s + 1);
#pragma unroll
                    for (int et = 0; et < 8; ++et) sf[et] = RD_ST(et, s);
                    RET_SB();
#pragma unroll
                    for (int jt = 0; jt < 4; ++jt) sT[jt] = __builtin_amdgcn_mfma_f32_16x16x32_bf16(k0[jt], q0, sT[jt], 0, 0, 0);
                    RET_SB();
#pragma unroll
                    for (int et = 0; et < 8; ++et) O[et] = __builtin_amdgcn_mfma_f32_16x16x32_bf16(q0, sf[et], O[et], 0, 0, 0);
                    RET_SB();
                    if (s + 2 < 8) { q0 = RD_Q(s + 2);
#pragma unroll
                        for (int jt = 0; jt < 4; ++jt) k0[jt] = RD_K(jt, s + 2); }
#pragma unroll
                    for (int et = 0; et < 8; ++et) sf[et] = RD_ST(et, s + 1);
                    RET_SB();
#pragma unroll
                    for (int jt = 0; jt < 4; ++jt) sT[jt] = __builtin_amdgcn_mfma_f32_16x16x32_bf16(k1[jt], q1, sT[jt], 0, 0, 0);
                    RET_SB();
#pragma unroll
                    for (int et = 0; et < 8; ++et) O[et] = __builtin_amdgcn_mfma_f32_16x16x32_bf16(q1, sf[et], O[et], 0, 0, 0);
                    RET_SB();
                }
            }
#pragma unroll
            for (int et = 0; et < 8; ++et) O[et] = O[et] * cd;
            bf16x8 pA[2];
#pragma unroll
            for (int s2 = 0; s2 < 2; ++s2) { float v[8];
#pragma unroll
                for (int jj = 0; jj < 8; ++jj) { const int jt = 2 * s2 + (jj >> 2), r = jj & 3, diff = (16 * wa + cl) - (16 * jt + 4 * gl + r);
                    const bool keep = dir == 0 ? diff >= 0 : diff > 0;
                    v[jj] = keep ? sT[jt][r] : 0.f; }
                pA[s2] = pack8(v); }
            RET_SB();
            {
#define RD_VA(et, s2) cat8(ldstr(lds + V_OFF + (32 * (s2) + 4 * g + q4) * V_LD + (16 * (et) + 4 * p4) * 2), ldstr(lds + V_OFF + (32 * (s2) + 4 * g + q4 + 16) * V_LD + (16 * (et) + 4 * p4) * 2))
                bf16x8 va[2][2], vb[2][2];
#pragma unroll
                for (int q = 0; q < 2; ++q) { va[q][0] = RD_VA(q, 0); va[q][1] = RD_VA(q, 1); }
#pragma unroll
                for (int et = 0; et < 8; et += 4) {
#pragma unroll
                    for (int q = 0; q < 2; ++q) { vb[q][0] = RD_VA(et + 2 + q, 0); vb[q][1] = RD_VA(et + 2 + q, 1); }
                    RET_SB();
#pragma unroll
                    for (int q = 0; q < 2; ++q) { O[et + q] = __builtin_amdgcn_mfma_f32_16x16x32_bf16(pA[0], va[q][0], O[et + q], 0, 0, 0); O[et + q] = __builtin_amdgcn_mfma_f32_16x16x32_bf16(pA[1], va[q][1], O[et + q], 0, 0, 0); }
                    RET_SB();
                    if (et + 4 < 8) {
#pragma unroll
                        for (int q = 0; q < 2; ++q) { va[q][0] = RD_VA(et + 4 + q, 0); va[q][1] = RD_VA(et + 4 + q, 1); } }
                    RET_SB();
#pragma unroll
                    for (int q = 0; q < 2; ++q) { O[et + 2 + q] = __builtin_amdgcn_mfma_f32_16x16x32_bf16(pA[0], vb[q][0], O[et + 2 + q], 0, 0, 0); O[et + 2 + q] = __builtin_amdgcn_mfma_f32_16x16x32_bf16(pA[1], vb[q][1], O[et + 2 + q], 0, 0, 0); }
                    RET_SB();
                }
#undef RD_VA
            }
            {
                bf16* ob = Oo + (size_t)(dir == 0 ? rowbase : rowbase - 63) * OMIX;
#pragma unroll
                for (int r = 0; r < 4; ++r) { const int i = 16 * wa + 4 * g + r; const float rf = __builtin_amdgcn_exp2f((float)(16 * wa + 4 * gl + r - 63) * lg2v);
                    const unsigned off = (unsigned)(dir == 0 ? i : 63 - i) * OMIX;
#pragma unroll
                    for (int et = 0; et < 8; ++et) ob[off + 16 * et] = (bf16)(pk2(O[et][r] * rf, 0.f) & 0xffffu); }
            }
#undef RD_Q
#undef RD_K
#undef RD_ST
            }
            RET_BAR();
        }
    } else {
        const int wb = w - 4;
        v4u vreg[4];
        RET_LOADB(0);
        f32x4 st[2][2][8];
#pragma unroll
        for (int a = 0; a < 2; ++a)
#pragma unroll
            for (int d = 0; d < 2; ++d)
#pragma unroll
                for (int e = 0; e < 8; ++e) st[a][d][e] = (f32x4){0.f, 0.f, 0.f, 0.f};
        for (int n = 0; n < 36; ++n) {
            RET_STAGEB();
            RET_BAR();
            if (n + 1 < 36) RET_LOADB(n + 1);
            bf16x8 ka[2][2][2];
#pragma unroll
            for (int s2 = 0; s2 < 2; ++s2)
#pragma unroll
                for (int dp = 0; dp < 2; ++dp)
#pragma unroll
                    for (int dt = 0; dt < 2; ++dt) { const LAS unsigned char* kp = lds + K_OFF + (32 * s2 + 4 * g + q4) * K_LD + (64 * wb + 32 * dp + 8 * p4 + 4 * dt) * 2; ka[s2][dp][dt] = cat8(ldstr(kp), ldstr(kp + 16 * K_LD)); }
#define RD_V4(it) cat8(ldstr(lds + V_OFF + (32 * ((it) >> 3) + 4 * g + q4) * V_LD + (16 * ((it) & 7) + 4 * p4) * 2), ldstr(lds + V_OFF + (32 * ((it) >> 3) + 4 * g + q4 + 16) * V_LD + (16 * ((it) & 7) + 4 * p4) * 2))
            bf16x8 vbc = RD_V4(0), vbn = vbc;
            RET_SB();
#pragma unroll
            for (int a = 0; a < 2; ++a)
#pragma unroll
                for (int d = 0; d < 2; ++d)
#pragma unroll
                    for (int e = 0; e < 8; ++e) st[a][d][e] *= cd;
            RET_SB();
#pragma unroll
            for (int it = 0; it < 16; ++it) {
                if (it < 15) vbn = RD_V4(it + 1);
                RET_SB();
#pragma unroll
                for (int dp = 0; dp < 2; ++dp)
#pragma unroll
                    for (int dt = 0; dt < 2; ++dt) st[dp][dt][it & 7] = __builtin_amdgcn_mfma_f32_16x16x32_bf16(ka[it >> 3][dp][dt], vbc, st[dp][dt][it & 7], 0, 0, 0);
                RET_SB();
                vbc = vbn;
            }
#undef RD_V4
            RET_BAR();
            if (n + 1 < 36) {
#pragma unroll
                for (int dp = 0; dp < 2; ++dp)
#pragma unroll
                    for (int et = 0; et < 8; ++et)
                        *(LAS v4u*)(lds + ST_OFF + (16 * et + c) * ST_LD + (64 * wb + 32 * dp + 8 * g) * 2) = (v4u){pk2(st[dp][0][et][0], st[dp][0][et][1]), pk2(st[dp][0][et][2], st[dp][0][et][3]), pk2(st[dp][1][et][0], st[dp][1][et][1]), pk2(st[dp][1][et][2], st[dp][1][et][3])};
            }
        }
    }
#undef RET_LOADA
#undef RET_STAGEA
#undef RET_LOADB
#undef RET_STAGEB
#undef RET_ROWBASE
}

constexpr int S_OFF = ST_OFF, S_LD = 144;
constexpr int QR_LD = 528;
constexpr int Q1_OFF = S_OFF + 64 * S_LD, V1_OFF = Q1_OFF + 64 * Q_LD;
static_assert(V1_OFF + 64 * V_LD <= Q_OFF && Q1_OFF % 256 == 0 && V1_OFF % 256 == 0, "retention score image / second buffers");
#ifndef RET_PRIO
#define RET_PRIO 1
#endif
#ifndef RETP_T
#define RETP_T 0
#endif
#ifndef RETP_WAVE
#define RETP_WAVE 4
#endif
#ifndef RETP_CLK
#define RETP_CLK 0
#endif
#define RETP_FINE(k) do { if (RETP_T >= 5 && w == RETP_WAVE) { unsigned long t_; asm volatile("s_waitcnt lgkmcnt(0)\n\ts_memrealtime %0\n\ts_waitcnt lgkmcnt(0)" : "=s"(t_) :: "memory"); \
        if ((k) == RETP_T - 4 && t0_ != 0) tacc_ += (unsigned)(t_ - t0_); if ((k) == RETP_T - 5) t0_ = t_; } } while (0)
#define RETP_STAMP(k) do { if (RETP_T && RETP_T < 5 && w == RETP_WAVE) { unsigned long t_; if (RETP_CLK) asm volatile("s_memtime %0\n\ts_waitcnt lgkmcnt(0)" : "=s"(t_) :: "memory"); else asm volatile("s_memrealtime %0\n\ts_waitcnt lgkmcnt(0)" : "=s"(t_) :: "memory"); \
        if ((k) == ((RETP_T + 1) & 3) && t0_ != 0) tacc_ += (unsigned)(t_ - t0_); if ((k) == (RETP_T & 3)) t0_ = t_; } } while (0)
__device__ __forceinline__ unsigned ret_item_regst(LAS unsigned char* lds, const bf16* P, bf16* Odir, int b, int h, int dir, int es, float lg, int noctx) {
    int tid = threadIdx.x; asm volatile("" : "+v"(tid));
    const int w = __builtin_amdgcn_readfirstlane(tid >> 6), lane = tid & 63, g = lane >> 4, c = lane & 15, q4 = c >> 2, p4 = c & 3;
    const float lg2 = lg * 1.4426950408889634f;
    const bf16* Pq = P + (size_t)h * RP_PLANE + (tid & 31) * 8; const bf16* Pk = Pq + 8 * RP_PLANE; const bf16* Pv = P + RP_V + (size_t)(4 * h + es) * (RP_PLANE / 2) + (tid & 15) * 8;
    bf16* Po = Odir + h * 512 + es * 128 + (tid & 15) * 8;
    const int kr = (tid & 255) >> 5, vr = (tid & 255) >> 4;
    const float cd = __builtin_amdgcn_exp2f(64.0f * lg2);
    unsigned long t0_ = 0; unsigned tacc_ = 0;
#define RET_ROWBASE(n) (dir == 0 ? (b * TPB + ((n) < 4 ? SEQ + 64 * (n) : 64 * (n) - CTXL)) : (b * TPB + ((n) < 4 ? SEQ + 255 - 64 * (n) : 2303 - 64 * (n))))
#define RET_LOADK(n) do { const int rb_ = RET_ROWBASE(n), sg_ = dir == 0 ? 1 : -1; \
        _Pragma("unroll") for (int x = 0; x < 8; ++x) kreg[x] = *(const GAS v4u*)(Pk + (size_t)(rb_ + sg_ * (kr + 8 * x)) * 256); } while (0)
#define RET_LOADQ(n) do { const int rb_ = RET_ROWBASE(n), sg_ = dir == 0 ? 1 : -1; \
        _Pragma("unroll") for (int x = 0; x < 8; ++x) qreg[x] = *(const GAS v4u*)(Pq + (size_t)(rb_ + sg_ * (kr + 8 * x)) * 256); } while (0)
#define RET_STAGEK() do { \
        _Pragma("unroll") for (int x = 0; x < 8; ++x) *(LAS v4u*)(lds + K_OFF + (kr + 8 * x) * K_LD + (tid & 31) * 16) = kreg[x]; } while (0)
#define RET_STAGEQ(qo_) do { \
        _Pragma("unroll") for (int x = 0; x < 8; ++x) *(LAS v4u*)(lds + (qo_) + (kr + 8 * x) * QR_LD + (tid & 31) * 16) = qreg[x]; } while (0)
#define RET_LOADB(n) do { const int rb_ = RET_ROWBASE(n), sg_ = dir == 0 ? 1 : -1; \
        _Pragma("unroll") for (int x = 0; x < 4; ++x) vreg[x] = *(const GAS v4u*)(Pv + (size_t)(rb_ + sg_ * (vr + 16 * x)) * 128); } while (0)
#define RET_STAGEB(vo_) do { \
        _Pragma("unroll") for (int x = 0; x < 4; ++x) { const float kd = __builtin_amdgcn_exp2f((float)(63 - (vr + 16 * x)) * lg2); const v4u r = vreg[x]; \
            *(LAS v4u*)(lds + (vo_) + (vr + 16 * x) * V_LD + (tid & 15) * 16) = (v4u){pk2(bflo(r.x) * kd, bfhi(r.x) * kd), pk2(bflo(r.y) * kd, bfhi(r.y) * kd), pk2(bflo(r.z) * kd, bfhi(r.z) * kd), pk2(bflo(r.w) * kd, bfhi(r.w) * kd)}; } } while (0)
#define RET_OSTORE(m) do { const int rb_ = RET_ROWBASE(m), sg_ = dir == 0 ? 1 : -1; const int vb_ = ((m) & 1) ? V1_OFF : V_OFF; v4u o_[4]; \
        _Pragma("unroll") for (int x = 0; x < 4; ++x) o_[x] = *(const LAS v4u*)(lds + vb_ + (vr + 16 * x) * V_LD + (tid & 15) * 16); \
        _Pragma("unroll") for (int x = 0; x < 4; ++x) *(GAS v4u*)(Po + (size_t)(rb_ + sg_ * (vr + 16 * x)) * OMIX) = o_[x]; } while (0)
    RET_BAR();
    if (w < 4) {
        const int wa = w;
        if (RET_PRIO) __builtin_amdgcn_s_setprio(0);
        v4u kreg[8], qreg[8], vreg[4];
        RET_LOADQ(0); RET_LOADB(0); RET_LOADK(0);
        for (int n = 0; n < 36; ++n) {
            const int qo = (n & 1) ? Q1_OFF : Q_OFF, vo = (n & 1) ? V1_OFF : V_OFF;
            RET_STAGEK(); RET_STAGEQ(qo); RET_STAGEB(vo);
            RETP_STAMP(0);
            RET_BAR();
            RETP_STAMP(1);
            if (n + 1 < 36) { RET_LOADQ(n + 1); RET_LOADB(n + 1); RET_LOADK(n + 1); }
            if (n > 0 && !(noctx && n - 1 < 4)) RET_OSTORE(n - 1);
            if (!(noctx && n < 4)) {
                int gl = g, cl = c; asm volatile("" : "+v"(gl), "+v"(cl));
#define RD_Q(s)    lds16(lds + qo + (16 * wa + c) * QR_LD + (32 * (s) + 8 * g) * 2)
#define RD_K(jt, s) lds16(lds + K_OFF + (16 * (jt) + c) * K_LD + (32 * (s) + 8 * g) * 2)
                f32x4 sT[4];
#pragma unroll
                for (int jt = 0; jt < 4; ++jt) sT[jt] = (f32x4){0.f, 0.f, 0.f, 0.f};
                bf16x8 q0 = RD_Q(0), q1, k0[4], k1[4];
#pragma unroll
                for (int jt = 0; jt < 4; ++jt) k0[jt] = RD_K(jt, 0);
#pragma unroll
                for (int s = 0; s < 8; s += 2) {
                    q1 = RD_Q(s + 1);
#pragma unroll
                    for (int jt = 0; jt < 4; ++jt) k1[jt] = RD_K(jt, s + 1);
                    RET_SB();
#pragma unroll
                    for (int jt = 0; jt < 4; ++jt) sT[jt] = __builtin_amdgcn_mfma_f32_16x16x32_bf16(k0[jt], q0, sT[jt], 0, 0, 0);
                    RET_SB();
                    if (s + 2 < 8) { q0 = RD_Q(s + 2);
#pragma unroll
                        for (int jt = 0; jt < 4; ++jt) k0[jt] = RD_K(jt, s + 2); }
                    RET_SB();
#pragma unroll
                    for (int jt = 0; jt < 4; ++jt) sT[jt] = __builtin_amdgcn_mfma_f32_16x16x32_bf16(k1[jt], q1, sT[jt], 0, 0, 0);
                    RET_SB();
                }
#undef RD_Q
#undef RD_K
#pragma unroll
                for (int jt = 0; jt < 4; ++jt) { float v[4];
#pragma unroll
                    for (int r = 0; r < 4; ++r) { const int diff = (16 * wa + cl) - (16 * jt + 4 * gl + r); const bool keep = dir == 0 ? diff >= 0 : diff > 0; v[r] = keep ? sT[jt][r] : 0.f; }
                    *(LAS v2u*)(lds + S_OFF + (16 * wa + c) * S_LD + (16 * jt + 4 * g) * 2) = (v2u){pk2(v[0], v[1]), pk2(v[2], v[3])}; }
            }
            RETP_STAMP(2);
            RET_BAR();
            RETP_STAMP(3);
        }
        RET_BAR();
        RET_OSTORE(35);
    } else {
        const int wb = w - 4;
        if (RET_PRIO) __builtin_amdgcn_s_setprio(2);
        f32x4 st[8][2][2];
#pragma unroll
        for (int a = 0; a < 8; ++a)
#pragma unroll
            for (int d = 0; d < 2; ++d)
#pragma unroll
                for (int e = 0; e < 2; ++e) st[a][d][e] = (f32x4){0.f, 0.f, 0.f, 0.f};
        for (int n = 0; n < 36; ++n) {
            const bool doO = !(noctx && n < 4);
            const int qo = (n & 1) ? Q1_OFF : Q_OFF, vo = (n & 1) ? V1_OFF : V_OFF;
            RETP_STAMP(0);
            RET_BAR();
            RETP_STAMP(1);
            f32x4 OT[2][4];
#pragma unroll
            for (int et = 0; et < 2; ++et)
#pragma unroll
                for (int it = 0; it < 4; ++it) OT[et][it] = (f32x4){0.f, 0.f, 0.f, 0.f};
            if (doO) {
                const LAS unsigned char* qb0 = lds + qo + c * QR_LD + 8 * g; const LAS unsigned char* qb1 = qb0 + 32; asm volatile("" : "+v"(qb0), "+v"(qb1));
#define RD_QB(it, dq) cat8v(*(const LAS v2u*)(qb0 + 16 * (it) * QR_LD + 64 * (dq)), *(const LAS v2u*)(qb1 + 16 * (it) * QR_LD + 64 * (dq)))
#define RET_CVT(dq_, et_) __builtin_bit_cast(bf16x8, (v4u){pk2(st[dq_][0][et_][0], st[dq_][0][et_][1]), pk2(st[dq_][0][et_][2], st[dq_][0][et_][3]), pk2(st[dq_][1][et_][0], st[dq_][1][et_][1]), pk2(st[dq_][1][et_][2], st[dq_][1][et_][3])})
                bf16x8 qf[4], qn[4], sa[2], sn[2];
#pragma unroll
                for (int it = 0; it < 4; ++it) { qf[it] = RD_QB(it, 0); qn[it] = qf[it]; }
#pragma unroll
                for (int et = 0; et < 2; ++et) { sa[et] = RET_CVT(0, et); sn[et] = sa[et]; }
                RET_SB();
#pragma unroll
                for (int dq = 0; dq < 8; ++dq) {
                    if (dq + 1 < 8) {
#pragma unroll
                        for (int it = 0; it < 4; ++it) qn[it] = RD_QB(it, dq + 1);
#pragma unroll
                        for (int et = 0; et < 2; ++et) sn[et] = RET_CVT(dq + 1, et); }
#pragma unroll
                    for (int it = 0; it < 4; ++it) { OT[0][it] = __builtin_amdgcn_mfma_f32_16x16x32_bf16(sa[0], qf[it], OT[0][it], 0, 0, 0); OT[1][it] = __builtin_amdgcn_mfma_f32_16x16x32_bf16(sa[1], qf[it], OT[1][it], 0, 0, 0); }
                    __builtin_amdgcn_sched_group_barrier(0x100, 8, 0);
#pragma unroll
                    for (int k = 0; k < 4; ++k) { __builtin_amdgcn_sched_group_barrier(0x008, 1, 0); __builtin_amdgcn_sched_group_barrier(0x002, 2, 0); }
                    RET_SB();
#pragma unroll
                    for (int it = 0; it < 4; ++it) qf[it] = qn[it];
#pragma unroll
                    for (int et = 0; et < 2; ++et) sa[et] = sn[et];
                }
#undef RET_CVT
#undef RD_QB
            }
            bf16x8 vb[2][2];
#pragma unroll
            for (int s2 = 0; s2 < 2; ++s2)
#pragma unroll
                for (int et = 0; et < 2; ++et) { const LAS unsigned char* vp = lds + vo + (32 * s2 + 4 * g + q4) * V_LD + (32 * wb + 16 * et + 4 * p4) * 2; vb[s2][et] = cat8(ldstr(vp), ldstr(vp + 16 * V_LD)); }
#define RD_KA(s2, dq, dt) cat8(ldstr(lds + K_OFF + (32 * (s2) + 4 * g + q4) * K_LD + (32 * (dq) + 16 * (dt) + 4 * p4) * 2), ldstr(lds + K_OFF + (32 * (s2) + 4 * g + q4 + 16) * K_LD + (32 * (dq) + 16 * (dt) + 4 * p4) * 2))
            bf16x8 kc[2][2], kn[2][2];
#pragma unroll
            for (int dt = 0; dt < 2; ++dt)
#pragma unroll
                for (int s2 = 0; s2 < 2; ++s2) { kc[dt][s2] = RD_KA(s2, 0, dt); kn[dt][s2] = kc[dt][s2]; }
            RET_SB();
#pragma unroll
            for (int dq = 0; dq < 8; ++dq) {
                if (dq + 1 < 8) {
#pragma unroll
                    for (int dt = 0; dt < 2; ++dt)
#pragma unroll
                        for (int s2 = 0; s2 < 2; ++s2) kn[dt][s2] = RD_KA(s2, dq + 1, dt); }
                RET_SB();
#pragma unroll
                for (int s2 = 0; s2 < 2; ++s2)
#pragma unroll
                    for (int dt = 0; dt < 2; ++dt)
#pragma unroll
                        for (int et = 0; et < 2; ++et) st[dq][dt][et] = __builtin_amdgcn_mfma_f32_16x16x32_bf16(kc[dt][s2], vb[s2][et], st[dq][dt][et], 0, 0, 0);
                if (dq > 0) {
#pragma unroll
                    for (int dt = 0; dt < 2; ++dt)
#pragma unroll
                        for (int et = 0; et < 2; ++et) st[dq - 1][dt][et] = st[dq - 1][dt][et] * cd;
#pragma unroll
                    for (int k = 0; k < 8; ++k) { __builtin_amdgcn_sched_group_barrier(0x008, 1, 0); __builtin_amdgcn_sched_group_barrier(0x002, 1, 0); } }
                RET_SB();
#pragma unroll
                for (int dt = 0; dt < 2; ++dt)
#pragma unroll
                    for (int s2 = 0; s2 < 2; ++s2) kc[dt][s2] = kn[dt][s2];
            }
#undef RD_KA
            RETP_STAMP(2);
            RET_BAR();
            RETP_STAMP(3);
#pragma unroll
            for (int dt = 0; dt < 2; ++dt)
#pragma unroll
                for (int et = 0; et < 2; ++et) st[7][dt][et] = st[7][dt][et] * cd;
            if (doO) {
                float lg2v = lg2; int cl = c; asm volatile("" : "+v"(lg2v), "+v"(cl));
                bf16x8 sf[4][2];
#pragma unroll
                for (int it = 0; it < 4; ++it)
#pragma unroll
                    for (int s2 = 0; s2 < 2; ++s2) { const LAS unsigned char* sp = lds + S_OFF + (16 * it + c) * S_LD + (32 * s2 + 4 * g) * 2; const v2u lo = *(const LAS v2u*)sp, hi = *(const LAS v2u*)(sp + 32);
                        const v4u pw = {lo.x, lo.y, hi.x, hi.y}; sf[it][s2] = __builtin_bit_cast(bf16x8, pw); }
                RET_SB();
#pragma unroll
                for (int s2 = 0; s2 < 2; ++s2)
#pragma unroll
                    for (int it = 0; it < 4; ++it)
#pragma unroll
                        for (int et = 0; et < 2; ++et) OT[et][it] = __builtin_amdgcn_mfma_f32_16x16x32_bf16(vb[s2][et], sf[it][s2], OT[et][it], 0, 0, 0);
                RET_SB();
#pragma unroll
                for (int it = 0; it < 4; ++it) { const float rf = __builtin_amdgcn_exp2f((float)(16 * it + cl - 63) * lg2v);
#pragma unroll
                    for (int et = 0; et < 2; ++et) *(LAS v2u*)(lds + vo + (16 * it + c) * V_LD + (32 * wb + 16 * et + 4 * g) * 2) = (v2u){pk2(OT[et][it][0] * rf, OT[et][it][1] * rf), pk2(OT[et][it][2] * rf, OT[et][it][3] * rf)}; }
            }
        }
        RET_BAR();
    }
#undef RET_OSTORE
#undef RET_LOADK
#undef RET_LOADQ
#undef RET_STAGEK
#undef RET_STAGEQ
#undef RET_LOADB
#undef RET_STAGEB
#undef RET_ROWBASE
    if (RET_PRIO) __builtin_amdgcn_s_setprio(0);
    return RETP_CLK ? (tacc_ >> 4) : tacc_;
}
}
__device__ __forceinline__ void ph_retention(Frame& F, const Args& A, int j2, int noctx) {
    for (int item = F.vcu; item < 512; item += F.G) {
        const int es = item & 3, dir = (item >> 2) & 1, h = (item >> 3) & 7, b = item >> 6;
        const float lg = (dir ? IN_LDB(F) : IN_LDF(F))[j2 * 8 + h];
#ifndef RET_SPEC
#define RET_SPEC 2
#endif
#if RET_SPEC == 2
        const unsigned tk_ = ret::ret_item_regst(F.lds + RING_OFF, WSB(F, WS_P), dir ? WSB(F, WS_OB) : WSB(F, WS_OF), b, h, dir, es, lg, noctx);
        if (RETP_T && F.vcu == 0 && F.wave == RETP_WAVE && (tid_opaque() & 63) == 0) __hip_atomic_fetch_add(F.ctl + 20000, tk_, __ATOMIC_RELAXED, __HIP_MEMORY_SCOPE_AGENT);
#elif RET_SPEC
        ret::ret_item_spec(F.lds + RING_OFF, WSB(F, WS_P), dir ? WSB(F, WS_OB) : WSB(F, WS_OF), b, h, dir, es, lg, noctx);
#else
        ret::ret_item(F.lds + RING_OFF, WSB(F, WS_P), dir ? WSB(F, WS_OB) : WSB(F, WS_OF), b, h, dir, es, lg);
#endif
    }
}
__global__ void __launch_bounds__(NWAVES * 64, 2) dit_fwd(Args args) {
    extern __shared__ __attribute__((aligned(16))) unsigned char lds[];
    Frame F0;
    F0.lds = (LAS unsigned char*)lds;
    F0.MISC = (volatile LAS unsigned*)(F0.lds + MISC_OFF);
    F0.wave = __builtin_amdgcn_readfirstlane((int)threadIdx.x >> 6);
    F0.G = gridDim.x; { const int bx = blockIdx.x; F0.vcu = (F0.G % 8 == 0) ? (bx % 8) * (F0.G / 8) + bx / 8 : bx; }
    F0.ws = (GAS unsigned char*)args.ws; F0.out = (GAS float*)args.out;
    F0.ctl = (gu32*)(F0.ws + WS_CTL);
    for (int u = threadIdx.x; u < (LDS_BYTES - LDSCTL_OFF) / 4; u += NWAVES * 64) ((LAS unsigned*)(F0.lds + LDSCTL_OFF))[u] = 0u;
    __syncthreads();
    XcdBarrier bar; bar.bar = (unsigned*)(F0.ctl + CW_BAR); bar.x = 0; bar.st = nullptr;
    if (MK_N_LAUNCHES == 1) bar = xcd_barrier_post((unsigned*)(F0.ctl + CW_BAR), F0.MISC + 8);
    const int lo = args.ph_lo, hi = args.ph_hi;
#ifndef LATE_F_FIN
#define LATE_F_FIN 0
#endif
#ifndef LATE_F_EVEN
#define LATE_F_EVEN 15
#endif
#ifndef LATE_F_ODD
#define LATE_F_ODD 30
#endif
#ifndef RESID_G
#define RESID_G 0
#endif
#ifndef GEMM_SP2
#define GEMM_SP2 true
#endif
#ifndef GEMM_ALIGN
#define GEMM_ALIGN true
#endif
#ifndef PROBE_BAR2
#define PROBE_BAR2 0
#endif
#ifndef SPLITK
#define SPLITK 0
#endif
#ifndef SITE_MASK
#define SITE_MASK 0xffffffffu
#endif
#define SITE(n) (((SITE_MASK) >> (n)) & 1u)
#define IN(k) (lo <= (k) && (k) < hi)
#define SEAM(k) do { if ((k) + 1 < hi) { if (MK_N_LAUNCHES == 1) { XcdBarrier bv_ = bar; asm volatile("" : "+s"(bv_.bar)); xcd_barrier(bv_); if (PROBE_BAR2) { XcdBarrier bw_ = bar; asm volatile("" : "+s"(bw_.bar)); xcd_barrier(bw_); } } } } while (0)
#define LAUNDER(Fv) Frame Fv = F0; asm volatile("" : "+s"(Fv.ws), "+s"(Fv.out), "+s"(Fv.G), "+s"(Fv.vcu), "+s"(Fv.wave), "+s"(cid))
#define GEMM_CALL1(EPI, g_, S_, E_) pg8::gemm_phase<EPI, pg8::TokOrder, GEMM_ALIGN, GEMM_SP2>(F.lds + RING_OFF, g_, S_, E_)
#ifdef PROBE_GEMM_STORE2
#define GEMM_CALL(EPI, g_, S_, E_) do { for (int rep_ = 0; rep_ < 2; ++rep_) { GEMM_CALL1(EPI, g_, S_, E_); __syncthreads(); } } while (0)
#else
#define GEMM_CALL(EPI, g_, S_, E_) GEMM_CALL1(EPI, g_, S_, E_)
#endif
#ifdef PROBE_GEMM_RESID2
#define GEMM_CALLR(g_, S_, E_) do { pg8::EpiResid E2_ = E_; for (int rep_ = 0; rep_ < 2; ++rep_) { E2_.dry = rep_; GEMM_CALL1(pg8::EpiResid, g_, S_, E2_); __syncthreads(); } } while (0)
#else
#define GEMM_CALLR(g_, S_, E_) GEMM_CALL1(pg8::EpiResid, g_, S_, E_)
#endif
    int cid = (int)blockIdx.x;

    if (SITE(0) && IN(0)) { LAUNDER(F); ph_prologue(F, args);
#ifdef PROBE_PRO2
        __syncthreads(); { LAUNDER(F2); ph_prologue(F2, args); }
#endif
        SEAM(0); }
    for (int L = 0; L < 4; ++L) {
        const int pb = 1 + 9 * L, j2 = L >> 1, even = !(L & 1), last = (L == 3);
        if (SITE(1) && IN(pb + 0)) { LAUNDER(F); ph_modulate(F, args, L, 0, 0, SPLITK && L >= 1, L == 0);
#ifdef PROBE_MOD2
            { LAUNDER(F2); ph_modulate(F2, args, L, 0, 0, 0, L == 0); }
#endif
            SEAM(pb + 0); }
        if (SITE(2) && IN(pb + 1)) { LAUNDER(F);
            const int N = even ? EIN : OIN;
            pg8::Gemm g{WSB(F, WS_XN), even ? WSB(F, WS_W_INE) + (size_t)j2 * EIN * DM : WSB(F, WS_W_INO) + (size_t)j2 * OIN * DM, MROWS, N, DM};
            pg8::TokOrder S; if (last) S.init2(MLAT, N, DM, F.G, cid, 1, 0, 1); else S.init2(MROWS, N, DM, F.G, cid, 0, 0);
            pg8::EpiStore E{WSB(F, WS_P), N, even ? 0 : 3, WSF(F, WS_ROPE_O)};
            GEMM_CALL(pg8::EpiStore, g, S, E);
            SEAM(pb + 1);
        }
        if (even) {
            if (SITE(3) && IN(pb + 2)) { LAUNDER(F); ph_qk_even(F, args, j2); SEAM(pb + 2); }
            if (IN(pb + 3)) {
                if (SITE(4)) { LAUNDER(F); pg8::Gemm g{WSB(F, WS_WTL), WSB(F, WS_FT), 4096, 4096, 2048}; pg8::TokOrder S; S.init2(4096, 4096, 2048, F.G, cid, 0, 0); pg8::EpiStore E{WSB(F, WS_Z), 1024, 1, nullptr}; GEMM_CALL(pg8::EpiStore, g, S, E); }
                if (SITE(14)) { LAUNDER(F); pg8::Gemm g{WSB(F, WS_WTC), WSB(F, WS_FTC), 512, 4096, 256}; pg8::TokOrder S; S.init2(512, 4096, 256, F.G, cid, 0, 0); pg8::EpiStore E{WSB(F, WS_Z), 1024, 2, nullptr}; GEMM_CALL(pg8::EpiStore, g, S, E); }
                if (SITE(5)) { LAUNDER(F); ph_attention(F, args, j2); }
#ifdef PROBE_ATT2
                { LAUNDER(F); ph_attention(F, args, j2); }
#endif
                SEAM(pb + 3);
            }
            if (SITE(6) && IN(pb + 4)) { LAUNDER(F);
                pg8::Gemm g{WSB(F, WS_Z), WSB(F, WS_CB), MROWS, 512, 1024}; pg8::TokOrder S; S.init2(MROWS, 512, 1024, F.G, cid, 0, 0); pg8::EpiStore E{WSB(F, WS_MIX), DM, 0, nullptr};
                GEMM_CALL(pg8::EpiStore, g, S, E);
                SEAM(pb + 4);
            }
        } else {
            if (SITE(8) && IN(pb + 3)) { LAUNDER(F); ph_retention(F, args, j2, last);
#ifdef PROBE_RET2
                { LAUNDER(F2); ph_retention(F2, args, j2, last); }
#endif
                SEAM(pb + 3); }
            if (SITE(9) && IN(pb + 4)) { LAUNDER(F); ph_comb(F, last);
#ifdef PROBE_COMB2
                { LAUNDER(F2); ph_comb(F2, last, 1); }
#endif
                SEAM(pb + 4); }
        }
        if (SITE(10) && IN(pb + 5)) { LAUNDER(F); const float* gates = WSF(F, WS_MOD) + (size_t)L * NSET * MODW;
            const int K = even ? DM : OMIX, Ml = last ? MLAT : MROWS;
            pg8::Gemm g{even ? WSB(F, WS_MIX) : WSB(F, WS_OF), even ? WSB(F, WS_W_OUTE) + (size_t)j2 * DM * DM : WSB(F, WS_W_OUTO) + (size_t)j2 * DM * OMIX, Ml, DM, K};
            pg8::TokOrder S; S.init2(Ml, DM, K, F.G, cid, last, SPLITK && L > 0, 0, last ? 0 : RESID_G);
            pg8::EpiResid E{WSF(F, WS_H), gates, 2 * DM, nullptr, WSF(F, WS_DELTA), 0, L == 0 ? (const float*)(const GAS float*)args.in[0] : nullptr, (const float*)(const GAS float*)args.in[2]};
            GEMM_CALLR(g, S, E);
#if LATE_CONV
            if (!last && cid >= S.rem && S.rem > 0) { const int cnt = conv_layer_count(L + 1), c0 = (cnt * LATE_F_FIN) / 100, c1 = c0 + (cnt * (even ? LATE_F_EVEN : LATE_F_ODD)) / 100;
                conv_in_tail(F, args, L + 1, c0, c1, cid - S.rem, F.G - S.rem); }
#endif
            SEAM(pb + 5);
        }
        if (SITE(11) && IN(pb + 6)) { LAUNDER(F); ph_modulate(F, args, L, 1, last, SPLITK && !last && L > 0, 0);
#ifdef PROBE_MOD2
            { LAUNDER(F2); ph_modulate(F2, args, L, 1, last, 0, 0); }
#endif
            SEAM(pb + 6); }
        if (SITE(12) && IN(pb + 7)) { LAUNDER(F);
            const int Ml = last ? MLAT : MROWS;
            pg8::Gemm g{WSB(F, WS_XN), WSB(F, WS_W_FIN) + (size_t)L * FFN2 * DM, Ml, FFN2, DM};
            pg8::TokOrder S; S.init2(Ml, FFN2, DM, F.G, cid, last, 0);
            pg8::EpiSwiglu E{WSB(F, WS_P), FFN};
            GEMM_CALL(pg8::EpiSwiglu, g, S, E);
#if LATE_CONV
            if (!last && LATE_F_FIN > 0 && cid >= S.rem && S.rem > 0) { const int cnt = conv_layer_count(L + 1), c0 = (cnt * LATE_F_FIN) / 100;
                conv_in_tail(F, args, L + 1, 0, c0, cid - S.rem, F.G - S.rem); }
#endif
            SEAM(pb + 7);
        }
        if (SITE(13) && IN(pb + 8)) { LAUNDER(F); const float* gates = WSF(F, WS_MOD) + (size_t)L * NSET * MODW;
            const int Ml = last ? MLAT : MROWS;
            pg8::Gemm g{WSB(F, WS_P), WSB(F, WS_W_FOUT) + (size_t)L * DM * FFN, Ml, DM, FFN};
            pg8::TokOrder S; S.init2(Ml, DM, FFN, F.G, cid, last, SPLITK, 0, last ? 0 : RESID_G);
            pg8::EpiResid E{WSF(F, WS_H), gates, 5 * DM, last ? (float*)F.out : nullptr, WSF(F, WS_DELTA), 0, nullptr, nullptr};
            GEMM_CALLR(g, S, E);
#if LATE_CONV
            if (!last && cid >= S.rem && S.rem > 0) { const int cnt = conv_layer_count(L + 1), c1 = (cnt * LATE_F_FIN) / 100 + (cnt * (even ? LATE_F_EVEN : LATE_F_ODD)) / 100;
                conv_in_tail(F, args, L + 1, c1, cnt, cid - S.rem, F.G - S.rem); }
#endif
            SEAM(pb + 8);
        }
    }
#undef IN
#undef SEAM
#undef LAUNDER
#undef GEMM_CALL
#if RETP_T
#ifndef RETP_MULT
#define RETP_MULT 4
#endif
    if (F0.vcu == 0 && threadIdx.x == 0) {
        const unsigned v_ = __hip_atomic_load(F0.ctl + 20000, __ATOMIC_RELAXED, __HIP_MEMORY_SCOPE_AGENT);
        const unsigned long s_ = __builtin_amdgcn_s_memrealtime();
        while (__builtin_amdgcn_s_memrealtime() - s_ < (unsigned long)v_ * RETP_MULT) __builtin_amdgcn_s_sleep(16);
    }
#endif
}

extern "C" void kernel_launch(void* const* d_in, const int* in_sizes, int n_in, void* d_out, int out_size, void* d_ws, size_t ws_size, hipStream_t stream) {
    static int grid = 0;
    if (grid == 0) {
        if (n_in != 16 || out_size != MLAT * DM || ws_size < WS_END) { fprintf(stderr, "kernel_launch: unexpected shapes: n_in %d out %d ws %zu (need %zu)\n", n_in, out_size, ws_size, (size_t)WS_END); grid = -1; return; }
        int dev = 0, cus = 0, per_cu = 0;
        if (hipGetDevice(&dev) != hipSuccess || hipDeviceGetAttribute(&cus, hipDeviceAttributeMultiprocessorCount, dev) != hipSuccess) { fprintf(stderr, "kernel_launch: device query failed\n"); grid = -1; return; }
        if (hipFuncSetAttribute((const void*)dit_fwd, hipFuncAttributeMaxDynamicSharedMemorySize, LDS_BYTES) != hipSuccess) { fprintf(stderr, "kernel_launch: hipFuncSetAttribute failed\n"); grid = -1; return; }
        if (hipOccupancyMaxActiveBlocksPerMultiprocessor(&per_cu, (const void*)dit_fwd, NWAVES * 64, LDS_BYTES) != hipSuccess || per_cu < 1)
            fprintf(stderr, "kernel_launch: note: occupancy query reports %d workgroups per CU\n", per_cu);
        (void)hipGetLastError();
        grid = cus;
    }
    if (grid < 0) return;
    if (hipMemsetAsync((char*)d_ws + WS_CTL, 0, CTL_ZERO_BYTES, stream) != hipSuccess) { fprintf(stderr, "kernel_launch: memset failed\n"); return; }
    Args a{};
    for (int i = 0; i < 16; ++i) a.in[i] = (const float*)d_in[i];
    a.out = (float*)d_out; a.ws = (unsigned char*)d_ws;
#if MK_N_LAUNCHES == 1
    a.ph_lo = 0; a.ph_hi = N_PHASES;
    hipLaunchKernelGGL(dit_fwd, dim3(grid), dim3(NWAVES * 64), LDS_BYTES, stream, a);
#else
    for (int p = 0; p < N_PHASES; ++p) { a.ph_lo = p; a.ph_hi = p + 1; hipLaunchKernelGGL(dit_fwd, dim3(grid), dim3(NWAVES * 64), LDS_BYTES, stream, a); }
#endif
    const hipError_t le = hipPeekAtLastError();
    if (le != hipSuccess) fprintf(stderr, "kernel_launch: launch failed: %s\n", hipGetErrorName(le));
}
```

```cpp
#include <hip/hip_runtime.h>
#include <cstdio>
#include <cstdint>
#include <cmath>
#ifndef WGM_SET
#define WGM_SET 8
#endif
namespace pg8 {
#define PG8_LAS __attribute__((address_space(3)))
typedef unsigned short bf16_t;
typedef short bf16x8 __attribute__((ext_vector_type(8)));
typedef float f32x4 __attribute__((ext_vector_type(4)));
typedef unsigned u32x4 __attribute__((ext_vector_type(4)));
constexpr int BM = 256, BK = 64, HALF = 128, HTB = HALF * BK * 2  , STAGE_BYTES = 8 * HTB, NXCD = 8, WGM = WGM_SET;

__host__ __device__ __forceinline__ int lds_byte(int r, int c) { const int st = (r >> 4) * 2 + (c >> 5), rr = r & 15, cc = c & 31, ob = rr * 64 + cc * 2; return st * 1024 + (ob ^ (((ob >> 9) & 1) << 5)); }
__host__ __device__ __forceinline__ void stage_rc(int b, int& R, int& C) { const int st = b / 1024, sb = b % 1024, swz = sb ^ (((sb >> 9) & 1) << 5); R = (st >> 1) * 16 + swz / 64; C = (st & 1) * 32 + (swz % 64) / 2; }
__host__ __device__ __forceinline__ int perm32(int rho) { const int n = rho >> 4, i = rho & 15; return 8 * (i >> 2) + 4 * n + (i & 3); }

struct Unit { int pm, pn, kt0, nkt, split; };
struct Gemm { const bf16_t* A; const bf16_t* Bt; int M, N, K; };

#ifndef WGM_WIDE
#define WGM_WIDE WGM
#endif
#ifndef WGM_NARROW
#define WGM_NARROW 2
#endif
struct StaticOrder {
    int nM, nN, nwg, G, c;
    __host__ __device__ void init(int M, int N, int G_, int c_) { nM = M / BM; nN = N / BM; nwg = nM * nN; G = G_; c = c_; }
    __host__ __device__ void map(int wgid, Unit& u) const {
        { const int q = nwg / NXCD, r = nwg % NXCD, xcd = wgid % NXCD, off = wgid / NXCD; wgid = (xcd < r ? xcd * (q + 1) : r * (q + 1) + (xcd - r) * q) + off; }
        const int wgm = nN >= 12 ? WGM_WIDE : WGM_NARROW;
        const int nig = wgm * nN, gid = wgid / nig, fm = gid * wgm, gsz = (nM - fm) < wgm ? (nM - fm) : wgm;
        u.pm = fm + ((wgid % nig) % gsz); u.pn = (wgid % nig) / gsz;
    }
    __device__ __forceinline__ void a_ready(const Unit&) const {}
    __device__ __forceinline__ void done(const Unit&) const {}
};

typedef __bf16 bf16x2_cv __attribute__((ext_vector_type(2)));
typedef float f32x2_cv __attribute__((ext_vector_type(2)));
__device__ __forceinline__ unsigned cvt_pk_bf16(float lo, float hi) { const f32x2_cv v = {lo, hi}; const bf16x2_cv b = __builtin_convertvector(v, bf16x2_cv); return __builtin_bit_cast(unsigned, b); }
typedef float f32x2 __attribute__((ext_vector_type(2)));
#ifndef WT_STORES
#define WT_STORES 0
#endif
__device__ __forceinline__ void st16_wt(void* p, u32x4 v) {
#if WT_STORES
    asm volatile("global_store_dwordx4 %0, %1, off sc1" :: "v"(p), "v"(v) : "memory");
#else
    *(u32x4*)p = v;
#endif
}
__device__ __forceinline__ void st16_wt(void* p, f32x4 v) { st16_wt(p, __builtin_bit_cast(u32x4, v)); }
#ifndef WT_HID
#define WT_HID 0
#endif
__device__ __forceinline__ void st16_hid(void* p, u32x4 v) {
#if WT_HID
    asm volatile("global_store_dwordx4 %0, %1, off sc1" :: "v"(p), "v"(v) : "memory");
#else
    *(u32x4*)p = v;
#endif
}
#ifndef GEMM_G_LIMIT
#define GEMM_G_LIMIT 0
#endif
struct TokOrder : StaticOrder {
    int skip, nktfull, nfull, rem, S, nextra;
    __device__ __forceinline__ void init2(int M, int N, int K, int G_, int c_, int skip_, int allow_split, int ctxkv = 0, int glimit = 0) {
        init(M, N, G_, c_); if (glimit > 0 && glimit < G_) G = glimit;     if (GEMM_G_LIMIT > 0 && GEMM_G_LIMIT < G_) { G = GEMM_G_LIMIT; }     skip = skip_; nktfull = K / BK; nfull = (nwg / G) * G; rem = nwg - nfull; S = 1; nextra = ctxkv ? 8 * 24 : 0;
        if (allow_split && rem > 0) { const int s = G / rem; S = s >= 4 ? 4 : 1;     if ((nktfull % (2 * S)) != 0 || nktfull / S < 4) S = 1; }
    }
    __device__ __forceinline__ bool next(int i, Unit& u) const {
        if (c >= G) return false;
        const long L = (long)i * G + c; int idx;
        if (L < nfull || S == 1) {
            if (L >= nwg) { const int r = (int)(L - nwg); if (r >= nextra) return false; u.kt0 = 0; u.nkt = nktfull; u.split = 0; u.pm = 9 * (r / 24) + 8; u.pn = 8 + r % 24; return true; }
            idx = (int)L; u.kt0 = 0; u.nkt = nktfull; u.split = 0; }
        else { const int sub = (int)(L - nfull); if (sub >= rem * S) return false; idx = nfull + sub / S; u.nkt = nktfull / S; u.kt0 = (sub % S) * u.nkt; u.split = 1 + (sub / S) * 4 + (sub % S); }
        map(idx, u); if (skip) u.pm += (u.pm >> 3); return true;
    }
};
struct EpiStore {
    static constexpr bool PERM = true, AFTER_DRAIN = false;
    bf16_t* O; int ldc; int mode; const float* rope;
    __device__ __forceinline__ void operator()(const f32x4 (&acc)[2][2][4][2], const Unit& u, int wr, int wc, int fr, int fq) const {
        size_t base, bjs = HALF; int ld = ldc;
        if (mode == 3) {
            constexpr size_t RP = (size_t)18432 * 256;
            if (u.pn < 32) { ld = u.pn < 16 ? 256 : 128; base = (size_t)u.pn * RP + (size_t)u.pm * BM * (size_t)ld; if (u.pn >= 16) bjs = RP / 2; }
            else { ld = 4096; base = 32 * RP + (size_t)u.pm * BM * (size_t)4096 + (size_t)(u.pn - 32) * BM; }
        }
        else if (mode == 0) base = (size_t)u.pm * BM * (size_t)ldc + (size_t)u.pn * BM;
        else if (mode == 1) { const int part = u.pm >> 3, t0 = (u.pm & 7) * 256, b = u.pn >> 1, c0 = (u.pn & 1) * 256; base = ((size_t)(b * 2304 + t0)) * 1024 + part * 512 + c0; }
        else { const int part = u.pm, b = u.pn >> 1, c0 = (u.pn & 1) * 256; base = ((size_t)(b * 2304 + 2048)) * 1024 + part * 512 + c0; }
        const int tt = u.pm % 9;
        if (mode == 3 && u.pn < 16 && tt != 8) {
            const int half = wc >> 1, f0 = 32 * (wc & 1) + 8 * fq;
            bf16_t* p0 = O + base + (size_t)(wr * 64 + fr) * ld + half * 128 + f0;
#pragma unroll
            for (int ai = 0; ai < 2; ++ai)
#pragma unroll
                for (int m = 0; m < 4; ++m) { const int t = tt * 256 + ai * HALF + wr * 64 + m * 16 + fr, pos = half ? (t & 63) : (t >> 6);
                    const f32x4* tb = (const f32x4*)(rope + (size_t)(pos * 64 + f0) * 2);
                    const f32x4 t0 = tb[0], t1 = tb[1], t2 = tb[2], t3 = tb[3];
                    const f32x4 a0 = acc[ai][0][m][0], a1 = acc[ai][0][m][1], b0 = acc[ai][1][m][0], b1 = acc[ai][1][m][1];
                    const f32x4 cs0 = {t0[0], t0[2], t1[0], t1[2]}, sn0 = {t0[1], t0[3], t1[1], t1[3]}, cs1 = {t2[0], t2[2], t3[0], t3[2]}, sn1 = {t2[1], t2[3], t3[1], t3[3]};
                    const f32x4 x0 = a0 * cs0 - b0 * sn0, x1 = a1 * cs1 - b1 * sn1, y0 = b0 * cs0 + a0 * sn0, y1 = b1 * cs1 + a1 * sn1;
                    bf16_t* rowp = p0 + (size_t)(ai * HALF + m * 16) * ld;
                    u32x4 w; w.x = cvt_pk_bf16(x0[0], x0[1]); w.y = cvt_pk_bf16(x0[2], x0[3]); w.z = cvt_pk_bf16(x1[0], x1[1]); w.w = cvt_pk_bf16(x1[2], x1[3]);
                    st16_wt(rowp, w);
                    w.x = cvt_pk_bf16(y0[0], y0[1]); w.y = cvt_pk_bf16(y0[2], y0[3]); w.z = cvt_pk_bf16(y1[0], y1[1]); w.w = cvt_pk_bf16(y1[2], y1[3]);
                    st16_wt(rowp + 64, w); }
            return;
        }
        if (mode == 3 && u.pn < 16) {
            const int half = wc >> 1, f0 = 32 * (wc & 1) + 8 * fq;
            bf16_t* p0 = O + base + (size_t)(wr * 64 + fr) * ld + half * 128 + f0;
#pragma unroll
            for (int ai = 0; ai < 2; ++ai)
#pragma unroll
                for (int m = 0; m < 4; ++m) { bf16_t* rowp = p0 + (size_t)(ai * HALF + m * 16) * ld;
#pragma unroll
                    for (int bj = 0; bj < 2; ++bj) { const f32x4 v0 = acc[ai][bj][m][0], v1 = acc[ai][bj][m][1];
                        u32x4 w; w.x = cvt_pk_bf16(v0[0], v0[1]); w.y = cvt_pk_bf16(v0[2], v0[3]); w.z = cvt_pk_bf16(v1[0], v1[1]); w.w = cvt_pk_bf16(v1[2], v1[3]);
                        st16_wt(rowp + bj * 64, w); } }
            return;
        }
        bf16_t* p0 = O + base + (size_t)(wr * 64 + fr) * ld + wc * 32 + 8 * fq;
#pragma unroll
        for (int ai = 0; ai < 2; ++ai)
#pragma unroll
            for (int m = 0; m < 4; ++m) { bf16_t* rowp = p0 + (size_t)(ai * HALF + m * 16) * ld;
#pragma unroll
                for (int bj = 0; bj < 2; ++bj) { const f32x4 v0 = acc[ai][bj][m][0], v1 = acc[ai][bj][m][1];
                    u32x4 w; w.x = cvt_pk_bf16(v0[0], v0[1]); w.y = cvt_pk_bf16(v0[2], v0[3]); w.z = cvt_pk_bf16(v1[0], v1[1]); w.w = cvt_pk_bf16(v1[2], v1[3]);
                    st16_wt(rowp + bj * bjs, w); } }
    }
};
__device__ __forceinline__ float silu_f(float g) { return g * __builtin_amdgcn_rcpf(1.0f + __builtin_amdgcn_exp2f(-1.4426950408889634f * g)); }
struct EpiSwiglu {
    static constexpr bool PERM = true, AFTER_DRAIN = false;
    bf16_t* H; int ldh;
    __device__ __forceinline__ void operator()(const f32x4 (&acc)[2][2][4][2], const Unit& u, int wr, int wc, int fr, int fq) const {
        bf16_t* p0 = H + (size_t)(u.pm * BM + wr * 64 + fr) * ldh + u.pn * HALF + wc * 32 + 8 * fq;
#pragma unroll
        for (int ai = 0; ai < 2; ++ai)
#pragma unroll
            for (int m = 0; m < 4; ++m) { bf16_t* rowp = p0 + (size_t)(ai * HALF + m * 16) * ldh;
                const f32x4 g0 = acc[ai][0][m][0], g1 = acc[ai][0][m][1], u0 = acc[ai][1][m][0], u1 = acc[ai][1][m][1];
                u32x4 w; w.x = cvt_pk_bf16(silu_f(g0[0]) * u0[0], silu_f(g0[1]) * u0[1]); w.y = cvt_pk_bf16(silu_f(g0[2]) * u0[2], silu_f(g0[3]) * u0[3]);
                w.z = cvt_pk_bf16(silu_f(g1[0]) * u1[0], silu_f(g1[1]) * u1[1]); w.w = cvt_pk_bf16(silu_f(g1[2]) * u1[2], silu_f(g1[3]) * u1[3]);
                st16_hid(rowp, w); }
    }
};
#ifndef EPI_RB
#define EPI_RB 2
#endif
struct EpiResid {
    static constexpr bool PERM = true, AFTER_DRAIN = false;
    float* h; const float* gates; int goff; float* out; float* delta; int dry; const float* x0; const float* c0;
    __device__ __forceinline__ void operator()(const f32x4 (&acc)[2][2][4][2], const Unit& u, int wr, int wc, int fr, int fq) const {
        const int b = u.pm / 9, tt = u.pm - 9 * b, set = (tt == 8) ? 8 : b;
        const int col0 = u.pn * BM + wc * 32 + 8 * fq;
        const float* gp = gates + (size_t)set * 12288 + goff + col0;
        f32x4 gv[2][2];
#pragma unroll
        for (int bj = 0; bj < 2; ++bj)
#pragma unroll
            for (int n = 0; n < 2; ++n) { gv[bj][n] = *(const f32x4*)(gp + bj * HALF + n * 4); if (dry) gv[bj][n] = gv[bj][n] * 0.0f; }
        const int rl = wr * 64 + fr;
        const float* hp = (x0 && !dry) ? (tt == 8 ? c0 + (size_t)(b * 256 + rl) * 2048 + col0 : x0 + (size_t)(b * 2048 + tt * 256 + rl) * 2048 + col0) : h + (size_t)(u.pm * BM + rl) * 2048 + col0;
        float* op = (out && !dry) ? out + (size_t)(b * 2048 + tt * 256 + rl) * 2048 + col0 : h + (size_t)(u.pm * BM + rl) * 2048 + col0;
        if (u.split && dry) return;
        if (u.split) {
            float* sp = delta + (size_t)(u.split - 1) * 65536 + (size_t)rl * 256 + wc * 32 + 8 * fq;
#pragma unroll
            for (int ai = 0; ai < 2; ++ai)
#pragma unroll
                for (int m = 0; m < 4; ++m)
#pragma unroll
                    for (int bj = 0; bj < 2; ++bj)
#pragma unroll
                        for (int n = 0; n < 2; ++n) *(f32x4*)(sp + (ai * HALF + m * 16) * 256 + bj * HALF + n * 4) = gv[bj][n] * acc[ai][bj][m][n];
            return;
        }
#pragma unroll
        for (int ai = 0; ai < 2; ++ai)
#pragma unroll
            for (int mp = 0; mp < 4; mp += EPI_RB) {
                f32x4 hv[EPI_RB][2][2];
#pragma unroll
                for (int mm = 0; mm < EPI_RB; ++mm)
#pragma unroll
                    for (int bj = 0; bj < 2; ++bj)
#pragma unroll
                        for (int n = 0; n < 2; ++n) hv[mm][bj][n] = *(const f32x4*)(hp + (size_t)(ai * HALF + (mp + mm) * 16) * 2048 + bj * HALF + n * 4);
                asm volatile("" ::: "memory");
#pragma unroll
                for (int mm = 0; mm < EPI_RB; ++mm) { const int m = mp + mm; const size_t ro = (size_t)(ai * HALF + m * 16) * 2048;
#pragma unroll
                    for (int bj = 0; bj < 2; ++bj)
#pragma unroll
                        for (int n = 0; n < 2; ++n) st16_wt(op + ro + bj * HALF + n * 4, hv[mm][bj][n] + gv[bj][n] * acc[ai][bj][m][n]); }
                asm volatile("" ::: "memory"); }
    }
};

template <class Epi, class Sched, bool ALIGN_EPI = false, bool SP2 = false>
__device__ __forceinline__ void gemm_phase(PG8_LAS unsigned char* lds, const Gemm g, const Sched& S, const Epi& E) {
    int tid = threadIdx.x; asm volatile("" : "+v"(tid));
    const int wid = __builtin_amdgcn_readfirstlane(tid >> 6), lane = tid & 63, wr = wid >> 2, wc = wid & 3, fr = lane & 15, fq = lane >> 4;
    const int K = g.K;
    unsigned voffA[2], voffB[2];
#pragma unroll
    for (int i = 0; i < 2; ++i) { int R, C; stage_rc(tid * 16 + i * 8192, R, C); const int Rb = Epi::PERM ? ((R & ~31) + perm32(R & 31)) : R;
        voffA[i] = (unsigned)(R * K + C) * 2u; voffB[i] = (unsigned)(Rb * K + C) * 2u; }
    const size_t kstep = (size_t)(BK * 2);
    const size_t hstep = (size_t)HALF * K * 2;
    const size_t tstep = 2 * hstep;
    const unsigned ldsw = (unsigned)wid * 1024u;
    const int aoff = lds_byte(wr * 64 + fr, fq * 8), boff = lds_byte(wc * 32 + fr, fq * 8);
#define PG8_SA(b, h) (((b) * 2 + (h)) * HTB)
#define PG8_SB(b, h) ((4 + (b) * 2 + (h)) * HTB)
#define PG8_STAGE(bufoff, gbase, voff) do { _Pragma("unroll") for (int _i = 0; _i < 2; ++_i) \
        __builtin_amdgcn_global_load_lds((const unsigned*)((const char*)(gbase) + (voff)[_i]), (PG8_LAS unsigned*)(lds + (bufoff) + ldsw + _i * 8192), 16, 0, 0); } while (0)
#define PG8_LDA(dst, b, h) do { _Pragma("unroll") for (int m = 0; m < 4; ++m) _Pragma("unroll") for (int k = 0; k < 2; ++k) dst[m][k] = *(const PG8_LAS bf16x8*)(lds + PG8_SA(b, h) + aoff + m * 2048 + k * 1024); } while (0)
#define PG8_LDB(dst, b, h) do { _Pragma("unroll") for (int n = 0; n < 2; ++n) _Pragma("unroll") for (int k = 0; k < 2; ++k) dst[n][k] = *(const PG8_LAS bf16x8*)(lds + PG8_SB(b, h) + boff + n * 2048 + k * 1024); } while (0)
#define PG8_MMA(ai, bj, At, Bt) do { __builtin_amdgcn_s_setprio(1); _Pragma("unroll") for (int m = 0; m < 4; ++m) _Pragma("unroll") for (int n = 0; n < 2; ++n) _Pragma("unroll") for (int k = 0; k < 2; ++k) \
        acc[ai][bj][m][n] = __builtin_amdgcn_mfma_f32_16x16x32_bf16(Bt[n][k], At[m][k], acc[ai][bj][m][n], 0, 0, 0); __builtin_amdgcn_s_setprio(0); } while (0)
#define PG8_WAIT_V(n) asm volatile("s_waitcnt vmcnt(" #n ")" ::: "memory")
#define PG8_WAIT_L(n) asm volatile("s_waitcnt lgkmcnt(" #n ")" ::: "memory")
#define PG8_BAR __builtin_amdgcn_s_barrier()
#define PG8_SCHED __builtin_amdgcn_sched_barrier(0)
    Unit cur, nxt; int ui = 0;
    if (!S.next(0, cur)) return;
    f32x4 acc[2][2][4][2];
#pragma unroll
    for (int a = 0; a < 2; ++a)
#pragma unroll
        for (int b = 0; b < 2; ++b)
#pragma unroll
            for (int m = 0; m < 4; ++m)
#pragma unroll
                for (int n = 0; n < 2; ++n) acc[a][b][m][n] = (f32x4){0.f, 0.f, 0.f, 0.f};
    bf16x8 At[4][2], B0[2][2], B1[2][2];
    const char* cA = (const char*)g.A + (size_t)cur.pm * tstep + (size_t)cur.kt0 * kstep; const char* cB = (const char*)g.Bt + (size_t)cur.pn * tstep + (size_t)cur.kt0 * kstep;
    S.a_ready(cur);
    if constexpr (SP2) {
        PG8_STAGE(PG8_SB(0, 0), cB, voffB); PG8_STAGE(PG8_SB(0, 1), cB + hstep, voffB); PG8_STAGE(PG8_SA(0, 0), cA, voffA); PG8_STAGE(PG8_SA(0, 1), cA + hstep, voffA);
        if (wr == 1) PG8_BAR;
        PG8_WAIT_V(2); PG8_BAR;
        PG8_STAGE(PG8_SB(1, 0), cB + kstep, voffB); PG8_STAGE(PG8_SA(1, 0), cA + kstep, voffA); PG8_STAGE(PG8_SB(1, 1), cB + hstep + kstep, voffB);
        PG8_WAIT_V(6); PG8_BAR;
    } else {
        PG8_STAGE(PG8_SB(0, 0), cB, voffB); PG8_STAGE(PG8_SA(0, 0), cA, voffA); PG8_STAGE(PG8_SB(0, 1), cB + hstep, voffB); PG8_STAGE(PG8_SA(0, 1), cA + hstep, voffA);
        if (wr == 1) PG8_BAR;
        PG8_WAIT_V(4); PG8_BAR;
        PG8_STAGE(PG8_SB(1, 0), cB + kstep, voffB); PG8_STAGE(PG8_SA(1, 0), cA + kstep, voffA); PG8_STAGE(PG8_SB(1, 1), cB + hstep + kstep, voffB);
        PG8_WAIT_V(6); PG8_BAR;
    }
    for (;;) {
        const bool has_next = S.next(ui + 1, nxt);
        const char* nA = has_next ? (const char*)g.A + (size_t)nxt.pm * tstep + (size_t)nxt.kt0 * kstep : cA; const char* nB = has_next ? (const char*)g.Bt + (size_t)nxt.pn * tstep + (size_t)nxt.kt0 * kstep : cB;
        const int nt = cur.nkt;
        for (int t = 0; t < nt; t += 2) {
            const bool last = (t == nt - 2);
            const char* a1 = cA + (size_t)(t + 1) * kstep;
            const char* a2 = last ? nA : cA + (size_t)(t + 2) * kstep; const char* b2 = last ? nB : cB + (size_t)(t + 2) * kstep;
            const char* a3 = a2 + kstep; const char* b3 = b2 + kstep;
            if (last && has_next) S.a_ready(nxt);
            if constexpr (SP2) {
            PG8_LDB(B0, 0, 0); PG8_LDB(B1, 0, 1); PG8_SCHED; PG8_LDA(At, 0, 0); PG8_STAGE(PG8_SA(1, 1), a1 + hstep, voffA);
            PG8_WAIT_V(8); PG8_WAIT_L(0); PG8_BAR; PG8_MMA(0, 0, At, B0); PG8_MMA(0, 1, At, B1); PG8_BAR; PG8_SCHED;
            PG8_LDA(At, 0, 1); PG8_STAGE(PG8_SB(0, 0), b2, voffB); PG8_STAGE(PG8_SB(0, 1), b2 + hstep, voffB); PG8_STAGE(PG8_SA(0, 0), a2, voffA);
            PG8_WAIT_V(8); PG8_WAIT_L(0); PG8_BAR; PG8_MMA(1, 0, At, B0); PG8_MMA(1, 1, At, B1); PG8_BAR; PG8_SCHED;
            PG8_LDB(B0, 1, 0); PG8_LDB(B1, 1, 1); PG8_SCHED; PG8_LDA(At, 1, 0); PG8_STAGE(PG8_SA(0, 1), a2 + hstep, voffA);
            PG8_WAIT_V(8); PG8_WAIT_L(0); PG8_BAR; PG8_MMA(0, 0, At, B0); PG8_MMA(0, 1, At, B1); PG8_BAR; PG8_SCHED;
            PG8_LDA(At, 1, 1); PG8_STAGE(PG8_SB(1, 0), b3, voffB); PG8_STAGE(PG8_SB(1, 1), b3 + hstep, voffB); PG8_STAGE(PG8_SA(1, 0), a3, voffA);
            PG8_WAIT_V(8); PG8_WAIT_L(0); PG8_BAR; PG8_MMA(1, 0, At, B0); PG8_MMA(1, 1, At, B1); PG8_BAR; PG8_SCHED;
            } else {
            PG8_LDB(B0, 0, 0); PG8_SCHED; PG8_LDA(At, 0, 0); PG8_STAGE(PG8_SA(1, 1), a1 + hstep, voffA);
            PG8_WAIT_L(8); PG8_BAR; PG8_WAIT_L(0); PG8_MMA(0, 0, At, B0); PG8_BAR; PG8_SCHED;
            PG8_LDB(B1, 0, 1); PG8_STAGE(PG8_SB(0, 0), b2, voffB);
            PG8_BAR; PG8_WAIT_L(0); PG8_MMA(0, 1, At, B1); PG8_BAR;
            PG8_LDA(At, 0, 1); PG8_STAGE(PG8_SA(0, 0), a2, voffA);
            PG8_BAR; PG8_WAIT_L(0); PG8_MMA(1, 0, At, B0); PG8_BAR; PG8_SCHED;
            PG8_STAGE(PG8_SB(0, 1), b2 + hstep, voffB);
            PG8_WAIT_V(6); PG8_BAR; PG8_MMA(1, 1, At, B1); PG8_BAR;
            PG8_LDB(B0, 1, 0); PG8_SCHED; PG8_LDA(At, 1, 0); PG8_STAGE(PG8_SA(0, 1), a2 + hstep, voffA);
            PG8_WAIT_L(8); PG8_BAR; PG8_WAIT_L(0); PG8_MMA(0, 0, At, B0); PG8_BAR; PG8_SCHED;
            PG8_LDB(B1, 1, 1); PG8_STAGE(PG8_SB(1, 0), b3, voffB);
            PG8_BAR; PG8_WAIT_L(0); PG8_MMA(0, 1, At, B1); PG8_BAR;
            PG8_LDA(At, 1, 1); PG8_STAGE(PG8_SA(1, 0), a3, voffA);
            PG8_BAR; PG8_WAIT_L(0); PG8_MMA(1, 0, At, B0); PG8_BAR; PG8_SCHED;
            PG8_STAGE(PG8_SB(1, 1), b3 + hstep, voffB);
            PG8_WAIT_V(6); PG8_BAR; PG8_MMA(1, 1, At, B1); PG8_BAR;
            }
        }
        if constexpr (ALIGN_EPI) { if (wr == 0) PG8_BAR; }
        if constexpr (!Epi::AFTER_DRAIN) { E(acc, cur, wr, wc, fr, fq); S.done(cur); }
        if (!has_next) break;
#pragma unroll
        for (int a = 0; a < 2; ++a)
#pragma unroll
            for (int b = 0; b < 2; ++b)
#pragma unroll
                for (int m = 0; m < 4; ++m)
#pragma unroll
                    for (int n = 0; n < 2; ++n) acc[a][b][m][n] = (f32x4){0.f, 0.f, 0.f, 0.f};
        cur = nxt; cA = nA; cB = nB; ++ui;
        if constexpr (ALIGN_EPI) { if (wr == 1) PG8_BAR; }
    }
    PG8_WAIT_V(0);
    if constexpr (!ALIGN_EPI) { if (wr == 0) PG8_BAR; }
    PG8_BAR;
    if constexpr (Epi::AFTER_DRAIN) { E.fused(acc, cur, wr, wc, fr, fq, lds, wid, lane); S.done(cur); }
#undef PG8_SA
#undef PG8_SB
#undef PG8_STAGE
#undef PG8_LDA
#undef PG8_LDB
#undef PG8_MMA
#undef PG8_WAIT_V
#undef PG8_WAIT_L
#undef PG8_BAR
#undef PG8_SCHED
}
}
namespace att {
typedef unsigned short bf16;
constexpr int   D = 128, NW = 8, QBLK = 32, KVBLK = 64;
constexpr float SCALE = 0.088388347648318440f;
constexpr float THR = 8.f;
constexpr int LDQ = 3072, LDK = 3072, LDO = 2048;
constexpr size_t SHM_V = KVBLK * D * 2, SHM_K = KVBLK * D * 2, SHM_ATTN = 2 * SHM_V + 2 * SHM_K + NW * 64 * 4;
using bf16x8 = __attribute__((ext_vector_type(8))) short;
using s16x4  = __attribute__((ext_vector_type(4))) short;
using f32x16 = __attribute__((ext_vector_type(16))) float;
using u32x4  = __attribute__((ext_vector_type(4))) unsigned;
#define KSWZ(row, colB) ((row) * 256 + ((colB) ^ (((row) & 7) << 4)))
#define SBAR() __builtin_amdgcn_sched_barrier(0)
__device__ __forceinline__ int crow(int r, int hi) { return (r & 3) + 8 * (r >> 2) + 4 * hi; }
__device__ __forceinline__ unsigned cvtpk(float lo, float hi) {
  typedef __bf16 b2 __attribute__((ext_vector_type(2))); typedef float f2 __attribute__((ext_vector_type(2)));
  const f2 v = {lo, hi}; const b2 b = __builtin_convertvector(v, b2); return __builtin_bit_cast(unsigned, b);
}
__device__ __forceinline__ bf16x8 ld8(const bf16* p) { return *reinterpret_cast<const bf16x8*>(p); }
__device__ __forceinline__ void partialSM(f32x16& p0, f32x16& p1, float& m_reg, float& mn, float& alpha) {
  constexpr float C = SCALE * 1.4426950408889634f;
  float pmax = p0[0]; for (int r = 1; r < 16; ++r) pmax = fmaxf(pmax, p0[r]); for (int r = 0; r < 16; ++r) pmax = fmaxf(pmax, p1[r]);
  { auto rr = __builtin_amdgcn_permlane32_swap(__float_as_uint(pmax), __float_as_uint(pmax), false, false);
    pmax = fmaxf(__uint_as_float(rr[0]), __uint_as_float(rr[1])); }
  if (__builtin_expect(__all(pmax - m_reg <= THR / SCALE), 1)) { mn = m_reg; alpha = 1.f; }
  else { mn = fmaxf(m_reg, pmax); alpha = __builtin_amdgcn_exp2f((m_reg - mn) * C); m_reg = mn; }
  float mnC = -mn * C;
  for (int r = 0; r < 16; ++r) p0[r] = fmaf(p0[r], C, mnC); for (int r = 0; r < 16; ++r) p1[r] = fmaf(p1[r], C, mnC);
  for (int r = 0; r < 16; ++r) p0[r] = __builtin_amdgcn_exp2f(p0[r]);
}
__device__ __forceinline__ void finishSM(f32x16& p0, f32x16& p1, float alpha, float& l_reg, bf16x8& pa0, bf16x8& pa1, bf16x8& pa2, bf16x8& pa3) {
  for (int r = 0; r < 16; ++r) p1[r] = __builtin_amdgcn_exp2f(p1[r]);
  float ps = 0; for (int r = 0; r < 16; ++r) ps += p0[r]; for (int r = 0; r < 16; ++r) ps += p1[r];
  { auto rr = __builtin_amdgcn_permlane32_swap(__float_as_uint(ps), __float_as_uint(ps), false, false);
    ps = __uint_as_float(rr[0]) + __uint_as_float(rr[1]); }
  l_reg = l_reg * alpha + ps;
#define PK4(P, BASE, OUT) do { unsigned a0 = cvtpk(P[BASE + 0], P[BASE + 1]), a1 = cvtpk(P[BASE + 2], P[BASE + 3]);   \
    unsigned b0 = cvtpk(P[BASE + 4], P[BASE + 5]), b1 = cvtpk(P[BASE + 6], P[BASE + 7]);                              \
    auto r0 = __builtin_amdgcn_permlane32_swap(a0, b0, false, false); auto r1 = __builtin_amdgcn_permlane32_swap(a1, b1, false, false); \
    u32x4 w = {r0[0], r1[0], r0[1], r1[1]}; OUT = *reinterpret_cast<bf16x8*>(&w); } while (0)
  PK4(p0, 0, pa0); PK4(p0, 8, pa1); PK4(p1, 0, pa2); PK4(p1, 8, pa3);
#undef PK4
}
__device__ __forceinline__ void qkt(f32x16& p0, f32x16& p1, const bf16* Ks, const bf16x8* qr, int r32, int hi) {
  p0 = f32x16{}; p1 = f32x16{};
  for (int d0 = 0; d0 < 8; ++d0) { int cb = (d0 * 16 + hi * 8) * 2;
    bf16x8 b0 = *reinterpret_cast<const bf16x8*>((const char*)Ks + KSWZ(r32, cb));
    bf16x8 b1 = *reinterpret_cast<const bf16x8*>((const char*)Ks + KSWZ(32 + r32, cb));
    p0 = __builtin_amdgcn_mfma_f32_32x32x16_bf16(b0, qr[d0], p0, 0, 0, 0);
    p1 = __builtin_amdgcn_mfma_f32_32x32x16_bf16(b1, qr[d0], p1, 0, 0, 0); }
}
__device__ __forceinline__ int v_st(int k, int c) { const int kk = (k & ~0xC) | ((k & 4) << 1) | ((k & 8) >> 1); return ((kk >> 3) * 4 + (c >> 5)) * 512 + ((kk & 7) * 32 + (c & 31)) * 2; }
__device__ __forceinline__ int v_rd_base(int lane) { return ((lane & 3) << 3) | (((lane >> 2) & 3) << 6) | (((lane >> 4) & 1) << 5) | (((lane >> 5) & 1) << 8); }
constexpr int v_rd_off(int d0, int ks, int half) { return d0 * 512 + ks * 4096 + half * 2048; }
template <int OFF> __device__ __forceinline__ s16x4 tr_read(int vb) {
  s16x4 r; asm volatile("ds_read_b64_tr_b16 %0, %1 offset:%2" : "=&v"(r) : "v"(vb), "i"(OFF) : "memory"); return r;
}
template <int D0> __device__ __forceinline__ void pv_one(f32x16& od, int vb, bf16x8 pa0, bf16x8 pa1, bf16x8 pa2, bf16x8 pa3) {
  const s16x4 l0 = tr_read<v_rd_off(D0, 0, 0)>(vb), h0 = tr_read<v_rd_off(D0, 0, 1)>(vb), l1 = tr_read<v_rd_off(D0, 1, 0)>(vb), h1 = tr_read<v_rd_off(D0, 1, 1)>(vb);
  const s16x4 l2 = tr_read<v_rd_off(D0, 2, 0)>(vb), h2 = tr_read<v_rd_off(D0, 2, 1)>(vb), l3 = tr_read<v_rd_off(D0, 3, 0)>(vb), h3 = tr_read<v_rd_off(D0, 3, 1)>(vb);
  asm volatile("s_waitcnt lgkmcnt(0)" ::: "memory"); SBAR();
#define PK(L, H) (bf16x8){L[0], L[1], L[2], L[3], H[0], H[1], H[2], H[3]}
  od = __builtin_amdgcn_mfma_f32_32x32x16_bf16(pa0, PK(l0, h0), od, 0, 0, 0);
  od = __builtin_amdgcn_mfma_f32_32x32x16_bf16(pa1, PK(l1, h1), od, 0, 0, 0);
  od = __builtin_amdgcn_mfma_f32_32x32x16_bf16(pa2, PK(l2, h2), od, 0, 0, 0);
  od = __builtin_amdgcn_mfma_f32_32x32x16_bf16(pa3, PK(l3, h3), od, 0, 0, 0);
#undef PK
}
__device__ __forceinline__ void pv_d0(f32x16* o, int vb, bf16x8 pa0, bf16x8 pa1, bf16x8 pa2, bf16x8 pa3) {
  pv_one<0>(o[0], vb, pa0, pa1, pa2, pa3); pv_one<1>(o[1], vb, pa0, pa1, pa2, pa3); pv_one<2>(o[2], vb, pa0, pa1, pa2, pa3); pv_one<3>(o[3], vb, pa0, pa1, pa2, pa3);
}
__device__ __forceinline__ void attn_dense_body(const bf16* __restrict__ Qb, const bf16* __restrict__ Kh, const bf16* __restrict__ Vh,
                                                bf16* __restrict__ Ob, int seq, char* lds, const float* __restrict__ qgain = nullptr, const float* __restrict__ rope = nullptr, int t0 = 0) {
  int tid = threadIdx.x; asm volatile("" : "+v"(tid));
  const int wid = tid >> 6, lane = tid & 63, r32 = lane & 31, hi = lane >> 5;
  bf16* V_lds = (bf16*)lds; bf16* K_lds = (bf16*)(lds + 2 * SHM_V);
  float* ws = (float*)(lds + 2 * SHM_V + 2 * SHM_K) + wid * 64; float* li_l = ws; float* al_l = ws + 32;
  float m_reg = -1e30f, l_reg = 0; f32x16 o[4] = {}; bf16x8 qr[8];
  const bf16* Qw = Qb + (long)(wid * QBLK + r32) * LDQ + hi * 8;
#pragma unroll
  for (int d0 = 0; d0 < 8; ++d0) qr[d0] = ld8(Qw + d0 * 16);
  if (qgain) {
    float ssq = 0.f;
#pragma unroll
    for (int d0 = 0; d0 < 8; ++d0)
#pragma unroll
      for (int x = 0; x < 8; ++x) { const float v = __uint_as_float((unsigned)(unsigned short)qr[d0][x] << 16); ssq += v * v; }
    { auto rr = __builtin_amdgcn_permlane32_swap(__float_as_uint(ssq), __float_as_uint(ssq), false, false); ssq = __uint_as_float(rr[0]) + __uint_as_float(rr[1]); }
    const float rstd = 1.0f / sqrtf(ssq * (1.0f / 128.0f) + 1e-6f);
    const int t = t0 + wid * QBLK + r32;
#pragma unroll
    for (int hp = 0; hp < 2; ++hp) {
      const int pos = hp ? (t & 63) : (t >> 6);
#pragma unroll
      for (int dd = 0; dd < 2; ++dd) { const int d0 = 4 * hp + dd;
        const float* g1 = qgain + 16 * d0 + 8 * hi; const float* g2 = g1 + 32;
        const float* tb = rope ? rope + (size_t)(pos * 32 + 16 * dd + 8 * hi) * 2 : nullptr;
        float y1[8], y2[8];
#pragma unroll
        for (int x = 0; x < 8; ++x) { const float a1 = __uint_as_float((unsigned)(unsigned short)qr[d0][x] << 16) * rstd * g1[x], a2 = __uint_as_float((unsigned)(unsigned short)qr[d0 + 2][x] << 16) * rstd * g2[x];
          if (rope) { const float cs = tb[2 * x], sn = tb[2 * x + 1]; y1[x] = a1 * cs - a2 * sn; y2[x] = a2 * cs + a1 * sn; } else { y1[x] = a1; y2[x] = a2; } }
        { u32x4 w = {cvtpk(y1[0], y1[1]), cvtpk(y1[2], y1[3]), cvtpk(y1[4], y1[5]), cvtpk(y1[6], y1[7])}; qr[d0] = *reinterpret_cast<bf16x8*>(&w); }
        { u32x4 w = {cvtpk(y2[0], y2[1]), cvtpk(y2[2], y2[3]), cvtpk(y2[4], y2[5]), cvtpk(y2[6], y2[7])}; qr[d0 + 2] = *reinterpret_cast<bf16x8*>(&w); } }
    }
  }
  const int sr = tid >> 4, sc = (tid & 15) * 8, vst0 = v_st(sr, sc), vst1 = v_st(32 + sr, sc);
  const int vb0 = (int)(uintptr_t)V_lds + v_rd_base(lane);
  struct { bf16x8 vs0, vs1, ks0, ks1; } sr_[2];
#define SLOAD(i, k0) do { sr_[i].vs0 = ld8(&Vh[(long)((k0) + sr) * LDK + sc]); sr_[i].vs1 = ld8(&Vh[(long)((k0) + 32 + sr) * LDK + sc]); \
    sr_[i].ks0 = ld8(&Kh[(long)((k0) + sr) * LDK + sc]); sr_[i].ks1 = ld8(&Kh[(long)((k0) + 32 + sr) * LDK + sc]); } while (0)
#define SWRITE(b, i) do { *(bf16x8*)((char*)V_lds + (b) * SHM_V + vst0) = sr_[i].vs0;          \
    *(bf16x8*)((char*)V_lds + (b) * SHM_V + vst1) = sr_[i].vs1; int kc = sc * 2;               \
    *(bf16x8*)((char*)K_lds + (b) * SHM_K + KSWZ(sr, kc)) = sr_[i].ks0;                       \
    *(bf16x8*)((char*)K_lds + (b) * SHM_K + KSWZ(32 + sr, kc)) = sr_[i].ks1; } while (0)
#define SWAIT() asm volatile("s_waitcnt vmcnt(4)" ::: "memory")
#define RESC(a) do { if (__any((a) < 1.f)) { if (hi == 0) al_l[r32] = (a); asm volatile("s_waitcnt lgkmcnt(0)" ::: "memory"); \
    for (int d = 0; d < 4; ++d) for (int r = 0; r < 16; ++r) o[d][r] *= al_l[crow(r, hi)]; } } while (0)
  f32x16 pA0, pA1, pB0, pB1; float mnA, mnB, alA, alB; bf16x8 pa0, pa1, pa2, pa3; const int NT = seq / KVBLK;
  constexpr int SE = 0, SO = 1;
  SLOAD(SE, 0); asm volatile("s_waitcnt vmcnt(0)" ::: "memory"); SWRITE(0, SE); __syncthreads();
  qkt(pA0, pA1, K_lds, qr, r32, hi); partialSM(pA0, pA1, m_reg, mnA, alA);
  SLOAD(SO, KVBLK); if (2 < NT) SLOAD(SE, 2 * KVBLK);
  SWAIT(); SWRITE(1, SO); __syncthreads();
  for (int j = 1; j + 1 < NT; j += 2) {
    SBAR(); qkt(pB0, pB1, (bf16*)((char*)K_lds + SHM_K), qr, r32, hi);
    finishSM(pA0, pA1, alA, l_reg, pa0, pa1, pa2, pa3); SBAR();
    SLOAD(SO, (j + 2) * KVBLK); SBAR();
    pv_d0(o, vb0, pa0, pa1, pa2, pa3); partialSM(pB0, pB1, m_reg, mnB, alB);
    __syncthreads(); SWAIT(); SWRITE(0, SE);
    RESC(alB); __syncthreads();
    SBAR(); qkt(pA0, pA1, K_lds, qr, r32, hi);
    finishSM(pB0, pB1, alB, l_reg, pa0, pa1, pa2, pa3); SBAR();
    if (j + 3 < NT) SLOAD(SE, (j + 3) * KVBLK); SBAR();
    pv_d0(o, vb0 + (int)SHM_V, pa0, pa1, pa2, pa3); partialSM(pA0, pA1, m_reg, mnA, alA);
    __syncthreads(); SWAIT(); SWRITE(1, SO);
    RESC(alA); __syncthreads();
  }
  SBAR(); qkt(pB0, pB1, (bf16*)((char*)K_lds + SHM_K), qr, r32, hi);
  finishSM(pA0, pA1, alA, l_reg, pa0, pa1, pa2, pa3); SBAR();
  pv_d0(o, vb0, pa0, pa1, pa2, pa3); partialSM(pB0, pB1, m_reg, mnB, alB);
  __syncthreads(); RESC(alB);
  finishSM(pB0, pB1, alB, l_reg, pa0, pa1, pa2, pa3); SBAR();
  pv_d0(o, vb0 + (int)SHM_V, pa0, pa1, pa2, pa3);
  if (hi == 0) li_l[r32] = l_reg; asm volatile("s_waitcnt lgkmcnt(0)" ::: "memory");
  float rli[16];
#pragma unroll
  for (int r = 0; r < 16; ++r) rli[r] = __builtin_amdgcn_rcpf(li_l[crow(r, hi)]);
  bf16* Ow = Ob + (long)(wid * QBLK) * LDO;
#pragma unroll
  for (int r = 0; r < 16; ++r) { int orow = crow(r, hi);
#pragma unroll
    for (int d0 = 0; d0 < 4; ++d0) Ow[(long)orow * LDO + d0 * 32 + r32] = (bf16)(cvtpk(o[d0][r] * rli[r], 0.f) & 0xffffu); }
  __syncthreads();
#undef SLOAD
#undef SWRITE
#undef SWAIT
#undef RESC
}
#undef KSWZ
#undef SBAR
}

constexpr int NWAVES = 8;
#ifndef MK_N_LAUNCHES
#define MK_N_LAUNCHES 1
#endif
constexpr int DM = 2048, NBATCH = 8, SEQ = 2048, CTXL = 256, TPB = SEQ + CTXL, MROWS = NBATCH * TPB;
constexpr int MLAT = NBATCH * SEQ;
constexpr int MODW = 6 * DM, NSET = 9;
constexpr int EIN = 3072, OIN = 12288, OMIX = 4096, FFN = 5632, FFN2 = 2 * FFN;
constexpr size_t RP_PLANE = (size_t)MROWS * 256, RP_V = 16 * RP_PLANE, RP_G = 32 * RP_PLANE;
constexpr float EPS = 1e-6f;
constexpr int N_PHASES = 1 + 9 * 4;
constexpr size_t MiB = 1u << 20;
constexpr size_t WS_CTL = 0, CTL_ZERO_BYTES = 1 * MiB;
constexpr size_t WS_MOD = 1 * MiB;
constexpr size_t WS_ROPE_E = 3 * MiB, WS_ROPE_O = 3 * MiB + 65536;
constexpr size_t WS_WTC = 3 * MiB + 262144;
constexpr size_t WS_CB = 4 * MiB;
constexpr size_t WS_WTL = 5 * MiB;
constexpr size_t WS_W_INE = 21 * MiB, WS_W_OUTE = 45 * MiB, WS_W_INO = 61 * MiB, WS_W_OUTO = 157 * MiB, WS_W_FIN = 189 * MiB, WS_W_FOUT = 365 * MiB;
constexpr size_t WS_H = 453 * MiB;
constexpr size_t WS_XN = 597 * MiB;
constexpr size_t WS_P = 669 * MiB;
constexpr size_t WS_R = 1101 * MiB;
constexpr size_t WS_OF = WS_R, WS_OB = WS_R + 144 * MiB;
constexpr size_t WS_FT = WS_R, WS_FTC = WS_R + 16 * MiB, WS_Z = WS_R + 18 * MiB, WS_MIX = WS_R + 54 * MiB;
constexpr size_t WS_DELTA = 1389 * MiB;
constexpr size_t WS_SPLITTAB = 2 * MiB + 917504;
constexpr size_t WS_END = 1453 * MiB;
static_assert(WS_MIX + (size_t)MROWS * DM * 2 <= WS_END && WS_OB + (size_t)MROWS * OMIX * 2 <= WS_END && WS_P + (size_t)MROWS * OIN * 2 <= WS_R, "d_ws map");
constexpr int CW_TMO = 0, CW_CODE = 1, CW_BAR = 4096;
constexpr int RING_OFF = 0, RING_BYTES = 131072;
constexpr int LDSCTL_OFF = 158720, MISC_OFF = LDSCTL_OFF + 320;
constexpr int LDS_BYTES = 159744;
static_assert(MISC_OFF + 128 <= LDS_BYTES, "LDS map");

#define GAS __attribute__((address_space(1)))
#define LAS __attribute__((address_space(3)))
typedef unsigned short bf16;
typedef unsigned v4u __attribute__((ext_vector_type(4)));
typedef unsigned v2u __attribute__((ext_vector_type(2)));
typedef float f32x4 __attribute__((ext_vector_type(4)));
typedef short bf16x8 __attribute__((ext_vector_type(8)));
typedef short s16x4 __attribute__((ext_vector_type(4)));
typedef GAS unsigned gu32;
#define RLX_AGENT __ATOMIC_RELAXED, __HIP_MEMORY_SCOPE_AGENT
#define LDS_WAIT() asm volatile("s_waitcnt lgkmcnt(0)" ::: "memory")
#define VM_WAIT() asm volatile("s_waitcnt vmcnt(0)" ::: "memory")
typedef __bf16 bf16x2_t __attribute__((ext_vector_type(2)));
typedef float f32x2_t __attribute__((ext_vector_type(2)));
__device__ __forceinline__ unsigned pk2(float lo, float hi) { const f32x2_t v = {lo, hi}; const bf16x2_t b = __builtin_convertvector(v, bf16x2_t); return __builtin_bit_cast(unsigned, b); }
__device__ __forceinline__ float bflo(unsigned w) { return __uint_as_float(w << 16); }
__device__ __forceinline__ float bfhi(unsigned w) { return __uint_as_float(w & 0xffff0000u); }
__device__ __forceinline__ float silu(float g) { return g / (1.0f + __expf(-g)); }

#define XB_TMO      128
#define XB_XCNT(j)  (256  + 64 * (j))
#define XB_XSUB(j)  (1280 + 64 * (j))
#define XB_XGEN(j)  (2304 + 64 * (j))
#define XB_TOP      3328
#define XB_TOPGEN   3392
#define XCD_BAR_WORDS 3456
#define XB_SPIN_CAP (1u << 18)

__device__ __forceinline__ unsigned xb_ld(unsigned* p)              { return __hip_atomic_load(p, __ATOMIC_RELAXED, __HIP_MEMORY_SCOPE_AGENT); }
__device__ __forceinline__ unsigned xb_add(unsigned* p, unsigned v) { return __hip_atomic_fetch_add(p, v, __ATOMIC_RELAXED, __HIP_MEMORY_SCOPE_AGENT); }
__device__ __forceinline__ unsigned xb_xcc_id() { return (unsigned)__builtin_amdgcn_s_getreg((3 << 11) | 20) & 0xFu; }
#define XB_SPIN(cond, bar) do { unsigned _sp = 0; while (cond) { __builtin_amdgcn_s_sleep(1); \
    if ((++_sp & 255u) == 0u) { if (xb_ld(&(bar)[XB_TMO])) break; if (_sp > XB_SPIN_CAP) { atomicAdd(&(bar)[XB_TMO], 1u); break; } } } } while (0)

struct XcdBarrier {
    unsigned* bar; unsigned x;
    volatile LAS unsigned* st;
};

__device__ __forceinline__ XcdBarrier xcd_barrier_post(unsigned* bar, volatile LAS unsigned* st) {
    XcdBarrier b; b.bar = bar; b.x = xb_xcc_id(); b.st = st;
    if (threadIdx.x == 0) (void)xb_add(&bar[XB_XCNT(b.x)], 1u);
    return b;
}
__device__ __forceinline__ void xcd_barrier_complete(unsigned* bar, unsigned x, unsigned& nloc, unsigned& nx) {
    const unsigned G = gridDim.x * gridDim.y * gridDim.z;
    unsigned sum, cnt, mine, sp = 0u;
    for (;;) {
        sum = 0u; cnt = 0u; mine = 0u;
#pragma unroll
        for (unsigned j = 0; j < 16; ++j) { const unsigned c = xb_ld(&bar[XB_XCNT(j)]); sum += c; cnt += (c > 0u) ? 1u : 0u; mine = (j == x) ? c : mine; }
        if (sum == G) break;
        __builtin_amdgcn_s_sleep(1);
        if ((++sp & 255u) == 0u) { if (xb_ld(&bar[XB_TMO])) break; if (sp > XB_SPIN_CAP) { atomicAdd(&bar[XB_TMO], 1u); break; } }
    }
    nloc = mine > 0u ? mine : 1u; nx = cnt > 0u ? cnt : 1u;
}

__device__ __forceinline__ void xcd_barrier(const XcdBarrier& b) {
    asm volatile("s_waitcnt vmcnt(0)" ::: "memory");
    __syncthreads();
    if (threadIdx.x == 0) {
        unsigned* bar = b.bar;
        __builtin_amdgcn_s_waitcnt(0);
        unsigned nloc = b.st[0], nx = b.st[1];
        if (nloc == 0u) { xcd_barrier_complete(bar, b.x, nloc, nx); b.st[0] = nloc; b.st[1] = nx; }
        const unsigned old = xb_add(&bar[XB_XSUB(b.x)], 1u);
        const unsigned gen = old / nloc;
        if (old + 1u == (gen + 1u) * nloc) {
            __builtin_amdgcn_fence(__ATOMIC_RELEASE, "agent");
            asm volatile("s_waitcnt vmcnt(0)" ::: "memory");
            const unsigned og = xb_add(&bar[XB_TOP], 1u);
            const unsigned tg = og / nx;
            if (og + 1u == (tg + 1u) * nx) xb_add(&bar[XB_TOPGEN], 1u);
            else XB_SPIN(xb_ld(&bar[XB_TOPGEN]) == tg, bar);
            __builtin_amdgcn_fence(__ATOMIC_ACQUIRE, "agent");
            xb_add(&bar[XB_XGEN(b.x)], 1u);
            asm volatile("s_waitcnt vmcnt(0)" ::: "memory");
        } else {
            XB_SPIN(xb_ld(&bar[XB_XGEN(b.x)]) == gen, bar);
            __builtin_amdgcn_fence(__ATOMIC_ACQUIRE, "agent");
            asm volatile("s_waitcnt vmcnt(0)" ::: "memory");
        }
    }
    __syncthreads();
}

struct Args { const float* in[16]; float* out; unsigned char* ws; int ph_lo, ph_hi; };
static_assert(sizeof(Args) == 18 * 8 + 8, "Args has no padding");

struct Frame {
    LAS unsigned char* lds;
    volatile LAS unsigned* MISC;
    gu32* ctl;
    GAS unsigned char* ws;
    GAS float* out;
    int wave, vcu, G;
};
__device__ __forceinline__ int tid_opaque() { int t = threadIdx.x; asm volatile("" : "+v"(t)); return t; }
#define IN_X(F) ((const float*)(const GAS float*)A.in[0])
#define IN_C(F) ((const float*)(const GAS float*)A.in[1])
#define IN_CTX(F) ((const float*)(const GAS float*)A.in[2])
#define IN_CCTX(F) ((const float*)(const GAS float*)A.in[3])
#define IN_WMOD(F) ((const float*)(const GAS float*)A.in[4])
#define IN_BMOD(F) ((const float*)(const GAS float*)A.in[5])
#define IN_WINE(F) ((const float*)(const GAS float*)A.in[6])
#define IN_WOUTE(F) ((const float*)(const GAS float*)A.in[7])
#define IN_QG(F) ((const float*)(const GAS float*)A.in[8])
#define IN_KG(F) ((const float*)(const GAS float*)A.in[9])
#define IN_WINO(F) ((const float*)(const GAS float*)A.in[10])
#define IN_WOUTO(F) ((const float*)(const GAS float*)A.in[11])
#define IN_LDF(F) ((const float*)(const GAS float*)A.in[12])
#define IN_LDB(F) ((const float*)(const GAS float*)A.in[13])
#define IN_WFIN(F) ((const float*)(const GAS float*)A.in[14])
#define IN_WFOUT(F) ((const float*)(const GAS float*)A.in[15])
#define WSF(F, off) ((float*)((F).ws + (off)))
#define WSB(F, off) ((bf16*)((F).ws + (off)))
__device__ __forceinline__ float shx(float v, int k, int lane) { return __int_as_float(__builtin_amdgcn_ds_bpermute((lane ^ k) << 2, __float_as_int(v))); }
__device__ __forceinline__ float wave_sum(float v, int lane) {
#pragma unroll
    for (int o = 1; o < 64; o <<= 1) v += shx(v, o, lane);
    return v;
}
__device__ __forceinline__ void p0_transpose_item(const float* W, int K, int N, bf16* WT, int k0, int n0, int drow0, float scale, LAS float* scr, int lane) {
    const int kr = lane >> 4, c4 = (lane & 15) * 4;
    f32x4 v[16];
#pragma unroll
    for (int i = 0; i < 16; ++i) v[i] = *(const GAS f32x4*)(W + (size_t)(k0 + 4 * i + kr) * N + n0 + c4);
#pragma unroll
    for (int i = 0; i < 16; ++i) { LAS float* d = scr + (4 * i + kr) * 65 + c4; d[0] = v[i][0]; d[1] = v[i][1]; d[2] = v[i][2]; d[3] = v[i][3]; }
    LDS_WAIT(); asm volatile("" ::: "memory");
    const int c = lane & 7;
#pragma unroll
    for (int j = 0; j < 8; ++j) { const int n = (lane >> 3) + 8 * j; const LAS float* s = scr + (8 * c) * 65 + n;
        v4u o; o.x = pk2(s[0 * 65] * scale, s[1 * 65] * scale); o.y = pk2(s[2 * 65] * scale, s[3 * 65] * scale); o.z = pk2(s[4 * 65] * scale, s[5 * 65] * scale); o.w = pk2(s[6 * 65] * scale, s[7 * 65] * scale);
        *(GAS v4u*)(WT + (size_t)(drow0 + n) * K + k0 + 8 * c) = o; }
    LDS_WAIT(); asm volatile("" ::: "memory");
}
__device__ __forceinline__ void p0_conv(const float* W, bf16* WT, int K, int N, int kind, int r, LAS float* scr, int lane) {
    const int nbn = N / 64, per = (K / 64) * nbn, inst = r / per, rr = r - inst * per, kb = rr / nbn, nb = rr - kb * nbn, n0 = nb * 64;
    int drow0 = n0; float scale = 1.0f;
    if (kind == 2) { if (n0 >= 2048 && n0 < 4096) scale = 0.0625f;
        if (n0 < 4096) { const int d = n0 & 255, half = d >> 7, bj = (d >> 6) & 1; drow0 = (n0 & ~255) + 128 * bj + 64 * half; } }
    if (kind == 4) { const int bj = n0 >= FFN ? 1 : 0, hc = n0 - bj * FFN; drow0 = 256 * (hc >> 7) + 128 * bj + (hc & 127); }
    p0_transpose_item(W + (size_t)inst * K * N, K, N, WT + (size_t)inst * K * N, kb * 64, n0, drow0, scale, scr, lane);
}
__device__ __forceinline__ int conv_layer_count(int L) { return (L & 1) ? (32 * 192 + 64 * 32 + 32 * 176 + 88 * 32) : (32 * 48 + 32 * 32 + 32 * 176 + 88 * 32); }
__device__ __forceinline__ void conv_layer_item(Frame& F, const Args& A, int L, int r, LAS float* scr, int lane) {
    const int j2 = L >> 1;
    if (L & 1) {
        constexpr int P0 = 32 * 192, P1 = 64 * 32;
        if (r < P0) { p0_conv(IN_WINO(F), WSB(F, WS_W_INO), DM, OIN, 2, r + j2 * P0, scr, lane); return; } r -= P0;
        if (r < P1) { p0_conv(IN_WOUTO(F), WSB(F, WS_W_OUTO), OMIX, DM, 3, r + j2 * P1, scr, lane); return; } r -= P1;
    } else {
        constexpr int P0 = 32 * 48, P1 = 32 * 32;
        if (r < P0) { p0_conv(IN_WINE(F), WSB(F, WS_W_INE), DM, EIN, 0, r + j2 * P0, scr, lane); return; } r -= P0;
        if (r < P1) { p0_conv(IN_WOUTE(F), WSB(F, WS_W_OUTE), DM, DM, 1, r + j2 * P1, scr, lane); return; } r -= P1;
    }
    constexpr int P4 = 32 * 176, P5 = 88 * 32;
    if (r < P4) { p0_conv(IN_WFIN(F), WSB(F, WS_W_FIN), DM, FFN2, 4, r + L * P4, scr, lane); return; } r -= P4;
    p0_conv(IN_WFOUT(F), WSB(F, WS_W_FOUT), FFN, DM, 5, r + L * P5, scr, lane);
}
__device__ __forceinline__ void conv_in_tail(Frame& F, const Args& A, int L, int lo, int hi, int widx, int nw) {
    const int lane = tid_opaque() & 63;
    LAS float* scr = (LAS float*)(F.lds + RING_OFF + F.wave * 16640);
    for (int r = lo + widx * NWAVES + F.wave; r < hi; r += nw * NWAVES) conv_layer_item(F, A, L, r, scr, lane);
}
#ifndef LATE_CONV
#define LATE_CONV 1
#endif
#ifndef BUILD_SPLITTAB
#define BUILD_SPLITTAB 0
#endif
#ifndef PRO_GW
#define PRO_GW 3
#endif
__device__ __forceinline__ void ph_prologue(Frame& F, const Args& A) {
    const int tid = tid_opaque(), lane = tid & 63;
    constexpr int COND_BYTES = NSET * DM * 4;
    LAS float* cond = (LAS float*)(F.lds + RING_OFF);
    for (int i = tid; i < NSET * DM; i += NWAVES * 64) { const int s = i >> 11, k = i & 2047; const float v = (s < 8) ? IN_C(F)[s * DM + k] : IN_CCTX(F)[k]; cond[i] = v / (1.0f + expf(-v)); }
    LDS_WAIT(); __syncthreads();
    if (F.wave < PRO_GW) {
        for (int item = F.wave * F.G + F.vcu; item < 4 * 192; item += PRO_GW * F.G) {
            const int layer = item / 192, kk = lane >> 4, col = (item - layer * 192) * 64 + (lane & 15) * 4;
            const float* wp = IN_WMOD(F) + (size_t)layer * DM * MODW + (size_t)kk * MODW + col;
            f32x4 acc[NSET];
#pragma unroll
            for (int s = 0; s < NSET; ++s) acc[s] = (f32x4){0.f, 0.f, 0.f, 0.f};
            for (int k = 0; k < DM; k += 32) {
                f32x4 w[8];
#pragma unroll
                for (int u = 0; u < 8; ++u) w[u] = *(const GAS f32x4*)(wp + (size_t)(k + 4 * u) * MODW);
#pragma unroll
                for (int u = 0; u < 8; ++u)
#pragma unroll
                    for (int s = 0; s < NSET; ++s) acc[s] += w[u] * cond[s * DM + k + 4 * u + kk];
            }
#pragma unroll
            for (int s = 0; s < NSET; ++s)
#pragma unroll
                for (int x = 0; x < 4; ++x) { float t = acc[s][x]; t += shx(t, 16, lane); t += shx(t, 32, lane); acc[s][x] = t; }
            if (kk == 0) { const f32x4 bm = *(const GAS f32x4*)(IN_BMOD(F) + layer * MODW + col);
#pragma unroll
                for (int s = 0; s < NSET; ++s) *(GAS f32x4*)(WSF(F, WS_MOD) + (size_t)(layer * NSET + s) * MODW + col) = acc[s] + bm; }
        }
    } else {
        LAS float* scr = (LAS float*)(F.lds + RING_OFF + COND_BYTES + (F.wave - PRO_GW) * 16640);
        const int tw = (F.wave - PRO_GW) * F.G + F.vcu, NTW = (NWAVES - PRO_GW) * F.G;
#if LATE_CONV
        for (int it = tw; it < conv_layer_count(0); it += NTW) conv_layer_item(F, A, 0, it, scr, lane);
#else
        constexpr int I0 = 2 * 32 * 48, I1 = 2 * 32 * 32, I2 = 2 * 32 * 192, I3 = 2 * 64 * 32, I4 = 4 * 32 * 176, I5 = 4 * 88 * 32;
        for (int it = tw; it < I0 + I1 + I2 + I3 + I4 + I5; it += NTW) {
            int r = it;
            if (r < I0) { p0_conv(IN_WINE(F), WSB(F, WS_W_INE), DM, EIN, 0, r, scr, lane); continue; } r -= I0;
            if (r < I1) { p0_conv(IN_WOUTE(F), WSB(F, WS_W_OUTE), DM, DM, 1, r, scr, lane); continue; } r -= I1;
            if (r < I2) { p0_conv(IN_WINO(F), WSB(F, WS_W_INO), DM, OIN, 2, r, scr, lane); continue; } r -= I2;
            if (r < I3) { p0_conv(IN_WOUTO(F), WSB(F, WS_W_OUTO), OMIX, DM, 3, r, scr, lane); continue; } r -= I3;
            if (r < I4) { p0_conv(IN_WFIN(F), WSB(F, WS_W_FIN), DM, FFN2, 4, r, scr, lane); continue; } r -= I4;
            p0_conv(IN_WFOUT(F), WSB(F, WS_W_FOUT), FFN, DM, 5, r, scr, lane);
        }
#endif
    }
    const int gw = F.vcu * NWAVES + F.wave, NGW = F.G * NWAVES;
    if (BUILD_SPLITTAB && gw == 0) {
        pg8::StaticOrder so; so.init(MROWS, DM, F.G, 0); const int nfull = (so.nwg / F.G) * F.G; int* tab = (int*)(F.ws + WS_SPLITTAB);
        for (int e = lane; e < 576; e += 64) { int val = 0;
            for (int idx = nfull; idx < so.nwg; ++idx) { pg8::Unit u; so.map(idx, u); if (u.pm * 8 + u.pn == e) val = idx - nfull + 1; }
            tab[e] = val; }
    }
    const int gt = gw * 64 + lane, NGT = NGW * 64;
    for (int i = gt; i < 4096 * 256; i += NGT) {
        const int m = i >> 8, k0 = (i & 255) * 8, part = m >> 11, to = m & 2047; unsigned w[4];
#pragma unroll
        for (int u = 0; u < 4; ++u) { float s0, c0, s1, c1; sincospif((float)((to * (k0 + 2 * u)) & 2047) * (1.0f / 1024.0f), &s0, &c0); sincospif((float)((to * (k0 + 2 * u + 1)) & 2047) * (1.0f / 1024.0f), &s1, &c1);
            w[u] = pk2((part ? s0 : c0) * 0.022097086912079608f, (part ? s1 : c1) * 0.022097086912079608f); }
        *(GAS v4u*)(WSB(F, WS_WTL) + (size_t)m * 2048 + k0) = (v4u){w[0], w[1], w[2], w[3]};
    }
    for (int i = gt; i < 512 * 32; i += NGT) {
        const int m = i >> 5, k0 = (i & 31) * 8, part = m >> 8, to = m & 255; unsigned w[4];
#pragma unroll
        for (int u = 0; u < 4; ++u) { float s0, c0, s1, c1; sincospif((float)((to * (k0 + 2 * u)) & 255) * (1.0f / 128.0f), &s0, &c0); sincospif((float)((to * (k0 + 2 * u + 1)) & 255) * (1.0f / 128.0f), &s1, &c1);
            w[u] = pk2((part ? s0 : c0) * 0.0625f, (part ? s1 : c1) * 0.0625f); }
        *(GAS v4u*)(WSB(F, WS_WTC) + (size_t)m * 256 + k0) = (v4u){w[0], w[1], w[2], w[3]};
    }
    for (int i = gt; i < 512 * 128; i += NGT) {
        const int n = i >> 7, k0 = (i & 127) * 8, g = n >> 7, kq = n & 127, part = k0 >> 9, g2 = (k0 >> 7) & 3; unsigned w[4];
#pragma unroll
        for (int u = 0; u < 4; ++u) { float s0, c0, s1, c1; const int cc = (k0 & 127) + 2 * u; sincospif((float)((cc * kq) & 127) * (1.0f / 64.0f), &s0, &c0); sincospif((float)(((cc + 1) * kq) & 127) * (1.0f / 64.0f), &s1, &c1);
            const float a0 = (part ? -s0 : c0) * 0.08838834764831845f, a1 = (part ? -s1 : c1) * 0.08838834764831845f;
            w[u] = (g == g2) ? pk2(a0, a1) : 0u; }
        *(GAS v4u*)(WSB(F, WS_CB) + (size_t)n * 1024 + k0) = (v4u){w[0], w[1], w[2], w[3]};
    }
    for (int i = gt; i < 64 * 32; i += NGT) { const int pos = i >> 5, f = i & 31; const double inv = exp2(-(double)(2 * f) / 64.0 * 13.287712379549449), a = (double)pos * inv;
        WSF(F, WS_ROPE_E)[2 * i] = (float)cos(a); WSF(F, WS_ROPE_E)[2 * i + 1] = (float)sin(a); }
    for (int i = gt; i < 64 * 64; i += NGT) { const int pos = i >> 6, f = i & 63; const double inv = exp2(-(double)(2 * f) / 128.0 * 13.287712379549449), a = (double)pos * inv;
        WSF(F, WS_ROPE_O)[2 * i] = (float)cos(a); WSF(F, WS_ROPE_O)[2 * i + 1] = (float)sin(a); }
}
__device__ __forceinline__ void ph_modulate(Frame& F, const Args& A, int layer, int which, int skipctx, int merge, int from_x) {
    const int lane = tid_opaque() & 63;
    const int gw = F.vcu * NWAVES + F.wave, NGW = F.G * NWAVES, R = (MROWS + NGW - 1) / NGW;
    const int m0 = gw * R, m1 = (m0 + R < MROWS) ? m0 + R : MROWS;
    f32x4 sh[8], sc[8], v[8], vn[8]; int curset = -1;
#define MOD_SRC(m_, b_, t_) (from_x ? (const GAS f32x4*)((t_) >= SEQ ? IN_CTX(F) + (size_t)((b_) * CTXL + (t_) - SEQ) * DM : IN_X(F) + (size_t)((b_) * SEQ + (t_)) * DM) + lane : (const GAS f32x4*)(WSF(F, WS_H) + (size_t)(m_) * DM) + lane)
    if (m0 < MROWS) { const int b = m0 / TPB, t = m0 - b * TPB; const GAS f32x4* sr = MOD_SRC(m0, b, t);
#pragma unroll
        for (int j = 0; j < 8; ++j) vn[j] = sr[64 * j]; }
#pragma unroll 1
    for (int m = m0; m < m1; ++m) {
        const int b = m / TPB, t = m - b * TPB, isctx = t >= SEQ, set = isctx ? 8 : b;
#pragma unroll
        for (int j = 0; j < 8; ++j) v[j] = vn[j];
        if (m + 1 < m1) { const int b2 = (m + 1) / TPB, t2 = (m + 1) - b2 * TPB; const GAS f32x4* sr = MOD_SRC(m + 1, b2, t2);
#pragma unroll
            for (int j = 0; j < 8; ++j) vn[j] = sr[64 * j]; }
        if (skipctx && isctx) continue;
        if (set != curset) { curset = set; const float* shp = WSF(F, WS_MOD) + (size_t)(layer * NSET + set) * MODW + which * 3 * DM;
#pragma unroll
            for (int j = 0; j < 8; ++j) { sh[j] = *((const GAS f32x4*)shp + lane + 64 * j); sc[j] = *((const GAS f32x4*)(shp + DM) + lane + 64 * j) + 1.0f; } }
        if (merge) {
            GAS f32x4* hr = (GAS f32x4*)(WSF(F, WS_H) + (size_t)m * DM) + lane;
            const int pm = m >> 8; const int* tab = (const int*)(F.ws + WS_SPLITTAB) + pm * 8;
#pragma unroll
            for (int j = 0; j < 8; ++j) { const int sl = __builtin_amdgcn_readfirstlane(tab[j]);
                if (sl) { const GAS f32x4* dp = (const GAS f32x4*)(WSF(F, WS_DELTA) + (size_t)(sl - 1) * 4 * 65536 + (size_t)(m & 255) * 256) + lane;
                    const f32x4 d0 = dp[0], d1 = dp[16384], d2 = dp[32768], d3 = dp[49152];
                    v[j] = v[j] + ((d0 + d1) + (d2 + d3)); hr[64 * j] = v[j]; } }
        }
        float ss = 0.f;
#pragma unroll
        for (int j = 0; j < 8; ++j) { ss += (v[j][0] * v[j][0] + v[j][1] * v[j][1]) + (v[j][2] * v[j][2] + v[j][3] * v[j][3]); }
        const float rstd = 1.0f / sqrtf(wave_sum(ss, lane) * (1.0f / DM) + EPS);
        GAS v2u* o8 = (GAS v2u*)(WSB(F, WS_XN) + (size_t)m * DM) + lane;
#pragma unroll
        for (int j = 0; j < 8; ++j) { const f32x4 y = v[j] * rstd * sc[j] + sh[j]; o8[64 * j] = (v2u){pk2(y[0], y[1]), pk2(y[2], y[3])}; }
    }
#undef MOD_SRC
}
__device__ __forceinline__ void ph_qk_even(Frame& F, const Args& A, int j2) {
    const int gw = F.vcu * NWAVES + F.wave, NGW = F.G * NWAVES, l = tid_opaque() & 63;
    const float* qg = IN_QG(F) + j2 * 128 + (l & 15) * 8; const float* kg = IN_KG(F) + j2 * 128 + (l & 15) * 8;
    float gq[8], gk[8];
#pragma unroll
    for (int x = 0; x < 8; ++x) { gq[x] = qg[x]; gk[x] = kg[x]; }
    for (int m = gw; m < MROWS; m += NGW) {
        const int b = m / TPB, t = m - b * TPB, lat = t < SEQ;
        const int half = (l >> 3) & 1, pos = half ? (t & 63) : (t >> 6), isx2 = (l >> 2) & 1;
        f32x4 tb[4];
        if (lat) {
#pragma unroll
            for (int q = 0; q < 4; ++q) tb[q] = *(const GAS f32x4*)(WSF(F, WS_ROPE_E) + (size_t)(pos * 32 + (l & 3) * 8 + 2 * q) * 2);
        }
        GAS v4u* pr = (GAS v4u*)(WSB(F, WS_P) + (size_t)m * EIN + 512) + l;
#pragma unroll
        for (int j = 3; j < 4; ++j) {
            const v4u raw = pr[64 * j];
            float v[8] = {bflo(raw.x), bfhi(raw.x), bflo(raw.y), bfhi(raw.y), bflo(raw.z), bfhi(raw.z), bflo(raw.w), bfhi(raw.w)};
            float ss = 0.f;
#pragma unroll
            for (int x = 0; x < 8; ++x) ss += v[x] * v[x];
            ss += shx(ss, 1, l); ss += shx(ss, 2, l); ss += shx(ss, 4, l); ss += shx(ss, 8, l);
            const float rstd = 1.0f / sqrtf(ss * (1.0f / 128.0f) + EPS);
            const bool isq = (4 * j + (l >> 4)) < 12;
#pragma unroll
            for (int x = 0; x < 8; ++x) v[x] = v[x] * rstd * (isq ? gq[x] : gk[x]);
            if (lat) {
#pragma unroll
                for (int x = 0; x < 8; ++x) { const float p = shx(v[x], 4, l); const float cs = tb[x >> 1][(x & 1) * 2], sn = tb[x >> 1][(x & 1) * 2 + 1];
                    v[x] = isx2 ? (v[x] * cs + p * sn) : (v[x] * cs - p * sn); }
            }
            pr[64 * j] = (v4u){pk2(v[0], v[1]), pk2(v[2], v[3]), pk2(v[4], v[5]), pk2(v[6], v[7])};
        }
    }
    LAS bf16* scr = (LAS bf16*)(F.lds + RING_OFF + F.wave * 9216);
    for (int it = gw; it < NBATCH * 288; it += NGW) {
        const int b = it / 288, r = it - b * 288; int t0, c0, isc;
        if (r < 256) { isc = 0; t0 = (r >> 3) * 64; c0 = (r & 7) * 64; } else { isc = 1; t0 = ((r - 256) >> 3) * 64; c0 = ((r - 256) & 7) * 64; }
        const bf16* src = WSB(F, WS_P) + (size_t)(b * TPB + (isc ? SEQ : 0) + t0) * EIN + c0;
#pragma unroll
        for (int i = 0; i < 8; ++i) { const int rr = i * 8 + (l >> 3), ch = l & 7; const v4u val = *(const GAS v4u*)(src + (size_t)rr * EIN + ch * 8); *(LAS v4u*)(scr + rr * 72 + ch * 8) = val; }
        LDS_WAIT(); asm volatile("" ::: "memory");
        bf16* dst = isc ? WSB(F, WS_FTC) + (size_t)(b * 512 + c0) * CTXL + t0 : WSB(F, WS_FT) + (size_t)(b * 512 + c0) * SEQ + t0;
        const int ld = isc ? CTXL : SEQ;
#pragma unroll
        for (int i = 0; i < 8; ++i) { const int cc = i * 8 + (l >> 3), tc = (l & 7) * 8; const LAS bf16* s = scr + tc * 72 + cc;
            v4u o; o.x = (unsigned)s[0] | ((unsigned)s[72] << 16); o.y = (unsigned)s[144] | ((unsigned)s[216] << 16); o.z = (unsigned)s[288] | ((unsigned)s[360] << 16); o.w = (unsigned)s[432] | ((unsigned)s[504] << 16);
            *(GAS v4u*)(dst + (size_t)cc * ld + tc) = o; }
        LDS_WAIT(); asm volatile("" ::: "memory");
    }
}
__device__ __forceinline__ void ph_comb(Frame& F, int skipctx, int dry = 0) {
    const int gw = F.vcu * NWAVES + F.wave, NGW = F.G * NWAVES, l = tid_opaque() & 63;
    for (int m = gw; m < MROWS; m += NGW) {
        const int b = m / TPB, t = m - b * TPB;
        if (skipctx && t >= SEQ) continue;
        GAS v4u* pf = (GAS v4u*)(WSB(F, WS_OF) + (size_t)m * OMIX) + l; const GAS v4u* pb = (const GAS v4u*)(WSB(F, WS_OB) + (size_t)m * OMIX) + l;
        const GAS v4u* pg = (const GAS v4u*)(WSB(F, WS_P) + RP_G + (size_t)m * 4096) + l;
#pragma unroll
        for (int j = 0; j < 8; ++j) {
            const v4u a = pf[64 * j], bb = pb[64 * j], gg = pg[64 * j];
            float o[8] = {bflo(a.x) + bflo(bb.x), bfhi(a.x) + bfhi(bb.x), bflo(a.y) + bflo(bb.y), bfhi(a.y) + bfhi(bb.y), bflo(a.z) + bflo(bb.z), bfhi(a.z) + bfhi(bb.z), bflo(a.w) + bflo(bb.w), bfhi(a.w) + bfhi(bb.w)};
            const float g[8] = {bflo(gg.x), bfhi(gg.x), bflo(gg.y), bfhi(gg.y), bflo(gg.z), bfhi(gg.z), bflo(gg.w), bfhi(gg.w)};
            float ss = 0.f;
#pragma unroll
            for (int x = 0; x < 8; ++x) ss += o[x] * o[x];
            const float rstd = 1.0f / sqrtf(wave_sum(ss, l) * (1.0f / 512.0f) + EPS);
#pragma unroll
            for (int x = 0; x < 8; ++x) o[x] = silu(g[x]) * (o[x] * rstd);
            (dry ? (GAS v4u*)pb : pf)[64 * j] = (v4u){pk2(o[0], o[1]), pk2(o[2], o[3]), pk2(o[4], o[5]), pk2(o[6], o[7])};
        }
    }
}
__device__ __forceinline__ void ph_attention(Frame& F, const Args& A, int j2) {
    char* lds = (char*)(F.lds + RING_OFF);
    for (int i = 0;; ++i) {
        const int u = i * F.G + F.vcu; if (u >= 864) break;
        if (u < 768) { const int qb = u & 7, g3 = (u >> 3) % 3, bk = u / 24, kvh = bk & 3, b = bk >> 2, h = kvh * 3 + g3; const size_t rq = (size_t)(b * TPB + qb * 256);
            const bf16* Kh = WSB(F, WS_P) + (size_t)(b * TPB) * EIN + 2048 + kvh * 128;
            att::attn_dense_body(WSB(F, WS_P) + rq * EIN + 512 + h * 128, Kh, Kh + 512, WSB(F, WS_MIX) + rq * DM + 512 + h * 128, TPB, lds, IN_QG(F) + j2 * 128, WSF(F, WS_ROPE_E), qb * 256);
        } else { const int v = u - 768, b = v / 12, h = v - b * 12, kvh = h / 3; const size_t rq = (size_t)(b * TPB + SEQ);
            const bf16* Kh = WSB(F, WS_P) + rq * EIN + 2048 + kvh * 128;
            att::attn_dense_body(WSB(F, WS_P) + rq * EIN + 512 + h * 128, Kh, Kh + 512, WSB(F, WS_MIX) + rq * DM + 512 + h * 128, CTXL, lds, IN_QG(F) + j2 * 128, nullptr, 0);
        }
    }
}
namespace ret {
constexpr int K_LD = 544, V_LD = 288, ST_LD = 544, Q_LD = 544;
constexpr int K_OFF = 0, V_OFF = 64 * K_LD, ST_OFF = V_OFF + 64 * V_LD, Q_OFF = ST_OFF + 128 * ST_LD, LDS_END = Q_OFF + 64 * Q_LD;
static_assert(LDS_END <= LDSCTL_OFF, "retention LDS");
typedef short v4i16_t __attribute__((ext_vector_type(4)));
__device__ __forceinline__ bf16x8 lds16(const LAS unsigned char* p) { return *(const LAS bf16x8*)p; }
__device__ __forceinline__ s16x4 ldstr(const LAS unsigned char* p) { return __builtin_bit_cast(s16x4, __builtin_amdgcn_ds_read_tr16_b64_v4i16((LAS v4i16_t*)p)); }
__device__ __forceinline__ bf16x8 cat8v(v2u lo, v2u hi) { const v4u w = {lo.x, lo.y, hi.x, hi.y}; return __builtin_bit_cast(bf16x8, w); }
__device__ __forceinline__ bf16x8 cat8(s16x4 lo, s16x4 hi) { return (bf16x8){lo[0], lo[1], lo[2], lo[3], hi[0], hi[1], hi[2], hi[3]}; }
#ifndef PROBE_RETBAR
#define PROBE_RETBAR 0
#endif
#define RET_BAR() do { asm volatile("s_waitcnt lgkmcnt(0)" ::: "memory"); __builtin_amdgcn_s_barrier(); if (PROBE_RETBAR) __builtin_amdgcn_s_barrier(); asm volatile("" ::: "memory"); } while (0)
#ifndef RET_NOSB
#define RET_NOSB 0
#endif
#define RET_SB() do { if (!RET_NOSB) __builtin_amdgcn_sched_barrier(0); } while (0)
constexpr int S_OFF = ST_OFF, S_LD = 144;
constexpr int QR_LD = 528;
constexpr int Q1_OFF = S_OFF + 64 * S_LD, V1_OFF = Q1_OFF + 64 * Q_LD;
static_assert(V1_OFF + 64 * V_LD <= Q_OFF && Q1_OFF % 256 == 0 && V1_OFF % 256 == 0, "retention score image / second buffers");
#ifndef RET_PRIO
#define RET_PRIO 1
#endif
#ifndef RETP_T
#define RETP_T 0
#endif
#ifndef RETP_WAVE
#define RETP_WAVE 4
#endif
#ifndef RETP_CLK
#define RETP_CLK 0
#endif
#define RETP_FINE(k) do { if (RETP_T >= 5 && w == RETP_WAVE) { unsigned long t_; asm volatile("s_waitcnt lgkmcnt(0)\n\ts_memrealtime %0\n\ts_waitcnt lgkmcnt(0)" : "=s"(t_) :: "memory"); \
        if ((k) == RETP_T - 4 && t0_ != 0) tacc_ += (unsigned)(t_ - t0_); if ((k) == RETP_T - 5) t0_ = t_; } } while (0)
#define RETP_STAMP(k) do { if (RETP_T && RETP_T < 5 && w == RETP_WAVE) { unsigned long t_; if (RETP_CLK) asm volatile("s_memtime %0\n\ts_waitcnt lgkmcnt(0)" : "=s"(t_) :: "memory"); else asm volatile("s_memrealtime %0\n\ts_waitcnt lgkmcnt(0)" : "=s"(t_) :: "memory"); \
        if ((k) == ((RETP_T + 1) & 3) && t0_ != 0) tacc_ += (unsigned)(t_ - t0_); if ((k) == (RETP_T & 3)) t0_ = t_; } } while (0)
__device__ __forceinline__ unsigned ret_item_regst(LAS unsigned char* lds, const bf16* P, bf16* Odir, int b, int h, int dir, int es, float lg, int noctx) {
    int tid = threadIdx.x; asm volatile("" : "+v"(tid));
    const int w = __builtin_amdgcn_readfirstlane(tid >> 6), lane = tid & 63, g = lane >> 4, c = lane & 15, q4 = c >> 2, p4 = c & 3;
    const float lg2 = lg * 1.4426950408889634f;
    const bf16* Pq = P + (size_t)h * RP_PLANE + (tid & 31) * 8; const bf16* Pk = Pq + 8 * RP_PLANE; const bf16* Pv = P + RP_V + (size_t)(4 * h + es) * (RP_PLANE / 2) + (tid & 15) * 8;
    bf16* Po = Odir + h * 512 + es * 128 + (tid & 15) * 8;
    const int kr = (tid & 255) >> 5, vr = (tid & 255) >> 4;
    const float cd = __builtin_amdgcn_exp2f(64.0f * lg2);
    unsigned long t0_ = 0; unsigned tacc_ = 0;
#define RET_ROWBASE(n) (dir == 0 ? (b * TPB + ((n) < 4 ? SEQ + 64 * (n) : 64 * (n) - CTXL)) : (b * TPB + ((n) < 4 ? SEQ + 255 - 64 * (n) : 2303 - 64 * (n))))
#define RET_LOADK(n) do { const int rb_ = RET_ROWBASE(n), sg_ = dir == 0 ? 1 : -1; \
        _Pragma("unroll") for (int x = 0; x < 8; ++x) kreg[x] = *(const GAS v4u*)(Pk + (size_t)(rb_ + sg_ * (kr + 8 * x)) * 256); } while (0)
#define RET_LOADQ(n) do { const int rb_ = RET_ROWBASE(n), sg_ = dir == 0 ? 1 : -1; \
        _Pragma("unroll") for (int x = 0; x < 8; ++x) qreg[x] = *(const GAS v4u*)(Pq + (size_t)(rb_ + sg_ * (kr + 8 * x)) * 256); } while (0)
#define RET_STAGEK() do { \
        _Pragma("unroll") for (int x = 0; x < 8; ++x) *(LAS v4u*)(lds + K_OFF + (kr + 8 * x) * K_LD + (tid & 31) * 16) = kreg[x]; } while (0)
#define RET_STAGEQ(qo_) do { \
        _Pragma("unroll") for (int x = 0; x < 8; ++x) *(LAS v4u*)(lds + (qo_) + (kr + 8 * x) * QR_LD + (tid & 31) * 16) = qreg[x]; } while (0)
#define RET_LOADB(n) do { const int rb_ = RET_ROWBASE(n), sg_ = dir == 0 ? 1 : -1; \
        _Pragma("unroll") for (int x = 0; x < 4; ++x) vreg[x] = *(const GAS v4u*)(Pv + (size_t)(rb_ + sg_ * (vr + 16 * x)) * 128); } while (0)
#define RET_STAGEB(vo_) do { \
        _Pragma("unroll") for (int x = 0; x < 4; ++x) { const float kd = __builtin_amdgcn_exp2f((float)(63 - (vr + 16 * x)) * lg2); const v4u r = vreg[x]; \
            *(LAS v4u*)(lds + (vo_) + (vr + 16 * x) * V_LD + (tid & 15) * 16) = (v4u){pk2(bflo(r.x) * kd, bfhi(r.x) * kd), pk2(bflo(r.y) * kd, bfhi(r.y) * kd), pk2(bflo(r.z) * kd, bfhi(r.z) * kd), pk2(bflo(r.w) * kd, bfhi(r.w) * kd)}; } } while (0)
#define RET_OSTORE(m) do { const int rb_ = RET_ROWBASE(m), sg_ = dir == 0 ? 1 : -1; const int vb_ = ((m) & 1) ? V1_OFF : V_OFF; v4u o_[4]; \
        _Pragma("unroll") for (int x = 0; x < 4; ++x) o_[x] = *(const LAS v4u*)(lds + vb_ + (vr + 16 * x) * V_LD + (tid & 15) * 16); \
        _Pragma("unroll") for (int x = 0; x < 4; ++x) *(GAS v4u*)(Po + (size_t)(rb_ + sg_ * (vr + 16 * x)) * OMIX) = o_[x]; } while (0)
    RET_BAR();
    if (w < 4) {
        const int wa = w;
        if (RET_PRIO) __builtin_amdgcn_s_setprio(0);
        v4u kreg[8], qreg[8], vreg[4];
        RET_LOADQ(0); RET_LOADB(0); RET_LOADK(0);
        for (int n = 0; n < 36; ++n) {
            const int qo = (n & 1) ? Q1_OFF : Q_OFF, vo = (n & 1) ? V1_OFF : V_OFF;
            RET_STAGEK(); RET_STAGEQ(qo); RET_STAGEB(vo);
            RETP_STAMP(0);
            RET_BAR();
            RETP_STAMP(1);
            if (n + 1 < 36) { RET_LOADQ(n + 1); RET_LOADB(n + 1); RET_LOADK(n + 1); }
            if (n > 0 && !(noctx && n - 1 < 4)) RET_OSTORE(n - 1);
            if (!(noctx && n < 4)) {
                int gl = g, cl = c; asm volatile("" : "+v"(gl), "+v"(cl));
#define RD_Q(s)    lds16(lds + qo + (16 * wa + c) * QR_LD + (32 * (s) + 8 * g) * 2)
#define RD_K(jt, s) lds16(lds + K_OFF + (16 * (jt) + c) * K_LD + (32 * (s) + 8 * g) * 2)
                f32x4 sT[4];
#pragma unroll
                for (int jt = 0; jt < 4; ++jt) sT[jt] = (f32x4){0.f, 0.f, 0.f, 0.f};
                bf16x8 q0 = RD_Q(0), q1, k0[4], k1[4];
#pragma unroll
                for (int jt = 0; jt < 4; ++jt) k0[jt] = RD_K(jt, 0);
#pragma unroll
                for (int s = 0; s < 8; s += 2) {
                    q1 = RD_Q(s + 1);
#pragma unroll
                    for (int jt = 0; jt < 4; ++jt) k1[jt] = RD_K(jt, s + 1);
                    RET_SB();
#pragma unroll
                    for (int jt = 0; jt < 4; ++jt) sT[jt] = __builtin_amdgcn_mfma_f32_16x16x32_bf16(k0[jt], q0, sT[jt], 0, 0, 0);
                    RET_SB();
                    if (s + 2 < 8) { q0 = RD_Q(s + 2);
#pragma unroll
                        for (int jt = 0; jt < 4; ++jt) k0[jt] = RD_K(jt, s + 2); }
                    RET_SB();
#pragma unroll
                    for (int jt = 0; jt < 4; ++jt) sT[jt] = __builtin_amdgcn_mfma_f32_16x16x32_bf16(k1[jt], q1, sT[jt], 0, 0, 0);
                    RET_SB();
                }
#undef RD_Q
#undef RD_K
#pragma unroll
                for (int jt = 0; jt < 4; ++jt) { float v[4];
#pragma unroll
                    for (int r = 0; r < 4; ++r) { const int diff = (16 * wa + cl) - (16 * jt + 4 * gl + r); const bool keep = dir == 0 ? diff >= 0 : diff > 0; v[r] = keep ? sT[jt][r] : 0.f; }
                    *(LAS v2u*)(lds + S_OFF + (16 * wa + c) * S_LD + (16 * jt + 4 * g) * 2) = (v2u){pk2(v[0], v[1]), pk2(v[2], v[3])}; }
            }
            RETP_STAMP(2);
            RET_BAR();
            RETP_STAMP(3);
        }
        RET_BAR();
        RET_OSTORE(35);
    } else {
        const int wb = w - 4;
        if (RET_PRIO) __builtin_amdgcn_s_setprio(2);
        f32x4 st[8][2][2];
#pragma unroll
        for (int a = 0; a < 8; ++a)
#pragma unroll
            for (int d = 0; d < 2; ++d)
#pragma unroll
                for (int e = 0; e < 2; ++e) st[a][d][e] = (f32x4){0.f, 0.f, 0.f, 0.f};
        for (int n = 0; n < 36; ++n) {
            const bool doO = !(noctx && n < 4);
            const int qo = (n & 1) ? Q1_OFF : Q_OFF, vo = (n & 1) ? V1_OFF : V_OFF;
            RETP_STAMP(0);
            RET_BAR();
            RETP_STAMP(1);
            f32x4 OT[2][4];
#pragma unroll
            for (int et = 0; et < 2; ++et)
#pragma unroll
                for (int it = 0; it < 4; ++it) OT[et][it] = (f32x4){0.f, 0.f, 0.f, 0.f};
            if (doO) {
                const LAS unsigned char* qb0 = lds + qo + c * QR_LD + 8 * g; const LAS unsigned char* qb1 = qb0 + 32; asm volatile("" : "+v"(qb0), "+v"(qb1));
#define RD_QB(it, dq) cat8v(*(const LAS v2u*)(qb0 + 16 * (it) * QR_LD + 64 * (dq)), *(const LAS v2u*)(qb1 + 16 * (it) * QR_LD + 64 * (dq)))
#define RET_CVT(dq_, et_) __builtin_bit_cast(bf16x8, (v4u){pk2(st[dq_][0][et_][0], st[dq_][0][et_][1]), pk2(st[dq_][0][et_][2], st[dq_][0][et_][3]), pk2(st[dq_][1][et_][0], st[dq_][1][et_][1]), pk2(st[dq_][1][et_][2], st[dq_][1][et_][3])})
                bf16x8 qf[4], qn[4], sa[2], sn[2];
#pragma unroll
                for (int it = 0; it < 4; ++it) { qf[it] = RD_QB(it, 0); qn[it] = qf[it]; }
#pragma unroll
                for (int et = 0; et < 2; ++et) { sa[et] = RET_CVT(0, et); sn[et] = sa[et]; }
                RET_SB();
#pragma unroll
                for (int dq = 0; dq < 8; ++dq) {
                    if (dq + 1 < 8) {
#pragma unroll
                        for (int it = 0; it < 4; ++it) qn[it] = RD_QB(it, dq + 1);
#pragma unroll
                        for (int et = 0; et < 2; ++et) sn[et] = RET_CVT(dq + 1, et); }
#pragma unroll
                    for (int it = 0; it < 4; ++it) { OT[0][it] = __builtin_amdgcn_mfma_f32_16x16x32_bf16(sa[0], qf[it], OT[0][it], 0, 0, 0); OT[1][it] = __builtin_amdgcn_mfma_f32_16x16x32_bf16(sa[1], qf[it], OT[1][it], 0, 0, 0); }
                    __builtin_amdgcn_sched_group_barrier(0x100, 8, 0);
#pragma unroll
                    for (int k = 0; k < 4; ++k) { __builtin_amdgcn_sched_group_barrier(0x008, 1, 0); __builtin_amdgcn_sched_group_barrier(0x002, 2, 0); }
                    RET_SB();
#pragma unroll
                    for (int it = 0; it < 4; ++it) qf[it] = qn[it];
#pragma unroll
                    for (int et = 0; et < 2; ++et) sa[et] = sn[et];
                }
#undef RET_CVT
#undef RD_QB
            }
            bf16x8 vb[2][2];
#pragma unroll
            for (int s2 = 0; s2 < 2; ++s2)
#pragma unroll
                for (int et = 0; et < 2; ++et) { const LAS unsigned char* vp = lds + vo + (32 * s2 + 4 * g + q4) * V_LD + (32 * wb + 16 * et + 4 * p4) * 2; vb[s2][et] = cat8(ldstr(vp), ldstr(vp + 16 * V_LD)); }
#define RD_KA(s2, dq, dt) cat8(ldstr(lds + K_OFF + (32 * (s2) + 4 * g + q4) * K_LD + (32 * (dq) + 16 * (dt) + 4 * p4) * 2), ldstr(lds + K_OFF + (32 * (s2) + 4 * g + q4 + 16) * K_LD + (32 * (dq) + 16 * (dt) + 4 * p4) * 2))
            bf16x8 kc[2][2], kn[2][2];
#pragma unroll
            for (int dt = 0; dt < 2; ++dt)
#pragma unroll
                for (int s2 = 0; s2 < 2; ++s2) { kc[dt][s2] = RD_KA(s2, 0, dt); kn[dt][s2] = kc[dt][s2]; }
            RET_SB();
#pragma unroll
            for (int dq = 0; dq < 8; ++dq) {
                if (dq + 1 < 8) {
#pragma unroll
                    for (int dt = 0; dt < 2; ++dt)
#pragma unroll
                        for (int s2 = 0; s2 < 2; ++s2) kn[dt][s2] = RD_KA(s2, dq + 1, dt); }
                RET_SB();
#pragma unroll
                for (int s2 = 0; s2 < 2; ++s2)
#pragma unroll
                    for (int dt = 0; dt < 2; ++dt)
#pragma unroll
                        for (int et = 0; et < 2; ++et) st[dq][dt][et] = __builtin_amdgcn_mfma_f32_16x16x32_bf16(kc[dt][s2], vb[s2][et], st[dq][dt][et], 0, 0, 0);
                if (dq > 0) {
#pragma unroll
                    for (int dt = 0; dt < 2; ++dt)
#pragma unroll
                        for (int et = 0; et < 2; ++et) st[dq - 1][dt][et] = st[dq - 1][dt][et] * cd;
#pragma unroll
                    for (int k = 0; k < 8; ++k) { __builtin_amdgcn_sched_group_barrier(0x008, 1, 0); __builtin_amdgcn_sched_group_barrier(0x002, 1, 0); } }
                RET_SB();
#pragma unroll
                for (int dt = 0; dt < 2; ++dt)
#pragma unroll
                    for (int s2 = 0; s2 < 2; ++s2) kc[dt][s2] = kn[dt][s2];
            }
#undef RD_KA
            RETP_STAMP(2);
            RET_BAR();
            RETP_STAMP(3);
#pragma unroll
            for (int dt = 0; dt < 2; ++dt)
#pragma unroll
                for (int et = 0; et < 2; ++et) st[7][dt][et] = st[7][dt][et] * cd;
            if (doO) {
                float lg2v = lg2; int cl = c; asm volatile("" : "+v"(lg2v), "+v"(cl));
                bf16x8 sf[4][2];
#pragma unroll
                for (int it = 0; it < 4; ++it)
#pragma unroll
                    for (int s2 = 0; s2 < 2; ++s2) { const LAS unsigned char* sp = lds + S_OFF + (16 * it + c) * S_LD + (32 * s2 + 4 * g) * 2; const v2u lo = *(const LAS v2u*)sp, hi = *(const LAS v2u*)(sp + 32);
                        const v4u pw = {lo.x, lo.y, hi.x, hi.y}; sf[it][s2] = __builtin_bit_cast(bf16x8, pw); }
                RET_SB();
#pragma unroll
                for (int s2 = 0; s2 < 2; ++s2)
#pragma unroll
                    for (int it = 0; it < 4; ++it)
#pragma unroll
                        for (int et = 0; et < 2; ++et) OT[et][it] = __builtin_amdgcn_mfma_f32_16x16x32_bf16(vb[s2][et], sf[it][s2], OT[et][it], 0, 0, 0);
                RET_SB();
#pragma unroll
                for (int it = 0; it < 4; ++it) { const float rf = __builtin_amdgcn_exp2f((float)(16 * it + cl - 63) * lg2v);
#pragma unroll
                    for (int et = 0; et < 2; ++et) *(LAS v2u*)(lds + vo + (16 * it + c) * V_LD + (32 * wb + 16 * et + 4 * g) * 2) = (v2u){pk2(OT[et][it][0] * rf, OT[et][it][1] * rf), pk2(OT[et][it][2] * rf, OT[et][it][3] * rf)}; }
            }
        }
        RET_BAR();
    }
#undef RET_OSTORE
#undef RET_LOADK
#undef RET_LOADQ
#undef RET_STAGEK
#undef RET_STAGEQ
#undef RET_LOADB
#undef RET_STAGEB
#undef RET_ROWBASE
    if (RET_PRIO) __builtin_amdgcn_s_setprio(0);
    return RETP_CLK ? (tacc_ >> 4) : tacc_;
}
}
__device__ __forceinline__ void ph_retention(Frame& F, const Args& A, int j2, int noctx) {
    for (int item = F.vcu; item < 512; item += F.G) {
        const int es = item & 3, dir = (item >> 2) & 1, h = (item >> 3) & 7, b = item >> 6;
        const float lg = (dir ? IN_LDB(F) : IN_LDF(F))[j2 * 8 + h];
        const unsigned tk_ = ret::ret_item_regst(F.lds + RING_OFF, WSB(F, WS_P), dir ? WSB(F, WS_OB) : WSB(F, WS_OF), b, h, dir, es, lg, noctx);
        if (RETP_T && F.vcu == 0 && F.wave == RETP_WAVE && (tid_opaque() & 63) == 0) __hip_atomic_fetch_add(F.ctl + 20000, tk_, __ATOMIC_RELAXED, __HIP_MEMORY_SCOPE_AGENT);
    }
}
__global__ void __launch_bounds__(NWAVES * 64, 2) dit_fwd(Args args) {
    extern __shared__ __attribute__((aligned(16))) unsigned char lds[];
    Frame F0;
    F0.lds = (LAS unsigned char*)lds;
    F0.MISC = (volatile LAS unsigned*)(F0.lds + MISC_OFF);
    F0.wave = __builtin_amdgcn_readfirstlane((int)threadIdx.x >> 6);
    F0.G = gridDim.x; { const int bx = blockIdx.x; F0.vcu = (F0.G % 8 == 0) ? (bx % 8) * (F0.G / 8) + bx / 8 : bx; }
    F0.ws = (GAS unsigned char*)args.ws; F0.out = (GAS float*)args.out;
    F0.ctl = (gu32*)(F0.ws + WS_CTL);
    for (int u = threadIdx.x; u < (LDS_BYTES - LDSCTL_OFF) / 4; u += NWAVES * 64) ((LAS unsigned*)(F0.lds + LDSCTL_OFF))[u] = 0u;
    __syncthreads();
    XcdBarrier bar; bar.bar = (unsigned*)(F0.ctl + CW_BAR); bar.x = 0; bar.st = nullptr;
    if (MK_N_LAUNCHES == 1) bar = xcd_barrier_post((unsigned*)(F0.ctl + CW_BAR), F0.MISC + 8);
    const int lo = args.ph_lo, hi = args.ph_hi;
#ifndef LATE_F_FIN
#define LATE_F_FIN 0
#endif
#ifndef LATE_F_EVEN
#define LATE_F_EVEN 15
#endif
#ifndef LATE_F_ODD
#define LATE_F_ODD 30
#endif
#ifndef RESID_G
#define RESID_G 0
#endif
#ifndef GEMM_SP2
#define GEMM_SP2 true
#endif
#ifndef GEMM_ALIGN
#define GEMM_ALIGN true
#endif
#ifndef PROBE_BAR2
#define PROBE_BAR2 0
#endif
#ifndef SPLITK
#define SPLITK 0
#endif
#ifndef SITE_MASK
#define SITE_MASK 0xffffffffu
#endif
#define SITE(n) (((SITE_MASK) >> (n)) & 1u)
#define IN(k) (lo <= (k) && (k) < hi)
#define SEAM(k) do { if ((k) + 1 < hi) { if (MK_N_LAUNCHES == 1) { XcdBarrier bv_ = bar; asm volatile("" : "+s"(bv_.bar)); xcd_barrier(bv_); if (PROBE_BAR2) { XcdBarrier bw_ = bar; asm volatile("" : "+s"(bw_.bar)); xcd_barrier(bw_); } } } } while (0)
#define LAUNDER(Fv) Frame Fv = F0; asm volatile("" : "+s"(Fv.ws), "+s"(Fv.out), "+s"(Fv.G), "+s"(Fv.vcu), "+s"(Fv.wave), "+s"(cid))
#define GEMM_CALL1(EPI, g_, S_, E_) pg8::gemm_phase<EPI, pg8::TokOrder, GEMM_ALIGN, GEMM_SP2>(F.lds + RING_OFF, g_, S_, E_)
#ifdef PROBE_GEMM_STORE2
#define GEMM_CALL(EPI, g_, S_, E_) do { for (int rep_ = 0; rep_ < 2; ++rep_) { GEMM_CALL1(EPI, g_, S_, E_); __syncthreads(); } } while (0)
#else
#define GEMM_CALL(EPI, g_, S_, E_) GEMM_CALL1(EPI, g_, S_, E_)
#endif
#ifdef PROBE_GEMM_RESID2
#define GEMM_CALLR(g_, S_, E_) do { pg8::EpiResid E2_ = E_; for (int rep_ = 0; rep_ < 2; ++rep_) { E2_.dry = rep_; GEMM_CALL1(pg8::EpiResid, g_, S_, E2_); __syncthreads(); } } while (0)
#else
#define GEMM_CALLR(g_, S_, E_) GEMM_CALL1(pg8::EpiResid, g_, S_, E_)
#endif
    int cid = (int)blockIdx.x;

    if (SITE(0) && IN(0)) { LAUNDER(F); ph_prologue(F, args);
#ifdef PROBE_PRO2
        __syncthreads(); { LAUNDER(F2); ph_prologue(F2, args); }
#endif
        SEAM(0); }
    for (int L = 0; L < 4; ++L) {
        const int pb = 1 + 9 * L, j2 = L >> 1, even = !(L & 1), last = (L == 3);
        if (SITE(1) && IN(pb + 0)) { LAUNDER(F); ph_modulate(F, args, L, 0, 0, SPLITK && L >= 1, L == 0);
#ifdef PROBE_MOD2
            { LAUNDER(F2); ph_modulate(F2, args, L, 0, 0, 0, L == 0); }
#endif
            SEAM(pb + 0); }
        if (SITE(2) && IN(pb + 1)) { LAUNDER(F);
            const int N = even ? EIN : OIN;
            pg8::Gemm g{WSB(F, WS_XN), even ? WSB(F, WS_W_INE) + (size_t)j2 * EIN * DM : WSB(F, WS_W_INO) + (size_t)j2 * OIN * DM, MROWS, N, DM};
            pg8::TokOrder S; if (last) S.init2(MLAT, N, DM, F.G, cid, 1, 0, 1); else S.init2(MROWS, N, DM, F.G, cid, 0, 0);
            pg8::EpiStore E{WSB(F, WS_P), N, even ? 0 : 3, WSF(F, WS_ROPE_O)};
            GEMM_CALL(pg8::EpiStore, g, S, E);
            SEAM(pb + 1);
        }
        if (even) {
            if (SITE(3) && IN(pb + 2)) { LAUNDER(F); ph_qk_even(F, args, j2); SEAM(pb + 2); }
            if (IN(pb + 3)) {
                if (SITE(4)) { LAUNDER(F); pg8::Gemm g{WSB(F, WS_WTL), WSB(F, WS_FT), 4096, 4096, 2048}; pg8::TokOrder S; S.init2(4096, 4096, 2048, F.G, cid, 0, 0); pg8::EpiStore E{WSB(F, WS_Z), 1024, 1, nullptr}; GEMM_CALL(pg8::EpiStore, g, S, E); }
                if (SITE(14)) { LAUNDER(F); pg8::Gemm g{WSB(F, WS_WTC), WSB(F, WS_FTC), 512, 4096, 256}; pg8::TokOrder S; S.init2(512, 4096, 256, F.G, cid, 0, 0); pg8::EpiStore E{WSB(F, WS_Z), 1024, 2, nullptr}; GEMM_CALL(pg8::EpiStore, g, S, E); }
                if (SITE(5)) { LAUNDER(F); ph_attention(F, args, j2); }
#ifdef PROBE_ATT2
                { LAUNDER(F); ph_attention(F, args, j2); }
#endif
                SEAM(pb + 3);
            }
            if (SITE(6) && IN(pb + 4)) { LAUNDER(F);
                pg8::Gemm g{WSB(F, WS_Z), WSB(F, WS_CB), MROWS, 512, 1024}; pg8::TokOrder S; S.init2(MROWS, 512, 1024, F.G, cid, 0, 0); pg8::EpiStore E{WSB(F, WS_MIX), DM, 0, nullptr};
                GEMM_CALL(pg8::EpiStore, g, S, E);
                SEAM(pb + 4);
            }
        } else {
            if (SITE(8) && IN(pb + 3)) { LAUNDER(F); ph_retention(F, args, j2, last);
#ifdef PROBE_RET2
                { LAUNDER(F2); ph_retention(F2, args, j2, last); }
#endif
                SEAM(pb + 3); }
            if (SITE(9) && IN(pb + 4)) { LAUNDER(F); ph_comb(F, last);
#ifdef PROBE_COMB2
                { LAUNDER(F2); ph_comb(F2, last, 1); }
#endif
                SEAM(pb + 4); }
        }
        if (SITE(10) && IN(pb + 5)) { LAUNDER(F); const float* gates = WSF(F, WS_MOD) + (size_t)L * NSET * MODW;
            const int K = even ? DM : OMIX, Ml = last ? MLAT : MROWS;
            pg8::Gemm g{even ? WSB(F, WS_MIX) : WSB(F, WS_OF), even ? WSB(F, WS_W_OUTE) + (size_t)j2 * DM * DM : WSB(F, WS_W_OUTO) + (size_t)j2 * DM * OMIX, Ml, DM, K};
            pg8::TokOrder S; S.init2(Ml, DM, K, F.G, cid, last, SPLITK && L > 0, 0, last ? 0 : RESID_G);
            pg8::EpiResid E{WSF(F, WS_H), gates, 2 * DM, nullptr, WSF(F, WS_DELTA), 0, L == 0 ? (const float*)(const GAS float*)args.in[0] : nullptr, (const float*)(const GAS float*)args.in[2]};
            GEMM_CALLR(g, S, E);
#if LATE_CONV
            if (!last && cid >= S.rem && S.rem > 0) { const int cnt = conv_layer_count(L + 1), c0 = (cnt * LATE_F_FIN) / 100, c1 = c0 + (cnt * (even ? LATE_F_EVEN : LATE_F_ODD)) / 100;
                conv_in_tail(F, args, L + 1, c0, c1, cid - S.rem, F.G - S.rem); }
#endif
            SEAM(pb + 5);
        }
        if (SITE(11) && IN(pb + 6)) { LAUNDER(F); ph_modulate(F, args, L, 1, last, SPLITK && !last && L > 0, 0);
#ifdef PROBE_MOD2
            { LAUNDER(F2); ph_modulate(F2, args, L, 1, last, 0, 0); }
#endif
            SEAM(pb + 6); }
        if (SITE(12) && IN(pb + 7)) { LAUNDER(F);
            const int Ml = last ? MLAT : MROWS;
            pg8::Gemm g{WSB(F, WS_XN), WSB(F, WS_W_FIN) + (size_t)L * FFN2 * DM, Ml, FFN2, DM};
            pg8::TokOrder S; S.init2(Ml, FFN2, DM, F.G, cid, last, 0);
            pg8::EpiSwiglu E{WSB(F, WS_P), FFN};
            GEMM_CALL(pg8::EpiSwiglu, g, S, E);
#if LATE_CONV
            if (!last && LATE_F_FIN > 0 && cid >= S.rem && S.rem > 0) { const int cnt = conv_layer_count(L + 1), c0 = (cnt * LATE_F_FIN) / 100;
                conv_in_tail(F, args, L + 1, 0, c0, cid - S.rem, F.G - S.rem); }
#endif
            SEAM(pb + 7);
        }
        if (SITE(13) && IN(pb + 8)) { LAUNDER(F); const float* gates = WSF(F, WS_MOD) + (size_t)L * NSET * MODW;
            const int Ml = last ? MLAT : MROWS;
            pg8::Gemm g{WSB(F, WS_P), WSB(F, WS_W_FOUT) + (size_t)L * DM * FFN, Ml, DM, FFN};
            pg8::TokOrder S; S.init2(Ml, DM, FFN, F.G, cid, last, SPLITK, 0, last ? 0 : RESID_G);
            pg8::EpiResid E{WSF(F, WS_H), gates, 5 * DM, last ? (float*)F.out : nullptr, WSF(F, WS_DELTA), 0, nullptr, nullptr};
            GEMM_CALLR(g, S, E);
#if LATE_CONV
            if (!last && cid >= S.rem && S.rem > 0) { const int cnt = conv_layer_count(L + 1), c1 = (cnt * LATE_F_FIN) / 100 + (cnt * (even ? LATE_F_EVEN : LATE_F_ODD)) / 100;
                conv_in_tail(F, args, L + 1, c1, cnt, cid - S.rem, F.G - S.rem); }
#endif
            SEAM(pb + 8);
        }
    }
#undef IN
#undef SEAM
#undef LAUNDER
#undef GEMM_CALL
#if RETP_T
#ifndef RETP_MULT
#define RETP_MULT 4
#endif
    if (F0.vcu == 0 && threadIdx.x == 0) {
        const unsigned v_ = __hip_atomic_load(F0.ctl + 20000, __ATOMIC_RELAXED, __HIP_MEMORY_SCOPE_AGENT);
        const unsigned long s_ = __builtin_amdgcn_s_memrealtime();
        while (__builtin_amdgcn_s_memrealtime() - s_ < (unsigned long)v_ * RETP_MULT) __builtin_amdgcn_s_sleep(16);
    }
#endif
}

extern "C" void kernel_launch(void* const* d_in, const int* in_sizes, int n_in, void* d_out, int out_size, void* d_ws, size_t ws_size, hipStream_t stream) {
    static int grid = 0;
    if (grid == 0) {
        if (n_in != 16 || out_size != MLAT * DM || ws_size < WS_END) { fprintf(stderr, "kernel_launch: unexpected shapes: n_in %d out %d ws %zu (need %zu)\n", n_in, out_size, ws_size, (size_t)WS_END); grid = -1; return; }
        int dev = 0, cus = 0, per_cu = 0;
        if (hipGetDevice(&dev) != hipSuccess || hipDeviceGetAttribute(&cus, hipDeviceAttributeMultiprocessorCount, dev) != hipSuccess) { fprintf(stderr, "kernel_launch: device query failed\n"); grid = -1; return; }
        if (hipFuncSetAttribute((const void*)dit_fwd, hipFuncAttributeMaxDynamicSharedMemorySize, LDS_BYTES) != hipSuccess) { fprintf(stderr, "kernel_launch: hipFuncSetAttribute failed\n"); grid = -1; return; }
        if (hipOccupancyMaxActiveBlocksPerMultiprocessor(&per_cu, (const void*)dit_fwd, NWAVES * 64, LDS_BYTES) != hipSuccess || per_cu < 1)
            fprintf(stderr, "kernel_launch: note: occupancy query reports %d workgroups per CU\n", per_cu);
        (void)hipGetLastError();
        grid = cus;
    }
    if (grid < 0) return;
    if (hipMemsetAsync((char*)d_ws + WS_CTL, 0, CTL_ZERO_BYTES, stream) != hipSuccess) { fprintf(stderr, "kernel_launch: memset failed\n"); return; }
    Args a{};
    for (int i = 0; i < 16; ++i) a.in[i] = (const float*)d_in[i];
    a.out = (float*)d_out; a.ws = (unsigned char*)d_ws;
#if MK_N_LAUNCHES == 1
    a.ph_lo = 0; a.ph_hi = N_PHASES;
    hipLaunchKernelGGL(dit_fwd, dim3(grid), dim3(NWAVES * 64), LDS_BYTES, stream, a);
#else
    for (int p = 0; p < N_PHASES; ++p) { a.ph_lo = p; a.ph_hi = p + 1; hipLaunchKernelGGL(dit_fwd, dim3(grid), dim3(NWAVES * 64), LDS_BYTES, stream, a); }
#endif
    const hipError_t le = hipPeekAtLastError();
    if (le != hipSuccess) fprintf(stderr, "kernel_launch: launch failed: %s\n", hipGetErrorName(le));
}
```

```cpp
#include <hip/hip_runtime.h>
#include <cstdio>
#include <cstdint>
#include <cmath>
#ifndef WGM_SET
#define WGM_SET 8
#endif
namespace pg8 {
#define PG8_LAS __attribute__((address_space(3)))
typedef unsigned short bf16_t;
typedef short bf16x8 __attribute__((ext_vector_type(8)));
typedef float f32x4 __attribute__((ext_vector_type(4)));
typedef unsigned u32x4 __attribute__((ext_vector_type(4)));
constexpr int BM = 256, BK = 64, HALF = 128, HTB = HALF * BK * 2  , STAGE_BYTES = 8 * HTB, NXCD = 8, WGM = WGM_SET;

__host__ __device__ __forceinline__ int lds_byte(int r, int c) { const int st = (r >> 4) * 2 + (c >> 5), rr = r & 15, cc = c & 31, ob = rr * 64 + cc * 2; return st * 1024 + (ob ^ (((ob >> 9) & 1) << 5)); }
__host__ __device__ __forceinline__ void stage_rc(int b, int& R, int& C) { const int st = b / 1024, sb = b % 1024, swz = sb ^ (((sb >> 9) & 1) << 5); R = (st >> 1) * 16 + swz / 64; C = (st & 1) * 32 + (swz % 64) / 2; }
__host__ __device__ __forceinline__ int perm32(int rho) { const int n = rho >> 4, i = rho & 15; return 8 * (i >> 2) + 4 * n + (i & 3); }

struct Unit { int pm, pn, kt0, nkt, split; };
struct Gemm { const bf16_t* A; const bf16_t* Bt; int M, N, K; };

#ifndef WGM_WIDE
#define WGM_WIDE WGM
#endif
#ifndef WGM_NARROW
#define WGM_NARROW 2
#endif
struct StaticOrder {
    int nM, nN, nwg, G, c;
    __host__ __device__ void init(int M, int N, int G_, int c_) { nM = M / BM; nN = N / BM; nwg = nM * nN; G = G_; c = c_; }
    __host__ __device__ void map(int wgid, Unit& u) const {
        { const int q = nwg / NXCD, r = nwg % NXCD, xcd = wgid % NXCD, off = wgid / NXCD; wgid = (xcd < r ? xcd * (q + 1) : r * (q + 1) + (xcd - r) * q) + off; }
        const int wgm = nN >= 12 ? WGM_WIDE : WGM_NARROW;
        const int nig = wgm * nN, gid = wgid / nig, fm = gid * wgm, gsz = (nM - fm) < wgm ? (nM - fm) : wgm;
        u.pm = fm + ((wgid % nig) % gsz); u.pn = (wgid % nig) / gsz;
    }
    __device__ __forceinline__ void a_ready(const Unit&) const {}
    __device__ __forceinline__ void done(const Unit&) const {}
};

typedef __bf16 bf16x2_cv __attribute__((ext_vector_type(2)));
typedef float f32x2_cv __attribute__((ext_vector_type(2)));
__device__ __forceinline__ unsigned cvt_pk_bf16(float lo, float hi) { const f32x2_cv v = {lo, hi}; const bf16x2_cv b = __builtin_convertvector(v, bf16x2_cv); return __builtin_bit_cast(unsigned, b); }
typedef float f32x2 __attribute__((ext_vector_type(2)));
#ifndef WT_STORES
#define WT_STORES 0
#endif
__device__ __forceinline__ void st16_wt(void* p, u32x4 v) {
#if WT_STORES
    asm volatile("global_store_dwordx4 %0, %1, off sc1" :: "v"(p), "v"(v) : "memory");
#else
    *(u32x4*)p = v;
#endif
}
__device__ __forceinline__ void st16_wt(void* p, f32x4 v) { st16_wt(p, __builtin_bit_cast(u32x4, v)); }
#ifndef WT_HID
#define WT_HID 0
#endif
__device__ __forceinline__ void st16_hid(void* p, u32x4 v) {
#if WT_HID
    asm volatile("global_store_dwordx4 %0, %1, off sc1" :: "v"(p), "v"(v) : "memory");
#else
    *(u32x4*)p = v;
#endif
}
#ifndef GEMM_G_LIMIT
#define GEMM_G_LIMIT 0
#endif
struct TokOrder : StaticOrder {
    int skip, nktfull, nfull, rem, S, nextra;
    __device__ __forceinline__ void init2(int M, int N, int K, int G_, int c_, int skip_, int allow_split, int ctxkv = 0, int glimit = 0) {
        init(M, N, G_, c_); if (glimit > 0 && glimit < G_) G = glimit;     if (GEMM_G_LIMIT > 0 && GEMM_G_LIMIT < G_) { G = GEMM_G_LIMIT; }     skip = skip_; nktfull = K / BK; nfull = (nwg / G) * G; rem = nwg - nfull; S = 1; nextra = ctxkv ? 8 * 24 : 0;
        if (allow_split && rem > 0) { const int s = G / rem; S = s >= 4 ? 4 : 1;     if ((nktfull % (2 * S)) != 0 || nktfull / S < 4) S = 1; }
    }
    __device__ __forceinline__ bool next(int i, Unit& u) const {
        if (c >= G) return false;
        const long L = (long)i * G + c; int idx;
        if (L < nfull || S == 1) {
            if (L >= nwg) { const int r = (int)(L - nwg); if (r >= nextra) return false; u.kt0 = 0; u.nkt = nktfull; u.split = 0; u.pm = 9 * (r / 24) + 8; u.pn = 8 + r % 24; return true; }
            idx = (int)L; u.kt0 = 0; u.nkt = nktfull; u.split = 0; }
        else { const int sub = (int)(L - nfull); if (sub >= rem * S) return false; idx = nfull + sub / S; u.nkt = nktfull / S; u.kt0 = (sub % S) * u.nkt; u.split = 1 + (sub / S) * 4 + (sub % S); }
        map(idx, u); if (skip) u.pm += (u.pm >> 3); return true;
    }
};
struct EpiStore {
    static constexpr bool PERM = true, AFTER_DRAIN = false;
    bf16_t* O; int ldc; int mode; const float* rope;
    __device__ __forceinline__ void operator()(const f32x4 (&acc)[2][2][4][2], const Unit& u, int wr, int wc, int fr, int fq) const {
        size_t base, bjs = HALF; int ld = ldc;
        if (mode == 3) {
            constexpr size_t RP = (size_t)18432 * 256;
            if (u.pn < 32) { ld = u.pn < 16 ? 256 : 128; base = (size_t)u.pn * RP + (size_t)u.pm * BM * (size_t)ld; if (u.pn >= 16) bjs = RP / 2; }
            else { ld = 4096; base = 32 * RP + (size_t)u.pm * BM * (size_t)4096 + (size_t)(u.pn - 32) * BM; }
        }
        else if (mode == 0) base = (size_t)u.pm * BM * (size_t)ldc + (size_t)u.pn * BM;
        else if (mode == 1) { const int part = u.pm >> 3, t0 = (u.pm & 7) * 256, b = u.pn >> 1, c0 = (u.pn & 1) * 256; base = ((size_t)(b * 2304 + t0)) * 1024 + part * 512 + c0; }
        else { const int part = u.pm, b = u.pn >> 1, c0 = (u.pn & 1) * 256; base = ((size_t)(b * 2304 + 2048)) * 1024 + part * 512 + c0; }
        const int tt = u.pm % 9;
        if (mode == 3 && u.pn < 16 && tt != 8) {
            const int half = wc >> 1, f0 = 32 * (wc & 1) + 8 * fq;
            bf16_t* p0 = O + base + (size_t)(wr * 64 + fr) * ld + half * 128 + f0;
#pragma unroll
            for (int ai = 0; ai < 2; ++ai)
#pragma unroll
                for (int m = 0; m < 4; ++m) { const int t = tt * 256 + ai * HALF + wr * 64 + m * 16 + fr, pos = half ? (t & 63) : (t >> 6);
                    const f32x4* tb = (const f32x4*)(rope + (size_t)(pos * 64 + f0) * 2);
                    const f32x4 t0 = tb[0], t1 = tb[1], t2 = tb[2], t3 = tb[3];
                    const f32x4 a0 = acc[ai][0][m][0], a1 = acc[ai][0][m][1], b0 = acc[ai][1][m][0], b1 = acc[ai][1][m][1];
                    const f32x4 cs0 = {t0[0], t0[2], t1[0], t1[2]}, sn0 = {t0[1], t0[3], t1[1], t1[3]}, cs1 = {t2[0], t2[2], t3[0], t3[2]}, sn1 = {t2[1], t2[3], t3[1], t3[3]};
                    const f32x4 x0 = a0 * cs0 - b0 * sn0, x1 = a1 * cs1 - b1 * sn1, y0 = b0 * cs0 + a0 * sn0, y1 = b1 * cs1 + a1 * sn1;
                    bf16_t* rowp = p0 + (size_t)(ai * HALF + m * 16) * ld;
                    u32x4 w; w.x = cvt_pk_bf16(x0[0], x0[1]); w.y = cvt_pk_bf16(x0[2], x0[3]); w.z = cvt_pk_bf16(x1[0], x1[1]); w.w = cvt_pk_bf16(x1[2], x1[3]);
                    st16_wt(rowp, w);
                    w.x = cvt_pk_bf16(y0[0], y0[1]); w.y = cvt_pk_bf16(y0[2], y0[3]); w.z = cvt_pk_bf16(y1[0], y1[1]); w.w = cvt_pk_bf16(y1[2], y1[3]);
                    st16_wt(rowp + 64, w); }
            return;
        }
        if (mode == 3 && u.pn < 16) {
            const int half = wc >> 1, f0 = 32 * (wc & 1) + 8 * fq;
            bf16_t* p0 = O + base + (size_t)(wr * 64 + fr) * ld + half * 128 + f0;
#pragma unroll
            for (int ai = 0; ai < 2; ++ai)
#pragma unroll
                for (int m = 0; m < 4; ++m) { bf16_t* rowp = p0 + (size_t)(ai * HALF + m * 16) * ld;
#pragma unroll
                    for (int bj = 0; bj < 2; ++bj) { const f32x4 v0 = acc[ai][bj][m][0], v1 = acc[ai][bj][m][1];
                        u32x4 w; w.x = cvt_pk_bf16(v0[0], v0[1]); w.y = cvt_pk_bf16(v0[2], v0[3]); w.z = cvt_pk_bf16(v1[0], v1[1]); w.w = cvt_pk_bf16(v1[2], v1[3]);
                        st16_wt(rowp + bj * 64, w); } }
            return;
        }
        bf16_t* p0 = O + base + (size_t)(wr * 64 + fr) * ld + wc * 32 + 8 * fq;
#pragma unroll
        for (int ai = 0; ai < 2; ++ai)
#pragma unroll
            for (int m = 0; m < 4; ++m) { bf16_t* rowp = p0 + (size_t)(ai * HALF + m * 16) * ld;
#pragma unroll
                for (int bj = 0; bj < 2; ++bj) { const f32x4 v0 = acc[ai][bj][m][0], v1 = acc[ai][bj][m][1];
                    u32x4 w; w.x = cvt_pk_bf16(v0[0], v0[1]); w.y = cvt_pk_bf16(v0[2], v0[3]); w.z = cvt_pk_bf16(v1[0], v1[1]); w.w = cvt_pk_bf16(v1[2], v1[3]);
                    st16_wt(rowp + bj * bjs, w); } }
    }
};
__device__ __forceinline__ float silu_f(float g) { return g * __builtin_amdgcn_rcpf(1.0f + __builtin_amdgcn_exp2f(-1.4426950408889634f * g)); }
struct EpiSwiglu {
    static constexpr bool PERM = true, AFTER_DRAIN = false;
    bf16_t* H; int ldh;
    __device__ __forceinline__ void operator()(const f32x4 (&acc)[2][2][4][2], const Unit& u, int wr, int wc, int fr, int fq) const {
        bf16_t* p0 = H + (size_t)(u.pm * BM + wr * 64 + fr) * ldh + u.pn * HALF + wc * 32 + 8 * fq;
#pragma unroll
        for (int ai = 0; ai < 2; ++ai)
#pragma unroll
            for (int m = 0; m < 4; ++m) { bf16_t* rowp = p0 + (size_t)(ai * HALF + m * 16) * ldh;
                const f32x4 g0 = acc[ai][0][m][0], g1 = acc[ai][0][m][1], u0 = acc[ai][1][m][0], u1 = acc[ai][1][m][1];
                u32x4 w; w.x = cvt_pk_bf16(silu_f(g0[0]) * u0[0], silu_f(g0[1]) * u0[1]); w.y = cvt_pk_bf16(silu_f(g0[2]) * u0[2], silu_f(g0[3]) * u0[3]);
                w.z = cvt_pk_bf16(silu_f(g1[0]) * u1[0], silu_f(g1[1]) * u1[1]); w.w = cvt_pk_bf16(silu_f(g1[2]) * u1[2], silu_f(g1[3]) * u1[3]);
                st16_hid(rowp, w); }
    }
};
#ifndef EPI_RB
#define EPI_RB 2
#endif
struct EpiResid {
    static constexpr bool PERM = true, AFTER_DRAIN = false;
    bf16_t* h; const float* gates; int goff; float* out; float* delta; int dry; const float* x0; const float* c0;
    __device__ __forceinline__ void operator()(const f32x4 (&acc)[2][2][4][2], const Unit& u, int wr, int wc, int fr, int fq) const {
        const int b = u.pm / 9, tt = u.pm - 9 * b, set = (tt == 8) ? 8 : b;
        const int col0 = u.pn * BM + wc * 32 + 8 * fq;
        const float* gp = gates + (size_t)set * 12288 + goff + col0;
        f32x4 gv[2][2];
#pragma unroll
        for (int bj = 0; bj < 2; ++bj)
#pragma unroll
            for (int n = 0; n < 2; ++n) { gv[bj][n] = *(const f32x4*)(gp + bj * HALF + n * 4); if (dry) gv[bj][n] = gv[bj][n] * 0.0f; }
        const int rl = wr * 64 + fr;
        if (u.split) return;
        bf16_t* hb = h + (size_t)(u.pm * BM + rl) * 2048 + col0;
        const float* xp = (x0 && !dry) ? (tt == 8 ? c0 + (size_t)(b * 256 + rl) * 2048 + col0 : x0 + (size_t)(b * 2048 + tt * 256 + rl) * 2048 + col0) : nullptr;
        float* op = (out && !dry) ? out + (size_t)(b * 2048 + tt * 256 + rl) * 2048 + col0 : nullptr;
#pragma unroll
        for (int ai = 0; ai < 2; ++ai)
#pragma unroll
            for (int mp = 0; mp < 4; mp += EPI_RB) {
                f32x4 hv[EPI_RB][2][2];
                if (xp) {
#pragma unroll
                    for (int mm = 0; mm < EPI_RB; ++mm)
#pragma unroll
                        for (int bj = 0; bj < 2; ++bj)
#pragma unroll
                            for (int n = 0; n < 2; ++n) hv[mm][bj][n] = *(const f32x4*)(xp + (size_t)(ai * HALF + (mp + mm) * 16) * 2048 + bj * HALF + n * 4);
                } else {
                    u32x4 hr[EPI_RB][2];
#pragma unroll
                    for (int mm = 0; mm < EPI_RB; ++mm)
#pragma unroll
                        for (int bj = 0; bj < 2; ++bj) hr[mm][bj] = *(const u32x4*)(hb + (size_t)(ai * HALF + (mp + mm) * 16) * 2048 + bj * HALF);
#pragma unroll
                    for (int mm = 0; mm < EPI_RB; ++mm)
#pragma unroll
                        for (int bj = 0; bj < 2; ++bj) { const u32x4 r = hr[mm][bj];
                            hv[mm][bj][0] = (f32x4){__builtin_bit_cast(float, r.x << 16), __builtin_bit_cast(float, r.x & 0xffff0000u), __builtin_bit_cast(float, r.y << 16), __builtin_bit_cast(float, r.y & 0xffff0000u)};
                            hv[mm][bj][1] = (f32x4){__builtin_bit_cast(float, r.z << 16), __builtin_bit_cast(float, r.z & 0xffff0000u), __builtin_bit_cast(float, r.w << 16), __builtin_bit_cast(float, r.w & 0xffff0000u)}; }
                }
                asm volatile("" ::: "memory");
#pragma unroll
                for (int mm = 0; mm < EPI_RB; ++mm) { const int m = mp + mm; const size_t ro = (size_t)(ai * HALF + m * 16) * 2048;
#pragma unroll
                    for (int bj = 0; bj < 2; ++bj) { const f32x4 y0 = hv[mm][bj][0] + gv[bj][0] * acc[ai][bj][m][0], y1 = hv[mm][bj][1] + gv[bj][1] * acc[ai][bj][m][1];
                        if (op) { st16_wt(op + ro + bj * HALF, y0); st16_wt(op + ro + bj * HALF + 4, y1); }
                        else { u32x4 w; w.x = cvt_pk_bf16(y0[0], y0[1]); w.y = cvt_pk_bf16(y0[2], y0[3]); w.z = cvt_pk_bf16(y1[0], y1[1]); w.w = cvt_pk_bf16(y1[2], y1[3]); st16_wt(hb + ro + bj * HALF, w); } } }
                asm volatile("" ::: "memory"); }
    }
};

template <class Epi, class Sched, bool ALIGN_EPI = false, bool SP2 = false>
__device__ __forceinline__ void gemm_phase(PG8_LAS unsigned char* lds, const Gemm g, const Sched& S, const Epi& E) {
    int tid = threadIdx.x; asm volatile("" : "+v"(tid));
    const int wid = __builtin_amdgcn_readfirstlane(tid >> 6), lane = tid & 63, wr = wid >> 2, wc = wid & 3, fr = lane & 15, fq = lane >> 4;
    const int K = g.K;
    unsigned voffA[2], voffB[2];
#pragma unroll
    for (int i = 0; i < 2; ++i) { int R, C; stage_rc(tid * 16 + i * 8192, R, C); const int Rb = Epi::PERM ? ((R & ~31) + perm32(R & 31)) : R;
        voffA[i] = (unsigned)(R * K + C) * 2u; voffB[i] = (unsigned)(Rb * K + C) * 2u; }
    const size_t kstep = (size_t)(BK * 2);
    const size_t hstep = (size_t)HALF * K * 2;
    const size_t tstep = 2 * hstep;
    const unsigned ldsw = (unsigned)wid * 1024u;
    const int aoff = lds_byte(wr * 64 + fr, fq * 8), boff = lds_byte(wc * 32 + fr, fq * 8);
#define PG8_SA(b, h) (((b) * 2 + (h)) * HTB)
#define PG8_SB(b, h) ((4 + (b) * 2 + (h)) * HTB)
#define PG8_STAGE(bufoff, gbase, voff) do { _Pragma("unroll") for (int _i = 0; _i < 2; ++_i) \
        __builtin_amdgcn_global_load_lds((const unsigned*)((const char*)(gbase) + (voff)[_i]), (PG8_LAS unsigned*)(lds + (bufoff) + ldsw + _i * 8192), 16, 0, 0); } while (0)
#define PG8_LDA(dst, b, h) do { _Pragma("unroll") for (int m = 0; m < 4; ++m) _Pragma("unroll") for (int k = 0; k < 2; ++k) dst[m][k] = *(const PG8_LAS bf16x8*)(lds + PG8_SA(b, h) + aoff + m * 2048 + k * 1024); } while (0)
#define PG8_LDB(dst, b, h) do { _Pragma("unroll") for (int n = 0; n < 2; ++n) _Pragma("unroll") for (int k = 0; k < 2; ++k) dst[n][k] = *(const PG8_LAS bf16x8*)(lds + PG8_SB(b, h) + boff + n * 2048 + k * 1024); } while (0)
#define PG8_MMA(ai, bj, At, Bt) do { __builtin_amdgcn_s_setprio(1); _Pragma("unroll") for (int m = 0; m < 4; ++m) _Pragma("unroll") for (int n = 0; n < 2; ++n) _Pragma("unroll") for (int k = 0; k < 2; ++k) \
        acc[ai][bj][m][n] = __builtin_amdgcn_mfma_f32_16x16x32_bf16(Bt[n][k], At[m][k], acc[ai][bj][m][n], 0, 0, 0); __builtin_amdgcn_s_setprio(0); } while (0)
#define PG8_WAIT_V(n) asm volatile("s_waitcnt vmcnt(" #n ")" ::: "memory")
#define PG8_WAIT_L(n) asm volatile("s_waitcnt lgkmcnt(" #n ")" ::: "memory")
#define PG8_BAR __builtin_amdgcn_s_barrier()
#define PG8_SCHED __builtin_amdgcn_sched_barrier(0)
    Unit cur, nxt; int ui = 0;
    if (!S.next(0, cur)) return;
    f32x4 acc[2][2][4][2];
#pragma unroll
    for (int a = 0; a < 2; ++a)
#pragma unroll
        for (int b = 0; b < 2; ++b)
#pragma unroll
            for (int m = 0; m < 4; ++m)
#pragma unroll
                for (int n = 0; n < 2; ++n) acc[a][b][m][n] = (f32x4){0.f, 0.f, 0.f, 0.f};
    bf16x8 At[4][2], B0[2][2], B1[2][2];
    const char* cA = (const char*)g.A + (size_t)cur.pm * tstep + (size_t)cur.kt0 * kstep; const char* cB = (const char*)g.Bt + (size_t)cur.pn * tstep + (size_t)cur.kt0 * kstep;
    S.a_ready(cur);
    if constexpr (SP2) {
        PG8_STAGE(PG8_SB(0, 0), cB, voffB); PG8_STAGE(PG8_SB(0, 1), cB + hstep, voffB); PG8_STAGE(PG8_SA(0, 0), cA, voffA); PG8_STAGE(PG8_SA(0, 1), cA + hstep, voffA);
        if (wr == 1) PG8_BAR;
        PG8_WAIT_V(2); PG8_BAR;
        PG8_STAGE(PG8_SB(1, 0), cB + kstep, voffB); PG8_STAGE(PG8_SA(1, 0), cA + kstep, voffA); PG8_STAGE(PG8_SB(1, 1), cB + hstep + kstep, voffB);
        PG8_WAIT_V(6); PG8_BAR;
    } else {
        PG8_STAGE(PG8_SB(0, 0), cB, voffB); PG8_STAGE(PG8_SA(0, 0), cA, voffA); PG8_STAGE(PG8_SB(0, 1), cB + hstep, voffB); PG8_STAGE(PG8_SA(0, 1), cA + hstep, voffA);
        if (wr == 1) PG8_BAR;
        PG8_WAIT_V(4); PG8_BAR;
        PG8_STAGE(PG8_SB(1, 0), cB + kstep, voffB); PG8_STAGE(PG8_SA(1, 0), cA + kstep, voffA); PG8_STAGE(PG8_SB(1, 1), cB + hstep + kstep, voffB);
        PG8_WAIT_V(6); PG8_BAR;
    }
    for (;;) {
        const bool has_next = S.next(ui + 1, nxt);
        const char* nA = has_next ? (const char*)g.A + (size_t)nxt.pm * tstep + (size_t)nxt.kt0 * kstep : cA; const char* nB = has_next ? (const char*)g.Bt + (size_t)nxt.pn * tstep + (size_t)nxt.kt0 * kstep : cB;
        const int nt = cur.nkt;
        for (int t = 0; t < nt; t += 2) {
            const bool last = (t == nt - 2);
            const char* a1 = cA + (size_t)(t + 1) * kstep;
            const char* a2 = last ? nA : cA + (size_t)(t + 2) * kstep; const char* b2 = last ? nB : cB + (size_t)(t + 2) * kstep;
            const char* a3 = a2 + kstep; const char* b3 = b2 + kstep;
            if (last && has_next) S.a_ready(nxt);
            if constexpr (SP2) {
            PG8_LDB(B0, 0, 0); PG8_LDB(B1, 0, 1); PG8_SCHED; PG8_LDA(At, 0, 0); PG8_STAGE(PG8_SA(1, 1), a1 + hstep, voffA);
            PG8_WAIT_V(8); PG8_WAIT_L(0); PG8_BAR; PG8_MMA(0, 0, At, B0); PG8_MMA(0, 1, At, B1); PG8_BAR; PG8_SCHED;
            PG8_LDA(At, 0, 1); PG8_STAGE(PG8_SB(0, 0), b2, voffB); PG8_STAGE(PG8_SB(0, 1), b2 + hstep, voffB); PG8_STAGE(PG8_SA(0, 0), a2, voffA);
            PG8_WAIT_V(8); PG8_WAIT_L(0); PG8_BAR; PG8_MMA(1, 0, At, B0); PG8_MMA(1, 1, At, B1); PG8_BAR; PG8_SCHED;
            PG8_LDB(B0, 1, 0); PG8_LDB(B1, 1, 1); PG8_SCHED; PG8_LDA(At, 1, 0); PG8_STAGE(PG8_SA(0, 1), a2 + hstep, voffA);
            PG8_WAIT_V(8); PG8_WAIT_L(0); PG8_BAR; PG8_MMA(0, 0, At, B0); PG8_MMA(0, 1, At, B1); PG8_BAR; PG8_SCHED;
            PG8_LDA(At, 1, 1); PG8_STAGE(PG8_SB(1, 0), b3, voffB); PG8_STAGE(PG8_SB(1, 1), b3 + hstep, voffB); PG8_STAGE(PG8_SA(1, 0), a3, voffA);
            PG8_WAIT_V(8); PG8_WAIT_L(0); PG8_BAR; PG8_MMA(1, 0, At, B0); PG8_MMA(1, 1, At, B1); PG8_BAR; PG8_SCHED;
            } else {
            PG8_LDB(B0, 0, 0); PG8_SCHED; PG8_LDA(At, 0, 0); PG8_STAGE(PG8_SA(1, 1), a1 + hstep, voffA);
            PG8_WAIT_L(8); PG8_BAR; PG8_WAIT_L(0); PG8_MMA(0, 0, At, B0); PG8_BAR; PG8_SCHED;
            PG8_LDB(B1, 0, 1); PG8_STAGE(PG8_SB(0, 0), b2, voffB);
            PG8_BAR; PG8_WAIT_L(0); PG8_MMA(0, 1, At, B1); PG8_BAR;
            PG8_LDA(At, 0, 1); PG8_STAGE(PG8_SA(0, 0), a2, voffA);
            PG8_BAR; PG8_WAIT_L(0); PG8_MMA(1, 0, At, B0); PG8_BAR; PG8_SCHED;
            PG8_STAGE(PG8_SB(0, 1), b2 + hstep, voffB);
            PG8_WAIT_V(6); PG8_BAR; PG8_MMA(1, 1, At, B1); PG8_BAR;
            PG8_LDB(B0, 1, 0); PG8_SCHED; PG8_LDA(At, 1, 0); PG8_STAGE(PG8_SA(0, 1), a2 + hstep, voffA);
            PG8_WAIT_L(8); PG8_BAR; PG8_WAIT_L(0); PG8_MMA(0, 0, At, B0); PG8_BAR; PG8_SCHED;
            PG8_LDB(B1, 1, 1); PG8_STAGE(PG8_SB(1, 0), b3, voffB);
            PG8_BAR; PG8_WAIT_L(0); PG8_MMA(0, 1, At, B1); PG8_BAR;
            PG8_LDA(At, 1, 1); PG8_STAGE(PG8_SA(1, 0), a3, voffA);
            PG8_BAR; PG8_WAIT_L(0); PG8_MMA(1, 0, At, B0); PG8_BAR; PG8_SCHED;
            PG8_STAGE(PG8_SB(1, 1), b3 + hstep, voffB);
            PG8_WAIT_V(6); PG8_BAR; PG8_MMA(1, 1, At, B1); PG8_BAR;
            }
        }
        if constexpr (ALIGN_EPI) { if (wr == 0) PG8_BAR; }
        if constexpr (!Epi::AFTER_DRAIN) { E(acc, cur, wr, wc, fr, fq); S.done(cur); }
        if (!has_next) break;
#pragma unroll
        for (int a = 0; a < 2; ++a)
#pragma unroll
            for (int b = 0; b < 2; ++b)
#pragma unroll
                for (int m = 0; m < 4; ++m)
#pragma unroll
                    for (int n = 0; n < 2; ++n) acc[a][b][m][n] = (f32x4){0.f, 0.f, 0.f, 0.f};
        cur = nxt; cA = nA; cB = nB; ++ui;
        if constexpr (ALIGN_EPI) { if (wr == 1) PG8_BAR; }
    }
    PG8_WAIT_V(0);
    if constexpr (!ALIGN_EPI) { if (wr == 0) PG8_BAR; }
    PG8_BAR;
    if constexpr (Epi::AFTER_DRAIN) { E.fused(acc, cur, wr, wc, fr, fq, lds, wid, lane); S.done(cur); }
#undef PG8_SA
#undef PG8_SB
#undef PG8_STAGE
#undef PG8_LDA
#undef PG8_LDB
#undef PG8_MMA
#undef PG8_WAIT_V
#undef PG8_WAIT_L
#undef PG8_BAR
#undef PG8_SCHED
}
}
namespace att {
typedef unsigned short bf16;
constexpr int   D = 128, NW = 8, QBLK = 32, KVBLK = 64;
constexpr float SCALE = 0.088388347648318440f;
constexpr float THR = 8.f;
constexpr int LDQ = 3072, LDK = 3072, LDO = 2048;
constexpr size_t SHM_V = KVBLK * D * 2, SHM_K = KVBLK * D * 2, SHM_ATTN = 2 * SHM_V + 2 * SHM_K + NW * 64 * 4;
using bf16x8 = __attribute__((ext_vector_type(8))) short;
using s16x4  = __attribute__((ext_vector_type(4))) short;
using f32x16 = __attribute__((ext_vector_type(16))) float;
using u32x4  = __attribute__((ext_vector_type(4))) unsigned;
#define KSWZ(row, colB) ((row) * 256 + ((colB) ^ (((row) & 7) << 4)))
#define SBAR() __builtin_amdgcn_sched_barrier(0)
__device__ __forceinline__ int crow(int r, int hi) { return (r & 3) + 8 * (r >> 2) + 4 * hi; }
__device__ __forceinline__ unsigned cvtpk(float lo, float hi) {
  typedef __bf16 b2 __attribute__((ext_vector_type(2))); typedef float f2 __attribute__((ext_vector_type(2)));
  const f2 v = {lo, hi}; const b2 b = __builtin_convertvector(v, b2); return __builtin_bit_cast(unsigned, b);
}
__device__ __forceinline__ bf16x8 ld8(const bf16* p) { return *reinterpret_cast<const bf16x8*>(p); }
__device__ __forceinline__ void partialSM(f32x16& p0, f32x16& p1, float& m_reg, float& mn, float& alpha) {
  constexpr float C = SCALE * 1.4426950408889634f;
  float pmax = p0[0]; for (int r = 1; r < 16; ++r) pmax = fmaxf(pmax, p0[r]); for (int r = 0; r < 16; ++r) pmax = fmaxf(pmax, p1[r]);
  { auto rr = __builtin_amdgcn_permlane32_swap(__float_as_uint(pmax), __float_as_uint(pmax), false, false);
    pmax = fmaxf(__uint_as_float(rr[0]), __uint_as_float(rr[1])); }
  if (__builtin_expect(__all(pmax - m_reg <= THR / SCALE), 1)) { mn = m_reg; alpha = 1.f; }
  else { mn = fmaxf(m_reg, pmax); alpha = __builtin_amdgcn_exp2f((m_reg - mn) * C); m_reg = mn; }
  float mnC = -mn * C;
  for (int r = 0; r < 16; ++r) p0[r] = fmaf(p0[r], C, mnC); for (int r = 0; r < 16; ++r) p1[r] = fmaf(p1[r], C, mnC);
  for (int r = 0; r < 16; ++r) p0[r] = __builtin_amdgcn_exp2f(p0[r]);
}
__device__ __forceinline__ void finishSM(f32x16& p0, f32x16& p1, float alpha, float& l_reg, bf16x8& pa0, bf16x8& pa1, bf16x8& pa2, bf16x8& pa3) {
  for (int r = 0; r < 16; ++r) p1[r] = __builtin_amdgcn_exp2f(p1[r]);
  float ps = 0; for (int r = 0; r < 16; ++r) ps += p0[r]; for (int r = 0; r < 16; ++r) ps += p1[r];
  { auto rr = __builtin_amdgcn_permlane32_swap(__float_as_uint(ps), __float_as_uint(ps), false, false);
    ps = __uint_as_float(rr[0]) + __uint_as_float(rr[1]); }
  l_reg = l_reg * alpha + ps;
#define PK4(P, BASE, OUT) do { unsigned a0 = cvtpk(P[BASE + 0], P[BASE + 1]), a1 = cvtpk(P[BASE + 2], P[BASE + 3]);   \
    unsigned b0 = cvtpk(P[BASE + 4], P[BASE + 5]), b1 = cvtpk(P[BASE + 6], P[BASE + 7]);                              \
    auto r0 = __builtin_amdgcn_permlane32_swap(a0, b0, false, false); auto r1 = __builtin_amdgcn_permlane32_swap(a1, b1, false, false); \
    u32x4 w = {r0[0], r1[0], r0[1], r1[1]}; OUT = *reinterpret_cast<bf16x8*>(&w); } while (0)
  PK4(p0, 0, pa0); PK4(p0, 8, pa1); PK4(p1, 0, pa2); PK4(p1, 8, pa3);
#undef PK4
}
__device__ __forceinline__ void qkt(f32x16& p0, f32x16& p1, const bf16* Ks, const bf16x8* qr, int r32, int hi) {
  p0 = f32x16{}; p1 = f32x16{};
  for (int d0 = 0; d0 < 8; ++d0) { int cb = (d0 * 16 + hi * 8) * 2;
    bf16x8 b0 = *reinterpret_cast<const bf16x8*>((const char*)Ks + KSWZ(r32, cb));
    bf16x8 b1 = *reinterpret_cast<const bf16x8*>((const char*)Ks + KSWZ(32 + r32, cb));
    p0 = __builtin_amdgcn_mfma_f32_32x32x16_bf16(b0, qr[d0], p0, 0, 0, 0);
    p1 = __builtin_amdgcn_mfma_f32_32x32x16_bf16(b1, qr[d0], p1, 0, 0, 0); }
}
__device__ __forceinline__ int v_st(int k, int c) { const int kk = (k & ~0xC) | ((k & 4) << 1) | ((k & 8) >> 1); return ((kk >> 3) * 4 + (c >> 5)) * 512 + ((kk & 7) * 32 + (c & 31)) * 2; }
__device__ __forceinline__ int v_rd_base(int lane) { return ((lane & 3) << 3) | (((lane >> 2) & 3) << 6) | (((lane >> 4) & 1) << 5) | (((lane >> 5) & 1) << 8); }
constexpr int v_rd_off(int d0, int ks, int half) { return d0 * 512 + ks * 4096 + half * 2048; }
template <int OFF> __device__ __forceinline__ s16x4 tr_read(int vb) {
  s16x4 r; asm volatile("ds_read_b64_tr_b16 %0, %1 offset:%2" : "=&v"(r) : "v"(vb), "i"(OFF) : "memory"); return r;
}
template <int D0> __device__ __forceinline__ void pv_one(f32x16& od, int vb, bf16x8 pa0, bf16x8 pa1, bf16x8 pa2, bf16x8 pa3) {
  const s16x4 l0 = tr_read<v_rd_off(D0, 0, 0)>(vb), h0 = tr_read<v_rd_off(D0, 0, 1)>(vb), l1 = tr_read<v_rd_off(D0, 1, 0)>(vb), h1 = tr_read<v_rd_off(D0, 1, 1)>(vb);
  const s16x4 l2 = tr_read<v_rd_off(D0, 2, 0)>(vb), h2 = tr_read<v_rd_off(D0, 2, 1)>(vb), l3 = tr_read<v_rd_off(D0, 3, 0)>(vb), h3 = tr_read<v_rd_off(D0, 3, 1)>(vb);
  asm volatile("s_waitcnt lgkmcnt(0)" ::: "memory"); SBAR();
#define PK(L, H) (bf16x8){L[0], L[1], L[2], L[3], H[0], H[1], H[2], H[3]}
  od = __builtin_amdgcn_mfma_f32_32x32x16_bf16(pa0, PK(l0, h0), od, 0, 0, 0);
  od = __builtin_amdgcn_mfma_f32_32x32x16_bf16(pa1, PK(l1, h1), od, 0, 0, 0);
  od = __builtin_amdgcn_mfma_f32_32x32x16_bf16(pa2, PK(l2, h2), od, 0, 0, 0);
  od = __builtin_amdgcn_mfma_f32_32x32x16_bf16(pa3, PK(l3, h3), od, 0, 0, 0);
#undef PK
}
__device__ __forceinline__ void pv_d0(f32x16* o, int vb, bf16x8 pa0, bf16x8 pa1, bf16x8 pa2, bf16x8 pa3) {
  pv_one<0>(o[0], vb, pa0, pa1, pa2, pa3); pv_one<1>(o[1], vb, pa0, pa1, pa2, pa3); pv_one<2>(o[2], vb, pa0, pa1, pa2, pa3); pv_one<3>(o[3], vb, pa0, pa1, pa2, pa3);
}
__device__ __forceinline__ void attn_dense_body(const bf16* __restrict__ Qb, const bf16* __restrict__ Kh, const bf16* __restrict__ Vh,
                                                bf16* __restrict__ Ob, int seq, char* lds, const float* __restrict__ qgain = nullptr, const float* __restrict__ rope = nullptr, int t0 = 0) {
  int tid = threadIdx.x; asm volatile("" : "+v"(tid));
  const int wid = tid >> 6, lane = tid & 63, r32 = lane & 31, hi = lane >> 5;
  bf16* V_lds = (bf16*)lds; bf16* K_lds = (bf16*)(lds + 2 * SHM_V);
  float* ws = (float*)(lds + 2 * SHM_V + 2 * SHM_K) + wid * 64; float* li_l = ws; float* al_l = ws + 32;
  float m_reg = -1e30f, l_reg = 0; f32x16 o[4] = {}; bf16x8 qr[8];
  const bf16* Qw = Qb + (long)(wid * QBLK + r32) * LDQ + hi * 8;
#pragma unroll
  for (int d0 = 0; d0 < 8; ++d0) qr[d0] = ld8(Qw + d0 * 16);
  if (qgain) {
    float ssq = 0.f;
#pragma unroll
    for (int d0 = 0; d0 < 8; ++d0)
#pragma unroll
      for (int x = 0; x < 8; ++x) { const float v = __uint_as_float((unsigned)(unsigned short)qr[d0][x] << 16); ssq += v * v; }
    { auto rr = __builtin_amdgcn_permlane32_swap(__float_as_uint(ssq), __float_as_uint(ssq), false, false); ssq = __uint_as_float(rr[0]) + __uint_as_float(rr[1]); }
    const float rstd = 1.0f / sqrtf(ssq * (1.0f / 128.0f) + 1e-6f);
    const int t = t0 + wid * QBLK + r32;
#pragma unroll
    for (int hp = 0; hp < 2; ++hp) {
      const int pos = hp ? (t & 63) : (t >> 6);
#pragma unroll
      for (int dd = 0; dd < 2; ++dd) { const int d0 = 4 * hp + dd;
        const float* g1 = qgain + 16 * d0 + 8 * hi; const float* g2 = g1 + 32;
        const float* tb = rope ? rope + (size_t)(pos * 32 + 16 * dd + 8 * hi) * 2 : nullptr;
        float y1[8], y2[8];
#pragma unroll
        for (int x = 0; x < 8; ++x) { const float a1 = __uint_as_float((unsigned)(unsigned short)qr[d0][x] << 16) * rstd * g1[x], a2 = __uint_as_float((unsigned)(unsigned short)qr[d0 + 2][x] << 16) * rstd * g2[x];
          if (rope) { const float cs = tb[2 * x], sn = tb[2 * x + 1]; y1[x] = a1 * cs - a2 * sn; y2[x] = a2 * cs + a1 * sn; } else { y1[x] = a1; y2[x] = a2; } }
        { u32x4 w = {cvtpk(y1[0], y1[1]), cvtpk(y1[2], y1[3]), cvtpk(y1[4], y1[5]), cvtpk(y1[6], y1[7])}; qr[d0] = *reinterpret_cast<bf16x8*>(&w); }
        { u32x4 w = {cvtpk(y2[0], y2[1]), cvtpk(y2[2], y2[3]), cvtpk(y2[4], y2[5]), cvtpk(y2[6], y2[7])}; qr[d0 + 2] = *reinterpret_cast<bf16x8*>(&w); } }
    }
  }
  const int sr = tid >> 4, sc = (tid & 15) * 8, vst0 = v_st(sr, sc), vst1 = v_st(32 + sr, sc);
  const int vb0 = (int)(uintptr_t)V_lds + v_rd_base(lane);
  struct { bf16x8 vs0, vs1, ks0, ks1; } sr_[2];
#define SLOAD(i, k0) do { sr_[i].vs0 = ld8(&Vh[(long)((k0) + sr) * LDK + sc]); sr_[i].vs1 = ld8(&Vh[(long)((k0) + 32 + sr) * LDK + sc]); \
    sr_[i].ks0 = ld8(&Kh[(long)((k0) + sr) * LDK + sc]); sr_[i].ks1 = ld8(&Kh[(long)((k0) + 32 + sr) * LDK + sc]); } while (0)
#define SWRITE(b, i) do { *(bf16x8*)((char*)V_lds + (b) * SHM_V + vst0) = sr_[i].vs0;          \
    *(bf16x8*)((char*)V_lds + (b) * SHM_V + vst1) = sr_[i].vs1; int kc = sc * 2;               \
    *(bf16x8*)((char*)K_lds + (b) * SHM_K + KSWZ(sr, kc)) = sr_[i].ks0;                       \
    *(bf16x8*)((char*)K_lds + (b) * SHM_K + KSWZ(32 + sr, kc)) = sr_[i].ks1; } while (0)
#define SWAIT() asm volatile("s_waitcnt vmcnt(4)" ::: "memory")
#define RESC(a) do { if (__any((a) < 1.f)) { if (hi == 0) al_l[r32] = (a); asm volatile("s_waitcnt lgkmcnt(0)" ::: "memory"); \
    for (int d = 0; d < 4; ++d) for (int r = 0; r < 16; ++r) o[d][r] *= al_l[crow(r, hi)]; } } while (0)
  f32x16 pA0, pA1, pB0, pB1; float mnA, mnB, alA, alB; bf16x8 pa0, pa1, pa2, pa3; const int NT = seq / KVBLK;
  constexpr int SE = 0, SO = 1;
  SLOAD(SE, 0); asm volatile("s_waitcnt vmcnt(0)" ::: "memory"); SWRITE(0, SE); __syncthreads();
  qkt(pA0, pA1, K_lds, qr, r32, hi); partialSM(pA0, pA1, m_reg, mnA, alA);
  SLOAD(SO, KVBLK); if (2 < NT) SLOAD(SE, 2 * KVBLK);
  SWAIT(); SWRITE(1, SO); __syncthreads();
  for (int j = 1; j + 1 < NT; j += 2) {
    SBAR(); qkt(pB0, pB1, (bf16*)((char*)K_lds + SHM_K), qr, r32, hi);
    finishSM(pA0, pA1, alA, l_reg, pa0, pa1, pa2, pa3); SBAR();
    SLOAD(SO, (j + 2) * KVBLK); SBAR();
    pv_d0(o, vb0, pa0, pa1, pa2, pa3); partialSM(pB0, pB1, m_reg, mnB, alB);
    __syncthreads(); SWAIT(); SWRITE(0, SE);
    RESC(alB); __syncthreads();
    SBAR(); qkt(pA0, pA1, K_lds, qr, r32, hi);
    finishSM(pB0, pB1, alB, l_reg, pa0, pa1, pa2, pa3); SBAR();
    if (j + 3 < NT) SLOAD(SE, (j + 3) * KVBLK); SBAR();
    pv_d0(o, vb0 + (int)SHM_V, pa0, pa1, pa2, pa3); partialSM(pA0, pA1, m_reg, mnA, alA);
    __syncthreads(); SWAIT(); SWRITE(1, SO);
    RESC(alA); __syncthreads();
  }
  SBAR(); qkt(pB0, pB1, (bf16*)((char*)K_lds + SHM_K), qr, r32, hi);
  finishSM(pA0, pA1, alA, l_reg, pa0, pa1, pa2, pa3); SBAR();
  pv_d0(o, vb0, pa0, pa1, pa2, pa3); partialSM(pB0, pB1, m_reg, mnB, alB);
  __syncthreads(); RESC(alB);
  finishSM(pB0, pB1, alB, l_reg, pa0, pa1, pa2, pa3); SBAR();
  pv_d0(o, vb0 + (int)SHM_V, pa0, pa1, pa2, pa3);
  if (hi == 0) li_l[r32] = l_reg; asm volatile("s_waitcnt lgkmcnt(0)" ::: "memory");
  float rli[16];
#pragma unroll
  for (int r = 0; r < 16; ++r) rli[r] = __builtin_amdgcn_rcpf(li_l[crow(r, hi)]);
  bf16* Ow = Ob + (long)(wid * QBLK) * LDO;
#pragma unroll
  for (int r = 0; r < 16; ++r) { int orow = crow(r, hi);
#pragma unroll
    for (int d0 = 0; d0 < 4; ++d0) Ow[(long)orow * LDO + d0 * 32 + r32] = (bf16)(cvtpk(o[d0][r] * rli[r], 0.f) & 0xffffu); }
  __syncthreads();
#undef SLOAD
#undef SWRITE
#undef SWAIT
#undef RESC
}
#undef KSWZ
#undef SBAR
}

constexpr int NWAVES = 8;
#ifndef MK_N_LAUNCHES
#define MK_N_LAUNCHES 1
#endif
constexpr int DM = 2048, NBATCH = 8, SEQ = 2048, CTXL = 256, TPB = SEQ + CTXL, MROWS = NBATCH * TPB;
constexpr int MLAT = NBATCH * SEQ;
constexpr int MODW = 6 * DM, NSET = 9;
constexpr int EIN = 3072, OIN = 12288, OMIX = 4096, FFN = 5632, FFN2 = 2 * FFN;
constexpr size_t RP_PLANE = (size_t)MROWS * 256, RP_V = 16 * RP_PLANE, RP_G = 32 * RP_PLANE;
constexpr float EPS = 1e-6f;
constexpr int N_PHASES = 1 + 9 * 4;
constexpr size_t MiB = 1u << 20;
constexpr size_t WS_CTL = 0, CTL_ZERO_BYTES = 1 * MiB;
constexpr size_t WS_MOD = 1 * MiB;
constexpr size_t WS_ROPE_E = 3 * MiB, WS_ROPE_O = 3 * MiB + 65536;
constexpr size_t WS_WTC = 3 * MiB + 262144;
constexpr size_t WS_CB = 4 * MiB;
constexpr size_t WS_WTL = 5 * MiB;
constexpr size_t WS_W_INE = 21 * MiB, WS_W_OUTE = 45 * MiB, WS_W_INO = 61 * MiB, WS_W_OUTO = 157 * MiB, WS_W_FIN = 189 * MiB, WS_W_FOUT = 365 * MiB;
constexpr size_t WS_H = 453 * MiB;
constexpr size_t WS_XN = 597 * MiB;
constexpr size_t WS_P = 669 * MiB;
constexpr size_t WS_R = 1101 * MiB;
constexpr size_t WS_OF = WS_R, WS_OB = WS_R + 144 * MiB;
constexpr size_t WS_FT = WS_R, WS_FTC = WS_R + 16 * MiB, WS_Z = WS_R + 18 * MiB, WS_MIX = WS_R + 54 * MiB;
constexpr size_t WS_DELTA = 1389 * MiB;
constexpr size_t WS_SPLITTAB = 2 * MiB + 917504;
constexpr size_t WS_END = 1453 * MiB;
static_assert(WS_MIX + (size_t)MROWS * DM * 2 <= WS_END && WS_OB + (size_t)MROWS * OMIX * 2 <= WS_END && WS_P + (size_t)MROWS * OIN * 2 <= WS_R, "d_ws map");
constexpr int CW_TMO = 0, CW_CODE = 1, CW_BAR = 4096;
constexpr int RING_OFF = 0, RING_BYTES = 131072;
constexpr int LDSCTL_OFF = 158720, MISC_OFF = LDSCTL_OFF + 320;
constexpr int LDS_BYTES = 159744;
static_assert(MISC_OFF + 128 <= LDS_BYTES, "LDS map");

#define GAS __attribute__((address_space(1)))
#define LAS __attribute__((address_space(3)))
typedef unsigned short bf16;
typedef unsigned v4u __attribute__((ext_vector_type(4)));
typedef unsigned v2u __attribute__((ext_vector_type(2)));
typedef float f32x4 __attribute__((ext_vector_type(4)));
typedef short bf16x8 __attribute__((ext_vector_type(8)));
typedef short s16x4 __attribute__((ext_vector_type(4)));
typedef GAS unsigned gu32;
#define RLX_AGENT __ATOMIC_RELAXED, __HIP_MEMORY_SCOPE_AGENT
#define LDS_WAIT() asm volatile("s_waitcnt lgkmcnt(0)" ::: "memory")
#define VM_WAIT() asm volatile("s_waitcnt vmcnt(0)" ::: "memory")
typedef __bf16 bf16x2_t __attribute__((ext_vector_type(2)));
typedef float f32x2_t __attribute__((ext_vector_type(2)));
__device__ __forceinline__ unsigned pk2(float lo, float hi) { const f32x2_t v = {lo, hi}; const bf16x2_t b = __builtin_convertvector(v, bf16x2_t); return __builtin_bit_cast(unsigned, b); }
__device__ __forceinline__ float bflo(unsigned w) { return __uint_as_float(w << 16); }
__device__ __forceinline__ float bfhi(unsigned w) { return __uint_as_float(w & 0xffff0000u); }
__device__ __forceinline__ float silu(float g) { return g / (1.0f + __expf(-g)); }

#define XB_TMO      128
#define XB_XCNT(j)  (256  + 64 * (j))
#define XB_XSUB(j)  (1280 + 64 * (j))
#define XB_XGEN(j)  (2304 + 64 * (j))
#define XB_TOP      3328
#define XB_TOPGEN   3392
#define XCD_BAR_WORDS 3456
#define XB_SPIN_CAP (1u << 18)

__device__ __forceinline__ unsigned xb_ld(unsigned* p)              { return __hip_atomic_load(p, __ATOMIC_RELAXED, __HIP_MEMORY_SCOPE_AGENT); }
__device__ __forceinline__ unsigned xb_add(unsigned* p, unsigned v) { return __hip_atomic_fetch_add(p, v, __ATOMIC_RELAXED, __HIP_MEMORY_SCOPE_AGENT); }
__device__ __forceinline__ unsigned xb_xcc_id() { return (unsigned)__builtin_amdgcn_s_getreg((3 << 11) | 20) & 0xFu; }
#define XB_SPIN(cond, bar) do { unsigned _sp = 0; while (cond) { __builtin_amdgcn_s_sleep(1); \
    if ((++_sp & 255u) == 0u) { if (xb_ld(&(bar)[XB_TMO])) break; if (_sp > XB_SPIN_CAP) { atomicAdd(&(bar)[XB_TMO], 1u); break; } } } } while (0)

struct XcdBarrier {
    unsigned* bar; unsigned x;
    volatile LAS unsigned* st;
};

__device__ __forceinline__ XcdBarrier xcd_barrier_post(unsigned* bar, volatile LAS unsigned* st) {
    XcdBarrier b; b.bar = bar; b.x = xb_xcc_id(); b.st = st;
    if (threadIdx.x == 0) (void)xb_add(&bar[XB_XCNT(b.x)], 1u);
    return b;
}
__device__ __forceinline__ void xcd_barrier_complete(unsigned* bar, unsigned x, unsigned& nloc, unsigned& nx) {
    const unsigned G = gridDim.x * gridDim.y * gridDim.z;
    unsigned sum, cnt, mine, sp = 0u;
    for (;;) {
        sum = 0u; cnt = 0u; mine = 0u;
#pragma unroll
        for (unsigned j = 0; j < 16; ++j) { const unsigned c = xb_ld(&bar[XB_XCNT(j)]); sum += c; cnt += (c > 0u) ? 1u : 0u; mine = (j == x) ? c : mine; }
        if (sum == G) break;
        __builtin_amdgcn_s_sleep(1);
        if ((++sp & 255u) == 0u) { if (xb_ld(&bar[XB_TMO])) break; if (sp > XB_SPIN_CAP) { atomicAdd(&bar[XB_TMO], 1u); break; } }
    }
    nloc = mine > 0u ? mine : 1u; nx = cnt > 0u ? cnt : 1u;
}

__device__ __forceinline__ void xcd_barrier(const XcdBarrier& b) {
    asm volatile("s_waitcnt vmcnt(0)" ::: "memory");
    __syncthreads();
    if (threadIdx.x == 0) {
        unsigned* bar = b.bar;
        __builtin_amdgcn_s_waitcnt(0);
        unsigned nloc = b.st[0], nx = b.st[1];
        if (nloc == 0u) { xcd_barrier_complete(bar, b.x, nloc, nx); b.st[0] = nloc; b.st[1] = nx; }
        const unsigned old = xb_add(&bar[XB_XSUB(b.x)], 1u);
        const unsigned gen = old / nloc;
        if (old + 1u == (gen + 1u) * nloc) {
            __builtin_amdgcn_fence(__ATOMIC_RELEASE, "agent");
            asm volatile("s_waitcnt vmcnt(0)" ::: "memory");
            const unsigned og = xb_add(&bar[XB_TOP], 1u);
            const unsigned tg = og / nx;
            if (og + 1u == (tg + 1u) * nx) xb_add(&bar[XB_TOPGEN], 1u);
            else XB_SPIN(xb_ld(&bar[XB_TOPGEN]) == tg, bar);
            __builtin_amdgcn_fence(__ATOMIC_ACQUIRE, "agent");
            xb_add(&bar[XB_XGEN(b.x)], 1u);
            asm volatile("s_waitcnt vmcnt(0)" ::: "memory");
        } else {
            XB_SPIN(xb_ld(&bar[XB_XGEN(b.x)]) == gen, bar);
            __builtin_amdgcn_fence(__ATOMIC_ACQUIRE, "agent");
            asm volatile("s_waitcnt vmcnt(0)" ::: "memory");
        }
    }
    __syncthreads();
}

struct Args { const float* in[16]; float* out; unsigned char* ws; int ph_lo, ph_hi; };
static_assert(sizeof(Args) == 18 * 8 + 8, "Args has no padding");

struct Frame {
    LAS unsigned char* lds;
    volatile LAS unsigned* MISC;
    gu32* ctl;
    GAS unsigned char* ws;
    GAS float* out;
    int wave, vcu, G;
};
__device__ __forceinline__ int tid_opaque() { int t = threadIdx.x; asm volatile("" : "+v"(t)); return t; }
#define IN_X(F) ((const float*)(const GAS float*)A.in[0])
#define IN_C(F) ((const float*)(const GAS float*)A.in[1])
#define IN_CTX(F) ((const float*)(const GAS float*)A.in[2])
#define IN_CCTX(F) ((const float*)(const GAS float*)A.in[3])
#define IN_WMOD(F) ((const float*)(const GAS float*)A.in[4])
#define IN_BMOD(F) ((const float*)(const GAS float*)A.in[5])
#define IN_WINE(F) ((const float*)(const GAS float*)A.in[6])
#define IN_WOUTE(F) ((const float*)(const GAS float*)A.in[7])
#define IN_QG(F) ((const float*)(const GAS float*)A.in[8])
#define IN_KG(F) ((const float*)(const GAS float*)A.in[9])
#define IN_WINO(F) ((const float*)(const GAS float*)A.in[10])
#define IN_WOUTO(F) ((const float*)(const GAS float*)A.in[11])
#define IN_LDF(F) ((const float*)(const GAS float*)A.in[12])
#define IN_LDB(F) ((const float*)(const GAS float*)A.in[13])
#define IN_WFIN(F) ((const float*)(const GAS float*)A.in[14])
#define IN_WFOUT(F) ((const float*)(const GAS float*)A.in[15])
#define WSF(F, off) ((float*)((F).ws + (off)))
#define WSB(F, off) ((bf16*)((F).ws + (off)))
__device__ __forceinline__ float shx(float v, int k, int lane) { return __int_as_float(__builtin_amdgcn_ds_bpermute((lane ^ k) << 2, __float_as_int(v))); }
__device__ __forceinline__ float wave_sum(float v, int lane) {
#pragma unroll
    for (int o = 1; o < 64; o <<= 1) v += shx(v, o, lane);
    return v;
}
__device__ __forceinline__ void p0_transpose_item(const float* W, int K, int N, bf16* WT, int k0, int n0, int drow0, float scale, LAS float* scr, int lane) {
    const int kr = lane >> 4, c4 = (lane & 15) * 4;
    f32x4 v[16];
#pragma unroll
    for (int i = 0; i < 16; ++i) v[i] = *(const GAS f32x4*)(W + (size_t)(k0 + 4 * i + kr) * N + n0 + c4);
#pragma unroll
    for (int i = 0; i < 16; ++i) { LAS float* d = scr + (4 * i + kr) * 65 + c4; d[0] = v[i][0]; d[1] = v[i][1]; d[2] = v[i][2]; d[3] = v[i][3]; }
    LDS_WAIT(); asm volatile("" ::: "memory");
    const int c = lane & 7;
#pragma unroll
    for (int j = 0; j < 8; ++j) { const int n = (lane >> 3) + 8 * j; const LAS float* s = scr + (8 * c) * 65 + n;
        v4u o; o.x = pk2(s[0 * 65] * scale, s[1 * 65] * scale); o.y = pk2(s[2 * 65] * scale, s[3 * 65] * scale); o.z = pk2(s[4 * 65] * scale, s[5 * 65] * scale); o.w = pk2(s[6 * 65] * scale, s[7 * 65] * scale);
        *(GAS v4u*)(WT + (size_t)(drow0 + n) * K + k0 + 8 * c) = o; }
    LDS_WAIT(); asm volatile("" ::: "memory");
}
__device__ __forceinline__ void p0_conv(const float* W, bf16* WT, int K, int N, int kind, int r, LAS float* scr, int lane) {
    const int nbn = N / 64, per = (K / 64) * nbn, inst = r / per, rr = r - inst * per, kb = rr / nbn, nb = rr - kb * nbn, n0 = nb * 64;
    int drow0 = n0; float scale = 1.0f;
    if (kind == 2) { if (n0 >= 2048 && n0 < 4096) scale = 0.0625f;
        if (n0 < 4096) { const int d = n0 & 255, half = d >> 7, bj = (d >> 6) & 1; drow0 = (n0 & ~255) + 128 * bj + 64 * half; } }
    if (kind == 4) { const int bj = n0 >= FFN ? 1 : 0, hc = n0 - bj * FFN; drow0 = 256 * (hc >> 7) + 128 * bj + (hc & 127); }
    p0_transpose_item(W + (size_t)inst * K * N, K, N, WT + (size_t)inst * K * N, kb * 64, n0, drow0, scale, scr, lane);
}
__device__ __forceinline__ int conv_layer_count(int L) { return (L & 1) ? (32 * 192 + 64 * 32 + 32 * 176 + 88 * 32) : (32 * 48 + 32 * 32 + 32 * 176 + 88 * 32); }
__device__ __forceinline__ void conv_layer_item(Frame& F, const Args& A, int L, int r, LAS float* scr, int lane) {
    const int j2 = L >> 1;
    if (L & 1) {
        constexpr int P0 = 32 * 192, P1 = 64 * 32;
        if (r < P0) { p0_conv(IN_WINO(F), WSB(F, WS_W_INO), DM, OIN, 2, r + j2 * P0, scr, lane); return; } r -= P0;
        if (r < P1) { p0_conv(IN_WOUTO(F), WSB(F, WS_W_OUTO), OMIX, DM, 3, r + j2 * P1, scr, lane); return; } r -= P1;
    } else {
        constexpr int P0 = 32 * 48, P1 = 32 * 32;
        if (r < P0) { p0_conv(IN_WINE(F), WSB(F, WS_W_INE), DM, EIN, 0, r + j2 * P0, scr, lane); return; } r -= P0;
        if (r < P1) { p0_conv(IN_WOUTE(F), WSB(F, WS_W_OUTE), DM, DM, 1, r + j2 * P1, scr, lane); return; } r -= P1;
    }
    constexpr int P4 = 32 * 176, P5 = 88 * 32;
    if (r < P4) { p0_conv(IN_WFIN(F), WSB(F, WS_W_FIN), DM, FFN2, 4, r + L * P4, scr, lane); return; } r -= P4;
    p0_conv(IN_WFOUT(F), WSB(F, WS_W_FOUT), FFN, DM, 5, r + L * P5, scr, lane);
}
__device__ __forceinline__ void conv_in_tail(Frame& F, const Args& A, int L, int lo, int hi, int widx, int nw) {
    const int lane = tid_opaque() & 63;
    LAS float* scr = (LAS float*)(F.lds + RING_OFF + F.wave * 16640);
    for (int r = lo + widx * NWAVES + F.wave; r < hi; r += nw * NWAVES) conv_layer_item(F, A, L, r, scr, lane);
}
#ifndef LATE_CONV
#define LATE_CONV 1
#endif
#ifndef BUILD_SPLITTAB
#define BUILD_SPLITTAB 0
#endif
#ifndef PRO_GW
#define PRO_GW 3
#endif
__device__ __forceinline__ void ph_prologue(Frame& F, const Args& A) {
    const int tid = tid_opaque(), lane = tid & 63;
    constexpr int COND_BYTES = NSET * DM * 4;
    LAS float* cond = (LAS float*)(F.lds + RING_OFF);
    for (int i = tid; i < NSET * DM; i += NWAVES * 64) { const int s = i >> 11, k = i & 2047; const float v = (s < 8) ? IN_C(F)[s * DM + k] : IN_CCTX(F)[k]; cond[i] = v / (1.0f + expf(-v)); }
    LDS_WAIT(); __syncthreads();
    if (F.wave < PRO_GW) {
        for (int item = F.wave * F.G + F.vcu; item < 4 * 192; item += PRO_GW * F.G) {
            const int layer = item / 192, kk = lane >> 4, col = (item - layer * 192) * 64 + (lane & 15) * 4;
            const float* wp = IN_WMOD(F) + (size_t)layer * DM * MODW + (size_t)kk * MODW + col;
            f32x4 acc[NSET];
#pragma unroll
            for (int s = 0; s < NSET; ++s) acc[s] = (f32x4){0.f, 0.f, 0.f, 0.f};
            for (int k = 0; k < DM; k += 32) {
                f32x4 w[8];
#pragma unroll
                for (int u = 0; u < 8; ++u) w[u] = *(const GAS f32x4*)(wp + (size_t)(k + 4 * u) * MODW);
#pragma unroll
                for (int u = 0; u < 8; ++u)
#pragma unroll
                    for (int s = 0; s < NSET; ++s) acc[s] += w[u] * cond[s * DM + k + 4 * u + kk];
            }
#pragma unroll
            for (int s = 0; s < NSET; ++s)
#pragma unroll
                for (int x = 0; x < 4; ++x) { float t = acc[s][x]; t += shx(t, 16, lane); t += shx(t, 32, lane); acc[s][x] = t; }
            if (kk == 0) { const f32x4 bm = *(const GAS f32x4*)(IN_BMOD(F) + layer * MODW + col);
#pragma unroll
                for (int s = 0; s < NSET; ++s) *(GAS f32x4*)(WSF(F, WS_MOD) + (size_t)(layer * NSET + s) * MODW + col) = acc[s] + bm; }
        }
    } else {
        LAS float* scr = (LAS float*)(F.lds + RING_OFF + COND_BYTES + (F.wave - PRO_GW) * 16640);
        const int tw = (F.wave - PRO_GW) * F.G + F.vcu, NTW = (NWAVES - PRO_GW) * F.G;
#if LATE_CONV
        for (int it = tw; it < conv_layer_count(0); it += NTW) conv_layer_item(F, A, 0, it, scr, lane);
#else
        constexpr int I0 = 2 * 32 * 48, I1 = 2 * 32 * 32, I2 = 2 * 32 * 192, I3 = 2 * 64 * 32, I4 = 4 * 32 * 176, I5 = 4 * 88 * 32;
        for (int it = tw; it < I0 + I1 + I2 + I3 + I4 + I5; it += NTW) {
            int r = it;
            if (r < I0) { p0_conv(IN_WINE(F), WSB(F, WS_W_INE), DM, EIN, 0, r, scr, lane); continue; } r -= I0;
            if (r < I1) { p0_conv(IN_WOUTE(F), WSB(F, WS_W_OUTE), DM, DM, 1, r, scr, lane); continue; } r -= I1;
            if (r < I2) { p0_conv(IN_WINO(F), WSB(F, WS_W_INO), DM, OIN, 2, r, scr, lane); continue; } r -= I2;
            if (r < I3) { p0_conv(IN_WOUTO(F), WSB(F, WS_W_OUTO), OMIX, DM, 3, r, scr, lane); continue; } r -= I3;
            if (r < I4) { p0_conv(IN_WFIN(F), WSB(F, WS_W_FIN), DM, FFN2, 4, r, scr, lane); continue; } r -= I4;
            p0_conv(IN_WFOUT(F), WSB(F, WS_W_FOUT), FFN, DM, 5, r, scr, lane);
        }
#endif
    }
    const int gw = F.vcu * NWAVES + F.wave, NGW = F.G * NWAVES;
    if (BUILD_SPLITTAB && gw == 0) {
        pg8::StaticOrder so; so.init(MROWS, DM, F.G, 0); const int nfull = (so.nwg / F.G) * F.G; int* tab = (int*)(F.ws + WS_SPLITTAB);
        for (int e = lane; e < 576; e += 64) { int val = 0;
            for (int idx = nfull; idx < so.nwg; ++idx) { pg8::Unit u; so.map(idx, u); if (u.pm * 8 + u.pn == e) val = idx - nfull + 1; }
            tab[e] = val; }
    }
    const int gt = gw * 64 + lane, NGT = NGW * 64;
    for (int i = gt; i < 4096 * 256; i += NGT) {
        const int m = i >> 8, k0 = (i & 255) * 8, part = m >> 11, to = m & 2047; unsigned w[4];
#pragma unroll
        for (int u = 0; u < 4; ++u) { float s0, c0, s1, c1; sincospif((float)((to * (k0 + 2 * u)) & 2047) * (1.0f / 1024.0f), &s0, &c0); sincospif((float)((to * (k0 + 2 * u + 1)) & 2047) * (1.0f / 1024.0f), &s1, &c1);
            w[u] = pk2((part ? s0 : c0) * 0.022097086912079608f, (part ? s1 : c1) * 0.022097086912079608f); }
        *(GAS v4u*)(WSB(F, WS_WTL) + (size_t)m * 2048 + k0) = (v4u){w[0], w[1], w[2], w[3]};
    }
    for (int i = gt; i < 512 * 32; i += NGT) {
        const int m = i >> 5, k0 = (i & 31) * 8, part = m >> 8, to = m & 255; unsigned w[4];
#pragma unroll
        for (int u = 0; u < 4; ++u) { float s0, c0, s1, c1; sincospif((float)((to * (k0 + 2 * u)) & 255) * (1.0f / 128.0f), &s0, &c0); sincospif((float)((to * (k0 + 2 * u + 1)) & 255) * (1.0f / 128.0f), &s1, &c1);
            w[u] = pk2((part ? s0 : c0) * 0.0625f, (part ? s1 : c1) * 0.0625f); }
        *(GAS v4u*)(WSB(F, WS_WTC) + (size_t)m * 256 + k0) = (v4u){w[0], w[1], w[2], w[3]};
    }
    for (int i = gt; i < 512 * 128; i += NGT) {
        const int n = i >> 7, k0 = (i & 127) * 8, g = n >> 7, kq = n & 127, part = k0 >> 9, g2 = (k0 >> 7) & 3; unsigned w[4];
#pragma unroll
        for (int u = 0; u < 4; ++u) { float s0, c0, s1, c1; const int cc = (k0 & 127) + 2 * u; sincospif((float)((cc * kq) & 127) * (1.0f / 64.0f), &s0, &c0); sincospif((float)(((cc + 1) * kq) & 127) * (1.0f / 64.0f), &s1, &c1);
            const float a0 = (part ? -s0 : c0) * 0.08838834764831845f, a1 = (part ? -s1 : c1) * 0.08838834764831845f;
            w[u] = (g == g2) ? pk2(a0, a1) : 0u; }
        *(GAS v4u*)(WSB(F, WS_CB) + (size_t)n * 1024 + k0) = (v4u){w[0], w[1], w[2], w[3]};
    }
    for (int i = gt; i < 64 * 32; i += NGT) { const int pos = i >> 5, f = i & 31; const double inv = exp2(-(double)(2 * f) / 64.0 * 13.287712379549449), a = (double)pos * inv;
        WSF(F, WS_ROPE_E)[2 * i] = (float)cos(a); WSF(F, WS_ROPE_E)[2 * i + 1] = (float)sin(a); }
    for (int i = gt; i < 64 * 64; i += NGT) { const int pos = i >> 6, f = i & 63; const double inv = exp2(-(double)(2 * f) / 128.0 * 13.287712379549449), a = (double)pos * inv;
        WSF(F, WS_ROPE_O)[2 * i] = (float)cos(a); WSF(F, WS_ROPE_O)[2 * i + 1] = (float)sin(a); }
}
__device__ __forceinline__ void ph_modulate(Frame& F, const Args& A, int layer, int which, int skipctx, int merge, int from_x) {
    const int lane = tid_opaque() & 63;
    const int gw = F.vcu * NWAVES + F.wave, NGW = F.G * NWAVES, R = (MROWS + NGW - 1) / NGW;
    const int m0 = gw * R, m1 = (m0 + R < MROWS) ? m0 + R : MROWS;
    f32x4 sh[8], sc[8], v[8], vn[8]; v4u rn[4]; int curset = -1;
#define MOD_LOAD(m_) do { const int b_ = (m_) / TPB, t_ = (m_) - b_ * TPB; \
        if (from_x) { const GAS f32x4* sr_ = (const GAS f32x4*)(t_ >= SEQ ? IN_CTX(F) + (size_t)(b_ * CTXL + t_ - SEQ) * DM : IN_X(F) + (size_t)(b_ * SEQ + t_) * DM) + 2 * lane; \
            _Pragma("unroll") for (int j = 0; j < 4; ++j) { vn[2 * j] = sr_[128 * j]; vn[2 * j + 1] = sr_[128 * j + 1]; } } \
        else { const GAS v4u* sr_ = (const GAS v4u*)(WSB(F, WS_H) + (size_t)(m_) * DM) + lane; \
            _Pragma("unroll") for (int j = 0; j < 4; ++j) rn[j] = sr_[64 * j]; } } while (0)
    if (m0 < MROWS) MOD_LOAD(m0);
#pragma unroll 1
    for (int m = m0; m < m1; ++m) {
        const int b = m / TPB, t = m - b * TPB, isctx = t >= SEQ, set = isctx ? 8 : b;
        if (from_x) {
#pragma unroll
            for (int j = 0; j < 8; ++j) v[j] = vn[j];
        } else {
#pragma unroll
            for (int j = 0; j < 4; ++j) { const v4u r = rn[j]; v[2 * j] = (f32x4){bflo(r.x), bfhi(r.x), bflo(r.y), bfhi(r.y)}; v[2 * j + 1] = (f32x4){bflo(r.z), bfhi(r.z), bflo(r.w), bfhi(r.w)}; }
        }
        if (m + 1 < m1) MOD_LOAD(m + 1);
        if (skipctx && isctx) continue;
        if (set != curset) { curset = set; const float* shp = WSF(F, WS_MOD) + (size_t)(layer * NSET + set) * MODW + which * 3 * DM;
#pragma unroll
            for (int j = 0; j < 4; ++j)
#pragma unroll
                for (int q = 0; q < 2; ++q) { sh[2 * j + q] = *((const GAS f32x4*)shp + 2 * (lane + 64 * j) + q); sc[2 * j + q] = *((const GAS f32x4*)(shp + DM) + 2 * (lane + 64 * j) + q) + 1.0f; } }
        float ss = 0.f;
#pragma unroll
        for (int j = 0; j < 8; ++j) { ss += (v[j][0] * v[j][0] + v[j][1] * v[j][1]) + (v[j][2] * v[j][2] + v[j][3] * v[j][3]); }
        const float rstd = 1.0f / sqrtf(wave_sum(ss, lane) * (1.0f / DM) + EPS);
        GAS v4u* o16 = (GAS v4u*)(WSB(F, WS_XN) + (size_t)m * DM) + lane;
#pragma unroll
        for (int j = 0; j < 4; ++j) { const f32x4 y0 = v[2 * j] * rstd * sc[2 * j] + sh[2 * j], y1 = v[2 * j + 1] * rstd * sc[2 * j + 1] + sh[2 * j + 1];
            o16[64 * j] = (v4u){pk2(y0[0], y0[1]), pk2(y0[2], y0[3]), pk2(y1[0], y1[1]), pk2(y1[2], y1[3])}; }
    }
#undef MOD_LOAD
}
__device__ __forceinline__ void ph_qk_even(Frame& F, const Args& A, int j2) {
    const int gw = F.vcu * NWAVES + F.wave, NGW = F.G * NWAVES, l = tid_opaque() & 63;
    const float* qg = IN_QG(F) + j2 * 128 + (l & 15) * 8; const float* kg = IN_KG(F) + j2 * 128 + (l & 15) * 8;
    float gq[8], gk[8];
#pragma unroll
    for (int x = 0; x < 8; ++x) { gq[x] = qg[x]; gk[x] = kg[x]; }
    for (int m = gw; m < MROWS; m += NGW) {
        const int b = m / TPB, t = m - b * TPB, lat = t < SEQ;
        const int half = (l >> 3) & 1, pos = half ? (t & 63) : (t >> 6), isx2 = (l >> 2) & 1;
        f32x4 tb[4];
        if (lat) {
#pragma unroll
            for (int q = 0; q < 4; ++q) tb[q] = *(const GAS f32x4*)(WSF(F, WS_ROPE_E) + (size_t)(pos * 32 + (l & 3) * 8 + 2 * q) * 2);
        }
        GAS v4u* pr = (GAS v4u*)(WSB(F, WS_P) + (size_t)m * EIN + 512) + l;
#pragma unroll
        for (int j = 3; j < 4; ++j) {
            const v4u raw = pr[64 * j];
            float v[8] = {bflo(raw.x), bfhi(raw.x), bflo(raw.y), bfhi(raw.y), bflo(raw.z), bfhi(raw.z), bflo(raw.w), bfhi(raw.w)};
            float ss = 0.f;
#pragma unroll
            for (int x = 0; x < 8; ++x) ss += v[x] * v[x];
            ss += shx(ss, 1, l); ss += shx(ss, 2, l); ss += shx(ss, 4, l); ss += shx(ss, 8, l);
            const float rstd = 1.0f / sqrtf(ss * (1.0f / 128.0f) + EPS);
            const bool isq = (4 * j + (l >> 4)) < 12;
#pragma unroll
            for (int x = 0; x < 8; ++x) v[x] = v[x] * rstd * (isq ? gq[x] : gk[x]);
            if (lat) {
#pragma unroll
                for (int x = 0; x < 8; ++x) { const float p = shx(v[x], 4, l); const float cs = tb[x >> 1][(x & 1) * 2], sn = tb[x >> 1][(x & 1) * 2 + 1];
                    v[x] = isx2 ? (v[x] * cs + p * sn) : (v[x] * cs - p * sn); }
            }
            pr[64 * j] = (v4u){pk2(v[0], v[1]), pk2(v[2], v[3]), pk2(v[4], v[5]), pk2(v[6], v[7])};
        }
    }
    LAS bf16* scr = (LAS bf16*)(F.lds + RING_OFF + F.wave * 9216);
    for (int it = gw; it < NBATCH * 288; it += NGW) {
        const int b = it / 288, r = it - b * 288; int t0, c0, isc;
        if (r < 256) { isc = 0; t0 = (r >> 3) * 64; c0 = (r & 7) * 64; } else { isc = 1; t0 = ((r - 256) >> 3) * 64; c0 = ((r - 256) & 7) * 64; }
        const bf16* src = WSB(F, WS_P) + (size_t)(b * TPB + (isc ? SEQ : 0) + t0) * EIN + c0;
#pragma unroll
        for (int i = 0; i < 8; ++i) { const int rr = i * 8 + (l >> 3), ch = l & 7; const v4u val = *(const GAS v4u*)(src + (size_t)rr * EIN + ch * 8); *(LAS v4u*)(scr + rr * 72 + ch * 8) = val; }
        LDS_WAIT(); asm volatile("" ::: "memory");
        bf16* dst = isc ? WSB(F, WS_FTC) + (size_t)(b * 512 + c0) * CTXL + t0 : WSB(F, WS_FT) + (size_t)(b * 512 + c0) * SEQ + t0;
        const int ld = isc ? CTXL : SEQ;
#pragma unroll
        for (int i = 0; i < 8; ++i) { const int cc = i * 8 + (l >> 3), tc = (l & 7) * 8; const LAS bf16* s = scr + tc * 72 + cc;
            v4u o; o.x = (unsigned)s[0] | ((unsigned)s[72] << 16); o.y = (unsigned)s[144] | ((unsigned)s[216] << 16); o.z = (unsigned)s[288] | ((unsigned)s[360] << 16); o.w = (unsigned)s[432] | ((unsigned)s[504] << 16);
            *(GAS v4u*)(dst + (size_t)cc * ld + tc) = o; }
        LDS_WAIT(); asm volatile("" ::: "memory");
    }
}
__device__ __forceinline__ void ph_comb(Frame& F, int skipctx, int dry = 0) {
    const int gw = F.vcu * NWAVES + F.wave, NGW = F.G * NWAVES, l = tid_opaque() & 63;
    for (int m = gw; m < MROWS; m += NGW) {
        const int b = m / TPB, t = m - b * TPB;
        if (skipctx && t >= SEQ) continue;
        GAS v4u* pf = (GAS v4u*)(WSB(F, WS_OF) + (size_t)m * OMIX) + l; const GAS v4u* pb = (const GAS v4u*)(WSB(F, WS_OB) + (size_t)m * OMIX) + l;
        const GAS v4u* pg = (const GAS v4u*)(WSB(F, WS_P) + RP_G + (size_t)m * 4096) + l;
#pragma unroll
        for (int j = 0; j < 8; ++j) {
            const v4u a = pf[64 * j], bb = pb[64 * j], gg = pg[64 * j];
            float o[8] = {bflo(a.x) + bflo(bb.x), bfhi(a.x) + bfhi(bb.x), bflo(a.y) + bflo(bb.y), bfhi(a.y) + bfhi(bb.y), bflo(a.z) + bflo(bb.z), bfhi(a.z) + bfhi(bb.z), bflo(a.w) + bflo(bb.w), bfhi(a.w) + bfhi(bb.w)};
            const float g[8] = {bflo(gg.x), bfhi(gg.x), bflo(gg.y), bfhi(gg.y), bflo(gg.z), bfhi(gg.z), bflo(gg.w), bfhi(gg.w)};
            float ss = 0.f;
#pragma unroll
            for (int x = 0; x < 8; ++x) ss += o[x] * o[x];
            const float rstd = 1.0f / sqrtf(wave_sum(ss, l) * (1.0f / 512.0f) + EPS);
#pragma unroll
            for (int x = 0; x < 8; ++x) o[x] = silu(g[x]) * (o[x] * rstd);
            (dry ? (GAS v4u*)pb : pf)[64 * j] = (v4u){pk2(o[0], o[1]), pk2(o[2], o[3]), pk2(o[4], o[5]), pk2(o[6], o[7])};
        }
    }
}
__device__ __forceinline__ void ph_attention(Frame& F, const Args& A, int j2) {
    char* lds = (char*)(F.lds + RING_OFF);
    for (int i = 0;; ++i) {
        const int u = i * F.G + F.vcu; if (u >= 864) break;
        if (u < 768) { const int qb = u & 7, g3 = (u >> 3) % 3, bk = u / 24, kvh = bk & 3, b = bk >> 2, h = kvh * 3 + g3; const size_t rq = (size_t)(b * TPB + qb * 256);
            const bf16* Kh = WSB(F, WS_P) + (size_t)(b * TPB) * EIN + 2048 + kvh * 128;
            att::attn_dense_body(WSB(F, WS_P) + rq * EIN + 512 + h * 128, Kh, Kh + 512, WSB(F, WS_MIX) + rq * DM + 512 + h * 128, TPB, lds, IN_QG(F) + j2 * 128, WSF(F, WS_ROPE_E), qb * 256);
        } else { const int v = u - 768, b = v / 12, h = v - b * 12, kvh = h / 3; const size_t rq = (size_t)(b * TPB + SEQ);
            const bf16* Kh = WSB(F, WS_P) + rq * EIN + 2048 + kvh * 128;
            att::attn_dense_body(WSB(F, WS_P) + rq * EIN + 512 + h * 128, Kh, Kh + 512, WSB(F, WS_MIX) + rq * DM + 512 + h * 128, CTXL, lds, IN_QG(F) + j2 * 128, nullptr, 0);
        }
    }
}
namespace ret {
constexpr int K_LD = 544, V_LD = 288, ST_LD = 544, Q_LD = 544;
constexpr int K_OFF = 0, V_OFF = 64 * K_LD, ST_OFF = V_OFF + 64 * V_LD, Q_OFF = ST_OFF + 128 * ST_LD, LDS_END = Q_OFF + 64 * Q_LD;
static_assert(LDS_END <= LDSCTL_OFF, "retention LDS");
typedef short v4i16_t __attribute__((ext_vector_type(4)));
__device__ __forceinline__ bf16x8 lds16(const LAS unsigned char* p) { return *(const LAS bf16x8*)p; }
__device__ __forceinline__ s16x4 ldstr(const LAS unsigned char* p) { return __builtin_bit_cast(s16x4, __builtin_amdgcn_ds_read_tr16_b64_v4i16((LAS v4i16_t*)p)); }
__device__ __forceinline__ bf16x8 cat8v(v2u lo, v2u hi) { const v4u w = {lo.x, lo.y, hi.x, hi.y}; return __builtin_bit_cast(bf16x8, w); }
__device__ __forceinline__ bf16x8 cat8(s16x4 lo, s16x4 hi) { return (bf16x8){lo[0], lo[1], lo[2], lo[3], hi[0], hi[1], hi[2], hi[3]}; }
#ifndef PROBE_RETBAR
#define PROBE_RETBAR 0
#endif
#define RET_BAR() do { asm volatile("s_waitcnt lgkmcnt(0)" ::: "memory"); __builtin_amdgcn_s_barrier(); if (PROBE_RETBAR) __builtin_amdgcn_s_barrier(); asm volatile("" ::: "memory"); } while (0)
#ifndef RET_NOSB
#define RET_NOSB 0
#endif
#define RET_SB() do { if (!RET_NOSB) __builtin_amdgcn_sched_barrier(0); } while (0)
constexpr int S_OFF = ST_OFF, S_LD = 144;
constexpr int QR_LD = 528;
constexpr int Q1_OFF = S_OFF + 64 * S_LD, V1_OFF = Q1_OFF + 64 * Q_LD;
static_assert(V1_OFF + 64 * V_LD <= Q_OFF && Q1_OFF % 256 == 0 && V1_OFF % 256 == 0, "retention score image / second buffers");
#ifndef RET_PRIO
#define RET_PRIO 1
#endif
#ifndef RETP_T
#define RETP_T 0
#endif
#ifndef RETP_WAVE
#define RETP_WAVE 4
#endif
#ifndef RETP_CLK
#define RETP_CLK 0
#endif
#define RETP_FINE(k) do { if (RETP_T >= 5 && w == RETP_WAVE) { unsigned long t_; asm volatile("s_waitcnt lgkmcnt(0)\n\ts_memrealtime %0\n\ts_waitcnt lgkmcnt(0)" : "=s"(t_) :: "memory"); \
        if ((k) == RETP_T - 4 && t0_ != 0) tacc_ += (unsigned)(t_ - t0_); if ((k) == RETP_T - 5) t0_ = t_; } } while (0)
#define RETP_STAMP(k) do { if (RETP_T && RETP_T < 5 && w == RETP_WAVE) { unsigned long t_; if (RETP_CLK) asm volatile("s_memtime %0\n\ts_waitcnt lgkmcnt(0)" : "=s"(t_) :: "memory"); else asm volatile("s_memrealtime %0\n\ts_waitcnt lgkmcnt(0)" : "=s"(t_) :: "memory"); \
        if ((k) == ((RETP_T + 1) & 3) && t0_ != 0) tacc_ += (unsigned)(t_ - t0_); if ((k) == (RETP_T & 3)) t0_ = t_; } } while (0)
__device__ __forceinline__ unsigned ret_item_regst(LAS unsigned char* lds, const bf16* P, bf16* Odir, int b, int h, int dir, int es, float lg, int noctx) {
    int tid = threadIdx.x; asm volatile("" : "+v"(tid));
    const int w = __builtin_amdgcn_readfirstlane(tid >> 6), lane = tid & 63, g = lane >> 4, c = lane & 15, q4 = c >> 2, p4 = c & 3;
    const float lg2 = lg * 1.4426950408889634f;
    const bf16* Pq = P + (size_t)h * RP_PLANE + (tid & 31) * 8; const bf16* Pk = Pq + 8 * RP_PLANE; const bf16* Pv = P + RP_V + (size_t)(4 * h + es) * (RP_PLANE / 2) + (tid & 15) * 8;
    bf16* Po = Odir + h * 512 + es * 128 + (tid & 15) * 8;
    const int kr = (tid & 255) >> 5, vr = (tid & 255) >> 4;
    const float cd = __builtin_amdgcn_exp2f(64.0f * lg2);
    unsigned long t0_ = 0; unsigned tacc_ = 0;
#define RET_ROWBASE(n) (dir == 0 ? (b * TPB + ((n) < 4 ? SEQ + 64 * (n) : 64 * (n) - CTXL)) : (b * TPB + ((n) < 4 ? SEQ + 255 - 64 * (n) : 2303 - 64 * (n))))
#define RET_LOADK(n) do { const int rb_ = RET_ROWBASE(n), sg_ = dir == 0 ? 1 : -1; \
        _Pragma("unroll") for (int x = 0; x < 8; ++x) kreg[x] = *(const GAS v4u*)(Pk + (size_t)(rb_ + sg_ * (kr + 8 * x)) * 256); } while (0)
#define RET_LOADQ(n) do { const int rb_ = RET_ROWBASE(n), sg_ = dir == 0 ? 1 : -1; \
        _Pragma("unroll") for (int x = 0; x < 8; ++x) qreg[x] = *(const GAS v4u*)(Pq + (size_t)(rb_ + sg_ * (kr + 8 * x)) * 256); } while (0)
#define RET_STAGEK() do { \
        _Pragma("unroll") for (int x = 0; x < 8; ++x) *(LAS v4u*)(lds + K_OFF + (kr + 8 * x) * K_LD + (tid & 31) * 16) = kreg[x]; } while (0)
#define RET_STAGEQ(qo_) do { \
        _Pragma("unroll") for (int x = 0; x < 8; ++x) *(LAS v4u*)(lds + (qo_) + (kr + 8 * x) * QR_LD + (tid & 31) * 16) = qreg[x]; } while (0)
#define RET_LOADB(n) do { const int rb_ = RET_ROWBASE(n), sg_ = dir == 0 ? 1 : -1; \
        _Pragma("unroll") for (int x = 0; x < 4; ++x) vreg[x] = *(const GAS v4u*)(Pv + (size_t)(rb_ + sg_ * (vr + 16 * x)) * 128); } while (0)
#define RET_STAGEB(vo_) do { \
        _Pragma("unroll") for (int x = 0; x < 4; ++x) { const float kd = __builtin_amdgcn_exp2f((float)(63 - (vr + 16 * x)) * lg2); const v4u r = vreg[x]; \
            *(LAS v4u*)(lds + (vo_) + (vr + 16 * x) * V_LD + (tid & 15) * 16) = (v4u){pk2(bflo(r.x) * kd, bfhi(r.x) * kd), pk2(bflo(r.y) * kd, bfhi(r.y) * kd), pk2(bflo(r.z) * kd, bfhi(r.z) * kd), pk2(bflo(r.w) * kd, bfhi(r.w) * kd)}; } } while (0)
#define RET_OSTORE(m) do { const int rb_ = RET_ROWBASE(m), sg_ = dir == 0 ? 1 : -1; const int vb_ = ((m) & 1) ? V1_OFF : V_OFF; v4u o_[4]; \
        _Pragma("unroll") for (int x = 0; x < 4; ++x) o_[x] = *(const LAS v4u*)(lds + vb_ + (vr + 16 * x) * V_LD + (tid & 15) * 16); \
        _Pragma("unroll") for (int x = 0; x < 4; ++x) *(GAS v4u*)(Po + (size_t)(rb_ + sg_ * (vr + 16 * x)) * OMIX) = o_[x]; } while (0)
    RET_BAR();
    if (w < 4) {
        const int wa = w;
        if (RET_PRIO) __builtin_amdgcn_s_setprio(0);
        v4u kreg[8], qreg[8], vreg[4];
        RET_LOADQ(0); RET_LOADB(0); RET_LOADK(0);
        for (int n = 0; n < 36; ++n) {
            const int qo = (n & 1) ? Q1_OFF : Q_OFF, vo = (n & 1) ? V1_OFF : V_OFF;
            RET_STAGEK(); RET_STAGEQ(qo); RET_STAGEB(vo);
            RETP_STAMP(0);
            RET_BAR();
            RETP_STAMP(1);
            if (n + 1 < 36) { RET_LOADQ(n + 1); RET_LOADB(n + 1); RET_LOADK(n + 1); }
            if (n > 0 && !(noctx && n - 1 < 4)) RET_OSTORE(n - 1);
            if (!(noctx && n < 4)) {
                int gl = g, cl = c; asm volatile("" : "+v"(gl), "+v"(cl));
#define RD_Q(s)    lds16(lds + qo + (16 * wa + c) * QR_LD + (32 * (s) + 8 * g) * 2)
#define RD_K(jt, s) lds16(lds + K_OFF + (16 * (jt) + c) * K_LD + (32 * (s) + 8 * g) * 2)
                f32x4 sT[4];
#pragma unroll
                for (int jt = 0; jt < 4; ++jt) sT[jt] = (f32x4){0.f, 0.f, 0.f, 0.f};
                bf16x8 q0 = RD_Q(0), q1, k0[4], k1[4];
#pragma unroll
                for (int jt = 0; jt < 4; ++jt) k0[jt] = RD_K(jt, 0);
#pragma unroll
                for (int s = 0; s < 8; s += 2) {
                    q1 = RD_Q(s + 1);
#pragma unroll
                    for (int jt = 0; jt < 4; ++jt) k1[jt] = RD_K(jt, s + 1);
                    RET_SB();
#pragma unroll
                    for (int jt = 0; jt < 4; ++jt) sT[jt] = __builtin_amdgcn_mfma_f32_16x16x32_bf16(k0[jt], q0, sT[jt], 0, 0, 0);
                    RET_SB();
                    if (s + 2 < 8) { q0 = RD_Q(s + 2);
#pragma unroll
                        for (int jt = 0; jt < 4; ++jt) k0[jt] = RD_K(jt, s + 2); }
                    RET_SB();
#pragma unroll
                    for (int jt = 0; jt < 4; ++jt) sT[jt] = __builtin_amdgcn_mfma_f32_16x16x32_bf16(k1[jt], q1, sT[jt], 0, 0, 0);
                    RET_SB();
                }
#undef RD_Q
#undef RD_K
#pragma unroll
                for (int jt = 0; jt < 4; ++jt) { float v[4];
#pragma unroll
                    for (int r = 0; r < 4; ++r) { const int diff = (16 * wa + cl) - (16 * jt + 4 * gl + r); const bool keep = dir == 0 ? diff >= 0 : diff > 0; v[r] = keep ? sT[jt][r] : 0.f; }
                    *(LAS v2u*)(lds + S_OFF + (16 * wa + c) * S_LD + (16 * jt + 4 * g) * 2) = (v2u){pk2(v[0], v[1]), pk2(v[2], v[3])}; }
            }
            RETP_STAMP(2);
            RET_BAR();
            RETP_STAMP(3);
        }
        RET_BAR();
        RET_OSTORE(35);
    } else {
        const int wb = w - 4;
        if (RET_PRIO) __builtin_amdgcn_s_setprio(2);
        f32x4 st[8][2][2];
#pragma unroll
        for (int a = 0; a < 8; ++a)
#pragma unroll
            for (int d = 0; d < 2; ++d)
#pragma unroll
                for (int e = 0; e < 2; ++e) st[a][d][e] = (f32x4){0.f, 0.f, 0.f, 0.f};
        for (int n = 0; n < 36; ++n) {
            const bool doO = !(noctx && n < 4);
            const int qo = (n & 1) ? Q1_OFF : Q_OFF, vo = (n & 1) ? V1_OFF : V_OFF;
            RETP_STAMP(0);
            RET_BAR();
            RETP_STAMP(1);
            f32x4 OT[2][4];
#pragma unroll
            for (int et = 0; et < 2; ++et)
#pragma unroll
                for (int it = 0; it < 4; ++it) OT[et][it] = (f32x4){0.f, 0.f, 0.f, 0.f};
            if (doO) {
                const LAS unsigned char* qb0 = lds + qo + c * QR_LD + 8 * g; const LAS unsigned char* qb1 = qb0 + 32; asm volatile("" : "+v"(qb0), "+v"(qb1));
#define RD_QB(it, dq) cat8v(*(const LAS v2u*)(qb0 + 16 * (it) * QR_LD + 64 * (dq)), *(const LAS v2u*)(qb1 + 16 * (it) * QR_LD + 64 * (dq)))
#define RET_CVT(dq_, et_) __builtin_bit_cast(bf16x8, (v4u){pk2(st[dq_][0][et_][0], st[dq_][0][et_][1]), pk2(st[dq_][0][et_][2], st[dq_][0][et_][3]), pk2(st[dq_][1][et_][0], st[dq_][1][et_][1]), pk2(st[dq_][1][et_][2], st[dq_][1][et_][3])})
                bf16x8 qf[4], qn[4], sa[2], sn[2];
#pragma unroll
                for (int it = 0; it < 4; ++it) { qf[it] = RD_QB(it, 0); qn[it] = qf[it]; }
#pragma unroll
                for (int et = 0; et < 2; ++et) { sa[et] = RET_CVT(0, et); sn[et] = sa[et]; }
                RET_SB();
#pragma unroll
                for (int dq = 0; dq < 8; ++dq) {
                    if (dq + 1 < 8) {
#pragma unroll
                        for (int it = 0; it < 4; ++it) qn[it] = RD_QB(it, dq + 1);
#pragma unroll
                        for (int et = 0; et < 2; ++et) sn[et] = RET_CVT(dq + 1, et); }
#pragma unroll
                    for (int it = 0; it < 4; ++it) { OT[0][it] = __builtin_amdgcn_mfma_f32_16x16x32_bf16(sa[0], qf[it], OT[0][it], 0, 0, 0); OT[1][it] = __builtin_amdgcn_mfma_f32_16x16x32_bf16(sa[1], qf[it], OT[1][it], 0, 0, 0); }
                    __builtin_amdgcn_sched_group_barrier(0x100, 8, 0);
#pragma unroll
                    for (int k = 0; k < 4; ++k) { __builtin_amdgcn_sched_group_barrier(0x008, 1, 0); __builtin_amdgcn_sched_group_barrier(0x002, 2, 0); }
                    RET_SB();
#pragma unroll
                    for (int it = 0; it < 4; ++it) qf[it] = qn[it];
#pragma unroll
                    for (int et = 0; et < 2; ++et) sa[et] = sn[et];
                }
#undef RET_CVT
#undef RD_QB
            }
            bf16x8 vb[2][2];
#pragma unroll
            for (int s2 = 0; s2 < 2; ++s2)
#pragma unroll
                for (int et = 0; et < 2; ++et) { const LAS unsigned char* vp = lds + vo + (32 * s2 + 4 * g + q4) * V_LD + (32 * wb + 16 * et + 4 * p4) * 2; vb[s2][et] = cat8(ldstr(vp), ldstr(vp + 16 * V_LD)); }
#define RD_KA(s2, dq, dt) cat8(ldstr(lds + K_OFF + (32 * (s2) + 4 * g + q4) * K_LD + (32 * (dq) + 16 * (dt) + 4 * p4) * 2), ldstr(lds + K_OFF + (32 * (s2) + 4 * g + q4 + 16) * K_LD + (32 * (dq) + 16 * (dt) + 4 * p4) * 2))
            bf16x8 kc[2][2], kn[2][2];
#pragma unroll
            for (int dt = 0; dt < 2; ++dt)
#pragma unroll
                for (int s2 = 0; s2 < 2; ++s2) { kc[dt][s2] = RD_KA(s2, 0, dt); kn[dt][s2] = kc[dt][s2]; }
            RET_SB();
#pragma unroll
            for (int dq = 0; dq < 8; ++dq) {
                if (dq + 1 < 8) {
#pragma unroll
                    for (int dt = 0; dt < 2; ++dt)
#pragma unroll
                        for (int s2 = 0; s2 < 2; ++s2) kn[dt][s2] = RD_KA(s2, dq + 1, dt); }
                RET_SB();
#pragma unroll
                for (int s2 = 0; s2 < 2; ++s2)
#pragma unroll
                    for (int dt = 0; dt < 2; ++dt)
#pragma unroll
                        for (int et = 0; et < 2; ++et) st[dq][dt][et] = __builtin_amdgcn_mfma_f32_16x16x32_bf16(kc[dt][s2], vb[s2][et], st[dq][dt][et], 0, 0, 0);
                if (dq > 0) {
#pragma unroll
                    for (int dt = 0; dt < 2; ++dt)
#pragma unroll
                        for (int et = 0; et < 2; ++et) st[dq - 1][dt][et] = st[dq - 1][dt][et] * cd;
#pragma unroll
                    for (int k = 0; k < 8; ++k) { __builtin_amdgcn_sched_group_barrier(0x008, 1, 0); __builtin_amdgcn_sched_group_barrier(0x002, 1, 0); } }
                RET_SB();
#pragma unroll
                for (int dt = 0; dt < 2; ++dt)
#pragma unroll
                    for (int s2 = 0; s2 < 2; ++s2) kc[dt][s2] = kn[dt][s2];
            }
#undef RD_KA
            RETP_STAMP(2);
            RET_BAR();
            RETP_STAMP(3);
#pragma unroll
            for (int dt = 0; dt < 2; ++dt)
#pragma unroll
                for (int et = 0; et < 2; ++et) st[7][dt][et] = st[7][dt][et] * cd;
            if (doO) {
                float lg2v = lg2; int cl = c; asm volatile("" : "+v"(lg2v), "+v"(cl));
                bf16x8 sf[4][2];
#pragma unroll
                for (int it = 0; it < 4; ++it)
#pragma unroll
                    for (int s2 = 0; s2 < 2; ++s2) { const LAS unsigned char* sp = lds + S_OFF + (16 * it + c) * S_LD + (32 * s2 + 4 * g) * 2; const v2u lo = *(const LAS v2u*)sp, hi = *(const LAS v2u*)(sp + 32);
                        const v4u pw = {lo.x, lo.y, hi.x, hi.y}; sf[it][s2] = __builtin_bit_cast(bf16x8, pw); }
                RET_SB();
#pragma unroll
                for (int s2 = 0; s2 < 2; ++s2)
#pragma unroll
                    for (int it = 0; it < 4; ++it)
#pragma unroll
                        for (int et = 0; et < 2; ++et) OT[et][it] = __builtin_amdgcn_mfma_f32_16x16x32_bf16(vb[s2][et], sf[it][s2], OT[et][it], 0, 0, 0);
                RET_SB();
#pragma unroll
                for (int it = 0; it < 4; ++it) { const float rf = __builtin_amdgcn_exp2f((float)(16 * it + cl - 63) * lg2v);
#pragma unroll
                    for (int et = 0; et < 2; ++et) *(LAS v2u*)(lds + vo + (16 * it + c) * V_LD + (32 * wb + 16 * et + 4 * g) * 2) = (v2u){pk2(OT[et][it][0] * rf, OT[et][it][1] * rf), pk2(OT[et][it][2] * rf, OT[et][it][3] * rf)}; }
            }
        }
        RET_BAR();
    }
#undef RET_OSTORE
#undef RET_LOADK
#undef RET_LOADQ
#undef RET_STAGEK
#undef RET_STAGEQ
#undef RET_LOADB
#undef RET_STAGEB
#undef RET_ROWBASE
    if (RET_PRIO) __builtin_amdgcn_s_setprio(0);
    return RETP_CLK ? (tacc_ >> 4) : tacc_;
}
}
__device__ __forceinline__ void ph_retention(Frame& F, const Args& A, int j2, int noctx) {
    for (int item = F.vcu; item < 512; item += F.G) {
        const int es = item & 3, dir = (item >> 2) & 1, h = (item >> 3) & 7, b = item >> 6;
        const float lg = (dir ? IN_LDB(F) : IN_LDF(F))[j2 * 8 + h];
        const unsigned tk_ = ret::ret_item_regst(F.lds + RING_OFF, WSB(F, WS_P), dir ? WSB(F, WS_OB) : WSB(F, WS_OF), b, h, dir, es, lg, noctx);
        if (RETP_T && F.vcu == 0 && F.wave == RETP_WAVE && (tid_opaque() & 63) == 0) __hip_atomic_fetch_add(F.ctl + 20000, tk_, __ATOMIC_RELAXED, __HIP_MEMORY_SCOPE_AGENT);
    }
}
__global__ void __launch_bounds__(NWAVES * 64, 2) dit_fwd(Args args) {
    extern __shared__ __attribute__((aligned(16))) unsigned char lds[];
    Frame F0;
    F0.lds = (LAS unsigned char*)lds;
    F0.MISC = (volatile LAS unsigned*)(F0.lds + MISC_OFF);
    F0.wave = __builtin_amdgcn_readfirstlane((int)threadIdx.x >> 6);
    F0.G = gridDim.x; { const int bx = blockIdx.x; F0.vcu = (F0.G % 8 == 0) ? (bx % 8) * (F0.G / 8) + bx / 8 : bx; }
    F0.ws = (GAS unsigned char*)args.ws; F0.out = (GAS float*)args.out;
    F0.ctl = (gu32*)(F0.ws + WS_CTL);
    for (int u = threadIdx.x; u < (LDS_BYTES - LDSCTL_OFF) / 4; u += NWAVES * 64) ((LAS unsigned*)(F0.lds + LDSCTL_OFF))[u] = 0u;
    __syncthreads();
    XcdBarrier bar; bar.bar = (unsigned*)(F0.ctl + CW_BAR); bar.x = 0; bar.st = nullptr;
    if (MK_N_LAUNCHES == 1) bar = xcd_barrier_post((unsigned*)(F0.ctl + CW_BAR), F0.MISC + 8);
    const int lo = args.ph_lo, hi = args.ph_hi;
#ifndef LATE_F_FIN
#define LATE_F_FIN 0
#endif
#ifndef LATE_F_EVEN
#define LATE_F_EVEN 15
#endif
#ifndef LATE_F_ODD
#define LATE_F_ODD 30
#endif
#ifndef RESID_G
#define RESID_G 0
#endif
#ifndef GEMM_SP2
#define GEMM_SP2 true
#endif
#ifndef GEMM_ALIGN
#define GEMM_ALIGN true
#endif
#ifndef PROBE_BAR2
#define PROBE_BAR2 0
#endif
#ifndef SPLITK
#define SPLITK 0
#endif
#ifndef SITE_MASK
#define SITE_MASK 0xffffffffu
#endif
#define SITE(n) (((SITE_MASK) >> (n)) & 1u)
#define IN(k) (lo <= (k) && (k) < hi)
#define SEAM(k) do { if ((k) + 1 < hi) { if (MK_N_LAUNCHES == 1) { XcdBarrier bv_ = bar; asm volatile("" : "+s"(bv_.bar)); xcd_barrier(bv_); if (PROBE_BAR2) { XcdBarrier bw_ = bar; asm volatile("" : "+s"(bw_.bar)); xcd_barrier(bw_); } } } } while (0)
#define LAUNDER(Fv) Frame Fv = F0; asm volatile("" : "+s"(Fv.ws), "+s"(Fv.out), "+s"(Fv.G), "+s"(Fv.vcu), "+s"(Fv.wave), "+s"(cid))
#define GEMM_CALL1(EPI, g_, S_, E_) pg8::gemm_phase<EPI, pg8::TokOrder, GEMM_ALIGN, GEMM_SP2>(F.lds + RING_OFF, g_, S_, E_)
#ifdef PROBE_GEMM_STORE2
#define GEMM_CALL(EPI, g_, S_, E_) do { for (int rep_ = 0; rep_ < 2; ++rep_) { GEMM_CALL1(EPI, g_, S_, E_); __syncthreads(); } } while (0)
#else
#define GEMM_CALL(EPI, g_, S_, E_) GEMM_CALL1(EPI, g_, S_, E_)
#endif
#ifdef PROBE_GEMM_RESID2
#define GEMM_CALLR(g_, S_, E_) do { pg8::EpiResid E2_ = E_; for (int rep_ = 0; rep_ < 2; ++rep_) { E2_.dry = rep_; GEMM_CALL1(pg8::EpiResid, g_, S_, E2_); __syncthreads(); } } while (0)
#else
#define GEMM_CALLR(g_, S_, E_) GEMM_CALL1(pg8::EpiResid, g_, S_, E_)
#endif
    int cid = (int)blockIdx.x;

    if (SITE(0) && IN(0)) { LAUNDER(F); ph_prologue(F, args);
#ifdef PROBE_PRO2
        __syncthreads(); { LAUNDER(F2); ph_prologue(F2, args); }
#endif
        SEAM(0); }
    for (int L = 0; L < 4; ++L) {
        const int pb = 1 + 9 * L, j2 = L >> 1, even = !(L & 1), last = (L == 3);
        if (SITE(1) && IN(pb + 0)) { LAUNDER(F); ph_modulate(F, args, L, 0, 0, SPLITK && L >= 1, L == 0);
#ifdef PROBE_MOD2
            { LAUNDER(F2); ph_modulate(F2, args, L, 0, 0, 0, L == 0); }
#endif
            SEAM(pb + 0); }
        if (SITE(2) && IN(pb + 1)) { LAUNDER(F);
            const int N = even ? EIN : OIN;
            pg8::Gemm g{WSB(F, WS_XN), even ? WSB(F, WS_W_INE) + (size_t)j2 * EIN * DM : WSB(F, WS_W_INO) + (size_t)j2 * OIN * DM, MROWS, N, DM};
            pg8::TokOrder S; if (last) S.init2(MLAT, N, DM, F.G, cid, 1, 0, 1); else S.init2(MROWS, N, DM, F.G, cid, 0, 0);
            pg8::EpiStore E{WSB(F, WS_P), N, even ? 0 : 3, WSF(F, WS_ROPE_O)};
            GEMM_CALL(pg8::EpiStore, g, S, E);
            SEAM(pb + 1);
        }
        if (even) {
            if (SITE(3) && IN(pb + 2)) { LAUNDER(F); ph_qk_even(F, args, j2); SEAM(pb + 2); }
            if (IN(pb + 3)) {
                if (SITE(4)) { LAUNDER(F); pg8::Gemm g{WSB(F, WS_WTL), WSB(F, WS_FT), 4096, 4096, 2048}; pg8::TokOrder S; S.init2(4096, 4096, 2048, F.G, cid, 0, 0); pg8::EpiStore E{WSB(F, WS_Z), 1024, 1, nullptr}; GEMM_CALL(pg8::EpiStore, g, S, E); }
                if (SITE(14)) { LAUNDER(F); pg8::Gemm g{WSB(F, WS_WTC), WSB(F, WS_FTC), 512, 4096, 256}; pg8::TokOrder S; S.init2(512, 4096, 256, F.G, cid, 0, 0); pg8::EpiStore E{WSB(F, WS_Z), 1024, 2, nullptr}; GEMM_CALL(pg8::EpiStore, g, S, E); }
                if (SITE(5)) { LAUNDER(F); ph_attention(F, args, j2); }
#ifdef PROBE_ATT2
                { LAUNDER(F); ph_attention(F, args, j2); }
#endif
                SEAM(pb + 3);
            }
            if (SITE(6) && IN(pb + 4)) { LAUNDER(F);
                pg8::Gemm g{WSB(F, WS_Z), WSB(F, WS_CB), MROWS, 512, 1024}; pg8::TokOrder S; S.init2(MROWS, 512, 1024, F.G, cid, 0, 0); pg8::EpiStore E{WSB(F, WS_MIX), DM, 0, nullptr};
                GEMM_CALL(pg8::EpiStore, g, S, E);
                SEAM(pb + 4);
            }
        } else {
            if (SITE(8) && IN(pb + 3)) { LAUNDER(F); ph_retention(F, args, j2, last);
#ifdef PROBE_RET2
                { LAUNDER(F2); ph_retention(F2, args, j2, last); }
#endif
                SEAM(pb + 3); }
            if (SITE(9) && IN(pb + 4)) { LAUNDER(F); ph_comb(F, last);
#ifdef PROBE_COMB2
                { LAUNDER(F2); ph_comb(F2, last, 1); }
#endif
                SEAM(pb + 4); }
        }
        if (SITE(10) && IN(pb + 5)) { LAUNDER(F); const float* gates = WSF(F, WS_MOD) + (size_t)L * NSET * MODW;
            const int K = even ? DM : OMIX, Ml = last ? MLAT : MROWS;
            pg8::Gemm g{even ? WSB(F, WS_MIX) : WSB(F, WS_OF), even ? WSB(F, WS_W_OUTE) + (size_t)j2 * DM * DM : WSB(F, WS_W_OUTO) + (size_t)j2 * DM * OMIX, Ml, DM, K};
            pg8::TokOrder S; S.init2(Ml, DM, K, F.G, cid, last, SPLITK && L > 0, 0, last ? 0 : RESID_G);
            pg8::EpiResid E{WSB(F, WS_H), gates, 2 * DM, nullptr, WSF(F, WS_DELTA), 0, L == 0 ? (const float*)(const GAS float*)args.in[0] : nullptr, (const float*)(const GAS float*)args.in[2]};
            GEMM_CALLR(g, S, E);
#if LATE_CONV
            if (!last && cid >= S.rem && S.rem > 0) { const int cnt = conv_layer_count(L + 1), c0 = (cnt * LATE_F_FIN) / 100, c1 = c0 + (cnt * (even ? LATE_F_EVEN : LATE_F_ODD)) / 100;
                conv_in_tail(F, args, L + 1, c0, c1, cid - S.rem, F.G - S.rem); }
#endif
            SEAM(pb + 5);
        }
        if (SITE(11) && IN(pb + 6)) { LAUNDER(F); ph_modulate(F, args, L, 1, last, SPLITK && !last && L > 0, 0);
#ifdef PROBE_MOD2
            { LAUNDER(F2); ph_modulate(F2, args, L, 1, last, 0, 0); }
#endif
            SEAM(pb + 6); }
        if (SITE(12) && IN(pb + 7)) { LAUNDER(F);
            const int Ml = last ? MLAT : MROWS;
            pg8::Gemm g{WSB(F, WS_XN), WSB(F, WS_W_FIN) + (size_t)L * FFN2 * DM, Ml, FFN2, DM};
            pg8::TokOrder S; S.init2(Ml, FFN2, DM, F.G, cid, last, 0);
            pg8::EpiSwiglu E{WSB(F, WS_P), FFN};
            GEMM_CALL(pg8::EpiSwiglu, g, S, E);
#if LATE_CONV
            if (!last && LATE_F_FIN > 0 && cid >= S.rem && S.rem > 0) { const int cnt = conv_layer_count(L + 1), c0 = (cnt * LATE_F_FIN) / 100;
                conv_in_tail(F, args, L + 1, 0, c0, cid - S.rem, F.G - S.rem); }
#endif
            SEAM(pb + 7);
        }
        if (SITE(13) && IN(pb + 8)) { LAUNDER(F); const float* gates = WSF(F, WS_MOD) + (size_t)L * NSET * MODW;
            const int Ml = last ? MLAT : MROWS;
            pg8::Gemm g{WSB(F, WS_P), WSB(F, WS_W_FOUT) + (size_t)L * DM * FFN, Ml, DM, FFN};
            pg8::TokOrder S; S.init2(Ml, DM, FFN, F.G, cid, last, SPLITK, 0, last ? 0 : RESID_G);
            pg8::EpiResid E{WSB(F, WS_H), gates, 5 * DM, last ? (float*)F.out : nullptr, WSF(F, WS_DELTA), 0, nullptr, nullptr};
            GEMM_CALLR(g, S, E);
#if LATE_CONV
            if (!last && cid >= S.rem && S.rem > 0) { const int cnt = conv_layer_count(L + 1), c1 = (cnt * LATE_F_FIN) / 100 + (cnt * (even ? LATE_F_EVEN : LATE_F_ODD)) / 100;
                conv_in_tail(F, args, L + 1, c1, cnt, cid - S.rem, F.G - S.rem); }
#endif
            SEAM(pb + 8);
        }
    }
#undef IN
#undef SEAM
#undef LAUNDER
#undef GEMM_CALL
#if RETP_T
#ifndef RETP_MULT
#define RETP_MULT 4
#endif
    if (F0.vcu == 0 && threadIdx.x == 0) {
        const unsigned v_ = __hip_atomic_load(F0.ctl + 20000, __ATOMIC_RELAXED, __HIP_MEMORY_SCOPE_AGENT);
        const unsigned long s_ = __builtin_amdgcn_s_memrealtime();
        while (__builtin_amdgcn_s_memrealtime() - s_ < (unsigned long)v_ * RETP_MULT) __builtin_amdgcn_s_sleep(16);
    }
#endif
}

extern "C" void kernel_launch(void* const* d_in, const int* in_sizes, int n_in, void* d_out, int out_size, void* d_ws, size_t ws_size, hipStream_t stream) {
    static int grid = 0;
    if (grid == 0) {
        if (n_in != 16 || out_size != MLAT * DM || ws_size < WS_END) { fprintf(stderr, "kernel_launch: unexpected shapes: n_in %d out %d ws %zu (need %zu)\n", n_in, out_size, ws_size, (size_t)WS_END); grid = -1; return; }
        int dev = 0, cus = 0, per_cu = 0;
        if (hipGetDevice(&dev) != hipSuccess || hipDeviceGetAttribute(&cus, hipDeviceAttributeMultiprocessorCount, dev) != hipSuccess) { fprintf(stderr, "kernel_launch: device query failed\n"); grid = -1; return; }
        if (hipFuncSetAttribute((const void*)dit_fwd, hipFuncAttributeMaxDynamicSharedMemorySize, LDS_BYTES) != hipSuccess) { fprintf(stderr, "kernel_launch: hipFuncSetAttribute failed\n"); grid = -1; return; }
        if (hipOccupancyMaxActiveBlocksPerMultiprocessor(&per_cu, (const void*)dit_fwd, NWAVES * 64, LDS_BYTES) != hipSuccess || per_cu < 1)
            fprintf(stderr, "kernel_launch: note: occupancy query reports %d workgroups per CU\n", per_cu);
        (void)hipGetLastError();
        grid = cus;
    }
    if (grid < 0) return;
    if (hipMemsetAsync((char*)d_ws + WS_CTL, 0, CTL_ZERO_BYTES, stream) != hipSuccess) { fprintf(stderr, "kernel_launch: memset failed\n"); return; }
    Args a{};
    for (int i = 0; i < 16; ++i) a.in[i] = (const float*)d_in[i];
    a.out = (float*)d_out; a.ws = (unsigned char*)d_ws;
#if MK_N_LAUNCHES == 1
    a.ph_lo = 0; a.ph_hi = N_PHASES;
    hipLaunchKernelGGL(dit_fwd, dim3(grid), dim3(NWAVES * 64), LDS_BYTES, stream, a);
#else
    for (int p = 0; p < N_PHASES; ++p) { a.ph_lo = p; a.ph_hi = p + 1; hipLaunchKernelGGL(dit_fwd, dim3(grid), dim3(NWAVES * 64), LDS_BYTES, stream, a); }
#endif
    const hipError_t le = hipPeekAtLastError();
    if (le != hipSuccess) fprintf(stderr, "kernel_launch: launch failed: %s\n", hipGetErrorName(le));
}
```
